# Optimizing an MI355X kernel written in HIP

```python
import jax, jax.numpy as jnp
from jax import lax
import numpy as np

D_MODEL = 4096
BATCH = 4
SEQ = 4096
DEPTH = 1
DEC_BATCH = 32
DEC_SEQ = 16
PAST_LEN = 4096

CHUNK = 64
Q_BLOCK = 128
MIX_WIDTH = D_MODEL
MLA_HEADS = 16
QK_NOPE = 128
QK_ROPE = 64
V_DIM = 128
Q_LORA = 1024
KV_LORA = 512
MLA_WIDTH = MLA_HEADS * V_DIM
ATTN_SCALE = float((QK_NOPE + QK_ROPE) ** -0.5)
ROPE_THETA = 10000.0
HG_WIDTH = MIX_WIDTH - MLA_WIDTH
HG_HEAD_DIM = 128
HG_HEADS = HG_WIDTH // HG_HEAD_DIM
D_FF = 11008
CONV_W = 3
PLE_DIM = 256
EPS = 1e-6
IN_WIDTH = Q_LORA + KV_LORA + QK_ROPE + 4 * HG_WIDTH

kernel_name = "hybrid_mla_hgrn2_streaming_step"

F32 = jnp.float32


def rmsnorm(x, g):
    xf = x.astype(F32)
    y = xf * lax.rsqrt(jnp.mean(xf * xf, axis=-1, keepdims=True) + EPS)
    return (y * g.astype(F32)).astype(x.dtype)


def rope(x, pos):
    half = QK_ROPE // 2
    inv = 1.0 / (ROPE_THETA ** (jnp.arange(half, dtype=F32) / half))
    ang = pos.astype(F32)[:, None] * inv[None, :]
    cos = jnp.cos(ang)[None, :, None, :]
    sin = jnp.sin(ang)[None, :, None, :]
    xf = x.astype(F32)
    x1, x2 = xf[..., :half], xf[..., half:]
    return jnp.concatenate([x1 * cos - x2 * sin, x2 * cos + x1 * sin], axis=-1).astype(x.dtype)


def mixer_inputs(h, pos, lb, w_in, g_q_a, w_uq, g_kv_a, g_q_nope, g_q_rope, g_k_rope):
    B, T, _ = h.shape
    z = h @ w_in
    o1 = Q_LORA
    o2 = o1 + KV_LORA
    o3 = o2 + QK_ROPE
    cq, ckv, kr, zh = z[..., :o1], z[..., o1:o2], z[..., o2:o3], z[..., o3:]
    q = (rmsnorm(cq, g_q_a) @ w_uq).reshape(B, T, MLA_HEADS, QK_NOPE + QK_ROPE)
    q_nope = rmsnorm(q[..., :QK_NOPE], g_q_nope)
    q_rope = rope(rmsnorm(q[..., QK_NOPE:], g_q_rope), pos)
    ckv = rmsnorm(ckv, g_kv_a)
    kr = rope(rmsnorm(kr, g_k_rope)[:, :, None, :], pos)[:, :, 0, :]
    hq, hf, hi, hg = jnp.split(zh, 4, axis=-1)
    lbf = lb.astype(F32)
    hff = hf.astype(F32)
    log_f = jnp.log(lbf + (1.0 - lbf) * jax.nn.sigmoid(hff))
    k = (1.0 - lbf) * jax.nn.sigmoid(-hff)
    heads = lambda a: a.reshape(B, T, HG_HEADS, HG_HEAD_DIM)
    hgrn = (heads(hq.astype(F32)), heads(k), heads(hi.astype(F32)), heads(log_f))
    return (q_nope, q_rope, ckv, kr), hgrn, hg


def mla_keys(ckv, w_uk, g_k_nope):
    return rmsnorm(jnp.einsum('bkc,chd->bkhd', ckv, w_uk), g_k_nope)


def mla_scores(q_nope, q_rope, k_nope, k_rope):
    s = (jnp.einsum('bqhd,bkhd->bhqk', q_nope, k_nope).astype(F32)
         + jnp.einsum('bqhr,bkr->bhqk', q_rope, k_rope).astype(F32))
    return s * ATTN_SCALE


def mla_prompt(q_nope, q_rope, ckv, kr, w_uk, w_uv, g_k_nope):
    B, S = ckv.shape[0], ckv.shape[1]
    k_nope = mla_keys(ckv, w_uk, g_k_nope)
    v = jnp.einsum('bkc,chd->bkhd', ckv, w_uv)
    k_chunk = jnp.arange(S) // CHUNK

    def block(i):
        start = i * Q_BLOCK
        qn = lax.dynamic_slice_in_dim(q_nope, start, Q_BLOCK, axis=1)
        qr = lax.dynamic_slice_in_dim(q_rope, start, Q_BLOCK, axis=1)
        s = mla_scores(qn, qr, k_nope, kr)
        q_chunk = (start + jnp.arange(Q_BLOCK)) // CHUNK
        mask = k_chunk[None, :] <= q_chunk[:, None]
        p = jax.nn.softmax(jnp.where(mask[None, None], s, -jnp.inf), axis=-1).astype(v.dtype)
        return jnp.einsum('bhqk,bkhd->bqhd', p, v)

    o = lax.map(block, jnp.arange(S // Q_BLOCK))
    return jnp.moveaxis(o, 0, 1).reshape(B, S, MLA_WIDTH)


def mla_sample(q_nope, q_rope, ckv_all, kr_all, w_uk, w_uv, g_k_nope):
    B, T = q_nope.shape[0], q_nope.shape[1]
    k_nope = mla_keys(ckv_all, w_uk, g_k_nope)
    p = jax.nn.softmax(mla_scores(q_nope, q_rope, k_nope, kr_all), axis=-1).astype(ckv_all.dtype)
    o_lat = jnp.einsum('bhqk,bkc->bqhc', p, ckv_all)
    o = jnp.einsum('bqhc,chd->bqhd', o_lat, w_uv)
    return o.reshape(B, T, MLA_WIDTH)


def hgrn2_chunk(S, q, k, v, log_f):
    L = q.shape[1]
    b = jnp.cumsum(log_f, axis=1)
    inter = jnp.einsum('bthk,bhkv->bthv', q * jnp.exp(b), S)
    causal = jnp.tril(jnp.ones((L, L), dtype=bool))
    decay = jnp.where(causal[None, :, :, None, None], b[:, :, None] - b[:, None, :], -jnp.inf)
    qd = q[:, :, None] * jnp.exp(decay)
    A = jnp.einsum('btshk,bshk->bhts', qd, k)
    intra = jnp.einsum('bhts,bshv->bthv', A, v)
    b_last = b[:, -1]
    S_new = (jnp.exp(b_last)[..., None] * S
             + jnp.einsum('bshk,bshv->bhkv', k * jnp.exp(b_last[:, None] - b), v))
    return S_new, inter + intra


def hgrn2_prompt(q, k, v, log_f):
    B, S = q.shape[0], q.shape[1]
    n = S // CHUNK
    to_chunks = lambda a: jnp.moveaxis(a.reshape(B, n, CHUNK, *a.shape[2:]), 1, 0)
    S0 = jnp.zeros((B, HG_HEADS, HG_HEAD_DIM, HG_HEAD_DIM), F32)
    S_fin, o = lax.scan(lambda c, xs: hgrn2_chunk(c, *xs), S0,
                        (to_chunks(q), to_chunks(k), to_chunks(v), to_chunks(log_f)))
    return jnp.moveaxis(o, 0, 1).reshape(B, S, HG_HEADS, HG_HEAD_DIM), S_fin


def hgrn2_readout(o, hg, g_hg_out, dtype):
    B, T = o.shape[0], o.shape[1]
    gate = jax.nn.silu(hg.astype(F32)).reshape(B, T, HG_HEADS, HG_HEAD_DIM)
    return (rmsnorm(o, g_hg_out) * gate).reshape(B, T, HG_WIDTH).astype(dtype)


def conv_ffn_ple(x, hist, p, g_ffn_norm, w_up, conv_w, conv_b, w_down, g_ple_norm, w_ple_gate, w_ple):
    T = x.shape[1]
    u = rmsnorm(x, g_ffn_norm) @ w_up
    u_all = jnp.concatenate([hist.astype(u.dtype), u], axis=1)
    c = conv_b + sum(conv_w[j] * u_all[:, j:j + T] for j in range(CONV_W))
    c_gate, c_up = jnp.split(c, 2, axis=-1)
    x = x + (jax.nn.silu(c_gate) * c_up) @ w_down
    gate = jax.nn.sigmoid(rmsnorm(x, g_ple_norm) @ w_ple_gate)
    x = x + (p.astype(x.dtype) @ w_ple) * gate
    return x, u_all[:, -(CONV_W - 1):]


def setup_inputs(seed: int = 0) -> dict:
    key = jax.random.key(seed)
    ks = jax.random.split(key, 32)
    nrm = lambda k, shape, s: jax.random.normal(k, shape, F32) * s
    gain = lambda k, shape: 1.0 + 0.05 * jax.random.normal(k, shape, F32)
    return {
        "x_prompt": nrm(ks[0], (BATCH, SEQ, D_MODEL), 1.0),
        "x_sample": nrm(ks[1], (DEC_BATCH, DEC_SEQ, D_MODEL), 1.0),
        "cache_ckv": nrm(ks[2], (DEPTH, DEC_BATCH, PAST_LEN, KV_LORA), 1.0),
        "cache_k_rope": nrm(ks[3], (DEPTH, DEC_BATCH, PAST_LEN, QK_ROPE), 1.0),
        "state_hgrn": nrm(ks[4], (DEPTH, DEC_BATCH, HG_HEADS, HG_HEAD_DIM, HG_HEAD_DIM), 0.3),
        "state_ffn_conv": nrm(ks[5], (DEPTH, DEC_BATCH, CONV_W - 1, 2 * D_FF), 1.0),
        "p_prompt": nrm(ks[6], (DEPTH, BATCH, SEQ, PLE_DIM), 1.0),
        "p_sample": nrm(ks[7], (DEPTH, DEC_BATCH, DEC_SEQ, PLE_DIM), 1.0),
        "g_attn_norm": gain(ks[8], (DEPTH, D_MODEL)),
        "w_in": nrm(ks[9], (DEPTH, D_MODEL, IN_WIDTH), D_MODEL ** -0.5),
        "g_q_a": gain(ks[10], (DEPTH, Q_LORA)),
        "w_uq": nrm(ks[11], (DEPTH, Q_LORA, MLA_HEADS * (QK_NOPE + QK_ROPE)), Q_LORA ** -0.5),
        "g_kv_a": gain(ks[12], (DEPTH, KV_LORA)),
        "w_uk": nrm(ks[13], (DEPTH, KV_LORA, MLA_HEADS, QK_NOPE), KV_LORA ** -0.5),
        "w_uv": nrm(ks[14], (DEPTH, KV_LORA, MLA_HEADS, V_DIM), KV_LORA ** -0.5),
        "g_q_nope": gain(ks[15], (DEPTH, QK_NOPE)),
        "g_q_rope": gain(ks[16], (DEPTH, QK_ROPE)),
        "g_k_nope": gain(ks[17], (DEPTH, QK_NOPE)),
        "g_k_rope": gain(ks[18], (DEPTH, QK_ROPE)),
        "lb_logits": nrm(ks[19], (DEPTH + 1, HG_WIDTH), 0.5),
        "g_hg_out": gain(ks[20], (DEPTH, HG_HEAD_DIM)),
        "w_o": nrm(ks[21], (DEPTH, MIX_WIDTH, D_MODEL), MIX_WIDTH ** -0.5),
        "g_ffn_norm": gain(ks[22], (DEPTH, D_MODEL)),
        "w_up": nrm(ks[23], (DEPTH, D_MODEL, 2 * D_FF), D_MODEL ** -0.5),
        "conv_w": nrm(ks[24], (DEPTH, CONV_W, 2 * D_FF), CONV_W ** -0.5),
        "conv_b": nrm(ks[25], (DEPTH, 2 * D_FF), 0.01),
        "w_down": nrm(ks[26], (DEPTH, D_FF, D_MODEL), D_FF ** -0.5),
        "g_ple_norm": gain(ks[27], (DEPTH, D_MODEL)),
        "w_ple_gate": nrm(ks[28], (DEPTH, D_MODEL, D_MODEL), D_MODEL ** -0.5),
        "w_ple": nrm(ks[29], (DEPTH, PLE_DIM, D_MODEL), PLE_DIM ** -0.5),
    }


def reference(x_prompt, x_sample, cache_ckv, cache_k_rope, state_hgrn, state_ffn_conv, p_prompt, p_sample,
              g_attn_norm, w_in, g_q_a, w_uq, g_kv_a, w_uk, w_uv, g_q_nope, g_q_rope, g_k_nope, g_k_rope,
              lb_logits, g_hg_out, w_o, g_ffn_norm, w_up, conv_w, conv_b, w_down, g_ple_norm, w_ple_gate, w_ple):
    S = x_prompt.shape[1]
    T = x_sample.shape[1]
    pos_p = jnp.arange(S)
    pos_s = PAST_LEN + jnp.arange(T)
    lb_all = jnp.cumsum(jax.nn.softmax(lb_logits.astype(F32), axis=0), axis=0)
    xp, xs = x_prompt, x_sample
    ckv_p_l, kr_p_l, hg_p_l, cv_p_l = [], [], [], []
    ckv_s_l, kr_s_l, hg_s_l, cv_s_l = [], [], [], []
    for i in range(DEPTH):
        proj = (lb_all[i], w_in[i], g_q_a[i], w_uq[i], g_kv_a[i], g_q_nope[i], g_q_rope[i], g_k_rope[i])
        ffn = (g_ffn_norm[i], w_up[i], conv_w[i], conv_b[i], w_down[i], g_ple_norm[i], w_ple_gate[i], w_ple[i])
        (qn, qr, ckv, kr), (hq, hk, hv, hlf), hg = mixer_inputs(rmsnorm(xp, g_attn_norm[i]), pos_p, *proj)
        o_mla = mla_prompt(qn, qr, ckv, kr, w_uk[i], w_uv[i], g_k_nope[i])
        o_h, s_fin = hgrn2_prompt(hq, hk, hv, hlf)
        o_hg = hgrn2_readout(o_h, hg, g_hg_out[i], xp.dtype)
        xp = xp + jnp.concatenate([o_mla, o_hg], axis=-1) @ w_o[i]
        hist0 = jnp.zeros((xp.shape[0], CONV_W - 1, 2 * D_FF), xp.dtype)
        xp, cv_p = conv_ffn_ple(xp, hist0, p_prompt[i], *ffn)
        ckv_p_l.append(ckv)
        kr_p_l.append(kr)
        hg_p_l.append(s_fin.astype(x_prompt.dtype))
        cv_p_l.append(cv_p)
        (qn, qr, ckv, kr), (hq, hk, hv, hlf), hg = mixer_inputs(rmsnorm(xs, g_attn_norm[i]), pos_s, *proj)
        ckv_all = jnp.concatenate([cache_ckv[i].astype(ckv.dtype), ckv], axis=1)
        kr_all = jnp.concatenate([cache_k_rope[i].astype(kr.dtype), kr], axis=1)
        o_mla = mla_sample(qn, qr, ckv_all, kr_all, w_uk[i], w_uv[i], g_k_nope[i])
        s_new, o_h = hgrn2_chunk(state_hgrn[i].astype(F32), hq, hk, hv, hlf)
        o_hg = hgrn2_readout(o_h, hg, g_hg_out[i], xs.dtype)
        xs = xs + jnp.concatenate([o_mla, o_hg], axis=-1) @ w_o[i]
        xs, cv_s = conv_ffn_ple(xs, state_ffn_conv[i], p_sample[i], *ffn)
        ckv_s_l.append(ckv)
        kr_s_l.append(kr)
        hg_s_l.append(s_new.astype(state_hgrn.dtype))
        cv_s_l.append(cv_s)
    return (xp, xs,
            jnp.stack(ckv_p_l), jnp.stack(kr_p_l), jnp.stack(hg_p_l), jnp.stack(cv_p_l),
            jnp.stack(ckv_s_l), jnp.stack(kr_s_l), jnp.stack(hg_s_l), jnp.stack(cv_s_l))
```

```cpp
#include <hip/hip_runtime.h>
#include <cstdio>
#include <cstdint>
#include <cmath>

#define LAS __attribute__((address_space(3)))
#define GAS __attribute__((address_space(1)))
typedef unsigned short bf16_t;
typedef short bf16x8 __attribute__((ext_vector_type(8)));
typedef short s16x4 __attribute__((ext_vector_type(4)));
typedef float f32x2 __attribute__((ext_vector_type(2)));
typedef float f32x4 __attribute__((ext_vector_type(4)));
typedef float f32x16 __attribute__((ext_vector_type(16)));
typedef unsigned u32x2 __attribute__((ext_vector_type(2)));
typedef unsigned u32x4 __attribute__((ext_vector_type(4)));
typedef __bf16 bf16x2_t __attribute__((ext_vector_type(2)));
typedef GAS unsigned gu32;
#define RLX_AGENT __ATOMIC_RELAXED, __HIP_MEMORY_SCOPE_AGENT
#define DI __device__ __forceinline__

DI unsigned cvtpk(float lo, float hi) { f32x2 v = {lo, hi}; bf16x2_t b = __builtin_convertvector(v, bf16x2_t); return __builtin_bit_cast(unsigned, b); }
DI float bf_lo(unsigned w) { return __uint_as_float(w << 16); }
DI float bf_hi(unsigned w) { return __uint_as_float(w & 0xffff0000u); }
DI float bf2f(bf16_t b) { return __uint_as_float(((unsigned)b) << 16); }
DI bf16_t f2bf(float f) { return (bf16_t)(cvtpk(f, 0.f) & 0xffffu); }
DI u32x4 pack8(f32x4 a, f32x4 b) { u32x4 w; w.x = cvtpk(a[0], a[1]); w.y = cvtpk(a[2], a[3]); w.z = cvtpk(b[0], b[1]); w.w = cvtpk(b[2], b[3]); return w; }
DI float wave_sum(float v) {
#pragma unroll
    for (int o = 1; o < 64; o <<= 1) v += __shfl_xor(v, o);
    return v;
}
DI int lane_id() { int l; asm volatile("v_mbcnt_lo_u32_b32 %0, -1, 0\n\tv_mbcnt_hi_u32_b32 %0, -1, %0" : "=v"(l)); return l; }
DI float sigmoidf_(float x) { return 1.0f / (1.0f + __expf(-x)); }

constexpr int D = 4096, NB = 4, SEQ = 4096, MP = NB * SEQ, SB = 32, ST = 16, MS = SB * ST, M = MP + MS;
constexpr int PAST = 4096, NKEY = PAST + ST  , KPAD = 4352  , KT = 4224  ;
constexpr int QL = 1024, KVL = 512, ROPE = 64, NOPE = 128, NH = 16, QH = NOPE + ROPE  , KC = KVL + ROPE  ;
constexpr int HGW = 2048, HGH = 16, HGD = 128;
constexpr int FF = 11008, FF2 = 22016, PLE = 256;
constexpr int NIN = 9984;
constexpr float EPS = 1e-6f;
constexpr float ATT_SCALE = 0.07216878364870322f;

constexpr size_t O_Y = 0, O_CKVP = (size_t)M * D, O_KRP = O_CKVP + (size_t)MP * KVL, O_HGP = O_KRP + (size_t)MP * ROPE, O_CVP = O_HGP + (size_t)NB * HGH * HGD * HGD,
                 O_CKVS = O_CVP + (size_t)NB * 2 * FF2, O_KRS = O_CKVS + (size_t)MS * KVL, O_HGS = O_KRS + (size_t)MS * ROPE, O_CVS = O_HGS + (size_t)SB * HGH * HGD * HGD, O_END = O_CVS + (size_t)SB * 2 * FF2;
static_assert(O_END == 89960448, "output size");

constexpr size_t MiB = (size_t)1 << 20;
constexpr size_t WS_CTL = 0, CTL_BYTES = 2 * MiB;
constexpr int CW_TMO = 0, CW_BAR = 4096, CW_QUEUE = 16384  ;
constexpr size_t OFF_SSQ1 = 256 * 1024, OFF_SSQQ = 384 * 1024, OFF_SSQ2 = 512 * 1024, OFF_SSQ3 = 640 * 1024, OFF_LB = 768 * 1024;
constexpr size_t WS_WINT = 2 * MiB, WS_XB = 80 * MiB, WS_MIX = 2 * MiB, WS_S = 134 * MiB, WS_P = 270 * MiB, WS_CKVT = 336 * MiB, WS_KCAT = 468 * MiB, WS_OLAT = 621 * MiB, WS_SSK = 637 * MiB,
                 WS_QCAT = 646 * MiB, WS_WUKVT = 655 * MiB, WS_WUKN = 659 * MiB, WS_WUQT = 661 * MiB, WS_ROPE = 667 * MiB, WS_CKVN = 669 * MiB, WS_KRN = 686 * MiB,
                 WS_HQ = 712 * MiB, WS_HK = 778 * MiB, WS_HV = 844 * MiB, WS_HG = 910 * MiB, WS_LF = 976 * MiB, WS_Q = 1108 * MiB, WS_KN = 1207 * MiB, WS_V = 1271 * MiB,
                 WS_CQ = 1335 * MiB, WS_CKVRAW = 1368 * MiB, WS_KRRAW = 1401 * MiB, WS_EARLY_END = 1406 * MiB;
constexpr size_t WS_U = 2 * MiB, WS_ACT = 712 * MiB, WS_WUPT = 712 * MiB, WS_WOT = 884 * MiB, WS_WDT = 1067 * MiB, WS_WGT = 1153 * MiB, WS_X1B = 1185 * MiB, WS_WPT = 1317 * MiB, WS_PB = 1319 * MiB, WS_PW = 2 * MiB;
constexpr size_t WS_NEED = 1406 * MiB;
static_assert(WS_WINT + (size_t)NIN * D * 2 <= WS_XB && WS_XB + (size_t)M * D * 2 <= WS_CKVT, "early A region");
static_assert(WS_MIX + (size_t)M * D * 2 <= WS_S && WS_S + (size_t)SB * 256 * KPAD * 4 <= WS_P && WS_P + (size_t)SB * 256 * KT * 2 <= WS_CKVT, "mix/S/P");
static_assert(WS_CKVT + (size_t)SB * KVL * KT * 2 <= WS_KCAT && WS_KCAT + (size_t)SB * KPAD * KC * 2 <= WS_OLAT && WS_OLAT + (size_t)SB * 256 * KVL * 4 <= WS_SSK && WS_SSK + (size_t)SB * KPAD * 16 * 4 <= WS_QCAT, "ckvT/Kcat/OLAT/SSK");
static_assert(WS_QCAT + (size_t)SB * 256 * KC * 2 <= WS_WUKVT && WS_WUKVT + (size_t)4096 * 512 * 2 <= WS_WUKN && WS_WUKN + (size_t)512 * 2048 * 2 <= WS_WUQT && WS_WUQT + (size_t)3072 * 1024 * 2 <= WS_ROPE, "small early");
static_assert(WS_ROPE + (size_t)NKEY * 64 * 4 <= WS_CKVN && WS_CKVN + (size_t)M * KVL * 2 <= WS_KRN && WS_KRN + (size_t)M * ROPE * 2 <= WS_HQ, "rope/ckvn/krn");
static_assert(WS_HQ + (size_t)M * HGW * 2 <= WS_HK && WS_HG + (size_t)M * HGW * 2 <= WS_LF && WS_LF + (size_t)M * HGW * 4 <= WS_Q && WS_Q + (size_t)M * 3072 * 2 <= WS_KN && WS_KN + (size_t)MP * 2048 * 2 <= WS_V && WS_V + (size_t)MP * 2048 * 2 <= WS_CQ, "hgrn/q/k/v");
static_assert(WS_CQ + (size_t)M * QL * 2 <= WS_CKVRAW && WS_CKVRAW + (size_t)M * KVL * 4 <= WS_KRRAW && WS_KRRAW + (size_t)M * ROPE * 4 <= WS_EARLY_END, "cq/raw");
static_assert(WS_U + (size_t)M * FF2 * 2 <= WS_ACT && WS_ACT + (size_t)M * FF * 2 <= WS_WDT && WS_WUPT + (size_t)FF2 * D * 2 <= WS_WOT && WS_WOT + (size_t)D * D * 2 <= WS_WDT, "late 1");
static_assert(WS_WDT + (size_t)D * FF * 2 <= WS_WGT && WS_WGT + (size_t)D * D * 2 <= WS_X1B && WS_X1B + (size_t)M * D * 2 <= WS_WPT && WS_WPT + (size_t)D * PLE * 2 <= WS_PB && WS_PB + (size_t)M * PLE * 2 <= WS_NEED, "late 2");

constexpr int RING_BYTES = 131072;
constexpr int XCH_OFF = RING_BYTES, XCH_BYTES = 12288;
constexpr int MISC_OFF = XCH_OFF + XCH_BYTES;
constexpr int LDS_BYTES = 147456;
static_assert(MISC_OFF + 128 <= LDS_BYTES, "LDS map");
#define N_LAUNCH_SPLIT 0

namespace pg8 {
constexpr int BM = 256, BK = 64, HALF = 128, HTB = HALF * BK * 2  , STAGE_BYTES = 8 * HTB, NXCD = 8, WGM = 8;
static_assert(STAGE_BYTES == RING_BYTES, "stage region");
__host__ __device__ __forceinline__ int lds_byte(int r, int c) { const int st = (r >> 4) * 2 + (c >> 5), rr = r & 15, cc = c & 31, ob = rr * 64 + cc * 2; return st * 1024 + (ob ^ (((ob >> 9) & 1) << 5)); }
__host__ __device__ __forceinline__ void stage_rc(int b, int& R, int& C) { const int st = b / 1024, sb = b % 1024, swz = sb ^ (((sb >> 9) & 1) << 5); R = (st >> 1) * 16 + swz / 64; C = (st & 1) * 32 + (swz % 64) / 2; }
__host__ __device__ __forceinline__ int perm32(int rho) { const int n = rho >> 4, i = rho & 15; return 8 * (i >> 2) + 4 * n + (i & 3); }

struct Unit { int pm, pn; };
struct Gemm { const bf16_t* A; const bf16_t* Bt; int lda, ldb, K; };

struct StaticOrder {
    int nM, nN, nwg, G, c;
    __host__ __device__ void init(int nM_, int nN_, int G_, int c_) { nM = nM_; nN = nN_; nwg = nM * nN; G = G_; c = c_; }
    __host__ __device__ bool next(int i, Unit& u) const {
        const long L = (long)i * G + c; if (L >= nwg) return false;
        int wgid = (int)L; { const int q = nwg / NXCD, r = nwg % NXCD, xcd = wgid % NXCD, off = wgid / NXCD; wgid = (xcd < r ? xcd * (q + 1) : r * (q + 1) + (xcd - r) * q) + off; }
        const int nig = WGM * nN, gid = wgid / nig, fm = gid * WGM, gsz = (nM - fm) < WGM ? (nM - fm) : WGM;
        u.pm = fm + ((wgid % nig) % gsz); u.pn = (wgid % nig) / gsz; return true;
    }
};
struct MappedOrder : StaticOrder {
    int per, stride, off;
    __host__ __device__ bool next(int i, Unit& u) const { if (!StaticOrder::next(i, u)) return false; u.pm = (u.pm / per) * stride + off + (u.pm % per); return true; }
};

template <class Epi, class Sched>
__device__ __forceinline__ void gemm_phase(LAS unsigned char* lds, const Gemm g, const Sched& S, const Epi& E, int wid) {
    const int lane = lane_id(), tid = wid * 64 + lane, wr = wid >> 2, wc = wid & 3, fr = lane & 15, fq = lane >> 4;
    const int K = g.K, nt = K / BK;
    unsigned voffA[2], voffB[2];
#pragma unroll
    for (int i = 0; i < 2; ++i) { int R, C; stage_rc(tid * 16 + i * 8192, R, C); const int Rb = (R & ~31) + perm32(R & 31);
        voffA[i] = (unsigned)(R * g.lda + C) * 2u; voffB[i] = (unsigned)(Rb * g.ldb + C) * 2u; }
    const size_t kstep = (size_t)(BK * 2);
    const size_t hstepA = (size_t)HALF * g.lda * 2, hstepB = (size_t)HALF * g.ldb * 2;
    const size_t tstepA = 2 * hstepA, tstepB = 2 * hstepB;
    const unsigned ldsw = (unsigned)wid * 1024u;
    const int aoff = lds_byte(wr * 64 + fr, fq * 8), boff = lds_byte(wc * 32 + fr, fq * 8);
#define PG8_SA(b, h) (((b) * 2 + (h)) * HTB)
#define PG8_SB(b, h) ((4 + (b) * 2 + (h)) * HTB)
#define PG8_STAGE(bufoff, gbase, voff) do { _Pragma("unroll") for (int _i = 0; _i < 2; ++_i) \
        __builtin_amdgcn_global_load_lds((const unsigned*)((const char*)(gbase) + (voff)[_i]), (LAS unsigned*)(lds + (bufoff) + ldsw + _i * 8192), 16, 0, 0); } while (0)
#define PG8_LDA(dst, b, h) do { _Pragma("unroll") for (int m = 0; m < 4; ++m) _Pragma("unroll") for (int k = 0; k < 2; ++k) dst[m][k] = *(const LAS bf16x8*)(lds + PG8_SA(b, h) + aoff + m * 2048 + k * 1024); } while (0)
#define PG8_LDB(dst, b, h) do { _Pragma("unroll") for (int n = 0; n < 2; ++n) _Pragma("unroll") for (int k = 0; k < 2; ++k) dst[n][k] = *(const LAS bf16x8*)(lds + PG8_SB(b, h) + boff + n * 2048 + k * 1024); } while (0)
#define PG8_MMA(ai, bj, At, Bt) do { __builtin_amdgcn_s_setprio(1); _Pragma("unroll") for (int m = 0; m < 4; ++m) _Pragma("unroll") for (int n = 0; n < 2; ++n) _Pragma("unroll") for (int k = 0; k < 2; ++k) \
        acc[ai][bj][m][n] = __builtin_amdgcn_mfma_f32_16x16x32_bf16(Bt[n][k], At[m][k], acc[ai][bj][m][n], 0, 0, 0); __builtin_amdgcn_s_setprio(0); } while (0)
#define PG8_WAIT_V(n) asm volatile("s_waitcnt vmcnt(" #n ")" ::: "memory")
#define PG8_WAIT_L(n) asm volatile("s_waitcnt lgkmcnt(" #n ")" ::: "memory")
#define PG8_BAR __builtin_amdgcn_s_barrier()
#define PG8_SCHED __builtin_amdgcn_sched_barrier(0)
    Unit cur, nxt; int ui = 0;
    if (!S.next(0, cur)) return;
    f32x4 acc[2][2][4][2];
#pragma unroll
    for (int a = 0; a < 2; ++a)
#pragma unroll
        for (int b = 0; b < 2; ++b)
#pragma unroll
            for (int m = 0; m < 4; ++m)
#pragma unroll
                for (int n = 0; n < 2; ++n) acc[a][b][m][n] = (f32x4){0.f, 0.f, 0.f, 0.f};
    bf16x8 At[4][2], B0[2][2], B1[2][2];
    const char* cA = (const char*)g.A + (size_t)cur.pm * tstepA; const char* cB = (const char*)g.Bt + (size_t)cur.pn * tstepB;
    PG8_STAGE(PG8_SB(0, 0), cB, voffB); PG8_STAGE(PG8_SB(0, 1), cB + hstepB, voffB); PG8_STAGE(PG8_SA(0, 0), cA, voffA); PG8_STAGE(PG8_SA(0, 1), cA + hstepA, voffA);
    if (wr == 1) PG8_BAR;
    PG8_WAIT_V(2); PG8_BAR;
    PG8_STAGE(PG8_SB(1, 0), cB + kstep, voffB); PG8_STAGE(PG8_SA(1, 0), cA + kstep, voffA); PG8_STAGE(PG8_SB(1, 1), cB + hstepB + kstep, voffB);
    PG8_WAIT_V(6); PG8_BAR;
    for (;;) {
        const bool has_next = S.next(ui + 1, nxt);
        const char* nA = has_next ? (const char*)g.A + (size_t)nxt.pm * tstepA : cA; const char* nB = has_next ? (const char*)g.Bt + (size_t)nxt.pn * tstepB : cB;
        for (int t = 0; t < nt; t += 2) {
            const bool last = (t == nt - 2);
            const char* a1 = cA + (size_t)(t + 1) * kstep;
            const char* a2 = last ? nA : cA + (size_t)(t + 2) * kstep; const char* b2 = last ? nB : cB + (size_t)(t + 2) * kstep;
            const char* a3 = a2 + kstep; const char* b3 = b2 + kstep;
            PG8_LDB(B0, 0, 0); PG8_LDB(B1, 0, 1); PG8_SCHED; PG8_LDA(At, 0, 0); PG8_STAGE(PG8_SA(1, 1), a1 + hstepA, voffA);
            PG8_WAIT_V(8); PG8_WAIT_L(0); PG8_BAR; PG8_MMA(0, 0, At, B0); PG8_MMA(0, 1, At, B1); PG8_BAR; PG8_SCHED;
            PG8_LDA(At, 0, 1); PG8_STAGE(PG8_SB(0, 0), b2, voffB); PG8_STAGE(PG8_SB(0, 1), b2 + hstepB, voffB); PG8_STAGE(PG8_SA(0, 0), a2, voffA);
            PG8_WAIT_V(8); PG8_WAIT_L(0); PG8_BAR; PG8_MMA(1, 0, At, B0); PG8_MMA(1, 1, At, B1); PG8_BAR; PG8_SCHED;
            PG8_LDB(B0, 1, 0); PG8_LDB(B1, 1, 1); PG8_SCHED; PG8_LDA(At, 1, 0); PG8_STAGE(PG8_SA(0, 1), a2 + hstepA, voffA);
            PG8_WAIT_V(8); PG8_WAIT_L(0); PG8_BAR; PG8_MMA(0, 0, At, B0); PG8_MMA(0, 1, At, B1); PG8_BAR; PG8_SCHED;
            PG8_LDA(At, 1, 1); PG8_STAGE(PG8_SB(1, 0), b3, voffB); PG8_STAGE(PG8_SB(1, 1), b3 + hstepB, voffB); PG8_STAGE(PG8_SA(1, 0), a3, voffA);
            PG8_WAIT_V(8); PG8_WAIT_L(0); PG8_BAR; PG8_MMA(1, 0, At, B0); PG8_MMA(1, 1, At, B1); PG8_BAR; PG8_SCHED;
        }
        if (wr == 0) PG8_BAR;
        E(acc, cur, wr, wc, fr, fq, lane);
        if (!has_next) break;
#pragma unroll
        for (int a = 0; a < 2; ++a)
#pragma unroll
            for (int b = 0; b < 2; ++b)
#pragma unroll
                for (int m = 0; m < 4; ++m)
#pragma unroll
                    for (int n = 0; n < 2; ++n) acc[a][b][m][n] = (f32x4){0.f, 0.f, 0.f, 0.f};
        cur = nxt; cA = nA; cB = nB; ++ui;
        if (wr == 1) PG8_BAR;
    }
    PG8_WAIT_V(0);
    PG8_BAR;
#undef PG8_SA
#undef PG8_SB
#undef PG8_STAGE
#undef PG8_LDA
#undef PG8_LDB
#undef PG8_MMA
#undef PG8_WAIT_V
#undef PG8_WAIT_L
#undef PG8_BAR
#undef PG8_SCHED
}
}

#define XB_TMO      128
#define XB_XCNT(j)  (256  + 64 * (j))
#define XB_XSUB(j)  (1280 + 64 * (j))
#define XB_XGEN(j)  (2304 + 64 * (j))
#define XB_TOP      3328
#define XB_TOPGEN   3392
#define XCD_BAR_WORDS 3456
#define XB_SPIN_CAP (1u << 22)

__device__ __forceinline__ unsigned xb_ld(unsigned* p)              { return __hip_atomic_load(p, __ATOMIC_RELAXED, __HIP_MEMORY_SCOPE_AGENT); }
__device__ __forceinline__ unsigned xb_add(unsigned* p, unsigned v) { return __hip_atomic_fetch_add(p, v, __ATOMIC_RELAXED, __HIP_MEMORY_SCOPE_AGENT); }
__device__ __forceinline__ unsigned xb_xcc_id() { return (unsigned)__builtin_amdgcn_s_getreg((3 << 11) | 20) & 0xFu; }
#define XB_SPIN(cond, bar) do { unsigned _sp = 0; while (cond) { __builtin_amdgcn_s_sleep(1); \
    if ((++_sp & 255u) == 0u) { if (xb_ld(&(bar)[XB_TMO])) break; if (_sp > XB_SPIN_CAP) { atomicAdd(&(bar)[XB_TMO], 1u); break; } } } } while (0)

struct XcdBarrier {
    unsigned* bar; unsigned x;
    volatile LAS unsigned* st;
};
__device__ __forceinline__ XcdBarrier xcd_barrier_post(unsigned* bar, volatile LAS unsigned* st, bool leader) {
    XcdBarrier b; b.bar = bar; b.x = xb_xcc_id(); b.st = st;
    if (leader) (void)xb_add(&bar[XB_XCNT(b.x)], 1u);
    return b;
}
__device__ __forceinline__ void xcd_barrier_complete(unsigned* bar, unsigned x, unsigned& nloc, unsigned& nx) {
    const unsigned G = gridDim.x * gridDim.y * gridDim.z;
    unsigned sum, cnt, mine, sp = 0u;
    for (;;) {
        sum = 0u; cnt = 0u; mine = 0u;
#pragma unroll
        for (unsigned j = 0; j < 16; ++j) { const unsigned c = xb_ld(&bar[XB_XCNT(j)]); sum += c; cnt += (c > 0u) ? 1u : 0u; mine = (j == x) ? c : mine; }
        if (sum == G) break;
        __builtin_amdgcn_s_sleep(1);
        if ((++sp & 255u) == 0u) { if (xb_ld(&bar[XB_TMO])) break; if (sp > XB_SPIN_CAP) { atomicAdd(&bar[XB_TMO], 1u); break; } }
    }
    nloc = mine > 0u ? mine : 1u; nx = cnt > 0u ? cnt : 1u;
}
__device__ __forceinline__ void xcd_barrier(const XcdBarrier& b, bool leader) {
    asm volatile("s_waitcnt vmcnt(0)" ::: "memory");
    __syncthreads();
    if (leader) {
        unsigned* bar = b.bar;
        __builtin_amdgcn_s_waitcnt(0);
        unsigned nloc = b.st[0], nx = b.st[1];
        if (nloc == 0u) { xcd_barrier_complete(bar, b.x, nloc, nx); b.st[0] = nloc; b.st[1] = nx; }
        const unsigned old = xb_add(&bar[XB_XSUB(b.x)], 1u);
        const unsigned gen = old / nloc;
        if (old + 1u == (gen + 1u) * nloc) {
            __builtin_amdgcn_fence(__ATOMIC_RELEASE, "agent");
            asm volatile("s_waitcnt vmcnt(0)" ::: "memory");
            const unsigned og = xb_add(&bar[XB_TOP], 1u);
            const unsigned tg = og / nx;
            if (og + 1u == (tg + 1u) * nx) xb_add(&bar[XB_TOPGEN], 1u);
            else XB_SPIN(xb_ld(&bar[XB_TOPGEN]) == tg, bar);
            __builtin_amdgcn_fence(__ATOMIC_ACQUIRE, "agent");
            xb_add(&bar[XB_XGEN(b.x)], 1u);
            asm volatile("s_waitcnt vmcnt(0)" ::: "memory");
        } else {
            XB_SPIN(xb_ld(&bar[XB_XGEN(b.x)]) == gen, bar);
            __builtin_amdgcn_fence(__ATOMIC_ACQUIRE, "agent");
            asm volatile("s_waitcnt vmcnt(0)" ::: "memory");
        }
    }
    __syncthreads();
}

struct Args { const float* in[30]; float* out; unsigned char* ws; float inv[32]; int ph_lo, ph_hi; };
enum { I_XP = 0, I_XS, I_CCKV, I_CKR, I_SHG, I_SCV, I_PP, I_PS, I_GATT, I_WIN, I_GQA, I_WUQ, I_GKVA, I_WUK, I_WUV, I_GQN, I_GQR, I_GKN, I_GKR, I_LB, I_GHG, I_WO, I_GFFN, I_WUP, I_CW, I_CB, I_WD, I_GPLE, I_WPG, I_WPLE };
struct Frame { LAS unsigned char* lds; int wave, vcu, G, gw, NGW; };
#define LDS_WAIT() asm volatile("s_waitcnt lgkmcnt(0)" ::: "memory")
#define VM_WAIT() asm volatile("s_waitcnt vmcnt(0)" ::: "memory")

DI void tr_item(const float* __restrict__ W, size_t ldw, bf16_t* __restrict__ WT, size_t ldt, const float* __restrict__ gain, int k0, int n0, int dst_row0, LAS float* scr, int lane, bf16_t* NAT, size_t ldn) {
#pragma unroll 8
    for (int i = 0; i < 32; ++i) { const int kk = 2 * i + (lane >> 5); scr[kk * 33 + (lane & 31)] = W[(size_t)(k0 + kk) * ldw + n0 + (lane & 31)]; }
    LDS_WAIT(); asm volatile("" ::: "memory");
    const int c = lane & 7;
    float gv[8];
#pragma unroll
    for (int j = 0; j < 8; ++j) gv[j] = gain ? gain[k0 + 8 * c + j] : 1.0f;
#pragma unroll
    for (int j = 0; j < 4; ++j) { const int n = (lane >> 3) + 8 * j; const LAS float* s = scr + (8 * c) * 33 + n;
        u32x4 o; o.x = cvtpk(s[0 * 33] * gv[0], s[1 * 33] * gv[1]); o.y = cvtpk(s[2 * 33] * gv[2], s[3 * 33] * gv[3]); o.z = cvtpk(s[4 * 33] * gv[4], s[5 * 33] * gv[5]); o.w = cvtpk(s[6 * 33] * gv[6], s[7 * 33] * gv[7]);
        *(u32x4*)(WT + (size_t)(dst_row0 + n) * ldt + k0 + 8 * c) = o; }
    if (NAT) {
#pragma unroll
        for (int j = 0; j < 4; ++j) { const int r = (lane >> 2) + 16 * j, ch = lane & 3; const LAS float* s = scr + r * 33 + ch * 8;
            u32x4 o; o.x = cvtpk(s[0], s[1]); o.y = cvtpk(s[2], s[3]); o.z = cvtpk(s[4], s[5]); o.w = cvtpk(s[6], s[7]);
            *(u32x4*)(NAT + (size_t)(k0 + r) * ldn + n0 + ch * 8) = o; }
    }
    LDS_WAIT(); asm volatile("" ::: "memory");
}
DI bool tr_matrix(int& r, const float* W, int K, int N, bf16_t* WT, size_t ldt, const float* gain, LAS float* scr, int lane, int split_n = 1 << 30, int pad = 0) {
    const int nblk = N / 32, nitems = (K / 64) * nblk;
    if (r >= nitems) { r -= nitems; return false; }
    const int kb = r / nblk, nb = r % nblk, n0 = 32 * nb;
    tr_item(W, (size_t)N, WT, ldt, gain, 64 * kb, n0, n0 < split_n ? n0 : n0 + pad, scr, lane, nullptr, 0);
    return true;
}
DI void zero16(void* p, size_t bytes, int gw, int NGW, int lane) {
    const size_t n = bytes / 1024;
    for (size_t i = gw; i < n; i += NGW) *(u32x4*)((char*)p + i * 1024 + lane * 16) = (u32x4){0u, 0u, 0u, 0u};
}

DI void p0_prologue(const Frame& F, const Args& a) {
    unsigned char* ws = a.ws;
    LAS float* scr = (LAS float*)(F.lds + F.wave * 16384);
    const int lane = lane_id();
    {
        constexpr int I_IN = (D / 64) * (9792 / 32), I_UQ = (QL / 64) * (3072 / 32), I_UK = (KVL / 64) * (2048 / 32), I_CACHE = SB * (PAST / 64) * (KVL / 32);
        constexpr int NIT = I_IN + I_UQ + 2 * I_UK + I_CACHE;
        for (int it = F.gw; it < NIT; it += F.NGW) {
            int r = it;
            if (tr_matrix(r, a.in[I_WIN], D, 9792, (bf16_t*)(ws + WS_WINT), D, a.in[I_GATT], scr, lane, 1600, 192)) continue;
            if (tr_matrix(r, a.in[I_WUQ], QL, 3072, (bf16_t*)(ws + WS_WUQT), QL, a.in[I_GQA], scr, lane)) continue;
            if (tr_matrix(r, a.in[I_WUK], KVL, 2048, (bf16_t*)(ws + WS_WUKVT), KVL, nullptr, scr, lane)) continue;
            if (tr_matrix(r, a.in[I_WUV], KVL, 2048, (bf16_t*)(ws + WS_WUKVT) + (size_t)2048 * KVL, KVL, nullptr, scr, lane)) continue;
            { const int b = r / ((PAST / 64) * (KVL / 32)), rr = r % ((PAST / 64) * (KVL / 32)), kb = rr / (KVL / 32), nb = rr % (KVL / 32);
              tr_item(a.in[I_CCKV] + (size_t)b * PAST * KVL, KVL, (bf16_t*)(ws + WS_CKVT) + (size_t)b * KVL * KT, KT, nullptr, 64 * kb, 32 * nb, 32 * nb, scr, lane,
                      (bf16_t*)(ws + WS_KCAT) + (size_t)b * KPAD * KC, KC); }
        }
    }
    for (int row = F.gw; row < M; row += F.NGW) {
        const float* src = row < MP ? a.in[I_XP] + (size_t)row * D : a.in[I_XS] + (size_t)(row - MP) * D;
        bf16_t* dst = (bf16_t*)(ws + WS_XB) + (size_t)row * D;
        float ss = 0.f;
#pragma unroll 4
        for (int j = 0; j < 16; ++j) { const f32x4 v = *(const f32x4*)(src + j * 256 + lane * 4); ss += v[0] * v[0] + v[1] * v[1] + v[2] * v[2] + v[3] * v[3];
            u32x2 o; o.x = cvtpk(v[0], v[1]); o.y = cvtpk(v[2], v[3]); *(u32x2*)(dst + j * 256 + lane * 4) = o; }
        ss = wave_sum(ss);
        if (lane == 0) ((float*)(ws + OFF_SSQ1))[row] = ss;
    }
    for (int it = F.gw; it < SB * PAST / 8; it += F.NGW) {
        const int kg = it * 8 + (lane >> 3), b = kg / PAST, key = kg % PAST, ch = lane & 7;
        const float* s = a.in[I_CKR] + (size_t)kg * ROPE + ch * 8;
        const f32x4 v0 = *(const f32x4*)s, v1 = *(const f32x4*)(s + 4);
        *(u32x4*)((bf16_t*)(ws + WS_KCAT) + ((size_t)b * KPAD + key) * KC + KVL + ch * 8) = pack8(v0, v1);
    }
    for (int it = F.gw; it < 512 * 2048 / 512; it += F.NGW) {
        const size_t e = (size_t)it * 512 + lane * 8; const int d = (int)(e & 127);
        const f32x4 v0 = *(const f32x4*)(a.in[I_WUK] + e), v1 = *(const f32x4*)(a.in[I_WUK] + e + 4);
        const f32x4 g0 = *(const f32x4*)(a.in[I_GKN] + d), g1 = *(const f32x4*)(a.in[I_GKN] + d + 4);
        *(u32x4*)((bf16_t*)(ws + WS_WUKN) + e) = pack8(v0 * g0, v1 * g1);
    }
    for (int it = F.gw; it < NKEY * 32 / 64; it += F.NGW) {
        const int e = it * 64 + lane, pos = e >> 5, i = e & 31;
        const float ang = (float)pos * a.inv[i];
        const double rev = (double)ang * 0.15915494309189535; const float fr = (float)(rev - __builtin_rint(rev));
        ((float*)(ws + WS_ROPE))[e] = __builtin_amdgcn_cosf(fr);
        ((float*)(ws + WS_ROPE))[NKEY * 32 + e] = __builtin_amdgcn_sinf(fr);
    }
    for (int it = F.gw; it < HGW / 64; it += F.NGW) { const int j = it * 64 + lane; const float l0 = a.in[I_LB][j], l1 = a.in[I_LB][HGW + j]; ((float*)(ws + OFF_LB))[j] = 1.0f / (1.0f + __expf(l1 - l0)); }
    zero16((bf16_t*)(ws + WS_WINT) + (size_t)1600 * D, (size_t)192 * D * 2, F.gw, F.NGW, lane);
    for (int b = 0; b < SB; ++b) zero16((bf16_t*)(ws + WS_KCAT) + ((size_t)b * KPAD + PAST) * KC, (size_t)(KPAD - PAST) * KC * 2, F.gw, F.NGW, lane);
    for (int it = F.gw; it < SB * KVL / 4; it += F.NGW) { const int rowi = it * 4 + (lane >> 4); *(u32x4*)((bf16_t*)(ws + WS_CKVT) + (size_t)rowi * KT + PAST + (lane & 15) * 8) = (u32x4){0u, 0u, 0u, 0u}; }
    zero16(ws + WS_OLAT, (size_t)SB * 256 * KVL * 4, F.gw, F.NGW, lane);
    zero16(ws + WS_SSK, (size_t)SB * KPAD * 16 * 4, F.gw, F.NGW, lane);
}

#define ACC_T const f32x4 (&acc)[2][2][4][2]
DI void st_bf16x8(bf16_t* p, f32x4 a, f32x4 b) { *(u32x4*)p = pack8(a, b); }
DI void st_f32x8(float* p, f32x4 a, f32x4 b) { *(f32x4*)p = a; *(f32x4*)(p + 4) = b; }
DI float dot8(f32x4 a, f32x4 b) { return (a[0] * a[0] + a[1] * a[1]) + (a[2] * a[2] + a[3] * a[3]) + (b[0] * b[0] + b[1] * b[1]) + (b[2] * b[2] + b[3] * b[3]); }

struct EpiInProj {
    unsigned char* ws;
    DI void operator()(ACC_T, const pg8::Unit& u, int wr, int wc, int fr, int fq, int lane) const {
        const float* ssq1 = (const float*)(ws + OFF_SSQ1);
        const int row0 = u.pm * 256 + wr * 64 + fr, c8 = wc * 32 + 8 * fq, pn = u.pn;
#pragma unroll
        for (int ai = 0; ai < 2; ++ai)
#pragma unroll
            for (int m = 0; m < 4; ++m) {
                const int row = row0 + ai * 128 + m * 16;
                const float rs = rsqrtf(ssq1[row] * (1.f / D) + EPS);
                f32x4 v[2][2];
#pragma unroll
                for (int bj = 0; bj < 2; ++bj) { v[bj][0] = acc[ai][bj][m][0] * rs; v[bj][1] = acc[ai][bj][m][1] * rs; }
                if (pn < 4) {
                    float ss = 0.f;
#pragma unroll
                    for (int bj = 0; bj < 2; ++bj) { st_bf16x8((bf16_t*)(ws + WS_CQ) + (size_t)row * QL + pn * 256 + bj * 128 + c8, v[bj][0], v[bj][1]); ss += dot8(v[bj][0], v[bj][1]); }
                    ss += __shfl_xor(ss, 16); ss += __shfl_xor(ss, 32);
                    if (fq == 0) unsafeAtomicAdd((float*)(ws + OFF_SSQQ) + row, ss);
                } else if (pn < 6) {
#pragma unroll
                    for (int bj = 0; bj < 2; ++bj) st_f32x8((float*)(ws + WS_CKVRAW) + (size_t)row * KVL + (pn - 4) * 256 + bj * 128 + c8, v[bj][0], v[bj][1]);
                } else if (pn == 6) {
                    if (wc < 2) st_f32x8((float*)(ws + WS_KRRAW) + (size_t)row * ROPE + c8, v[0][0], v[0][1]);
                } else if (pn < 15) {
#pragma unroll
                    for (int bj = 0; bj < 2; ++bj) st_bf16x8((bf16_t*)(ws + WS_HQ) + (size_t)row * HGW + (pn - 7) * 256 + bj * 128 + c8, v[bj][0], v[bj][1]);
                } else if (pn < 23) {
#pragma unroll
                    for (int bj = 0; bj < 2; ++bj) { const int col = (pn - 15) * 256 + bj * 128 + c8;
                        const f32x4 l0 = *(const f32x4*)((const float*)(ws + OFF_LB) + col), l1 = *(const f32x4*)((const float*)(ws + OFF_LB) + col + 4);
                        f32x4 lf[2], kk[2];
#pragma unroll
                        for (int n = 0; n < 2; ++n)
#pragma unroll
                            for (int e = 0; e < 4; ++e) { const float lb = n ? l1[e] : l0[e], x = v[bj][n][e], ex = __expf(-x), sg = 1.0f / (1.0f + ex), sgn = ex * sg;
                                lf[n][e] = __logf(lb + (1.0f - lb) * sg); kk[n][e] = (1.0f - lb) * sgn; }
                        st_f32x8((float*)(ws + WS_LF) + (size_t)row * HGW + col, lf[0], lf[1]);
                        st_bf16x8((bf16_t*)(ws + WS_HK) + (size_t)row * HGW + col, kk[0], kk[1]); }
                } else if (pn < 31) {
#pragma unroll
                    for (int bj = 0; bj < 2; ++bj) st_bf16x8((bf16_t*)(ws + WS_HV) + (size_t)row * HGW + (pn - 23) * 256 + bj * 128 + c8, v[bj][0], v[bj][1]);
                } else {
#pragma unroll
                    for (int bj = 0; bj < 2; ++bj) { f32x4 g[2];
#pragma unroll
                        for (int n = 0; n < 2; ++n)
#pragma unroll
                            for (int e = 0; e < 4; ++e) { const float x = v[bj][n][e]; g[n][e] = x / (1.0f + __expf(-x)); }
                        st_bf16x8((bf16_t*)(ws + WS_HG) + (size_t)row * HGW + (pn - 31) * 256 + bj * 128 + c8, g[0], g[1]); }
                }
            }
    }
};
struct EpiSumsq {
    unsigned char* ws;
    DI void operator()(ACC_T, const pg8::Unit& u, int wr, int wc, int fr, int fq, int lane) const {
        const int row0 = u.pm * 256 + wr * 64 + fr;
#pragma unroll
        for (int ai = 0; ai < 2; ++ai)
#pragma unroll
            for (int bj = 0; bj < 2; ++bj) {
                float s[4];
#pragma unroll
                for (int m = 0; m < 4; ++m) { float t = dot8(acc[ai][bj][m][0], acc[ai][bj][m][1]); t += __shfl_xor(t, 16); t += __shfl_xor(t, 32); s[m] = t; }
                const float sv = fq == 0 ? s[0] : fq == 1 ? s[1] : fq == 2 ? s[2] : s[3];
                unsafeAtomicAdd((float*)(ws + WS_SSK) + (size_t)(row0 + ai * 128 + fq * 16) * 16 + u.pn * 2 + bj, sv);
            }
    }
};
struct EpiUq {
    unsigned char* ws;
    DI void operator()(ACC_T, const pg8::Unit& u, int wr, int wc, int fr, int fq, int lane) const {
        const float* ssq = (const float*)(ws + OFF_SSQQ);
        const int row0 = u.pm * 256 + wr * 64 + fr, c8 = wc * 32 + 8 * fq;
#pragma unroll
        for (int ai = 0; ai < 2; ++ai)
#pragma unroll
            for (int m = 0; m < 4; ++m) { const int row = row0 + ai * 128 + m * 16; const float rs = rsqrtf(ssq[row] * (1.f / QL) + EPS);
#pragma unroll
                for (int bj = 0; bj < 2; ++bj) st_bf16x8((bf16_t*)(ws + WS_Q) + (size_t)row * 3072 + u.pn * 256 + bj * 128 + c8, acc[ai][bj][m][0] * rs, acc[ai][bj][m][1] * rs); }
    }
};

DI void p2_norm_rows(const Frame& F, const Args& a) {
    unsigned char* ws = a.ws; const int lane = lane_id();
    const float* ropec = (const float*)(ws + WS_ROPE); const float* ropes = ropec + NKEY * 32;
    for (int row = F.gw; row < M; row += F.NGW) {
        const bool smp = row >= MP; const int sr = row - MP, sb = sr >> 4, st = sr & 15;
        const float* cr = (const float*)(ws + WS_CKVRAW) + (size_t)row * KVL;
        f32x4 v0 = *(const f32x4*)(cr + 4 * lane), v1 = *(const f32x4*)(cr + 256 + 4 * lane);
        float ss = (v0[0] * v0[0] + v0[1] * v0[1]) + (v0[2] * v0[2] + v0[3] * v0[3]) + (v1[0] * v1[0] + v1[1] * v1[1]) + (v1[2] * v1[2] + v1[3] * v1[3]);
        ss = wave_sum(ss);
        const float rs = rsqrtf(ss * (1.f / KVL) + EPS);
        const f32x4 g0 = *(const f32x4*)(a.in[I_GKVA] + 4 * lane), g1 = *(const f32x4*)(a.in[I_GKVA] + 256 + 4 * lane);
        v0 = v0 * rs * g0; v1 = v1 * rs * g1;
        float* oc = a.out + (smp ? O_CKVS + (size_t)sr * KVL : O_CKVP + (size_t)row * KVL);
        *(f32x4*)(oc + 4 * lane) = v0; *(f32x4*)(oc + 256 + 4 * lane) = v1;
        u32x2 w0, w1; w0.x = cvtpk(v0[0], v0[1]); w0.y = cvtpk(v0[2], v0[3]); w1.x = cvtpk(v1[0], v1[1]); w1.y = cvtpk(v1[2], v1[3]);
        bf16_t* cn = (bf16_t*)(ws + WS_CKVN) + (size_t)row * KVL;
        *(u32x2*)(cn + 4 * lane) = w0; *(u32x2*)(cn + 256 + 4 * lane) = w1;
        if (smp) {
            bf16_t* kc = (bf16_t*)(ws + WS_KCAT) + ((size_t)sb * KPAD + PAST + st) * KC;
            *(u32x2*)(kc + 4 * lane) = w0; *(u32x2*)(kc + 256 + 4 * lane) = w1;
            bf16_t* ct = (bf16_t*)(ws + WS_CKVT) + (size_t)sb * KVL * KT + PAST + st;
            const unsigned e0[4] = {w0.x & 0xffffu, w0.x >> 16, w0.y & 0xffffu, w0.y >> 16}, e1[4] = {w1.x & 0xffffu, w1.x >> 16, w1.y & 0xffffu, w1.y >> 16};
#pragma unroll
            for (int e = 0; e < 4; ++e) { ct[(size_t)(4 * lane + e) * KT] = (bf16_t)e0[e]; ct[(size_t)(256 + 4 * lane + e) * KT] = (bf16_t)e1[e]; }
        }
        const float kv = ((const float*)(ws + WS_KRRAW))[(size_t)row * ROPE + lane];
        const float s2 = wave_sum(kv * kv);
        const float y = kv * rsqrtf(s2 * (1.f / ROPE) + EPS) * a.in[I_GKR][lane];
        const float yo = __shfl_xor(y, 32);
        const int pos = smp ? PAST + st : (row & (SEQ - 1)), i = lane & 31;
        const float c = ropec[pos * 32 + i], s = ropes[pos * 32 + i];
        const float o = lane < 32 ? y * c - yo * s : y * c + yo * s;
        (a.out + (smp ? O_KRS + (size_t)sr * ROPE : O_KRP + (size_t)row * ROPE))[lane] = o;
        const bf16_t ob = f2bf(o);
        ((bf16_t*)(ws + WS_KRN))[(size_t)row * ROPE + lane] = ob;
        if (smp) ((bf16_t*)(ws + WS_KCAT))[((size_t)sb * KPAD + PAST + st) * KC + KVL + lane] = ob;
    }
}

DI void p3_qnorm_rows(const Frame& F, const Args& a) {
    unsigned char* ws = a.ws; const int lane = lane_id();
    const float* ropec = (const float*)(ws + WS_ROPE); const float* ropes = ropec + NKEY * 32;
    const float gn0 = a.in[I_GQN][2 * lane], gn1 = a.in[I_GQN][2 * lane + 1], gr = a.in[I_GQR][lane];
    for (int row = F.gw; row < M; row += F.NGW) {
        const bool smp = row >= MP; const int sr = row - MP;
        const int pos = smp ? PAST + (sr & 15) : (row & (SEQ - 1)), i = lane & 31;
        const float c = ropec[pos * 32 + i], s = ropes[pos * 32 + i];
        bf16_t* q = (bf16_t*)(ws + WS_Q) + (size_t)row * 3072;
        unsigned wn[16]; bf16_t wr_[16];
#pragma unroll
        for (int h = 0; h < 16; ++h) { wn[h] = *(const unsigned*)(q + h * QH + 2 * lane); wr_[h] = q[h * QH + NOPE + lane]; }
#pragma unroll
        for (int h = 0; h < 16; ++h) {
            float a0 = bf_lo(wn[h]), a1 = bf_hi(wn[h]), r = bf2f(wr_[h]);
            const float ssn = wave_sum(a0 * a0 + a1 * a1), ssr = wave_sum(r * r);
            const float rn = rsqrtf(ssn * (1.f / NOPE) + EPS), rr = rsqrtf(ssr * (1.f / ROPE) + EPS);
            *(unsigned*)(q + h * QH + 2 * lane) = cvtpk(a0 * rn * gn0, a1 * rn * gn1);
            const float y = r * rr * gr, yo = __shfl_xor(y, 32);
            const bf16_t ob = f2bf(lane < 32 ? y * c - yo * s : y * c + yo * s);
            q[h * QH + NOPE + lane] = ob;
            if (smp) ((bf16_t*)(ws + WS_QCAT))[((size_t)sr * 16 + h) * KC + KVL + lane] = ob;
        }
    }
}
struct EpiKup {
    unsigned char* ws;
    DI void operator()(ACC_T, const pg8::Unit& u, int wr, int wc, int fr, int fq, int lane) const {
        const int row0 = u.pm * 256 + wr * 64 + fr, c8 = wc * 32 + 8 * fq;
        bf16_t* base = (bf16_t*)(ws + (u.pn < 8 ? WS_KN : WS_V)) + (u.pn & 7) * 256 + c8;
#pragma unroll
        for (int ai = 0; ai < 2; ++ai)
#pragma unroll
            for (int m = 0; m < 4; ++m)
#pragma unroll
                for (int bj = 0; bj < 2; ++bj) st_bf16x8(base + (size_t)(row0 + ai * 128 + m * 16) * 2048 + bj * 128, acc[ai][bj][m][0], acc[ai][bj][m][1]);
    }
};
DI void p4_knorm_rows(const Frame& F, const Args& a) {
    unsigned char* ws = a.ws; const int lane = lane_id();
    const float g0 = a.in[I_GKN][2 * lane], g1 = a.in[I_GKN][2 * lane + 1];
    for (int row = F.gw; row < MP; row += F.NGW) {
        bf16_t* k = (bf16_t*)(ws + WS_KN) + (size_t)row * 2048;
        unsigned w[16];
#pragma unroll
        for (int h = 0; h < 16; ++h) w[h] = *(const unsigned*)(k + h * 128 + 2 * lane);
#pragma unroll
        for (int h = 0; h < 16; ++h) { const float a0 = bf_lo(w[h]), a1 = bf_hi(w[h]); const float rn = rsqrtf(wave_sum(a0 * a0 + a1 * a1) * (1.f / NOPE) + EPS);
            *(unsigned*)(k + h * 128 + 2 * lane) = cvtpk(a0 * rn * g0, a1 * rn * g1); }
    }
}

DI int crow(int r, int hi) { return (r & 3) + 8 * (r >> 2) + 4 * hi; }
template <int NJ, bool AF32, class Mid>
DI void sgemm_tile(const void* Av, size_t lda, const bf16_t* Bt, size_t ldb, int K, int mid_k, const Mid& mid, f32x16 (&acc)[2][NJ], int wave, int lane) {
    const int wm = wave >> 2, wn = wave & 3, r32 = lane & 31, hi = lane >> 5;
#pragma unroll
    for (int i = 0; i < 2; ++i)
#pragma unroll
        for (int j = 0; j < NJ; ++j)
#pragma unroll
            for (int r = 0; r < 16; ++r) acc[i][j][r] = 0.f;
    const bf16_t* bp[NJ];
#pragma unroll
    for (int j = 0; j < NJ; ++j) bp[j] = Bt + (size_t)(wn * 32 * NJ + j * 32 + r32) * ldb + hi * 8;
    if constexpr (AF32) {
        for (int k0 = 0; k0 < K; k0 += 16) {
            bf16x8 af[2], bf_[NJ];
#pragma unroll
            for (int i = 0; i < 2; ++i) { const float* p = (const float*)Av + (size_t)(wm * 64 + i * 32 + r32) * lda + hi * 8 + k0; af[i] = __builtin_bit_cast(bf16x8, pack8(*(const f32x4*)p, *(const f32x4*)(p + 4))); }
#pragma unroll
            for (int j = 0; j < NJ; ++j) bf_[j] = *(const bf16x8*)(bp[j] + k0);
#pragma unroll
            for (int i = 0; i < 2; ++i)
#pragma unroll
                for (int j = 0; j < NJ; ++j) acc[i][j] = __builtin_amdgcn_mfma_f32_32x32x16_bf16(af[i], bf_[j], acc[i][j], 0, 0, 0);
        }
    } else {
    for (int k0 = 0; k0 < K; k0 += 64) {
        bf16x8 af[2][4], bf_[NJ][4];
#pragma unroll
        for (int i = 0; i < 2; ++i)
#pragma unroll
            for (int ks = 0; ks < 4; ++ks) af[i][ks] = *(const bf16x8*)((const bf16_t*)Av + (size_t)(wm * 64 + i * 32 + r32) * lda + hi * 8 + k0 + ks * 16);
#pragma unroll
        for (int j = 0; j < NJ; ++j)
#pragma unroll
            for (int ks = 0; ks < 4; ++ks) bf_[j][ks] = *(const bf16x8*)(bp[j] + k0 + ks * 16);
        if (k0 == mid_k) mid(acc);
#pragma unroll
        for (int ks = 0; ks < 4; ++ks)
#pragma unroll
            for (int i = 0; i < 2; ++i)
#pragma unroll
                for (int j = 0; j < NJ; ++j) acc[i][j] = __builtin_amdgcn_mfma_f32_32x32x16_bf16(af[i][ks], bf_[j][ks], acc[i][j], 0, 0, 0);
    }
    }
}
struct NoMid { template <class T> DI void operator()(T&) const {} };

DI void p4_qa_unit(const Frame& F, const Args& a, int unit) {
    unsigned char* ws = a.ws; const int h = unit >> 3, mt = (unit >> 1) & 3, nt = unit & 1;
    f32x16 acc[2][2];
    sgemm_tile<2, false>((const bf16_t*)(ws + WS_Q) + (size_t)(MP + mt * 128) * 3072 + h * QH, 3072, (const bf16_t*)(ws + WS_WUKN) + (size_t)(nt * 256) * 2048 + h * 128, 2048, NOPE, -1, NoMid(), acc, F.wave, lane_id());
    const int wm = F.wave >> 2, wn = F.wave & 3, r32 = lane_id() & 31, hi = lane_id() >> 5;
#pragma unroll
    for (int i = 0; i < 2; ++i)
#pragma unroll
        for (int j = 0; j < 2; ++j)
#pragma unroll
            for (int r = 0; r < 16; ++r) { const int t = mt * 128 + wm * 64 + i * 32 + crow(r, hi), c = nt * 256 + wn * 64 + j * 32 + r32;
                ((bf16_t*)(ws + WS_QCAT))[((size_t)t * 16 + h) * KC + c] = f2bf(acc[i][j][r]); }
}

namespace att {
constexpr int SHM_K = 64 * 128 * 2, SHM_KR = 64 * 64 * 2, SHM_V = 64 * 128 * 2;
constexpr int OFF_V = 0, OFF_K = 2 * SHM_V, OFF_KR = OFF_K + 2 * SHM_K, OFF_WS = OFF_KR + 2 * SHM_KR, OFF_QR = OFF_WS + 8 * 64 * 4, LDS_NEED = OFF_QR + 8 * 4096;
static_assert(LDS_NEED <= RING_BYTES, "attention LDS");
#define KSWZ(row, colB) ((row) * 256 + ((colB) ^ (((row) & 7) << 4)))
#define KRSWZ(row, colB) ((row) * 128 + ((colB) ^ (((row) & 7) << 4)))
#define SBAR() __builtin_amdgcn_sched_barrier(0)
DI int v_st(int k, int c) { const int kk = (k & ~0xC) | ((k & 4) << 1) | ((k & 8) >> 1); return ((kk >> 3) * 4 + (c >> 5)) * 512 + ((kk & 7) * 32 + (c & 31)) * 2; }
DI int v_rd_base(int lane) { return ((lane & 3) << 3) | (((lane >> 2) & 3) << 6) | (((lane >> 4) & 1) << 5) | (((lane >> 5) & 1) << 8); }
constexpr float THR = 8.f;
constexpr float C2 = 1.4426950408889634f * ATT_SCALE;

DI void partialSM(f32x16& p0, f32x16& p1, float& m_reg, float& mn, float& alpha) {
    float pmax = p0[0];
#pragma unroll
    for (int r = 1; r < 16; ++r) pmax = fmaxf(pmax, p0[r]);
#pragma unroll
    for (int r = 0; r < 16; ++r) pmax = fmaxf(pmax, p1[r]);
    { auto rr = __builtin_amdgcn_permlane32_swap(__float_as_uint(pmax), __float_as_uint(pmax), false, false);
      pmax = fmaxf(__uint_as_float(rr[0]), __uint_as_float(rr[1])); }
    if (__builtin_expect(__all((pmax - m_reg) * ATT_SCALE <= THR), 1)) { mn = m_reg; alpha = 1.f; }
    else { mn = fmaxf(m_reg, pmax); alpha = __builtin_amdgcn_exp2f((m_reg - mn) * C2); m_reg = mn; }
    const float mnL = -mn * C2;
#pragma unroll
    for (int r = 0; r < 16; ++r) p0[r] = fmaf(p0[r], C2, mnL);
#pragma unroll
    for (int r = 0; r < 16; ++r) p1[r] = fmaf(p1[r], C2, mnL);
#pragma unroll
    for (int r = 0; r < 16; ++r) p0[r] = __builtin_amdgcn_exp2f(p0[r]);
}
DI void finishSM(f32x16& p0, f32x16& p1, float alpha, float& l_reg, bf16x8& pa0, bf16x8& pa1, bf16x8& pa2, bf16x8& pa3) {
#pragma unroll
    for (int r = 0; r < 16; ++r) p1[r] = __builtin_amdgcn_exp2f(p1[r]);
    float ps = 0;
#pragma unroll
    for (int r = 0; r < 16; ++r) ps += p0[r];
#pragma unroll
    for (int r = 0; r < 16; ++r) ps += p1[r];
    { auto rr = __builtin_amdgcn_permlane32_swap(__float_as_uint(ps), __float_as_uint(ps), false, false);
      ps = __uint_as_float(rr[0]) + __uint_as_float(rr[1]); }
    l_reg = l_reg * alpha + ps;
#define PK4(P, B_, OUT) do { unsigned a0 = cvtpk(P[B_+0], P[B_+1]), a1 = cvtpk(P[B_+2], P[B_+3]);                          \
        unsigned b0 = cvtpk(P[B_+4], P[B_+5]), b1 = cvtpk(P[B_+6], P[B_+7]);                                             \
        auto r0 = __builtin_amdgcn_permlane32_swap(a0, b0, false, false); auto r1 = __builtin_amdgcn_permlane32_swap(a1, b1, false, false); \
        u32x4 w = {r0[0], r1[0], r0[1], r1[1]}; OUT = __builtin_bit_cast(bf16x8, w); } while (0)
    PK4(p0, 0, pa0); PK4(p0, 8, pa1); PK4(p1, 0, pa2); PK4(p1, 8, pa3);
#undef PK4
}
template <int KB>
DI void qkt(f32x16& p0, f32x16& p1, const LAS char* lds, int r32, int hi, const bf16x8* qr, const LAS char* qrl, bool act) {
    if (!act) { const float NEG = -__builtin_inff();
#pragma unroll
        for (int r = 0; r < 16; ++r) { p0[r] = NEG; p1[r] = NEG; } return; }
#pragma unroll
    for (int r = 0; r < 16; ++r) { p0[r] = 0.f; p1[r] = 0.f; }
    const LAS char* kb[4];
#pragma unroll
    for (int dd = 0; dd < 4; ++dd) kb[dd] = lds + OFF_K + KB * SHM_K + KSWZ(r32, (dd * 16 + hi * 8) * 2);
#pragma unroll
    for (int d0 = 0; d0 < 8; ++d0) { const LAS char* a = kb[d0 & 3] + (d0 >> 2) * 128;
        const bf16x8 b0 = *(const LAS bf16x8*)(a);
        const bf16x8 b1 = *(const LAS bf16x8*)(a + 32 * 256);
        p0 = __builtin_amdgcn_mfma_f32_32x32x16_bf16(b0, qr[d0], p0, 0, 0, 0);
        p1 = __builtin_amdgcn_mfma_f32_32x32x16_bf16(b1, qr[d0], p1, 0, 0, 0); }
#pragma unroll
    for (int d0 = 0; d0 < 4; ++d0) { const LAS char* a = lds + OFF_KR + KB * SHM_KR + KRSWZ(r32, (d0 * 16 + hi * 8) * 2);
        const bf16x8 b0 = *(const LAS bf16x8*)(a);
        const bf16x8 b1 = *(const LAS bf16x8*)(a + 32 * 128);
        const bf16x8 qv = *(const LAS bf16x8*)(qrl + d0 * 1024);
        p0 = __builtin_amdgcn_mfma_f32_32x32x16_bf16(b0, qv, p0, 0, 0, 0);
        p1 = __builtin_amdgcn_mfma_f32_32x32x16_bf16(b1, qv, p1, 0, 0, 0); }
}
template <int VB>
DI void pv_tile(f32x16* o, int vb0, bf16x8 pa0, bf16x8 pa1, bf16x8 pa2, bf16x8 pa3, bool act) {
    if (!act) return;
#define TRRD(dst, off) asm volatile("ds_read_b64_tr_b16 %0, %1 offset:%2" : "=&v"(dst) : "v"(vb0), "i"(off) : "memory")
#define PV_D0(d0) do { s16x4 l0, l1, l2, l3, h0, h1, h2, h3; constexpr int b_ = OFF_V + VB * SHM_V + (d0) * 512; \
        TRRD(l0, b_); TRRD(h0, b_ + 2048); TRRD(l1, b_ + 4096); TRRD(h1, b_ + 6144); TRRD(l2, b_ + 8192); TRRD(h2, b_ + 10240); TRRD(l3, b_ + 12288); TRRD(h3, b_ + 14336); \
        asm volatile("s_waitcnt lgkmcnt(0)" ::: "memory"); SBAR();   \
        o[d0] = __builtin_amdgcn_mfma_f32_32x32x16_bf16(pa0, (bf16x8){l0[0], l0[1], l0[2], l0[3], h0[0], h0[1], h0[2], h0[3]}, o[d0], 0, 0, 0);   \
        o[d0] = __builtin_amdgcn_mfma_f32_32x32x16_bf16(pa1, (bf16x8){l1[0], l1[1], l1[2], l1[3], h1[0], h1[1], h1[2], h1[3]}, o[d0], 0, 0, 0);   \
        o[d0] = __builtin_amdgcn_mfma_f32_32x32x16_bf16(pa2, (bf16x8){l2[0], l2[1], l2[2], l2[3], h2[0], h2[1], h2[2], h2[3]}, o[d0], 0, 0, 0);   \
        o[d0] = __builtin_amdgcn_mfma_f32_32x32x16_bf16(pa3, (bf16x8){l3[0], l3[1], l3[2], l3[3], h3[0], h3[1], h3[2], h3[3]}, o[d0], 0, 0, 0); } while (0)
    PV_D0(0); PV_D0(1); PV_D0(2); PV_D0(3);
#undef PV_D0
#undef TRRD
}

DI void attn_unit(int b, int h, int qb, const bf16_t* __restrict__ Q, const bf16_t* __restrict__ KN, const bf16_t* __restrict__ KR, const bf16_t* __restrict__ V, bf16_t* __restrict__ O, LAS char* lds, int wid) {
    const int lane = lane_id(), tid = wid * 64 + lane, r32 = lane & 31, hi = lane >> 5;
    const int NT = 4 * qb + 4, wchunk = 4 * qb + (wid >> 1);
    const size_t krow0 = (size_t)b * SEQ;
    const bf16_t* Kh = KN + krow0 * 2048 + h * 128; const bf16_t* Vh = V + krow0 * 2048 + h * 128; const bf16_t* Rh = KR + krow0 * ROPE;
    LAS float* wsl = (LAS float*)(lds + OFF_WS) + wid * 64; LAS float* li_l = wsl; LAS float* al_l = wsl + 32;
    float m_reg = -1e30f, l_reg = 0; f32x16 o[4];
#pragma unroll
    for (int d = 0; d < 4; ++d)
#pragma unroll
        for (int r = 0; r < 16; ++r) o[d][r] = 0.f;
    const int sr = tid >> 4, sc = (tid & 15) * 8, vst0 = v_st(sr, sc), vst1 = v_st(32 + sr, sc), kws = KSWZ(sr, sc * 2);
    const int rr_ = tid >> 3, rc = (tid & 7) * 8, krws = KRSWZ(rr_, rc * 2);
    const int vb0 = (int)(unsigned)(size_t)(lds) + v_rd_base(lane);
    bf16x8 qr[8];
    const LAS char* qrl = lds + OFF_QR + wid * 4096 + lane * 16;
    { const bf16_t* qp = Q + ((size_t)b * SEQ + qb * 256 + wid * 32 + r32) * 3072 + h * QH + hi * 8;
#pragma unroll
      for (int d0 = 0; d0 < 8; ++d0) qr[d0] = *(const bf16x8*)(qp + d0 * 16);
#pragma unroll
      for (int d0 = 0; d0 < 4; ++d0) *(LAS bf16x8*)(lds + OFF_QR + wid * 4096 + lane * 16 + d0 * 1024) = *(const bf16x8*)(qp + (8 + d0) * 16); }
    bf16x8 st_v0, st_v1, st_k0, st_k1, st_kr;
#define SLOAD(k0) do { st_v0 = *(const bf16x8*)(Vh + (size_t)((k0) + sr) * 2048 + sc); st_v1 = *(const bf16x8*)(Vh + (size_t)((k0) + 32 + sr) * 2048 + sc); \
                       st_k0 = *(const bf16x8*)(Kh + (size_t)((k0) + sr) * 2048 + sc); st_k1 = *(const bf16x8*)(Kh + (size_t)((k0) + 32 + sr) * 2048 + sc); \
                       st_kr = *(const bf16x8*)(Rh + (size_t)((k0) + rr_) * ROPE + rc); } while (0)
#define SWRITE(bf) do { *(LAS bf16x8*)(lds + OFF_V + (bf) * SHM_V + vst0) = st_v0; *(LAS bf16x8*)(lds + OFF_V + (bf) * SHM_V + vst1) = st_v1; \
                        *(LAS bf16x8*)(lds + OFF_K + (bf) * SHM_K + kws) = st_k0; *(LAS bf16x8*)(lds + OFF_K + (bf) * SHM_K + kws + 32 * 256) = st_k1; \
                        *(LAS bf16x8*)(lds + OFF_KR + (bf) * SHM_KR + krws) = st_kr; } while (0)
#define VMW() asm volatile("s_waitcnt vmcnt(0)" ::: "memory")
#define RESC(a_) do { if (__any((a_) < 1.f)) { if (hi == 0) al_l[r32] = (a_); asm volatile("s_waitcnt lgkmcnt(0)" ::: "memory");              \
                     for (int d_ = 0; d_ < 4; ++d_) for (int r = 0; r < 16; ++r) o[d_][r] *= al_l[crow(r, hi)]; } } while (0)
#define ACT(t) ((t) <= wchunk)
    f32x16 pA0, pA1, pB0, pB1; float mnA, mnB, alA, alB; bf16x8 pa0, pa1, pa2, pa3;
    SLOAD(0); VMW(); SWRITE(0);
    __syncthreads();
    if (NT > 1) SLOAD(64);
    SBAR(); qkt<0>(pA0, pA1, lds, r32, hi, qr, qrl, ACT(0));
    partialSM(pA0, pA1, m_reg, mnA, alA);
    if (NT > 1) { VMW(); SWRITE(1); }
    __syncthreads();
#define HALF_STEP(PX0, PX1, mnX, alX, PY0, PY1, alY, t, KB, VB, SB_) do {                                                      \
        SBAR(); qkt<KB>(PX0, PX1, lds, r32, hi, qr, qrl, ACT(t));                                             \
        finishSM(PY0, PY1, alY, l_reg, pa0, pa1, pa2, pa3); SBAR();                                                           \
        if ((t) + 1 < NT) { SLOAD(((t) + 1) * 64); SBAR(); }                                               \
        pv_tile<VB>(o, vb0, pa0, pa1, pa2, pa3, ACT((t) - 1)); partialSM(PX0, PX1, m_reg, mnX, alX);                                        \
        __syncthreads();                                                                                                      \
        if ((t) + 1 < NT) { VMW(); SWRITE(SB_); }                                                                          \
        RESC(alX); __syncthreads(); } while (0)
    for (int t = 1; t + 1 < NT; t += 2) {
        HALF_STEP(pB0, pB1, mnB, alB, pA0, pA1, alA, t, 1, 0, 0);
        HALF_STEP(pA0, pA1, mnA, alA, pB0, pB1, alB, t + 1, 0, 1, 1);
    }
    SBAR(); qkt<1>(pB0, pB1, lds, r32, hi, qr, qrl, ACT(NT - 1)); SBAR();
    finishSM(pA0, pA1, alA, l_reg, pa0, pa1, pa2, pa3); SBAR();
    pv_tile<0>(o, vb0, pa0, pa1, pa2, pa3, ACT(NT - 2));
    partialSM(pB0, pB1, m_reg, mnB, alB); RESC(alB);
    finishSM(pB0, pB1, alB, l_reg, pa0, pa1, pa2, pa3); SBAR(); pv_tile<1>(o, vb0, pa0, pa1, pa2, pa3, ACT(NT - 1));
    if (hi == 0) li_l[r32] = l_reg; asm volatile("s_waitcnt lgkmcnt(0)" ::: "memory");
    float rli[16];
#pragma unroll
    for (int r = 0; r < 16; ++r) rli[r] = __builtin_amdgcn_rcpf(li_l[crow(r, hi)]);
    int r32e = r32, hie = hi; asm volatile("" : "+v"(r32e), "+v"(hie));
    bf16_t* Ow = O + ((size_t)b * SEQ + qb * 256 + wid * 32) * D + h * 128 + r32e;
#pragma unroll
    for (int r = 0; r < 16; ++r) { const int orow = crow(r, hie);
#pragma unroll
        for (int d0 = 0; d0 < 4; ++d0) { const float v = o[d0][r] * rli[r]; const float vn = __shfl_xor(v, 1);
            if ((r32e & 1) == 0) *(unsigned*)(Ow + (size_t)orow * D + d0 * 32) = cvtpk(v, vn); } }
    __syncthreads();
#undef SLOAD
#undef SWRITE
#undef VMW
#undef RESC
#undef ACT
#undef HALF_STEP
}
#undef KSWZ
#undef KRSWZ
#undef SBAR
}

namespace hg {
constexpr int P = 136, KP = 72, OP = 132;
constexpr int OFF_QE = 0, OFF_QD = 17408, OFF_KDD = 34816, OFF_KDT = 52224, OFF_V = 70656, OFF_AM = 88064, OFF_T = 97280, OFF_DL = 101376, OFF_OX = OFF_QD, LDS_NEED = 101888;
static_assert(OFF_OX + 64 * OP * 4 <= OFF_KDT && LDS_NEED <= RING_BYTES, "hgrn LDS");
DI bf16x8 mk8(u32x2 a, u32x2 b) { u32x4 w = {a.x, a.y, b.x, b.y}; return __builtin_bit_cast(bf16x8, w); }

DI void hgrn_unit(const Args& a, bool smp, int bb, int h, LAS char* lds, int w) {
    unsigned char* ws = a.ws;
    const int lane = lane_id(), tid = w * 64 + lane, n = lane & 15, g = lane >> 4;
    const int nch = smp ? 1 : SEQ / 64, nrow = smp ? ST : 64;
    const size_t row_base = smp ? (size_t)MP + (size_t)bb * ST : (size_t)bb * SEQ;
    const bf16_t* HQ = (const bf16_t*)(ws + WS_HQ) + h * HGD; const bf16_t* HK = (const bf16_t*)(ws + WS_HK) + h * HGD; const bf16_t* HV = (const bf16_t*)(ws + WS_HV) + h * HGD;
    const bf16_t* HGt = (const bf16_t*)(ws + WS_HG) + h * HGD; const float* LF = (const float*)(ws + WS_LF) + h * HGD;
    f32x4 sacc[8];
    float* sout = a.out + (smp ? O_HGS : O_HGP) + ((size_t)bb * HGH + h) * HGD * HGD;
    if (smp) { const float* s0 = a.in[I_SHG] + ((size_t)bb * HGH + h) * HGD * HGD;
#pragma unroll
        for (int kb = 0; kb < 8; ++kb)
#pragma unroll
            for (int i = 0; i < 4; ++i) sacc[kb][i] = s0[(size_t)(16 * kb + 4 * g + i) * HGD + 16 * w + n]; }
    else {
#pragma unroll
        for (int kb = 0; kb < 8; ++kb) sacc[kb] = (f32x4){0.f, 0.f, 0.f, 0.f}; }
    const int c0 = 2 * lane, vrow = tid >> 3, vg = tid & 7;
    f32x2 lfv[8]; unsigned qv[8], kv[8]; u32x4 vraw[2], graw[2];
#define HG_LOAD(cc) do { const size_t r0_ = row_base + (size_t)(cc) * 64; \
        _Pragma("unroll") for (int j = 0; j < 8; ++j) { const int t_ = 8 * w + j; const bool ok_ = t_ < nrow; const size_t ro_ = (r0_ + (ok_ ? t_ : 0)) * HGW + c0; \
            lfv[j] = ok_ ? *(const f32x2*)(LF + ro_) : (f32x2){0.f, 0.f}; qv[j] = ok_ ? *(const unsigned*)(HQ + ro_) : 0u; kv[j] = ok_ ? *(const unsigned*)(HK + ro_) : 0u; } \
        { const bool ok_ = vrow < nrow; const size_t ro_ = (r0_ + (ok_ ? vrow : 0)) * HGW + 16 * vg; const u32x4 z_ = {0u, 0u, 0u, 0u}; \
          vraw[0] = ok_ ? *(const u32x4*)(HV + ro_) : z_; vraw[1] = ok_ ? *(const u32x4*)(HV + ro_ + 8) : z_; graw[0] = ok_ ? *(const u32x4*)(HGt + ro_) : z_; graw[1] = ok_ ? *(const u32x4*)(HGt + ro_ + 8) : z_; } } while (0)
    HG_LOAD(0);
    for (int c = 0; c < nch; ++c) {
        float bl0[8], bl1[8]; float run0 = 0.f, run1 = 0.f;
#pragma unroll
        for (int j = 0; j < 8; ++j) { run0 += lfv[j].x; run1 += lfv[j].y; bl0[j] = run0; bl1[j] = run1; }
        *(LAS f32x2*)(lds + OFF_T + (w * 128 + c0) * 4) = (f32x2){run0, run1};
        *(LAS u32x4*)(lds + OFF_V + (vrow * P + 16 * vg) * 2) = vraw[0]; *(LAS u32x4*)(lds + OFF_V + (vrow * P + 16 * vg + 8) * 2) = vraw[1];
        const u32x4 gcur0 = graw[0], gcur1 = graw[1];
        asm volatile("s_waitcnt lgkmcnt(0)" ::: "memory"); __syncthreads();
        float off0 = 0.f, off1 = 0.f, br0 = 0.f, br1 = 0.f, bt0 = 0.f, bt1 = 0.f;
#pragma unroll
        for (int e = 0; e < 8; ++e) { const f32x2 tv = *(const LAS f32x2*)(lds + OFF_T + (e * 128 + c0) * 4); if (e < w) { off0 += tv.x; off1 += tv.y; } if (e < 4) { br0 += tv.x; br1 += tv.y; } bt0 += tv.x; bt1 += tv.y; }
        float kd0[8], kd1[8];
#pragma unroll
        for (int j = 0; j < 8; ++j) { const int t = 8 * w + j; const float b0 = off0 + bl0[j], b1 = off1 + bl1[j];
            const float q0 = bf_lo(qv[j]), q1 = bf_hi(qv[j]), k0 = bf_lo(kv[j]), k1 = bf_hi(kv[j]);
            *(LAS unsigned*)(lds + OFF_QE + (t * P + c0) * 2) = cvtpk(q0 * __expf(b0), q1 * __expf(b1));
            *(LAS unsigned*)(lds + OFF_QD + (t * P + c0) * 2) = cvtpk(q0 * __expf(b0 - br0), q1 * __expf(b1 - br1));
            *(LAS unsigned*)(lds + OFF_KDD + (t * P + c0) * 2) = cvtpk(k0 * __expf(br0 - b0), k1 * __expf(br1 - b1));
            kd0[j] = k0 * __expf(bt0 - b0); kd1[j] = k1 * __expf(bt1 - b1); }
        { u32x4 p0, p1; p0.x = cvtpk(kd0[0], kd0[1]); p0.y = cvtpk(kd0[2], kd0[3]); p0.z = cvtpk(kd0[4], kd0[5]); p0.w = cvtpk(kd0[6], kd0[7]);
          p1.x = cvtpk(kd1[0], kd1[1]); p1.y = cvtpk(kd1[2], kd1[3]); p1.z = cvtpk(kd1[4], kd1[5]); p1.w = cvtpk(kd1[6], kd1[7]);
          *(LAS u32x4*)(lds + OFF_KDT + (c0 * KP + 8 * w) * 2) = p0; *(LAS u32x4*)(lds + OFF_KDT + ((c0 + 1) * KP + 8 * w) * 2) = p1; }
        if (w == 0) *(LAS f32x2*)(lds + OFF_DL + c0 * 4) = (f32x2){__expf(bt0), __expf(bt1)};
        asm volatile("s_waitcnt lgkmcnt(0)" ::: "memory"); __syncthreads();
        if (c + 1 < nch) HG_LOAD(c + 1);
        { const int tb = w >> 1;
#pragma unroll
          for (int sbi = 0; sbi < 2; ++sbi) { const int sb = 2 * (w & 1) + sbi; f32x4 acc = {0.f, 0.f, 0.f, 0.f};
            if (sb <= tb) {
#pragma unroll
                for (int ks = 0; ks < 4; ++ks) { const bf16x8 af = *(const LAS bf16x8*)(lds + OFF_KDD + ((16 * sb + n) * P + 32 * ks + 8 * g) * 2), bfr = *(const LAS bf16x8*)(lds + OFF_QD + ((16 * tb + n) * P + 32 * ks + 8 * g) * 2);
                    acc = __builtin_amdgcn_mfma_f32_16x16x32_bf16(af, bfr, acc, 0, 0, 0); }
                if (sb == tb) {
#pragma unroll
                    for (int i = 0; i < 4; ++i) if (n < 4 * g + i) acc[i] = 0.f; }
            }
            u32x2 pk; pk.x = cvtpk(acc[0], acc[1]); pk.y = cvtpk(acc[2], acc[3]);
            *(LAS u32x2*)(lds + OFF_AM + ((16 * tb + n) * KP + 16 * sb + 4 * g) * 2) = pk; } }
        f32x4 oacc[4];
#pragma unroll
        for (int tb = 0; tb < 4; ++tb) oacc[tb] = (f32x4){0.f, 0.f, 0.f, 0.f};
#pragma unroll
        for (int j = 0; j < 4; ++j) { u32x4 sb4; sb4.x = cvtpk(sacc[2 * j][0], sacc[2 * j][1]); sb4.y = cvtpk(sacc[2 * j][2], sacc[2 * j][3]); sb4.z = cvtpk(sacc[2 * j + 1][0], sacc[2 * j + 1][1]); sb4.w = cvtpk(sacc[2 * j + 1][2], sacc[2 * j + 1][3]);
            const bf16x8 bfr = __builtin_bit_cast(bf16x8, sb4);
#pragma unroll
            for (int tb = 0; tb < 4; ++tb) { const LAS char* qp = lds + OFF_QE + ((16 * tb + n) * P + 32 * j + 4 * g) * 2;
                const bf16x8 af = mk8(*(const LAS u32x2*)qp, *(const LAS u32x2*)(qp + 32));
                oacc[tb] = __builtin_amdgcn_mfma_f32_16x16x32_bf16(af, bfr, oacc[tb], 0, 0, 0); } }
        asm volatile("s_waitcnt lgkmcnt(0)" ::: "memory"); __syncthreads();
        bf16x8 vf[2];
#pragma unroll
        for (int js = 0; js < 2; ++js) { unsigned short e_[8];
#pragma unroll
            for (int i = 0; i < 8; ++i) e_[i] = *(const LAS unsigned short*)(lds + OFF_V + ((32 * js + 8 * g + i) * P + 16 * w + n) * 2);
            u32x4 t_; t_.x = e_[0] | ((unsigned)e_[1] << 16); t_.y = e_[2] | ((unsigned)e_[3] << 16); t_.z = e_[4] | ((unsigned)e_[5] << 16); t_.w = e_[6] | ((unsigned)e_[7] << 16);
            vf[js] = __builtin_bit_cast(bf16x8, t_); }
#pragma unroll
        for (int tb = 0; tb < 4; ++tb)
#pragma unroll
            for (int js = 0; js < 2; ++js) { const bf16x8 af = *(const LAS bf16x8*)(lds + OFF_AM + ((16 * tb + n) * KP + 32 * js + 8 * g) * 2);
                oacc[tb] = __builtin_amdgcn_mfma_f32_16x16x32_bf16(af, vf[js], oacc[tb], 0, 0, 0); }
#pragma unroll
        for (int kb = 0; kb < 8; ++kb) { const f32x4 dl = *(const LAS f32x4*)(lds + OFF_DL + (16 * kb + 4 * g) * 4); sacc[kb] = sacc[kb] * dl;
#pragma unroll
            for (int js = 0; js < 2; ++js) { const bf16x8 af = *(const LAS bf16x8*)(lds + OFF_KDT + ((16 * kb + n) * KP + 32 * js + 8 * g) * 2);
                sacc[kb] = __builtin_amdgcn_mfma_f32_16x16x32_bf16(af, vf[js], sacc[kb], 0, 0, 0); } }
#pragma unroll
        for (int tb = 0; tb < 4; ++tb)
#pragma unroll
            for (int i = 0; i < 4; ++i) *(LAS float*)(lds + OFF_OX + ((16 * tb + 4 * g + i) * OP + 16 * w + n) * 4) = oacc[tb][i];
        asm volatile("s_waitcnt lgkmcnt(0)" ::: "memory"); __syncthreads();
        { f32x4 ov[4];
#pragma unroll
          for (int q4 = 0; q4 < 4; ++q4) ov[q4] = *(const LAS f32x4*)(lds + OFF_OX + (vrow * OP + 16 * vg + 4 * q4) * 4);
          float ss = 0.f;
#pragma unroll
          for (int q4 = 0; q4 < 4; ++q4) ss += (ov[q4][0] * ov[q4][0] + ov[q4][1] * ov[q4][1]) + (ov[q4][2] * ov[q4][2] + ov[q4][3] * ov[q4][3]);
          ss += __shfl_xor(ss, 1); ss += __shfl_xor(ss, 2); ss += __shfl_xor(ss, 4);
          const float rs = rsqrtf(ss * (1.f / HGD) + EPS);
          const unsigned gw_[8] = {gcur0.x, gcur0.y, gcur0.z, gcur0.w, gcur1.x, gcur1.y, gcur1.z, gcur1.w};
          u32x4 o0, o1; unsigned ow[8];
#pragma unroll
          for (int e2 = 0; e2 < 8; ++e2) { const float x0 = ov[e2 >> 1][(e2 & 1) * 2], x1 = ov[e2 >> 1][(e2 & 1) * 2 + 1];
              const f32x2 go = *(const f32x2*)(a.in[I_GHG] + 16 * vg + 2 * e2); ow[e2] = cvtpk(x0 * rs * go.x * bf_lo(gw_[e2]), x1 * rs * go.y * bf_hi(gw_[e2])); }
          o0.x = ow[0]; o0.y = ow[1]; o0.z = ow[2]; o0.w = ow[3]; o1.x = ow[4]; o1.y = ow[5]; o1.z = ow[6]; o1.w = ow[7];
          if (vrow < nrow) { bf16_t* mp = (bf16_t*)(ws + WS_MIX) + (row_base + (size_t)c * 64 + vrow) * D + 2048 + h * HGD + 16 * vg; *(u32x4*)mp = o0; *(u32x4*)(mp + 8) = o1; } }
    }
#undef HG_LOAD
#pragma unroll
    for (int kb = 0; kb < 8; ++kb)
#pragma unroll
        for (int i = 0; i < 4; ++i) sout[(size_t)(16 * kb + 4 * g + i) * HGD + 16 * w + n] = sacc[kb][i];
    __syncthreads();
}
}

DI int q_next(const Frame& F, unsigned* head) {
    volatile LAS unsigned* MISC = (volatile LAS unsigned*)(F.lds + MISC_OFF);
    if ((F.wave * 64 + lane_id()) == 0) MISC[16] = __hip_atomic_fetch_add(head, 1u, RLX_AGENT);
    __syncthreads();
    const int v = (int)MISC[16];
    __syncthreads();
    return v;
}

DI void s_unit(const Frame& F, const Args& a, int unit) {
    unsigned char* ws = a.ws; const int b = unit / 34, r_ = unit % 34, mt = r_ / 17, nt = r_ % 17;
    const int wm = F.wave >> 2, wn = F.wave & 3, r32 = lane_id() & 31, hi = lane_id() >> 5;
    auto mid = [&](f32x16 (&acc)[2][2]) {
        int l2 = lane_id(); asm volatile("" : "+v"(l2));
        const float* ssk = (const float*)(ws + WS_SSK) + ((size_t)b * KPAD + nt * 256 + wn * 64 + (l2 & 31)) * 16 + 4 * (l2 >> 5);
#pragma unroll
        for (int j = 0; j < 2; ++j) { f32x4 s0 = *(const f32x4*)(ssk + (size_t)j * 32 * 16), s1 = *(const f32x4*)(ssk + (size_t)j * 32 * 16 + 8);
#pragma unroll
            for (int e = 0; e < 4; ++e) { s0[e] = rsqrtf(s0[e] * (1.f / NOPE) + EPS); s1[e] = rsqrtf(s1[e] * (1.f / NOPE) + EPS); }
#pragma unroll
            for (int i = 0; i < 2; ++i)
#pragma unroll
                for (int r = 0; r < 16; ++r) acc[i][j][r] *= ((r >> 2) & 1) ? s1[r & 3] : s0[r & 3]; }
    };
    f32x16 acc[2][2];
    sgemm_tile<2, false>((const bf16_t*)(ws + WS_QCAT) + ((size_t)b * 256 + mt * 128) * KC, KC, (const bf16_t*)(ws + WS_KCAT) + ((size_t)b * KPAD + nt * 256) * KC, KC, KC, KVL, mid, acc, F.wave, lane_id());
    float* S = (float*)(ws + WS_S) + ((size_t)b * 256 + mt * 128) * KPAD + nt * 256;
#pragma unroll
    for (int i = 0; i < 2; ++i)
#pragma unroll
        for (int j = 0; j < 2; ++j)
#pragma unroll
            for (int r = 0; r < 16; ++r) S[(size_t)(wm * 64 + i * 32 + crow(r, hi)) * KPAD + wn * 64 + j * 32 + r32] = acc[i][j][r] * ATT_SCALE;
}

constexpr int MX_HG = 64 + SB * HGH, MX_ATT = 1024, MX_S = SB * 34;
DI void p5_mixer(const Frame& F, const Args& a) {
    unsigned char* ws = a.ws; unsigned* head = (unsigned*)(ws + WS_CTL) + CW_QUEUE;
#ifndef MX_OFF_HG
    for (;;) { const int u = q_next(F, head); if (u >= MX_HG) break;
        const bool smp = u >= 64; const int v = smp ? u - 64 : u; hg::hgrn_unit(a, smp, v >> 4, v & 15, (LAS char*)F.lds, F.wave); }
#endif
#ifndef MX_OFF_ATT
    for (;;) { const int u = q_next(F, head + 64); if (u >= MX_ATT) break;
        const int qb = 15 - (u >> 6), bh = u & 63;
        att::attn_unit(bh >> 4, bh & 15, qb, (const bf16_t*)(ws + WS_Q), (const bf16_t*)(ws + WS_KN), (const bf16_t*)(ws + WS_KRN), (const bf16_t*)(ws + WS_V), (bf16_t*)(ws + WS_MIX), (LAS char*)F.lds, F.wave); }
#endif
}

DI void p6_softmax_rows(const Frame& F, const Args& a) {
    unsigned char* ws = a.ws; const int lane = lane_id();
    for (int row = F.gw; row < SB * 256; row += F.NGW) {
        const float* s = (const float*)(ws + WS_S) + (size_t)row * KPAD; bf16_t* p = (bf16_t*)(ws + WS_P) + (size_t)row * KT;
        f32x4 v[17]; float mx = -1e30f;
#pragma unroll
        for (int j = 0; j < 17; ++j) { const int idx = 4 * lane + 256 * j; if (idx < NKEY) { v[j] = *(const f32x4*)(s + idx); mx = fmaxf(mx, fmaxf(fmaxf(v[j][0], v[j][1]), fmaxf(v[j][2], v[j][3]))); } else v[j] = (f32x4){-1e30f, -1e30f, -1e30f, -1e30f}; }
#pragma unroll
        for (int o = 1; o < 64; o <<= 1) mx = fmaxf(mx, __shfl_xor(mx, o));
        float sum = 0.f;
#pragma unroll
        for (int j = 0; j < 17; ++j) { const int idx = 4 * lane + 256 * j;
#pragma unroll
            for (int e = 0; e < 4; ++e) { const float ex = idx < NKEY ? __expf(v[j][e] - mx) : 0.f; v[j][e] = ex; sum += ex; } }
        sum = wave_sum(sum); const float inv = 1.0f / sum;
#pragma unroll
        for (int j = 0; j < 17; ++j) { const int idx = 4 * lane + 256 * j; if (idx < KT) { u32x2 o; o.x = cvtpk(v[j][0] * inv, v[j][1] * inv); o.y = cvtpk(v[j][2] * inv, v[j][3] * inv); *(u32x2*)(p + idx) = o; } }
    }
}
DI void p6_late_weights(const Frame& F, const Args& a) {
    unsigned char* ws = a.ws; LAS float* scr = (LAS float*)(F.lds + F.wave * 16384);
    constexpr int I_O = (D / 64) * (D / 32), I_UP = (D / 64) * (FF2 / 32), I_DN = (FF / 64) * (D / 32), NIT = 2 * I_O + I_UP + I_DN;
    for (int it = F.gw; it < NIT; it += F.NGW) { int r = it;
        if (tr_matrix(r, a.in[I_WO], D, D, (bf16_t*)(ws + WS_WOT), D, nullptr, scr, lane_id())) continue;
        if (tr_matrix(r, a.in[I_WUP], D, FF2, (bf16_t*)(ws + WS_WUPT), D, a.in[I_GFFN], scr, lane_id())) continue;
        if (tr_matrix(r, a.in[I_WD], FF, D, (bf16_t*)(ws + WS_WDT), FF, nullptr, scr, lane_id())) continue;
        tr_matrix(r, a.in[I_WPG], D, D, (bf16_t*)(ws + WS_WGT), D, a.in[I_GPLE], scr, lane_id()); }
}
DI void p7_pv_unit(const Frame& F, const Args& a, int unit) {
    unsigned char* ws = a.ws; const int b = unit / 12, r_ = unit % 12, mt = r_ / 6, nt = (r_ % 6) / 3, ks = r_ % 3;
    f32x16 acc[2][2];
    sgemm_tile<2, false>((const bf16_t*)(ws + WS_P) + ((size_t)b * 256 + mt * 128) * KT + ks * 1408, KT, (const bf16_t*)(ws + WS_CKVT) + ((size_t)b * KVL + nt * 256) * KT + ks * 1408, KT, 1408, -1, NoMid(), acc, F.wave, lane_id());
    const int wm = F.wave >> 2, wn = F.wave & 3, r32 = lane_id() & 31, hi = lane_id() >> 5;
    float* O = (float*)(ws + WS_OLAT) + ((size_t)b * 256 + mt * 128) * KVL + nt * 256;
#pragma unroll
    for (int i = 0; i < 2; ++i)
#pragma unroll
        for (int j = 0; j < 2; ++j)
#pragma unroll
            for (int r = 0; r < 16; ++r) unsafeAtomicAdd(O + (size_t)(wm * 64 + i * 32 + crow(r, hi)) * KVL + wn * 64 + j * 32 + r32, acc[i][j][r]);
}
DI void p8_o_unit(const Frame& F, const Args& a, int unit) {
    unsigned char* ws = a.ws; const int h = unit >> 2, mt = unit & 3;
    f32x16 acc[2][1];
    sgemm_tile<1, true>((const float*)(ws + WS_OLAT) + ((size_t)(mt * 128) * 16 + h) * KVL, (size_t)16 * KVL, (const bf16_t*)(ws + WS_WUKVT) + (size_t)(2048 + h * 128) * KVL, KVL, KVL, -1, NoMid(), acc, F.wave, lane_id());
    const int wm = F.wave >> 2, wn = F.wave & 3, r32 = lane_id() & 31, hi = lane_id() >> 5;
#pragma unroll
    for (int i = 0; i < 2; ++i)
#pragma unroll
        for (int r = 0; r < 16; ++r) ((bf16_t*)(ws + WS_MIX))[((size_t)MP + mt * 128 + wm * 64 + i * 32 + crow(r, hi)) * D + h * 128 + wn * 32 + r32] = f2bf(acc[i][0][r]);
}

struct EpiWo {
    unsigned char* ws; const float* xp; const float* xs; float* out;
    DI void operator()(ACC_T, const pg8::Unit& u, int wr, int wc, int fr, int fq, int lane) const {
        const int row0 = u.pm * 256 + wr * 64 + fr, c8 = wc * 32 + 8 * fq;
#pragma unroll
        for (int ai = 0; ai < 2; ++ai)
#pragma unroll
            for (int m = 0; m < 4; ++m) { const int row = row0 + ai * 128 + m * 16; const float* xr = row < MP ? xp + (size_t)row * D : xs + (size_t)(row - MP) * D; float ss = 0.f;
#pragma unroll
                for (int bj = 0; bj < 2; ++bj) { const int col = u.pn * 256 + bj * 128 + c8; const f32x4 v0 = acc[ai][bj][m][0] + *(const f32x4*)(xr + col), v1 = acc[ai][bj][m][1] + *(const f32x4*)(xr + col + 4);
                    st_f32x8(out + (size_t)row * D + col, v0, v1); st_bf16x8((bf16_t*)(ws + WS_X1B) + (size_t)row * D + col, v0, v1); ss += dot8(v0, v1); }
                ss += __shfl_xor(ss, 16); ss += __shfl_xor(ss, 32);
                if (fq == 0) unsafeAtomicAdd((float*)(ws + OFF_SSQ2) + row, ss); }
    }
};
struct EpiUp {
    unsigned char* ws; float* out;
    DI void operator()(ACC_T, const pg8::Unit& u, int wr, int wc, int fr, int fq, int lane) const {
        const float* ssq = (const float*)(ws + OFF_SSQ2);
        const int row0 = u.pm * 256 + wr * 64 + fr, c8 = wc * 32 + 8 * fq;
#pragma unroll
        for (int ai = 0; ai < 2; ++ai)
#pragma unroll
            for (int m = 0; m < 4; ++m) { const int row = row0 + ai * 128 + m * 16; const float rs = rsqrtf(ssq[row] * (1.f / D) + EPS);
                float* cv = nullptr;
                if (row < MP) { const int t = row & (SEQ - 1); if (t >= SEQ - 2) cv = out + O_CVP + ((size_t)(row >> 12) * 2 + (t - (SEQ - 2))) * FF2; }
                else { const int sr = row - MP, t = sr & 15; if (t >= ST - 2) cv = out + O_CVS + ((size_t)(sr >> 4) * 2 + (t - (ST - 2))) * FF2; }
#pragma unroll
                for (int bj = 0; bj < 2; ++bj) { const int col = u.pn * 256 + bj * 128 + c8; const f32x4 v0 = acc[ai][bj][m][0] * rs, v1 = acc[ai][bj][m][1] * rs;
                    st_bf16x8((bf16_t*)(ws + WS_U) + (size_t)row * FF2 + col, v0, v1); if (cv) st_f32x8(cv + col, v0, v1); } }
    }
};
struct EpiDown {
    unsigned char* ws; float* out;
    DI void operator()(ACC_T, const pg8::Unit& u, int wr, int wc, int fr, int fq, int lane) const {
        const int row0 = u.pm * 256 + wr * 64 + fr, c8 = wc * 32 + 8 * fq;
#pragma unroll
        for (int ai = 0; ai < 2; ++ai)
#pragma unroll
            for (int m = 0; m < 4; ++m) { const int row = row0 + ai * 128 + m * 16; float ss = 0.f;
#pragma unroll
                for (int bj = 0; bj < 2; ++bj) { const int col = u.pn * 256 + bj * 128 + c8; float* op = out + (size_t)row * D + col; const f32x4 v0 = acc[ai][bj][m][0] + *(const f32x4*)op, v1 = acc[ai][bj][m][1] + *(const f32x4*)(op + 4);
                    st_f32x8(op, v0, v1); st_bf16x8((bf16_t*)(ws + WS_X1B) + (size_t)row * D + col, v0, v1); ss += dot8(v0, v1); }
                ss += __shfl_xor(ss, 16); ss += __shfl_xor(ss, 32);
                if (fq == 0) unsafeAtomicAdd((float*)(ws + OFF_SSQ3) + row, ss); }
    }
};
struct EpiPle {
    unsigned char* ws;
    DI void operator()(ACC_T, const pg8::Unit& u, int wr, int wc, int fr, int fq, int lane) const {
        const int row0 = u.pm * 256 + wr * 64 + fr, c8 = wc * 32 + 8 * fq;
#pragma unroll
        for (int ai = 0; ai < 2; ++ai)
#pragma unroll
            for (int m = 0; m < 4; ++m)
#pragma unroll
                for (int bj = 0; bj < 2; ++bj) st_bf16x8((bf16_t*)(ws + WS_PW) + (size_t)(row0 + ai * 128 + m * 16) * D + u.pn * 256 + bj * 128 + c8, acc[ai][bj][m][0], acc[ai][bj][m][1]);
    }
};
struct EpiGate {
    unsigned char* ws; float* out;
    DI void operator()(ACC_T, const pg8::Unit& u, int wr, int wc, int fr, int fq, int lane) const {
        const float* ssq = (const float*)(ws + OFF_SSQ3);
        const int row0 = u.pm * 256 + wr * 64 + fr, c8 = wc * 32 + 8 * fq;
#pragma unroll
        for (int ai = 0; ai < 2; ++ai)
#pragma unroll
            for (int m = 0; m < 4; ++m) { const int row = row0 + ai * 128 + m * 16; const float rs = rsqrtf(ssq[row] * (1.f / D) + EPS);
#pragma unroll
                for (int bj = 0; bj < 2; ++bj) { const int col = u.pn * 256 + bj * 128 + c8; float* op = out + (size_t)row * D + col;
                    const u32x4 pw = *(const u32x4*)((const bf16_t*)(ws + WS_PW) + (size_t)row * D + col);
                    const f32x4 x0 = *(const f32x4*)op, x1 = *(const f32x4*)(op + 4); f32x4 v0, v1;
                    const float pwf[8] = {bf_lo(pw.x), bf_hi(pw.x), bf_lo(pw.y), bf_hi(pw.y), bf_lo(pw.z), bf_hi(pw.z), bf_lo(pw.w), bf_hi(pw.w)};
#pragma unroll
                    for (int e = 0; e < 4; ++e) { v0[e] = x0[e] + pwf[e] * sigmoidf_(acc[ai][bj][m][0][e] * rs); v1[e] = x1[e] + pwf[4 + e] * sigmoidf_(acc[ai][bj][m][1][e] * rs); }
                    st_f32x8(op, v0, v1); } }
    }
};
DI void p11_conv(const Frame& F, const Args& a) {
    unsigned char* ws = a.ws; const int lane = lane_id();
    const bf16_t* U = (const bf16_t*)(ws + WS_U); bf16_t* ACTp = (bf16_t*)(ws + WS_ACT);
    constexpr int NCG = FF / 8;
    constexpr int NRC = M / 16;
    const int ncw = (NCG + 63) / 64;
    for (int it = F.gw; it < NRC * ncw; it += F.NGW) {
        const int rc = it / ncw, cg = (it % ncw) * 64 + lane; if (cg >= NCG) continue;
        const int col = cg * 8, row0 = rc * 16;
        float w[3][2][8], bsv[2][8];
#pragma unroll
        for (int j = 0; j < 3; ++j)
#pragma unroll
            for (int s = 0; s < 2; ++s) { const f32x4 x0 = *(const f32x4*)(a.in[I_CW] + (size_t)j * FF2 + s * FF + col), x1 = *(const f32x4*)(a.in[I_CW] + (size_t)j * FF2 + s * FF + col + 4);
#pragma unroll
                for (int e = 0; e < 4; ++e) { w[j][s][e] = x0[e]; w[j][s][4 + e] = x1[e]; } }
#pragma unroll
        for (int s = 0; s < 2; ++s) { const f32x4 x0 = *(const f32x4*)(a.in[I_CB] + s * FF + col), x1 = *(const f32x4*)(a.in[I_CB] + s * FF + col + 4);
#pragma unroll
            for (int e = 0; e < 4; ++e) { bsv[s][e] = x0[e]; bsv[s][4 + e] = x1[e]; } }
        float h2[2][8], h1[2][8];
        const bool smp = row0 >= MP; const int tseq = smp ? ((row0 - MP) & 15) : (row0 & (SEQ - 1));
#pragma unroll
        for (int s = 0; s < 2; ++s) {
            if (tseq == 0) {
                if (smp) { const float* hs = a.in[I_SCV] + ((size_t)((row0 - MP) >> 4) * 2) * FF2 + s * FF + col;
                    const f32x4 a0 = *(const f32x4*)hs, a1 = *(const f32x4*)(hs + 4), b0 = *(const f32x4*)(hs + FF2), b1 = *(const f32x4*)(hs + FF2 + 4);
#pragma unroll
                    for (int e = 0; e < 4; ++e) { h2[s][e] = a0[e]; h2[s][4 + e] = a1[e]; h1[s][e] = b0[e]; h1[s][4 + e] = b1[e]; } }
                else {
#pragma unroll
                    for (int e = 0; e < 8; ++e) { h2[s][e] = 0.f; h1[s][e] = 0.f; } }
            } else { const u32x4 a_ = *(const u32x4*)(U + (size_t)(row0 - 2) * FF2 + s * FF + col), b_ = *(const u32x4*)(U + (size_t)(row0 - 1) * FF2 + s * FF + col);
                h2[s][0] = bf_lo(a_.x); h2[s][1] = bf_hi(a_.x); h2[s][2] = bf_lo(a_.y); h2[s][3] = bf_hi(a_.y); h2[s][4] = bf_lo(a_.z); h2[s][5] = bf_hi(a_.z); h2[s][6] = bf_lo(a_.w); h2[s][7] = bf_hi(a_.w);
                h1[s][0] = bf_lo(b_.x); h1[s][1] = bf_hi(b_.x); h1[s][2] = bf_lo(b_.y); h1[s][3] = bf_hi(b_.y); h1[s][4] = bf_lo(b_.z); h1[s][5] = bf_hi(b_.z); h1[s][6] = bf_lo(b_.w); h1[s][7] = bf_hi(b_.w); }
        }
#pragma unroll 4
        for (int t = 0; t < 16; ++t) { const size_t row = (size_t)row0 + t; float cur[2][8], c[2][8];
#pragma unroll
            for (int s = 0; s < 2; ++s) { const u32x4 u_ = *(const u32x4*)(U + row * FF2 + s * FF + col);
                cur[s][0] = bf_lo(u_.x); cur[s][1] = bf_hi(u_.x); cur[s][2] = bf_lo(u_.y); cur[s][3] = bf_hi(u_.y); cur[s][4] = bf_lo(u_.z); cur[s][5] = bf_hi(u_.z); cur[s][6] = bf_lo(u_.w); cur[s][7] = bf_hi(u_.w);
#pragma unroll
                for (int e = 0; e < 8; ++e) { c[s][e] = bsv[s][e] + w[0][s][e] * h2[s][e] + w[1][s][e] * h1[s][e] + w[2][s][e] * cur[s][e]; h2[s][e] = h1[s][e]; h1[s][e] = cur[s][e]; } }
            float o[8];
#pragma unroll
            for (int e = 0; e < 8; ++e) o[e] = c[0][e] / (1.0f + __expf(-c[0][e])) * c[1][e];
            u32x4 ov; ov.x = cvtpk(o[0], o[1]); ov.y = cvtpk(o[2], o[3]); ov.z = cvtpk(o[4], o[5]); ov.w = cvtpk(o[6], o[7]);
            *(u32x4*)(ACTp + row * FF + col) = ov; }
    }
    for (int row = F.gw; row < M; row += F.NGW) { const float* src = row < MP ? a.in[I_PP] + (size_t)row * PLE : a.in[I_PS] + (size_t)(row - MP) * PLE; const f32x4 v = *(const f32x4*)(src + 4 * lane);
        u32x2 o; o.x = cvtpk(v[0], v[1]); o.y = cvtpk(v[2], v[3]); *(u32x2*)((bf16_t*)(ws + WS_PB) + (size_t)row * PLE + 4 * lane) = o; }
    { LAS float* scr = (LAS float*)(F.lds + F.wave * 16384); constexpr int NIT = (PLE / 64) * (D / 32);
      for (int it = F.gw; it < NIT; it += F.NGW) { int r = it; tr_matrix(r, a.in[I_WPLE], PLE, D, (bf16_t*)(ws + WS_WPT), PLE, nullptr, scr, lane); } }
}
constexpr int LAST_PHASE = 15;

constexpr int NPHASE = 15;
__global__ void __launch_bounds__(512, 2) fwd(Args args) {
    extern __shared__ __attribute__((aligned(16))) unsigned char lds_raw[];
    Frame F;
    F.lds = (LAS unsigned char*)lds_raw;
    F.wave = __builtin_amdgcn_readfirstlane(threadIdx.x >> 6);
    F.G = gridDim.x; { const int bx = blockIdx.x; F.vcu = (F.G % 8 == 0) ? (bx % 8) * (F.G / 8) + bx / 8 : bx; }
    F.gw = F.vcu * 8 + F.wave; F.NGW = F.G * 8;
    volatile LAS unsigned* MISC = (volatile LAS unsigned*)(F.lds + MISC_OFF);
    if (F.wave == 0) { const int l0 = lane_id(); if (l0 < 32) MISC[l0] = 0u; }
    __syncthreads();
    unsigned char* ws = args.ws;
    unsigned* ctl = (unsigned*)(ws + WS_CTL);
    const int lo = args.ph_lo, hi = args.ph_hi;
    XcdBarrier bar; bar.bar = ctl + CW_BAR; bar.x = 0; bar.st = nullptr;
    if (hi - lo > 1) bar = xcd_barrier_post(ctl + CW_BAR, MISC + 8, F.wave == 0 && lane_id() == 0);
#define IN(k) (lo <= (k) && (k) < hi)
#ifndef PH_MASK
#define PH_MASK 0xffff
#endif
#define PH_EN(k) (((PH_MASK) >> (k)) & 1)
#define SEAM(k) do { if (IN(k) && IN((k) + 1)) xcd_barrier(bar, F.wave == 0 && lane_id() == 0); } while (0)

    if (PH_EN(0) && IN(0)) { p0_prologue(F, args);
#ifdef ZERO_OUT
        zero16(args.out, (size_t)M * D * 4, F.gw, F.NGW, lane_id()); zero16(args.out + O_HGP, (size_t)(O_CKVS - O_HGP) * 4, F.gw, F.NGW, lane_id()); zero16(args.out + O_HGS, (size_t)(O_END - O_HGS) * 4, F.gw, F.NGW, lane_id());
#endif
    }
    SEAM(0);
    if (PH_EN(1) && IN(1)) {
        { pg8::Gemm g{(const bf16_t*)(ws + WS_XB), (const bf16_t*)(ws + WS_WINT), D, D, D}; pg8::StaticOrder S; S.init(M / 256, NIN / 256, F.G, (int)blockIdx.x);
          EpiInProj E{ws}; pg8::gemm_phase(F.lds, g, S, E, F.wave); }
        { pg8::Gemm g{(const bf16_t*)(ws + WS_KCAT), (const bf16_t*)(ws + WS_WUKVT), KC, KVL, KVL}; pg8::MappedOrder S; S.init(SB * 16, 8, F.G, (int)blockIdx.x); S.per = 16; S.stride = 17; S.off = 0;
          EpiSumsq E{ws}; pg8::gemm_phase(F.lds, g, S, E, F.wave); }
    }
    SEAM(1);
    if (PH_EN(2) && IN(2)) {
        p2_norm_rows(F, args);
        { pg8::Gemm g{(const bf16_t*)(ws + WS_CQ), (const bf16_t*)(ws + WS_WUQT), QL, QL, QL}; pg8::StaticOrder S; S.init(M / 256, 3072 / 256, F.G, (int)blockIdx.x);
          EpiUq E{ws}; pg8::gemm_phase(F.lds, g, S, E, F.wave); }
    }
    SEAM(2);
    if (PH_EN(3) && IN(3)) {
        p3_qnorm_rows(F, args);
        { pg8::Gemm g{(const bf16_t*)(ws + WS_CKVN), (const bf16_t*)(ws + WS_WUKVT), KVL, KVL, KVL}; pg8::StaticOrder S; S.init(MP / 256, 16, F.G, (int)blockIdx.x);
          EpiKup E{ws}; pg8::gemm_phase(F.lds, g, S, E, F.wave); }
        { pg8::Gemm g{(const bf16_t*)(ws + WS_KCAT), (const bf16_t*)(ws + WS_WUKVT), KC, KVL, KVL}; pg8::MappedOrder S; S.init(SB, 8, F.G, (int)blockIdx.x); S.per = 1; S.stride = 17; S.off = 16;
          EpiSumsq E{ws}; pg8::gemm_phase(F.lds, g, S, E, F.wave); }
    }
    SEAM(3);
    if (PH_EN(4) && IN(4)) { p4_knorm_rows(F, args); for (int u = blockIdx.x; u < 128; u += F.G) p4_qa_unit(F, args, u); }
    SEAM(4);
    if (PH_EN(5) && IN(5)) { p5_mixer(F, args); }
    SEAM(5);
    if (PH_EN(6) && IN(6)) { for (int u = blockIdx.x; u < MX_S; u += F.G) s_unit(F, args, u); p6_late_weights(F, args); }
    SEAM(6);
    if (PH_EN(7) && IN(7)) { p6_softmax_rows(F, args); }
    SEAM(7);
    if (PH_EN(8) && IN(8)) { for (int u = blockIdx.x; u < SB * 12; u += F.G) p7_pv_unit(F, args, u); }
    SEAM(8);
    if (PH_EN(9) && IN(9)) { for (int u = blockIdx.x; u < 64; u += F.G) p8_o_unit(F, args, u); }
    SEAM(9);
    if (PH_EN(10) && IN(10)) { pg8::Gemm g{(const bf16_t*)(ws + WS_MIX), (const bf16_t*)(ws + WS_WOT), D, D, D}; pg8::StaticOrder S; S.init(M / 256, D / 256, F.G, (int)blockIdx.x);
        EpiWo E{ws, args.in[I_XP], args.in[I_XS], args.out}; pg8::gemm_phase(F.lds, g, S, E, F.wave); }
    SEAM(10);
    if (PH_EN(11) && IN(11)) { pg8::Gemm g{(const bf16_t*)(ws + WS_X1B), (const bf16_t*)(ws + WS_WUPT), D, D, D}; pg8::StaticOrder S; S.init(M / 256, FF2 / 256, F.G, (int)blockIdx.x);
        EpiUp E{ws, args.out}; pg8::gemm_phase(F.lds, g, S, E, F.wave); }
    SEAM(11);
    if (PH_EN(12) && IN(12)) { p11_conv(F, args); }
    SEAM(12);
    if (PH_EN(13) && IN(13)) {
        { pg8::Gemm g{(const bf16_t*)(ws + WS_ACT), (const bf16_t*)(ws + WS_WDT), FF, FF, FF}; pg8::StaticOrder S; S.init(M / 256, D / 256, F.G, (int)blockIdx.x);
          EpiDown E{ws, args.out}; pg8::gemm_phase(F.lds, g, S, E, F.wave); }
        { pg8::Gemm g{(const bf16_t*)(ws + WS_PB), (const bf16_t*)(ws + WS_WPT), PLE, PLE, PLE}; pg8::StaticOrder S; S.init(M / 256, D / 256, F.G, (int)blockIdx.x);
          EpiPle E{ws}; pg8::gemm_phase(F.lds, g, S, E, F.wave); }
    }
    SEAM(13);
    if (PH_EN(14) && IN(14)) { pg8::Gemm g{(const bf16_t*)(ws + WS_X1B), (const bf16_t*)(ws + WS_WGT), D, D, D}; pg8::StaticOrder S; S.init(M / 256, D / 256, F.G, (int)blockIdx.x);
        EpiGate E{ws, args.out}; pg8::gemm_phase(F.lds, g, S, E, F.wave); }
#undef IN
#undef SEAM
}

extern "C" void kernel_launch(void* const* d_in, const int* in_sizes, int n_in, void* d_out, int out_size, void* d_ws, size_t ws_size, hipStream_t stream) {
    static int grid = 0;
    if (grid == 0) {
        if (n_in != 30 || (size_t)out_size != O_END || ws_size < WS_NEED) { fprintf(stderr, "kernel_launch: unexpected problem: n_in %d out %d ws %zu (need %zu); nothing launched\n", n_in, out_size, ws_size, (size_t)WS_NEED); grid = -1; return; }
        int dev = 0, cus = 0, per_cu = 0;
        if (hipGetDevice(&dev) != hipSuccess || hipDeviceGetAttribute(&cus, hipDeviceAttributeMultiprocessorCount, dev) != hipSuccess) { grid = -1; return; }
        if (hipFuncSetAttribute((const void*)fwd, hipFuncAttributeMaxDynamicSharedMemorySize, LDS_BYTES) != hipSuccess) { fprintf(stderr, "kernel_launch: hipFuncSetAttribute failed\n"); grid = -1; return; }
        if (hipOccupancyMaxActiveBlocksPerMultiprocessor(&per_cu, (const void*)fwd, 512, LDS_BYTES) != hipSuccess || per_cu < 1) fprintf(stderr, "kernel_launch: occupancy query says %d\n", per_cu);
        (void)hipGetLastError();
        grid = cus;
    }
    if (grid < 0) return;
    (void)hipMemsetAsync((char*)d_ws + WS_CTL, 0, CTL_BYTES, stream);
    Args a{};
    for (int i = 0; i < 30; ++i) a.in[i] = (const float*)d_in[i];
    a.out = (float*)d_out; a.ws = (unsigned char*)d_ws;
    for (int i = 0; i < 32; ++i) { const float p = (float)pow(10000.0, (double)i / 32.0); a.inv[i] = 1.0f / p; }
#ifndef N_LAUNCH_SPLIT
#define N_LAUNCH_SPLIT 1
#endif
#if N_LAUNCH_SPLIT
    for (int p = 0; p < LAST_PHASE; ++p) { a.ph_lo = p; a.ph_hi = p + 1; hipLaunchKernelGGL(fwd, dim3(grid), dim3(512), LDS_BYTES, stream, a);
#ifdef SELFCHECK
        hipLaunchKernelGGL(check_kernel, dim3(64), dim3(64), 0, stream, a, p);
        if (p == 5) hipLaunchKernelGGL(check_hgrn, dim3(8), dim3(128), 0, stream, a);
#endif
    }
#ifdef SELFCHECK
    hipLaunchKernelGGL(report_kernel, dim3(1), dim3(64), 0, stream, a);
#endif
#else
    a.ph_lo = 0; a.ph_hi = LAST_PHASE; hipLaunchKernelGGL(fwd, dim3(grid), dim3(512), LDS_BYTES, stream, a);
#endif
}
```

```cpp
#include <hip/hip_runtime.h>
#include <cstdio>
#include <cstdint>
#include <cmath>

#define LAS __attribute__((address_space(3)))
#define GAS __attribute__((address_space(1)))
typedef unsigned short bf16_t;
typedef short bf16x8 __attribute__((ext_vector_type(8)));
typedef short s16x4 __attribute__((ext_vector_type(4)));
typedef float f32x2 __attribute__((ext_vector_type(2)));
typedef float f32x4 __attribute__((ext_vector_type(4)));
typedef float f32x16 __attribute__((ext_vector_type(16)));
typedef unsigned u32x2 __attribute__((ext_vector_type(2)));
typedef unsigned u32x4 __attribute__((ext_vector_type(4)));
typedef __bf16 bf16x2_t __attribute__((ext_vector_type(2)));
typedef GAS unsigned gu32;
#define RLX_AGENT __ATOMIC_RELAXED, __HIP_MEMORY_SCOPE_AGENT
#define DI __device__ __forceinline__

DI unsigned cvtpk(float lo, float hi) { f32x2 v = {lo, hi}; bf16x2_t b = __builtin_convertvector(v, bf16x2_t); return __builtin_bit_cast(unsigned, b); }
DI float bf_lo(unsigned w) { return __uint_as_float(w << 16); }
DI float bf_hi(unsigned w) { return __uint_as_float(w & 0xffff0000u); }
DI float bf2f(bf16_t b) { return __uint_as_float(((unsigned)b) << 16); }
DI bf16_t f2bf(float f) { return (bf16_t)(cvtpk(f, 0.f) & 0xffffu); }
typedef int i32x8 __attribute__((ext_vector_type(8)));
typedef int i32x4 __attribute__((ext_vector_type(4)));
DI unsigned pk4_fp8(float a, float b, float c, float d) { int w = 0; w = __builtin_amdgcn_cvt_pk_fp8_f32(a, b, w, false); w = __builtin_amdgcn_cvt_pk_fp8_f32(c, d, w, true); return (unsigned)w; }
DI u32x4 pack8(f32x4 a, f32x4 b) { u32x4 w; w.x = cvtpk(a[0], a[1]); w.y = cvtpk(a[2], a[3]); w.z = cvtpk(b[0], b[1]); w.w = cvtpk(b[2], b[3]); return w; }
DI float wave_sum(float v) {
#pragma unroll
    for (int o = 1; o < 64; o <<= 1) v += __shfl_xor(v, o);
    return v;
}
DI int lane_id() { int l; asm volatile("v_mbcnt_lo_u32_b32 %0, -1, 0\n\tv_mbcnt_hi_u32_b32 %0, -1, %0" : "=v"(l)); return l; }
DI float sigmoidf_(float x) { return 1.0f / (1.0f + __expf(-x)); }

constexpr int D = 4096, NB = 4, SEQ = 4096, MP = NB * SEQ, SB = 32, ST = 16, MS = SB * ST, M = MP + MS;
constexpr int PAST = 4096, NKEY = PAST + ST  , KPAD = 4352  , KT = 4224  ;
constexpr int QL = 1024, KVL = 512, ROPE = 64, NOPE = 128, NH = 16, QH = NOPE + ROPE  , KC = KVL + ROPE  ;
constexpr int HGW = 2048, HGH = 16, HGD = 128;
constexpr int FF = 11008, FF2 = 22016, PLE = 256;
constexpr int NIN = 9984;
constexpr float EPS = 1e-6f;
constexpr float ATT_SCALE = 0.07216878364870322f;

constexpr size_t O_Y = 0, O_CKVP = (size_t)M * D, O_KRP = O_CKVP + (size_t)MP * KVL, O_HGP = O_KRP + (size_t)MP * ROPE, O_CVP = O_HGP + (size_t)NB * HGH * HGD * HGD,
                 O_CKVS = O_CVP + (size_t)NB * 2 * FF2, O_KRS = O_CKVS + (size_t)MS * KVL, O_HGS = O_KRS + (size_t)MS * ROPE, O_CVS = O_HGS + (size_t)SB * HGH * HGD * HGD, O_END = O_CVS + (size_t)SB * 2 * FF2;
static_assert(O_END == 89960448, "output size");

constexpr float SC8_K = 16.f, SC8_W = 256.f;
constexpr size_t OS_XB = 0  ,
                 OS_S = (size_t)132 << 20  ;
constexpr size_t OS_XB8 = (size_t)132 << 20  , OS_WIN8 = (size_t)200 << 20  ;
constexpr float SC8_X0 = 8.f, SC8_WI = 1024.f;
static_assert(OS_XB8 + (size_t)M * D <= OS_WIN8 && OS_WIN8 + (size_t)QL * D <= (size_t)M * D * 4, "d_out scratch (fp8 in-projection operands)");
constexpr int SPITCH = 4224;
static_assert((size_t)M * D * 2 <= OS_S && OS_S + (size_t)SB * 256 * SPITCH * 4 <= (size_t)M * D * 4 && NKEY <= SPITCH, "d_out scratch");
constexpr size_t MiB = (size_t)1 << 20;
constexpr size_t WS_CTL = 0, CTL_BYTES = 2 * MiB;
constexpr int CW_TMO = 0, CW_BAR = 4096, CW_QUEUE = 16384  ;
constexpr size_t OFF_SSQ1 = 256 * 1024, OFF_SSQQ = 384 * 1024, OFF_SSQ2 = 512 * 1024, OFF_SSQ3 = 640 * 1024, OFF_LB = 768 * 1024;
constexpr size_t WS_WINT = 2 * MiB, WS_XB = 80 * MiB, WS_MIX = 2 * MiB, WS_S = 134 * MiB, WS_P = 270 * MiB, WS_CKVT = 336 * MiB, WS_KCAT = 468 * MiB, WS_OLAT = 621 * MiB, WS_SSK = 637 * MiB,
                 WS_QCAT = 646 * MiB, WS_WUKVT = 655 * MiB, WS_WUKN = 659 * MiB, WS_WUQT = 661 * MiB, WS_ROPE = 667 * MiB, WS_CKVN = 669 * MiB, WS_KRN = 686 * MiB,
                 WS_HQ = 712 * MiB, WS_HK = 778 * MiB, WS_HV = 844 * MiB, WS_HG = 910 * MiB, WS_LF = 976 * MiB, WS_Q = 1108 * MiB, WS_KN = 1207 * MiB, WS_V = 1271 * MiB,
                 WS_CQ = 1335 * MiB, WS_CKVRAW = 1368 * MiB, WS_KRRAW = 1401 * MiB, WS_EARLY_END = 1406 * MiB;
constexpr size_t WS_U = 2 * MiB, WS_ACT = 160 * MiB  , WS_WUPT = 712 * MiB, WS_WOT = 884 * MiB, WS_WDT = 1067 * MiB, WS_WGT = 1153 * MiB, WS_X1B = 1185 * MiB, WS_WPT = 1415 * MiB, WS_PB = 1406 * MiB  , WS_PW = 2 * MiB;
constexpr size_t WS_X2F8 = 916 * MiB  , WS_WG8 = 984 * MiB  ;
constexpr float SC8_X = 8.f, SC8_G = 1024.f;
static_assert(WS_X2F8 >= 916 * MiB && WS_X2F8 + (size_t)M * D <= WS_WG8 && WS_WG8 + (size_t)D * D <= 1067 * MiB, "fp8 gate operands");
constexpr size_t WS_CQ8 = 134 * MiB  , WS_WUQ8 = 152 * MiB  , WS_CKVN8 = 156 * MiB  ,
                 WS_WUKV8 = 166 * MiB  ;
constexpr size_t WS_QCAT8 = 168 * MiB  , WS_KC8 = 270 * MiB  ;
constexpr float SC8_QA = 32.f;
static_assert(WS_WUKV8 + (size_t)4096 * KVL <= WS_QCAT8 && WS_QCAT8 + (size_t)SB * 256 * KVL <= 212 * MiB && WS_KC8 >= 212 * MiB + (size_t)224 * 65536 * 4 && WS_KC8 + (size_t)SB * PAST * KVL <= 336 * MiB, "early fp8 (2)");
constexpr float SC8_Q = 512.f;
constexpr float SC8_A = 16.f;
static_assert(WS_CQ8 + (size_t)M * QL <= WS_WUQ8 && WS_WUQ8 + (size_t)3072 * QL <= WS_CKVN8 && WS_CKVN8 + (size_t)M * KVL <= WS_WUKV8 && WS_WUKV8 + (size_t)4096 * KVL <= 212 * MiB, "early fp8");
constexpr size_t WS_UH = 136 * MiB;
static_assert(WS_UH >= WS_PW + (size_t)M * D * 2 && WS_UH + (size_t)64 * 4 * FF2 * 4 <= WS_ACT, "UH");
constexpr size_t WS_SLAB_EARLY = 212 * MiB, WS_SLAB_LATE = 1328 * MiB;
constexpr size_t WS_NEED = 1417 * MiB;
static_assert(WS_SLAB_EARLY >= WS_XB + (size_t)M * D * 2 && WS_SLAB_EARLY + 64 * MiB <= WS_CKVT && WS_SLAB_LATE + 64 * MiB <= WS_PB, "slabs");
static_assert(WS_WINT + (size_t)NIN * D * 2 <= WS_XB && WS_XB + (size_t)M * D * 2 <= WS_CKVT, "early A region");
static_assert(WS_MIX + (size_t)M * D * 2 <= WS_S && WS_S + (size_t)SB * 256 * KPAD * 4 <= WS_P && WS_P + (size_t)SB * 256 * KT * 2 <= WS_CKVT, "mix/S/P");
static_assert(WS_CKVT + (size_t)SB * KVL * KT * 2 <= WS_KCAT && WS_KCAT + (size_t)SB * KPAD * KC * 2 <= WS_OLAT && WS_OLAT + (size_t)SB * 256 * KVL * 4 <= WS_SSK && WS_SSK + (size_t)SB * KPAD * 16 * 4 <= WS_QCAT, "ckvT/Kcat/OLAT/SSK");
static_assert(WS_QCAT + (size_t)SB * 256 * KC * 2 <= WS_WUKVT && WS_WUKVT + (size_t)4096 * 512 * 2 <= WS_WUKN && WS_WUKN + (size_t)512 * 2048 * 2 <= WS_WUQT && WS_WUQT + (size_t)3072 * 1024 * 2 <= WS_ROPE, "small early");
static_assert(WS_ROPE + (size_t)NKEY * 64 * 4 <= WS_CKVN && WS_CKVN + (size_t)M * KVL * 2 <= WS_KRN && WS_KRN + (size_t)M * ROPE * 2 <= WS_HQ, "rope/ckvn/krn");
static_assert(WS_HQ + (size_t)M * HGW * 2 <= WS_HK && WS_HG + (size_t)M * HGW * 2 <= WS_LF && WS_LF + (size_t)M * HGW * 4 <= WS_Q && WS_Q + (size_t)M * 3072 * 2 <= WS_KN && WS_KN + (size_t)MP * 2048 * 2 <= WS_V && WS_V + (size_t)MP * 2048 * 2 <= WS_CQ, "hgrn/q/k/v");
static_assert(WS_CQ + (size_t)M * QL * 2 <= WS_CKVRAW && WS_CKVRAW + (size_t)M * KVL * 4 <= WS_KRRAW && WS_KRRAW + (size_t)M * ROPE * 4 <= WS_EARLY_END, "cq/raw");
static_assert(WS_U + (size_t)M * FF2 * 2 <= WS_WUPT && WS_ACT + (size_t)M * FF * 2 <= WS_U + (size_t)MP * FF2 * 2 && WS_WUPT + (size_t)FF2 * D * 2 <= WS_WOT && WS_WOT + (size_t)D * D * 2 <= WS_WDT, "late 1");
static_assert(WS_WDT + (size_t)D * FF * 2 <= WS_WGT && WS_WGT + (size_t)D * D * 2 <= WS_X1B && WS_X1B + (size_t)M * D * 2 <= WS_SLAB_LATE && WS_PB >= WS_EARLY_END && WS_PB + (size_t)M * PLE * 2 <= WS_WPT && WS_WPT + (size_t)D * PLE * 2 <= WS_NEED, "late 2");

constexpr int RING_BYTES = 131072;
constexpr int XCH_OFF = RING_BYTES, XCH_BYTES = 12288;
constexpr int MISC_OFF = XCH_OFF + XCH_BYTES;
constexpr int LDS_BYTES = 147456;
static_assert(MISC_OFF + 128 <= LDS_BYTES, "LDS map");
#define N_LAUNCH_SPLIT 0

namespace pg8 {
constexpr int BM = 256, BK = 64, HALF = 128, HTB = HALF * BK * 2  , STAGE_BYTES = 8 * HTB, NXCD = 8, WGM = 8;
static_assert(STAGE_BYTES == RING_BYTES, "stage region");
__host__ __device__ __forceinline__ int lds_byte(int r, int c) { const int st = (r >> 4) * 2 + (c >> 5), rr = r & 15, cc = c & 31, ob = rr * 64 + cc * 2; return st * 1024 + (ob ^ (((ob >> 9) & 1) << 5)); }
__host__ __device__ __forceinline__ void stage_rc(int b, int& R, int& C) { const int st = b / 1024, sb = b % 1024, swz = sb ^ (((sb >> 9) & 1) << 5); R = (st >> 1) * 16 + swz / 64; C = (st & 1) * 32 + (swz % 64) / 2; }
__host__ __device__ __forceinline__ int perm32(int rho) { const int n = rho >> 4, i = rho & 15; return 8 * (i >> 2) + 4 * n + (i & 3); }

struct Unit { int pm, pn, koff, nt, sub; };
struct Gemm { const bf16_t* A; const bf16_t* Bt; int lda, ldb, K; float* slab; };

struct StaticOrder {
    int nM, nN, nwg, G, c, knt, nM1 = 0, rot = 0;
    __host__ __device__ __forceinline__ void init(int nM_, int nN_, int G_, int c_, int K_) { nM = nM_; nN = nN_; nwg = nM * nN; G = G_; c = c_; knt = K_ / BK; }
    __host__ __device__ __forceinline__ void tile(int L, Unit& u) const {
        const int nMa = nM1 > 0 ? nM1 : nM, nwa = nMa * nN;
        if (L >= nwa) { const int r = L - nwa, nr = nM - nMa; u.pm = nMa + r % nr; u.pn = r / nr; u.koff = 0; u.nt = knt; u.sub = -1; return; }
        int wgid = L; { const int q = nwa / NXCD, r = nwa % NXCD, xcd = wgid % NXCD, off = wgid / NXCD; wgid = (xcd < r ? xcd * (q + 1) : r * (q + 1) + (xcd - r) * q) + off; }
        const int nig = WGM * nN, gid = wgid / nig, fm = gid * WGM, gsz = (nMa - fm) < WGM ? (nMa - fm) : WGM;
        u.pm = fm + ((wgid % nig) % gsz); u.pn = (wgid % nig) / gsz; u.koff = 0; u.nt = knt; u.sub = -1;
        if (rot > 0) u.pm = u.pm < rot ? nM - rot + u.pm : u.pm - rot;
    }
    __host__ __device__ __forceinline__ bool next(int i, Unit& u) const { const long L = (long)i * G + c; if (L >= nwg) return false; tile((int)L, u); return true; }
};
struct SplitOrder : StaticOrder {
    int R, Lft, ns, kb;
    __host__ __device__ __forceinline__ void init(int nM_, int nN_, int G_, int c_, int K_) { StaticOrder::init(nM_, nN_, G_, c_, K_); R = nwg / G; Lft = nwg % G; ns = 1; kb = K_ / 128;
        if (Lft > 0) { const int k128 = K_ / 128; int s = G / Lft; if (s > k128 / 2) s = k128 / 2; if (s < 1) s = 1; kb = (k128 + s - 1) / s; if (k128 % kb == 1) ++kb; ns = (k128 + kb - 1) / kb; } }
    __host__ __device__ __forceinline__ bool next(int i, Unit& u) const {
        if (i < R) { tile(i * G + c, u); return true; }
        if (i > R || ns <= 1) { if (i == R && ns <= 1) { const long L = (long)i * G + c; if (L >= nwg) return false; tile((int)L, u); return true; } return false; }
        if (c >= Lft * ns) return false;
        const int l = c / ns, sl = c % ns; tile(R * G + l, u); const int k128 = knt / 2; u.koff = sl * kb * 128; const int nb = (k128 - sl * kb) < kb ? (k128 - sl * kb) : kb; u.nt = nb * 2; u.sub = c; return true; }
};
struct MappedOrder : StaticOrder {
    int per, stride, off;
    __host__ __device__ __forceinline__ bool next(int i, Unit& u) const { if (!StaticOrder::next(i, u)) return false; u.pm = (u.pm / per) * stride + off + (u.pm % per); return true; }
};

struct BatchOrder {
    int n, G, c, per, mode, kslice;
    int knt;
    __host__ __device__ __forceinline__ bool next(int i, Unit& u) const { const int L = i * G + c; if (L >= n) return false; const int b = L / per, r = L % per;
        u.pm = b; u.nt = knt; u.sub = -1; if (mode == 0) { u.pn = b * 17 + r; u.koff = 0; } else if (mode == 2) { u.pn = b * per + r; u.koff = 0; } else { u.pn = 2 * b + r / 3; u.koff = (r % 3) * kslice; } return true; }
};
struct OneBatchOrder {
    int b, per, knt, first = 0;
    __host__ __device__ __forceinline__ bool next(int i, Unit& u) const { if (first + i >= per) return false; u.pm = b; u.pn = b * per + first + i; u.koff = 0; u.nt = knt; u.sub = -1; return true; }
};
template <bool ALIGN_EPI = true, bool FP8 = false, class Epi, class Sched>
__device__ __forceinline__ void gemm_phase(LAS unsigned char* lds, const Gemm g, const Sched& S, const Epi& E, int wid) {
    const int lane = lane_id(), tid = wid * 64 + lane, wr = wid >> 2, wc = wid & 3, fr = lane & 15, fq = lane >> 4;
    unsigned voffA[2], voffB[2];
#pragma unroll
    for (int i = 0; i < 2; ++i) { int R, C; stage_rc(tid * 16 + i * 8192, R, C); const int Rb = (R & ~31) + perm32(R & 31);
        voffA[i] = (unsigned)(R * g.lda + C) * 2u; voffB[i] = (unsigned)(Rb * g.ldb + C) * 2u; }
    const size_t kstep = (size_t)(BK * 2);
    const size_t hstepA = (size_t)HALF * g.lda * 2, hstepB = (size_t)HALF * g.ldb * 2;
    const size_t tstepA = 2 * hstepA, tstepB = 2 * hstepB;
    const unsigned ldsw = (unsigned)wid * 1024u;
    const int aoff = lds_byte(wr * 64 + fr, fq * 8), boff = lds_byte(wc * 32 + fr, fq * 8);
#define PG8_SA(b, h) (((b) * 2 + (h)) * HTB)
#define PG8_SB(b, h) ((4 + (b) * 2 + (h)) * HTB)
#define PG8_STAGE(bufoff, gbase, voff) do { _Pragma("unroll") for (int _i = 0; _i < 2; ++_i) \
        __builtin_amdgcn_global_load_lds((const unsigned*)((const char*)(gbase) + (voff)[_i]), (LAS unsigned*)(lds + (bufoff) + ldsw + _i * 8192), 16, 0, 0); } while (0)
#define PG8_LDA(dst, b, h) do { if constexpr (FP8) { _Pragma("unroll") for (int m = 0; m < 4; ++m) { dst##8[m].lo = *(const LAS i32x4*)(lds + PG8_SA(b, h) + aoff + m * 2048); dst##8[m].hi = *(const LAS i32x4*)(lds + PG8_SA(b, h) + aoff + m * 2048 + 1024); } } else { \
        _Pragma("unroll") for (int m = 0; m < 4; ++m) _Pragma("unroll") for (int k = 0; k < 2; ++k) dst[m][k] = *(const LAS bf16x8*)(lds + PG8_SA(b, h) + aoff + m * 2048 + k * 1024); } } while (0)
#define PG8_LDB(dst, b, h) do { if constexpr (FP8) { _Pragma("unroll") for (int n = 0; n < 2; ++n) { dst##8[n].lo = *(const LAS i32x4*)(lds + PG8_SB(b, h) + boff + n * 2048); dst##8[n].hi = *(const LAS i32x4*)(lds + PG8_SB(b, h) + boff + n * 2048 + 1024); } } else { \
        _Pragma("unroll") for (int n = 0; n < 2; ++n) _Pragma("unroll") for (int k = 0; k < 2; ++k) dst[n][k] = *(const LAS bf16x8*)(lds + PG8_SB(b, h) + boff + n * 2048 + k * 1024); } } while (0)
#define PG8_MMA(ai, bj, At, Bt) do { __builtin_amdgcn_s_setprio(1); if constexpr (FP8) { _Pragma("unroll") for (int m = 0; m < 4; ++m) _Pragma("unroll") for (int n = 0; n < 2; ++n) \
        asm volatile("v_mfma_f32_16x16x128_f8f6f4 %0, %1, %2, %0" : "+v"(acc[ai][bj][m][n]) : "v"(Bt##8[n]), "v"(At##8[m])); } else { \
        _Pragma("unroll") for (int m = 0; m < 4; ++m) _Pragma("unroll") for (int n = 0; n < 2; ++n) _Pragma("unroll") for (int k = 0; k < 2; ++k) \
        acc[ai][bj][m][n] = __builtin_amdgcn_mfma_f32_16x16x32_bf16(Bt[n][k], At[m][k], acc[ai][bj][m][n], 0, 0, 0); } __builtin_amdgcn_s_setprio(0); } while (0)
#define PG8_WAIT_V(n) asm volatile("s_waitcnt vmcnt(" #n ")" ::: "memory")
#define PG8_WAIT_L(n) asm volatile("s_waitcnt lgkmcnt(" #n ")" ::: "memory")
#define PG8_BAR __builtin_amdgcn_s_barrier()
#define PG8_SCHED __builtin_amdgcn_sched_barrier(0)
    Unit cur, nxt; int ui = 0;
    if (!S.next(0, cur)) return;
    f32x4 acc[2][2][4][2];
#pragma unroll
    for (int a = 0; a < 2; ++a)
#pragma unroll
        for (int b = 0; b < 2; ++b)
#pragma unroll
            for (int m = 0; m < 4; ++m)
#pragma unroll
                for (int n = 0; n < 2; ++n) acc[a][b][m][n] = (f32x4){0.f, 0.f, 0.f, 0.f};
    bf16x8 At[4][2], B0[2][2], B1[2][2]; i32x8 At8[4], B08[2], B18[2];
    const char* cA = (const char*)g.A + (size_t)cur.pm * tstepA + (size_t)cur.koff * 2; const char* cB = (const char*)g.Bt + (size_t)cur.pn * tstepB + (size_t)cur.koff * 2;
    PG8_STAGE(PG8_SB(0, 0), cB, voffB); PG8_STAGE(PG8_SB(0, 1), cB + hstepB, voffB); PG8_STAGE(PG8_SA(0, 0), cA, voffA); PG8_STAGE(PG8_SA(0, 1), cA + hstepA, voffA);
    if (wr == 1) PG8_BAR;
    PG8_WAIT_V(2); PG8_BAR;
    PG8_STAGE(PG8_SB(1, 0), cB + kstep, voffB); PG8_STAGE(PG8_SA(1, 0), cA + kstep, voffA); PG8_STAGE(PG8_SB(1, 1), cB + hstepB + kstep, voffB);
    PG8_WAIT_V(6); PG8_BAR;
    for (;;) {
        const bool has_next = S.next(ui + 1, nxt);
        const char* nA = has_next ? (const char*)g.A + (size_t)nxt.pm * tstepA + (size_t)nxt.koff * 2 : cA; const char* nB = has_next ? (const char*)g.Bt + (size_t)nxt.pn * tstepB + (size_t)nxt.koff * 2 : cB;
        const int nt = cur.nt;
        for (int t = 0; t < nt; t += 2) {
            const bool last = (t == nt - 2);
            const char* a1 = cA + (size_t)(t + 1) * kstep;
            const char* a2 = last ? nA : cA + (size_t)(t + 2) * kstep; const char* b2 = last ? nB : cB + (size_t)(t + 2) * kstep;
            const char* a3 = a2 + kstep; const char* b3 = b2 + kstep;
            PG8_LDB(B0, 0, 0); PG8_LDB(B1, 0, 1); PG8_SCHED; PG8_LDA(At, 0, 0); PG8_STAGE(PG8_SA(1, 1), a1 + hstepA, voffA);
            PG8_WAIT_V(8); PG8_WAIT_L(0); PG8_BAR; PG8_MMA(0, 0, At, B0); PG8_MMA(0, 1, At, B1); PG8_BAR; PG8_SCHED;
            PG8_LDA(At, 0, 1); PG8_STAGE(PG8_SB(0, 0), b2, voffB); PG8_STAGE(PG8_SB(0, 1), b2 + hstepB, voffB); PG8_STAGE(PG8_SA(0, 0), a2, voffA);
            PG8_WAIT_V(8); PG8_WAIT_L(0); PG8_BAR; PG8_MMA(1, 0, At, B0); PG8_MMA(1, 1, At, B1); PG8_BAR; PG8_SCHED;
            PG8_LDB(B0, 1, 0); PG8_LDB(B1, 1, 1); PG8_SCHED; PG8_LDA(At, 1, 0); PG8_STAGE(PG8_SA(0, 1), a2 + hstepA, voffA);
            PG8_WAIT_V(8); PG8_WAIT_L(0); PG8_BAR; PG8_MMA(0, 0, At, B0); PG8_MMA(0, 1, At, B1); PG8_BAR; PG8_SCHED;
            PG8_LDA(At, 1, 1); PG8_STAGE(PG8_SB(1, 0), b3, voffB); PG8_STAGE(PG8_SB(1, 1), b3 + hstepB, voffB); PG8_STAGE(PG8_SA(1, 0), a3, voffA);
            PG8_WAIT_V(8); PG8_WAIT_L(0); PG8_BAR; PG8_MMA(1, 0, At, B0); PG8_MMA(1, 1, At, B1); PG8_BAR; PG8_SCHED;
        }
        if constexpr (ALIGN_EPI) { if (wr == 0) PG8_BAR; }
        if constexpr (FP8) asm volatile("s_nop 15\n\ts_nop 15" ::: "memory");
        if (cur.sub >= 0) {
            float* sp = g.slab + (size_t)cur.sub * 65536 + (size_t)(wr * 64 + fr) * 256 + wc * 32 + 8 * fq;
#pragma unroll
            for (int ai = 0; ai < 2; ++ai)
#pragma unroll
                for (int m = 0; m < 4; ++m)
#pragma unroll
                    for (int bj = 0; bj < 2; ++bj) { float* p = sp + (size_t)(ai * 128 + m * 16) * 256 + bj * 128; *(f32x4*)p = acc[ai][bj][m][0]; *(f32x4*)(p + 4) = acc[ai][bj][m][1]; }
        } else E(acc, cur, wr, wc, fr, fq, lane);
        if (!has_next) break;
#pragma unroll
        for (int a = 0; a < 2; ++a)
#pragma unroll
            for (int b = 0; b < 2; ++b)
#pragma unroll
                for (int m = 0; m < 4; ++m)
#pragma unroll
                    for (int n = 0; n < 2; ++n) acc[a][b][m][n] = (f32x4){0.f, 0.f, 0.f, 0.f};
        cur = nxt; cA = nA; cB = nB; ++ui;
        if constexpr (ALIGN_EPI) { if (wr == 1) PG8_BAR; }
    }
    PG8_WAIT_V(0);
    if constexpr (!ALIGN_EPI) { if (wr == 0) PG8_BAR; }
    PG8_BAR;
#undef PG8_SA
#undef PG8_SB
#undef PG8_STAGE
#undef PG8_LDA
#undef PG8_LDB
#undef PG8_MMA
#undef PG8_WAIT_V
#undef PG8_WAIT_L
#undef PG8_BAR
#undef PG8_SCHED
}
template <class Epi>
__device__ __forceinline__ void gemm_finalize(const Gemm g, const SplitOrder& S, Epi E, int wid, int blk) {
    if (S.Lft == 0 || S.ns <= 1 || blk >= S.Lft * S.ns) return;
    const int lane = lane_id(), wr = wid >> 2, wc = wid & 3, fr = lane & 15, fq = lane >> 4;
    const int l = blk / S.ns, j = blk % S.ns, n8 = S.ns < 8 ? S.ns : 8;
    if (j >= n8) return;
    E.s0 = j * 8 / n8; E.s1 = (j + 1) * 8 / n8;
    Unit u; S.tile(S.R * S.G + l, u);
    f32x4 acc[2][2][4][2];
    const float* sp = g.slab + (size_t)(l * S.ns) * 65536 + (size_t)(wr * 64 + fr) * 256 + wc * 32 + 8 * fq;
#pragma unroll
    for (int ai = 0; ai < 2; ++ai)
#pragma unroll
        for (int m = 0; m < 4; ++m)
#pragma unroll
            for (int bj = 0; bj < 2; ++bj) { f32x4 a0 = {0.f, 0.f, 0.f, 0.f}, a1 = {0.f, 0.f, 0.f, 0.f};
                if (ai * 4 + m >= E.s0 && ai * 4 + m < E.s1) { const float* p = sp + (size_t)(ai * 128 + m * 16) * 256 + bj * 128;
                    for (int sl = 0; sl < S.ns; ++sl) { a0 += *(const f32x4*)(p + (size_t)sl * 65536); a1 += *(const f32x4*)(p + (size_t)sl * 65536 + 4); } }
                acc[ai][bj][m][0] = a0; acc[ai][bj][m][1] = a1; }
    E(acc, u, wr, wc, fr, fq, lane);
}
}

#define XB_TMO      128
#define XB_XCNT(j)  (256  + 64 * (j))
#define XB_XSUB(j)  (1280 + 64 * (j))
#define XB_XGEN(j)  (2304 + 64 * (j))
#define XB_TOP      3328
#define XB_TOPGEN   3392
#define XCD_BAR_WORDS 3456
#define XB_SPIN_CAP (1u << 22)

__device__ __forceinline__ unsigned xb_ld(unsigned* p)              { return __hip_atomic_load(p, __ATOMIC_RELAXED, __HIP_MEMORY_SCOPE_AGENT); }
__device__ __forceinline__ unsigned xb_add(unsigned* p, unsigned v) { return __hip_atomic_fetch_add(p, v, __ATOMIC_RELAXED, __HIP_MEMORY_SCOPE_AGENT); }
__device__ __forceinline__ unsigned xb_xcc_id() { return (unsigned)__builtin_amdgcn_s_getreg((3 << 11) | 20) & 0xFu; }
#define XB_SPIN(cond, bar) do { unsigned _sp = 0; while (cond) { __builtin_amdgcn_s_sleep(1); \
    if ((++_sp & 255u) == 0u) { if (xb_ld(&(bar)[XB_TMO])) break; if (_sp > XB_SPIN_CAP) { atomicAdd(&(bar)[XB_TMO], 1u); break; } } } } while (0)

struct XcdBarrier {
    unsigned* bar; unsigned x;
    volatile LAS unsigned* st;
};
__device__ __forceinline__ XcdBarrier xcd_barrier_post(unsigned* bar, volatile LAS unsigned* st, bool leader) {
    XcdBarrier b; b.bar = bar; b.x = xb_xcc_id(); b.st = st;
    if (leader) (void)xb_add(&bar[XB_XCNT(b.x)], 1u);
    return b;
}
__device__ __forceinline__ void xcd_barrier_complete(unsigned* bar, unsigned x, unsigned& nloc, unsigned& nx) {
    const unsigned G = gridDim.x * gridDim.y * gridDim.z;
    unsigned sum, cnt, mine, sp = 0u;
    for (;;) {
        sum = 0u; cnt = 0u; mine = 0u;
#pragma unroll
        for (unsigned j = 0; j < 16; ++j) { const unsigned c = xb_ld(&bar[XB_XCNT(j)]); sum += c; cnt += (c > 0u) ? 1u : 0u; mine = (j == x) ? c : mine; }
        if (sum == G) break;
        __builtin_amdgcn_s_sleep(1);
        if ((++sp & 255u) == 0u) { if (xb_ld(&bar[XB_TMO])) break; if (sp > XB_SPIN_CAP) { atomicAdd(&bar[XB_TMO], 1u); break; } }
    }
    nloc = mine > 0u ? mine : 1u; nx = cnt > 0u ? cnt : 1u;
}
__device__ __forceinline__ void xcd_barrier(const XcdBarrier& b, bool leader) {
    asm volatile("s_waitcnt vmcnt(0)" ::: "memory");
    __syncthreads();
    if (leader) {
        unsigned* bar = b.bar;
        __builtin_amdgcn_s_waitcnt(0);
        unsigned nloc = b.st[0], nx = b.st[1];
        if (nloc == 0u) { xcd_barrier_complete(bar, b.x, nloc, nx); b.st[0] = nloc; b.st[1] = nx; }
        const unsigned old = xb_add(&bar[XB_XSUB(b.x)], 1u);
        const unsigned gen = old / nloc;
        if (old + 1u == (gen + 1u) * nloc) {
            __builtin_amdgcn_fence(__ATOMIC_RELEASE, "agent");
            asm volatile("s_waitcnt vmcnt(0)" ::: "memory");
            const unsigned og = xb_add(&bar[XB_TOP], 1u);
            const unsigned tg = og / nx;
            if (og + 1u == (tg + 1u) * nx) xb_add(&bar[XB_TOPGEN], 1u);
            else XB_SPIN(xb_ld(&bar[XB_TOPGEN]) == tg, bar);
            __builtin_amdgcn_fence(__ATOMIC_ACQUIRE, "agent");
            xb_add(&bar[XB_XGEN(b.x)], 1u);
            asm volatile("s_waitcnt vmcnt(0)" ::: "memory");
        } else {
            XB_SPIN(xb_ld(&bar[XB_XGEN(b.x)]) == gen, bar);
            __builtin_amdgcn_fence(__ATOMIC_ACQUIRE, "agent");
            asm volatile("s_waitcnt vmcnt(0)" ::: "memory");
        }
    }
    __syncthreads();
}

struct Args { const float* in[30]; float* out; unsigned char* ws; float inv[32]; int ph_lo, ph_hi; };
enum { I_XP = 0, I_XS, I_CCKV, I_CKR, I_SHG, I_SCV, I_PP, I_PS, I_GATT, I_WIN, I_GQA, I_WUQ, I_GKVA, I_WUK, I_WUV, I_GQN, I_GQR, I_GKN, I_GKR, I_LB, I_GHG, I_WO, I_GFFN, I_WUP, I_CW, I_CB, I_WD, I_GPLE, I_WPG, I_WPLE };
struct Frame { LAS unsigned char* lds; int wave, vcu, G, gw, NGW; };
#define LDS_WAIT() asm volatile("s_waitcnt lgkmcnt(0)" ::: "memory")
#define VM_WAIT() asm volatile("s_waitcnt vmcnt(0)" ::: "memory")

DI void tr_item(const float* __restrict__ W, size_t ldw, bf16_t* __restrict__ WT, size_t ldt, const float* __restrict__ gain, int k0, int n0, int dst_row0, LAS float* scr, int lane, bf16_t* NAT, size_t ldn, int rope_np = -1, unsigned char* NAT8 = nullptr, size_t ld8 = 0, unsigned char* WT8 = nullptr, float sc8 = 1.f) {
#pragma unroll 8
    for (int i = 0; i < 32; ++i) { const int kk = 2 * i + (lane >> 5); scr[kk * 33 + (lane & 31)] = W[(size_t)(k0 + kk) * ldw + n0 + (lane & 31)]; }
    LDS_WAIT(); asm volatile("" ::: "memory");
    const int c = lane & 7;
    float gv[8];
#pragma unroll
    for (int j = 0; j < 8; ++j) gv[j] = gain ? gain[k0 + 8 * c + j] : 1.0f;
#pragma unroll
    for (int j = 0; j < 4; ++j) { const int n = (lane >> 3) + 8 * j; const LAS float* s = scr + (8 * c) * 33 + n;
        const int nn = rope_np < 0 ? n : 32 * (n >> 4) + 8 * ((n >> 2) & 3) + 4 * rope_np + (n & 3);
        if (WT8) { u32x2 o8; o8.x = pk4_fp8(s[0 * 33] * gv[0] * sc8, s[1 * 33] * gv[1] * sc8, s[2 * 33] * gv[2] * sc8, s[3 * 33] * gv[3] * sc8); o8.y = pk4_fp8(s[4 * 33] * gv[4] * sc8, s[5 * 33] * gv[5] * sc8, s[6 * 33] * gv[6] * sc8, s[7 * 33] * gv[7] * sc8);
            *(u32x2*)(WT8 + (size_t)(dst_row0 + nn) * ldt + k0 + 8 * c) = o8; continue; }
        u32x4 o; o.x = cvtpk(s[0 * 33] * gv[0], s[1 * 33] * gv[1]); o.y = cvtpk(s[2 * 33] * gv[2], s[3 * 33] * gv[3]); o.z = cvtpk(s[4 * 33] * gv[4], s[5 * 33] * gv[5]); o.w = cvtpk(s[6 * 33] * gv[6], s[7 * 33] * gv[7]);
        *(u32x4*)(WT + (size_t)(dst_row0 + nn) * ldt + k0 + 8 * c) = o; }
    if (NAT || NAT8) {
#pragma unroll
        for (int j = 0; j < 4; ++j) { const int r = (lane >> 2) + 16 * j, ch = lane & 3; const LAS float* s = scr + r * 33 + ch * 8;
            if (NAT) { u32x4 o; o.x = cvtpk(s[0], s[1]); o.y = cvtpk(s[2], s[3]); o.z = cvtpk(s[4], s[5]); o.w = cvtpk(s[6], s[7]);
                *(u32x4*)(NAT + (size_t)(k0 + r) * ldn + n0 + ch * 8) = o; }
            if (NAT8) { u32x2 o8; o8.x = pk4_fp8(s[0] * SC8_K, s[1] * SC8_K, s[2] * SC8_K, s[3] * SC8_K); o8.y = pk4_fp8(s[4] * SC8_K, s[5] * SC8_K, s[6] * SC8_K, s[7] * SC8_K); *(u32x2*)(NAT8 + (size_t)(k0 + r) * ld8 + n0 + ch * 8) = o8; } }
    }
    LDS_WAIT(); asm volatile("" ::: "memory");
}
DI bool tr_matrix(int& r, const float* W, int K, int N, bf16_t* WT, size_t ldt, const float* gain, LAS float* scr, int lane, int split_n = 1 << 30, int pad = 0, bool gate_up = false, bool uq = false, unsigned char* WT8 = nullptr, float sc8 = 1.f, int n8_lim = 1 << 30) {
    const int nblk = N / 32, nitems = (K / 64) * nblk;
    if (r >= nitems) { r -= nitems; return false; }
    const int kb = r / nblk, nb = r % nblk, n0 = 32 * nb;
    int dst = n0 < split_n ? n0 : n0 + pad;
    if (gate_up) { const int s = n0 / FF, ch = n0 % FF; dst = (ch / 128) * 256 + s * 128 + (ch % 128); }
    int np = -1;
    if (uq) { const int h = n0 / QH, d0 = n0 % QH; if (d0 < NOPE) dst = h * NOPE + d0; else { dst = 2048 + (h >> 2) * 256 + (h & 3) * 64; np = (d0 - NOPE) >> 5; } }
    tr_item(W, (size_t)N, WT, ldt, gain, 64 * kb, n0, dst, scr, lane, nullptr, 0, np, nullptr, 0, n0 < n8_lim ? WT8 : nullptr, sc8);
    return true;
}
DI void zero16(void* p, size_t bytes, int gw, int NGW, int lane) {
    const size_t n = bytes / 1024;
    for (size_t i = gw; i < n; i += NGW) *(u32x4*)((char*)p + i * 1024 + lane * 16) = (u32x4){0u, 0u, 0u, 0u};
}

DI void p0_prologue(const Frame& F, const Args& a) {
    unsigned char* ws = a.ws;
    LAS float* scr = (LAS float*)(F.lds + F.wave * 16384);
    const int lane = lane_id();
    {
        constexpr int I_IN = (D / 64) * (9792 / 32), I_UQ = (QL / 64) * (3072 / 32), I_UK = (KVL / 64) * (2048 / 32), I_CACHE = SB * (PAST / 64) * (KVL / 32);
        constexpr int NIT = I_IN + I_UQ + 2 * I_UK + I_CACHE;
        for (int it = F.gw; it < NIT; it += F.NGW) {
            int r = it;
            if (tr_matrix(r, a.in[I_WIN], D, 9792, (bf16_t*)(ws + WS_WINT), D, a.in[I_GATT], scr, lane, 1600, 192, false, false, (unsigned char*)a.out + OS_WIN8, SC8_WI, QL)) continue;
            if (tr_matrix(r, a.in[I_WUQ], QL, 3072, nullptr, QL, a.in[I_GQA], scr, lane, 1 << 30, 0, false, true, ws + WS_WUQ8, SC8_Q)) continue;
            if (tr_matrix(r, a.in[I_WUK], KVL, 2048, (bf16_t*)(ws + WS_WUKVT), KVL, nullptr, scr, lane)) continue;
            if (tr_matrix(r, a.in[I_WUV], KVL, 2048, (bf16_t*)(ws + WS_WUKVT) + (size_t)2048 * KVL, KVL, nullptr, scr, lane)) continue;
            { const int b = r / ((PAST / 64) * (KVL / 32)), rr = r % ((PAST / 64) * (KVL / 32)), kb = rr / (KVL / 32), nb = rr % (KVL / 32);
              tr_item(a.in[I_CCKV] + (size_t)b * PAST * KVL, KVL, (bf16_t*)(ws + WS_CKVT) + (size_t)b * KVL * KT, KT, nullptr, 64 * kb, 32 * nb, 32 * nb, scr, lane,
                      nullptr, 0, -1, ws + WS_KC8 + (size_t)b * PAST * KVL, KVL); }
        }
    }
    for (int row = F.gw; row < M; row += F.NGW) {
        const float* src = row < MP ? a.in[I_XP] + (size_t)row * D : a.in[I_XS] + (size_t)(row - MP) * D;
        bf16_t* dst = (bf16_t*)((unsigned char*)a.out + OS_XB) + (size_t)row * D;
        float ss = 0.f;
#pragma unroll 4
        for (int j = 0; j < 16; ++j) { const f32x4 v = *(const f32x4*)(src + j * 256 + lane * 4); ss += v[0] * v[0] + v[1] * v[1] + v[2] * v[2] + v[3] * v[3];
            u32x2 o; o.x = cvtpk(v[0], v[1]); o.y = cvtpk(v[2], v[3]); *(u32x2*)(dst + j * 256 + lane * 4) = o;
            *(unsigned*)((unsigned char*)a.out + OS_XB8 + (size_t)row * D + j * 256 + lane * 4) = pk4_fp8(v[0] * SC8_X0, v[1] * SC8_X0, v[2] * SC8_X0, v[3] * SC8_X0); }
        ss = wave_sum(ss);
        if (lane == 0) ((float*)(ws + OFF_SSQ1))[row] = ss;
    }
    for (int it = F.gw; it < SB * PAST / 8; it += F.NGW) {
        const int kg = it * 8 + (lane >> 3), b = kg / PAST, key = kg % PAST, ch = lane & 7;
        const float* s = a.in[I_CKR] + (size_t)kg * ROPE + ch * 8;
        const f32x4 v0 = *(const f32x4*)s, v1 = *(const f32x4*)(s + 4);
        *(u32x4*)((bf16_t*)(ws + WS_KCAT) + ((size_t)b * KPAD + key) * KC + KVL + ch * 8) = pack8(v0, v1);
    }
    for (int it = F.gw; it < 512 * 2048 / 512; it += F.NGW) {
        const size_t e = (size_t)it * 512 + lane * 8; const int d = (int)(e & 127);
        const f32x4 v0 = *(const f32x4*)(a.in[I_WUK] + e), v1 = *(const f32x4*)(a.in[I_WUK] + e + 4);
        const f32x4 g0 = *(const f32x4*)(a.in[I_GKN] + d), g1 = *(const f32x4*)(a.in[I_GKN] + d + 4);
        *(u32x4*)((bf16_t*)(ws + WS_WUKN) + e) = pack8(v0 * g0, v1 * g1);
    }
    for (int it = F.gw; it < (4096 / 64) * (KVL / 8); it += F.NGW) { const int n = (it >> 6) * 64 + lane, c0 = (it & 63) * 8; float v[8];
        const float* src = n < 2048 ? a.in[I_WUK] + n : a.in[I_WUV] + (n - 2048);
#pragma unroll
        for (int j = 0; j < 8; ++j) v[j] = src[(size_t)(c0 + j) * 2048] * SC8_W;
        u32x2 o8; o8.x = pk4_fp8(v[0], v[1], v[2], v[3]); o8.y = pk4_fp8(v[4], v[5], v[6], v[7]); *(u32x2*)(ws + WS_WUKV8 + (size_t)n * KVL + c0) = o8; }
    for (int it = F.gw; it < NKEY * 32 / 64; it += F.NGW) {
        const int e = it * 64 + lane, pos = e >> 5, i = e & 31;
        const float ang = (float)pos * a.inv[i];
        const double rev = (double)ang * 0.15915494309189535; const float fr = (float)(rev - __builtin_rint(rev));
        ((float*)(ws + WS_ROPE))[e] = __builtin_amdgcn_cosf(fr);
        ((float*)(ws + WS_ROPE))[NKEY * 32 + e] = __builtin_amdgcn_sinf(fr);
    }
    for (int it = F.gw; it < HGW / 64; it += F.NGW) { const int j = it * 64 + lane; const float l0 = a.in[I_LB][j], l1 = a.in[I_LB][HGW + j]; ((float*)(ws + OFF_LB))[j] = 1.0f / (1.0f + __expf(l1 - l0)); }
    for (int row = F.gw; row < M; row += F.NGW) { const float* src = row < MP ? a.in[I_PP] + (size_t)row * PLE : a.in[I_PS] + (size_t)(row - MP) * PLE; const f32x4 v = *(const f32x4*)(src + 4 * lane);
        u32x2 o; o.x = cvtpk(v[0], v[1]); o.y = cvtpk(v[2], v[3]); *(u32x2*)((bf16_t*)(ws + WS_PB) + (size_t)row * PLE + 4 * lane) = o; }
    { constexpr int NITP = (PLE / 64) * (D / 32); for (int it = F.gw; it < NITP; it += F.NGW) { int r = it; tr_matrix(r, a.in[I_WPLE], PLE, D, (bf16_t*)(ws + WS_WPT), PLE, nullptr, scr, lane); } }
    zero16((bf16_t*)(ws + WS_WINT) + (size_t)1600 * D, (size_t)192 * D * 2, F.gw, F.NGW, lane);
    for (int b = 0; b < SB; ++b) zero16((bf16_t*)(ws + WS_KCAT) + ((size_t)b * KPAD + PAST) * KC, (size_t)(KPAD - PAST) * KC * 2, F.gw, F.NGW, lane);
    for (int it = F.gw; it < SB * KVL / 4; it += F.NGW) { const int rowi = it * 4 + (lane >> 4); *(u32x4*)((bf16_t*)(ws + WS_CKVT) + (size_t)rowi * KT + PAST + (lane & 15) * 8) = (u32x4){0u, 0u, 0u, 0u}; }
    zero16(ws + WS_SSK, (size_t)SB * KPAD * 16 * 4, F.gw, F.NGW, lane);
}

#define ACC_T const f32x4 (&acc)[2][2][4][2]
#ifndef NT_STORES
#define NT_STORES 1
#endif
DI void st_bf16x8(bf16_t* p, f32x4 a, f32x4 b) { const u32x4 w = pack8(a, b); if (NT_STORES) __builtin_nontemporal_store(w, (u32x4*)p); else *(u32x4*)p = w; }
DI void st_f32x8(float* p, f32x4 a, f32x4 b) { if (NT_STORES) { __builtin_nontemporal_store(a, (f32x4*)p); __builtin_nontemporal_store(b, (f32x4*)(p + 4)); } else { *(f32x4*)p = a; *(f32x4*)(p + 4) = b; } }
DI float dot8(f32x4 a, f32x4 b) { return (a[0] * a[0] + a[1] * a[1]) + (a[2] * a[2] + a[3] * a[3]) + (b[0] * b[0] + b[1] * b[1]) + (b[2] * b[2] + b[3] * b[3]); }

struct EpiInProj {
    unsigned char* ws; int pn_off; float sc; int s0 = 0, s1 = 8;
    DI void operator()(ACC_T, const pg8::Unit& u, int wr, int wc, int fr, int fq, int lane) const {
        const float* ssq1 = (const float*)(ws + OFF_SSQ1);
        const int row0 = u.pm * 256 + wr * 64 + fr, c8 = wc * 32 + 8 * fq, pn = u.pn + pn_off;
#pragma unroll
        for (int ai = 0; ai < 2; ++ai)
#pragma unroll
            for (int m = 0; m < 4; ++m) { if (ai * 4 + m < s0 || ai * 4 + m >= s1) continue;
                const int row = row0 + ai * 128 + m * 16;
                const float rs = rsqrtf(ssq1[row] * (1.f / D) + EPS) * sc;
                f32x4 v[2][2];
#pragma unroll
                for (int bj = 0; bj < 2; ++bj) { v[bj][0] = acc[ai][bj][m][0] * rs; v[bj][1] = acc[ai][bj][m][1] * rs; }
                if (pn < 4) {
                    float ss = 0.f;
#pragma unroll
                    for (int bj = 0; bj < 2; ++bj) { ss += dot8(v[bj][0], v[bj][1]);
                        u32x2 o8; o8.x = pk4_fp8(v[bj][0][0] * SC8_K, v[bj][0][1] * SC8_K, v[bj][0][2] * SC8_K, v[bj][0][3] * SC8_K); o8.y = pk4_fp8(v[bj][1][0] * SC8_K, v[bj][1][1] * SC8_K, v[bj][1][2] * SC8_K, v[bj][1][3] * SC8_K);
                        *(u32x2*)(ws + WS_CQ8 + (size_t)row * QL + pn * 256 + bj * 128 + c8) = o8; }
                    ss += __shfl_xor(ss, 16); ss += __shfl_xor(ss, 32);
                    if (fq == 0) unsafeAtomicAdd((float*)(ws + OFF_SSQQ) + row, ss);
                } else if (pn < 6) {
#pragma unroll
                    for (int bj = 0; bj < 2; ++bj) st_f32x8((float*)(ws + WS_CKVRAW) + (size_t)row * KVL + (pn - 4) * 256 + bj * 128 + c8, v[bj][0], v[bj][1]);
                } else if (pn == 6) {
                    if (wc < 2) st_f32x8((float*)(ws + WS_KRRAW) + (size_t)row * ROPE + c8, v[0][0], v[0][1]);
                } else if (pn < 15) {
#pragma unroll
                    for (int bj = 0; bj < 2; ++bj) st_bf16x8((bf16_t*)(ws + WS_HQ) + (size_t)row * HGW + (pn - 7) * 256 + bj * 128 + c8, v[bj][0], v[bj][1]);
                } else if (pn < 23) {
#pragma unroll
                    for (int bj = 0; bj < 2; ++bj) { const int col = (pn - 15) * 256 + bj * 128 + c8;
                        const f32x4 l0 = *(const f32x4*)((const float*)(ws + OFF_LB) + col), l1 = *(const f32x4*)((const float*)(ws + OFF_LB) + col + 4);
                        f32x4 lf[2], kk[2];
#pragma unroll
                        for (int n = 0; n < 2; ++n)
#pragma unroll
                            for (int e = 0; e < 4; ++e) { const float lb = n ? l1[e] : l0[e], x = v[bj][n][e], t = __expf(-fabsf(x)), ia = 1.0f / (1.0f + t), ib = t * ia, sg = x >= 0.f ? ia : ib, sgn = x >= 0.f ? ib : ia;
                                lf[n][e] = __logf(lb + (1.0f - lb) * sg); kk[n][e] = (1.0f - lb) * sgn; }
                        st_f32x8((float*)(ws + WS_LF) + (size_t)row * HGW + col, lf[0], lf[1]);
                        st_bf16x8((bf16_t*)(ws + WS_HK) + (size_t)row * HGW + col, kk[0], kk[1]); }
                } else if (pn < 31) {
#pragma unroll
                    for (int bj = 0; bj < 2; ++bj) st_bf16x8((bf16_t*)(ws + WS_HV) + (size_t)row * HGW + (pn - 23) * 256 + bj * 128 + c8, v[bj][0], v[bj][1]);
                } else {
#pragma unroll
                    for (int bj = 0; bj < 2; ++bj) { f32x4 g[2];
#pragma unroll
                        for (int n = 0; n < 2; ++n)
#pragma unroll
                            for (int e = 0; e < 4; ++e) { const float x = v[bj][n][e]; g[n][e] = x / (1.0f + __expf(-x)); }
                        st_bf16x8((bf16_t*)(ws + WS_HG) + (size_t)row * HGW + (pn - 31) * 256 + bj * 128 + c8, g[0], g[1]); }
                }
            }
    }
};
struct EpiSumsq {
    unsigned char* ws; float scale; int fix16;
    DI void operator()(ACC_T, const pg8::Unit& u, int wr, int wc, int fr, int fq, int lane) const {
        const int row0 = (u.pm + (fix16 ? u.pm >> 4 : 0)) * 256 + wr * 64 + fr;
#pragma unroll
        for (int ai = 0; ai < 2; ++ai)
#pragma unroll
            for (int bj = 0; bj < 2; ++bj) {
                float s[4];
#pragma unroll
                for (int m = 0; m < 4; ++m) { float t = dot8(acc[ai][bj][m][0], acc[ai][bj][m][1]); t += __shfl_xor(t, 16); t += __shfl_xor(t, 32); s[m] = t; }
                const float sv = fq == 0 ? s[0] : fq == 1 ? s[1] : fq == 2 ? s[2] : s[3];
                unsafeAtomicAdd((float*)(ws + WS_SSK) + (size_t)(u.pn * 2 + bj) * ((size_t)SB * KPAD) + (row0 + ai * 128 + fq * 16), sv * scale);
            }
    }
};
struct EpiUq {
    unsigned char* ws; const float* gqn; const float* gqr; LAS unsigned char* lds; float sc; int s0 = 0, s1 = 8;
    DI void operator()(ACC_T, const pg8::Unit& u, int wr, int wc, int fr, int fq, int lane) const {
        const float* ssq = (const float*)(ws + OFF_SSQQ);
        const int row0 = u.pm * 256 + wr * 64 + fr, c8 = wc * 32 + 8 * fq;
        LAS float* xs = (LAS float*)(lds + XCH_OFF);
        float rsk[8] = {};
#pragma unroll
        for (int ai = 0; ai < 2; ++ai)
#pragma unroll
            for (int m = 0; m < 4; ++m) { if (ai * 4 + m < s0 || ai * 4 + m >= s1) continue; const float rs = rsqrtf(ssq[row0 + ai * 128 + m * 16] * (1.f / QL) + EPS) * sc; rsk[ai * 4 + m] = rs;
#pragma unroll
                for (int bj = 0; bj < 2; ++bj) { float s = dot8(acc[ai][bj][m][0] * rs, acc[ai][bj][m][1] * rs); s += __shfl_xor(s, 16); s += __shfl_xor(s, 32);
                    if (fq == 0) xs[((ai * 128 + wr * 64 + m * 16 + fr) * 2 + bj) * 4 + wc] = s; } }
        asm volatile("s_waitcnt lgkmcnt(0)" ::: "memory"); __builtin_amdgcn_s_barrier(); asm volatile("" ::: "memory");
        bf16_t* Q = (bf16_t*)(ws + WS_Q);
        if (u.pn < 8) {
            const f32x4 g0 = *(const f32x4*)(gqn + c8), g1 = *(const f32x4*)(gqn + c8 + 4);
#pragma unroll
            for (int ai = 0; ai < 2; ++ai)
#pragma unroll
                for (int m = 0; m < 4; ++m) { if (ai * 4 + m < s0 || ai * 4 + m >= s1) continue; const int row = row0 + ai * 128 + m * 16; const float rs = rsk[ai * 4 + m];
#pragma unroll
                    for (int bj = 0; bj < 2; ++bj) { const f32x4 p = *(const LAS f32x4*)(xs + ((ai * 128 + wr * 64 + m * 16 + fr) * 2 + bj) * 4);
                        const float rn = rsqrtf(((p[0] + p[1]) + (p[2] + p[3])) * (1.f / NOPE) + EPS) * rs;
                        const f32x4 y0 = acc[ai][bj][m][0] * rn * g0, y1 = acc[ai][bj][m][1] * rn * g1;
                        if (u.pm >= MP / 256) st_bf16x8(Q + (size_t)row * 3072 + (u.pn * 2 + bj) * QH + c8, y0, y1);
                        else { u32x2 o8; o8.x = pk4_fp8(y0[0] * SC8_A, y0[1] * SC8_A, y0[2] * SC8_A, y0[3] * SC8_A); o8.y = pk4_fp8(y1[0] * SC8_A, y1[1] * SC8_A, y1[2] * SC8_A, y1[3] * SC8_A);
                            *(u32x2*)(ws + WS_Q + (size_t)row * 3072 + (u.pn * 2 + bj) * QH + c8) = o8; } } }
        } else {
            const int i0 = 16 * (wc & 1) + 4 * fq, hw = wc >> 1; const bool smp = u.pm >= MP / 256;
            const f32x4 ga = *(const f32x4*)(gqr + i0), gb = *(const f32x4*)(gqr + 32 + i0);
            const float* ropec = (const float*)(ws + WS_ROPE); const float* ropes = ropec + NKEY * 32;
#pragma unroll
            for (int ai = 0; ai < 2; ++ai)
#pragma unroll
                for (int m = 0; m < 4; ++m) { if (ai * 4 + m < s0 || ai * 4 + m >= s1) continue; const int row = row0 + ai * 128 + m * 16; const float rs = rsk[ai * 4 + m];
                    const int pos = smp ? PAST + ((row - MP) & 15) : (row & (SEQ - 1));
                    const f32x4 c = *(const f32x4*)(ropec + pos * 32 + i0), s = *(const f32x4*)(ropes + pos * 32 + i0);
#pragma unroll
                    for (int bj = 0; bj < 2; ++bj) { const f32x4 p = *(const LAS f32x4*)(xs + ((ai * 128 + wr * 64 + m * 16 + fr) * 2 + bj) * 4);
                        const float rr = rsqrtf((hw ? p[2] + p[3] : p[0] + p[1]) * (1.f / ROPE) + EPS) * rs;
                        const f32x4 y1 = acc[ai][bj][m][0] * rr * ga, y2 = acc[ai][bj][m][1] * rr * gb, o1 = y1 * c - y2 * s, o2 = y2 * c + y1 * s;
                        u32x2 w1, w2; w1.x = cvtpk(o1[0], o1[1]); w1.y = cvtpk(o1[2], o1[3]); w2.x = cvtpk(o2[0], o2[1]); w2.y = cvtpk(o2[2], o2[3]);
                        const int h = 4 * (u.pn - 8) + 2 * bj + hw;
                        if (smp) { bf16_t* qp = Q + (size_t)row * 3072 + h * QH + NOPE + i0; *(u32x2*)qp = w1; *(u32x2*)(qp + 32) = w2; }
                        else { unsigned char* q8 = ws + WS_Q + (size_t)row * 3072 + h * QH + NOPE + i0; *(unsigned*)q8 = pk4_fp8(o1[0] * SC8_A, o1[1] * SC8_A, o1[2] * SC8_A, o1[3] * SC8_A); *(unsigned*)(q8 + 32) = pk4_fp8(o2[0] * SC8_A, o2[1] * SC8_A, o2[2] * SC8_A, o2[3] * SC8_A); }
                        if (smp) { bf16_t* qc = (bf16_t*)(ws + WS_QCAT) + ((size_t)(row - MP) * 16 + h) * KC + KVL + i0; *(u32x2*)qc = w1; *(u32x2*)(qc + 32) = w2; } } }
        }
        asm volatile("s_waitcnt lgkmcnt(0)" ::: "memory"); __builtin_amdgcn_s_barrier(); asm volatile("" ::: "memory");
    }
};

DI void p2_norm_rows(const Frame& F, const Args& a) {
    unsigned char* ws = a.ws; const int lane = lane_id();
    const float* ropec = (const float*)(ws + WS_ROPE); const float* ropes = ropec + NKEY * 32;
    for (int row = F.gw; row < M; row += F.NGW) {
        const bool smp = row >= MP; const int sr = row - MP, sb = sr >> 4, st = sr & 15;
        const float* cr = (const float*)(ws + WS_CKVRAW) + (size_t)row * KVL;
        f32x4 v0 = *(const f32x4*)(cr + 4 * lane), v1 = *(const f32x4*)(cr + 256 + 4 * lane);
        float ss = (v0[0] * v0[0] + v0[1] * v0[1]) + (v0[2] * v0[2] + v0[3] * v0[3]) + (v1[0] * v1[0] + v1[1] * v1[1]) + (v1[2] * v1[2] + v1[3] * v1[3]);
        ss = wave_sum(ss);
        const float rs = rsqrtf(ss * (1.f / KVL) + EPS);
        const f32x4 g0 = *(const f32x4*)(a.in[I_GKVA] + 4 * lane), g1 = *(const f32x4*)(a.in[I_GKVA] + 256 + 4 * lane);
        v0 = v0 * rs * g0; v1 = v1 * rs * g1;
        float* oc = a.out + (smp ? O_CKVS + (size_t)sr * KVL : O_CKVP + (size_t)row * KVL);
        *(f32x4*)(oc + 4 * lane) = v0; *(f32x4*)(oc + 256 + 4 * lane) = v1;
        u32x2 w0, w1; w0.x = cvtpk(v0[0], v0[1]); w0.y = cvtpk(v0[2], v0[3]); w1.x = cvtpk(v1[0], v1[1]); w1.y = cvtpk(v1[2], v1[3]);
        { unsigned char* c8p = ws + WS_CKVN8 + (size_t)row * KVL; *(unsigned*)(c8p + 4 * lane) = pk4_fp8(v0[0] * SC8_K, v0[1] * SC8_K, v0[2] * SC8_K, v0[3] * SC8_K); *(unsigned*)(c8p + 256 + 4 * lane) = pk4_fp8(v1[0] * SC8_K, v1[1] * SC8_K, v1[2] * SC8_K, v1[3] * SC8_K); }
        if (smp) {
            bf16_t* kc = (bf16_t*)(ws + WS_KCAT) + ((size_t)sb * KPAD + PAST + st) * KC;
            *(u32x2*)(kc + 4 * lane) = w0; *(u32x2*)(kc + 256 + 4 * lane) = w1;
            bf16_t* ct = (bf16_t*)(ws + WS_CKVT) + (size_t)sb * KVL * KT + PAST + st;
            const unsigned e0[4] = {w0.x & 0xffffu, w0.x >> 16, w0.y & 0xffffu, w0.y >> 16}, e1[4] = {w1.x & 0xffffu, w1.x >> 16, w1.y & 0xffffu, w1.y >> 16};
#pragma unroll
            for (int e = 0; e < 4; ++e) { ct[(size_t)(4 * lane + e) * KT] = (bf16_t)e0[e]; ct[(size_t)(256 + 4 * lane + e) * KT] = (bf16_t)e1[e]; }
        }
        const float kv = ((const float*)(ws + WS_KRRAW))[(size_t)row * ROPE + lane];
        const float s2 = wave_sum(kv * kv);
        const float y = kv * rsqrtf(s2 * (1.f / ROPE) + EPS) * a.in[I_GKR][lane];
        const float yo = __shfl_xor(y, 32);
        const int pos = smp ? PAST + st : (row & (SEQ - 1)), i = lane & 31;
        const float c = ropec[pos * 32 + i], s = ropes[pos * 32 + i];
        const float o = lane < 32 ? y * c - yo * s : y * c + yo * s;
        (a.out + (smp ? O_KRS + (size_t)sr * ROPE : O_KRP + (size_t)row * ROPE))[lane] = o;
        const bf16_t ob = f2bf(o);
        if (!smp) (ws + WS_KRN)[(size_t)row * ROPE + lane] = (unsigned char)(pk4_fp8(o * SC8_A, 0.f, 0.f, 0.f) & 0xffu);
        if (smp) ((bf16_t*)(ws + WS_KCAT))[((size_t)sb * KPAD + PAST + st) * KC + KVL + lane] = ob;
    }
}

struct EpiKup {
    unsigned char* ws; const float* gkn; LAS unsigned char* lds; float sc;
    DI void operator()(ACC_T, const pg8::Unit& u, int wr, int wc, int fr, int fq, int lane) const {
        const int row0 = u.pm * 256 + wr * 64 + fr, c8 = wc * 32 + 8 * fq;
        if (u.pn >= 8) { bf16_t* base = (bf16_t*)(ws + WS_V) + (u.pn & 7) * 256 + c8;
#pragma unroll
            for (int ai = 0; ai < 2; ++ai)
#pragma unroll
                for (int m = 0; m < 4; ++m)
#pragma unroll
                    for (int bj = 0; bj < 2; ++bj) st_bf16x8(base + (size_t)(row0 + ai * 128 + m * 16) * 2048 + bj * 128, acc[ai][bj][m][0] * sc, acc[ai][bj][m][1] * sc);
            return; }
        LAS float* xs = (LAS float*)(lds + XCH_OFF);
#pragma unroll
        for (int ai = 0; ai < 2; ++ai)
#pragma unroll
            for (int m = 0; m < 4; ++m)
#pragma unroll
                for (int bj = 0; bj < 2; ++bj) { float s = dot8(acc[ai][bj][m][0] * sc, acc[ai][bj][m][1] * sc); s += __shfl_xor(s, 16); s += __shfl_xor(s, 32);
                    if (fq == 0) xs[((ai * 128 + wr * 64 + m * 16 + fr) * 2 + bj) * 4 + wc] = s; }
        asm volatile("s_waitcnt lgkmcnt(0)" ::: "memory"); __builtin_amdgcn_s_barrier(); asm volatile("" ::: "memory");
        const f32x4 g0 = *(const f32x4*)(gkn + c8), g1 = *(const f32x4*)(gkn + c8 + 4);
        unsigned char* base = ws + WS_KN + (u.pn & 7) * 256 + c8;
#pragma unroll
        for (int ai = 0; ai < 2; ++ai)
#pragma unroll
            for (int m = 0; m < 4; ++m)
#pragma unroll
                for (int bj = 0; bj < 2; ++bj) { const f32x4 p = *(const LAS f32x4*)(xs + ((ai * 128 + wr * 64 + m * 16 + fr) * 2 + bj) * 4);
                    const float rn = rsqrtf(((p[0] + p[1]) + (p[2] + p[3])) * (1.f / NOPE) + EPS) * sc;
                    const f32x4 y0 = acc[ai][bj][m][0] * (rn * SC8_A) * g0, y1 = acc[ai][bj][m][1] * (rn * SC8_A) * g1;
                    u32x2 o8; o8.x = pk4_fp8(y0[0], y0[1], y0[2], y0[3]); o8.y = pk4_fp8(y1[0], y1[1], y1[2], y1[3]); *(u32x2*)(base + (size_t)(row0 + ai * 128 + m * 16) * 2048 + bj * 128) = o8; }
        asm volatile("s_waitcnt lgkmcnt(0)" ::: "memory"); __builtin_amdgcn_s_barrier(); asm volatile("" ::: "memory");
    }
};
DI int crow(int r, int hi) { return (r & 3) + 8 * (r >> 2) + 4 * hi; }
template <int NJ, bool AF32, class Mid>
DI void sgemm_tile(const void* Av, size_t lda, const bf16_t* Bt, size_t ldb, int K, int mid_k, const Mid& mid, f32x16 (&acc)[2][NJ], int wave, int lane) {
    const int wm = wave >> 2, wn = wave & 3, r32 = lane & 31, hi = lane >> 5;
#pragma unroll
    for (int i = 0; i < 2; ++i)
#pragma unroll
        for (int j = 0; j < NJ; ++j)
#pragma unroll
            for (int r = 0; r < 16; ++r) acc[i][j][r] = 0.f;
    const bf16_t* bp[NJ];
#pragma unroll
    for (int j = 0; j < NJ; ++j) bp[j] = Bt + (size_t)(wn * 32 * NJ + j * 32 + r32) * ldb + hi * 8;
    if constexpr (AF32) {
        for (int k0 = 0; k0 < K; k0 += 16) {
            bf16x8 af[2], bf_[NJ];
#pragma unroll
            for (int i = 0; i < 2; ++i) { const float* p = (const float*)Av + (size_t)(wm * 64 + i * 32 + r32) * lda + hi * 8 + k0; af[i] = __builtin_bit_cast(bf16x8, pack8(*(const f32x4*)p, *(const f32x4*)(p + 4))); }
#pragma unroll
            for (int j = 0; j < NJ; ++j) bf_[j] = *(const bf16x8*)(bp[j] + k0);
#pragma unroll
            for (int i = 0; i < 2; ++i)
#pragma unroll
                for (int j = 0; j < NJ; ++j) acc[i][j] = __builtin_amdgcn_mfma_f32_32x32x16_bf16(af[i], bf_[j], acc[i][j], 0, 0, 0);
        }
    } else {
    for (int k0 = 0; k0 < K; k0 += 64) {
        bf16x8 af[2][4], bf_[NJ][4];
#pragma unroll
        for (int i = 0; i < 2; ++i)
#pragma unroll
            for (int ks = 0; ks < 4; ++ks) af[i][ks] = *(const bf16x8*)((const bf16_t*)Av + (size_t)(wm * 64 + i * 32 + r32) * lda + hi * 8 + k0 + ks * 16);
#pragma unroll
        for (int j = 0; j < NJ; ++j)
#pragma unroll
            for (int ks = 0; ks < 4; ++ks) bf_[j][ks] = *(const bf16x8*)(bp[j] + k0 + ks * 16);
        if (k0 == mid_k) mid(acc);
#pragma unroll
        for (int ks = 0; ks < 4; ++ks)
#pragma unroll
            for (int i = 0; i < 2; ++i)
#pragma unroll
                for (int j = 0; j < NJ; ++j) acc[i][j] = __builtin_amdgcn_mfma_f32_32x32x16_bf16(af[i][ks], bf_[j][ks], acc[i][j], 0, 0, 0);
    }
    }
}
struct NoMid { template <class T> DI void operator()(T&) const {} };

DI void p4_qa_unit(const Frame& F, const Args& a, int unit) {
    unsigned char* ws = a.ws; const int h = unit >> 3, mt = (unit >> 1) & 3, nt = unit & 1;
    f32x16 acc[2][2];
    sgemm_tile<2, false>((const bf16_t*)(ws + WS_Q) + (size_t)(MP + mt * 128) * 3072 + h * QH, 3072, (const bf16_t*)(ws + WS_WUKN) + (size_t)(nt * 256) * 2048 + h * 128, 2048, NOPE, -1, NoMid(), acc, F.wave, lane_id());
    const int wm = F.wave >> 2, wn = F.wave & 3, r32 = lane_id() & 31, hi = lane_id() >> 5;
#pragma unroll
    for (int i = 0; i < 2; ++i)
#pragma unroll
        for (int j = 0; j < 2; ++j)
#pragma unroll
            for (int r = 0; r < 16; ++r) { const int t = mt * 128 + wm * 64 + i * 32 + crow(r, hi), c = nt * 256 + wn * 64 + j * 32 + r32;
                ((bf16_t*)(ws + WS_QCAT))[((size_t)t * 16 + h) * KC + c] = f2bf(acc[i][j][r]); }
    __builtin_amdgcn_sched_barrier(0);
#pragma unroll
    for (int i = 0; i < 2; ++i)
#pragma unroll
        for (int j = 0; j < 2; ++j)
#pragma unroll
            for (int r4 = 0; r4 < 4; ++r4) {
#pragma unroll
                for (int e = 0; e < 4; ++e) { const int r = 4 * r4 + e, t = mt * 128 + wm * 64 + i * 32 + crow(r, hi), c = nt * 256 + wn * 64 + j * 32 + r32;
                    (ws + WS_QCAT8)[((size_t)t * 16 + h) * KVL + c] = (unsigned char)(pk4_fp8(acc[i][j][r] * SC8_QA, 0.f, 0.f, 0.f) & 0xffu); }
                __builtin_amdgcn_sched_barrier(0); }
}

namespace att {
constexpr int SHM_K = 64 * 256  , SHM_V = 64 * 128 * 2;
constexpr int OFF_V = 0, OFF_K = 2 * SHM_V, OFF_WS = OFF_K + 2 * SHM_K, LDS_NEED = OFF_WS + 8 * 64 * 4;
static_assert(LDS_NEED <= RING_BYTES, "attention LDS");
#define KSWZ(row, colB) ((row) * 256 + ((colB) ^ (((row) & 7) << 4)))
#define SBAR() __builtin_amdgcn_sched_barrier(0)
DI int v_st(int k, int c) { const int kk = (k & ~0xC) | ((k & 4) << 1) | ((k & 8) >> 1); return ((kk >> 3) * 4 + (c >> 5)) * 512 + ((kk & 7) * 32 + (c & 31)) * 2; }
DI int v_rd_base(int lane) { return ((lane & 3) << 3) | (((lane >> 2) & 3) << 6) | (((lane >> 4) & 1) << 5) | (((lane >> 5) & 1) << 8); }
constexpr float THR = 8.f;
constexpr float ASC = ATT_SCALE / (SC8_A * SC8_A);
constexpr float C2 = 1.4426950408889634f * ASC;

DI void partialSM(f32x16& p0, f32x16& p1, float& m_reg, float& mn, float& alpha) {
    float pmax = p0[0];
#pragma unroll
    for (int r = 1; r < 16; ++r) pmax = fmaxf(pmax, p0[r]);
#pragma unroll
    for (int r = 0; r < 16; ++r) pmax = fmaxf(pmax, p1[r]);
    { auto rr = __builtin_amdgcn_permlane32_swap(__float_as_uint(pmax), __float_as_uint(pmax), false, false);
      pmax = fmaxf(__uint_as_float(rr[0]), __uint_as_float(rr[1])); }
    if (__builtin_expect(__all((pmax - m_reg) * ASC <= THR), 1)) { mn = m_reg; alpha = 1.f; }
    else { mn = fmaxf(m_reg, pmax); alpha = __builtin_amdgcn_exp2f((m_reg - mn) * C2); m_reg = mn; }
    const float mnL = -mn * C2;
#pragma unroll
    for (int r = 0; r < 16; ++r) p0[r] = fmaf(p0[r], C2, mnL);
#pragma unroll
    for (int r = 0; r < 16; ++r) p1[r] = fmaf(p1[r], C2, mnL);
#pragma unroll
    for (int r = 0; r < 16; ++r) p0[r] = __builtin_amdgcn_exp2f(p0[r]);
}
DI void finishSM(f32x16& p0, f32x16& p1, float alpha, float& l_reg, bf16x8& pa0, bf16x8& pa1, bf16x8& pa2, bf16x8& pa3) {
#pragma unroll
    for (int r = 0; r < 16; ++r) p1[r] = __builtin_amdgcn_exp2f(p1[r]);
    float ps = 0;
#pragma unroll
    for (int r = 0; r < 16; ++r) ps += p0[r];
#pragma unroll
    for (int r = 0; r < 16; ++r) ps += p1[r];
    { auto rr = __builtin_amdgcn_permlane32_swap(__float_as_uint(ps), __float_as_uint(ps), false, false);
      ps = __uint_as_float(rr[0]) + __uint_as_float(rr[1]); }
    l_reg = l_reg * alpha + ps;
#define PK4(P, B_, OUT) do { unsigned a0 = cvtpk(P[B_+0], P[B_+1]), a1 = cvtpk(P[B_+2], P[B_+3]);                          \
        unsigned b0 = cvtpk(P[B_+4], P[B_+5]), b1 = cvtpk(P[B_+6], P[B_+7]);                                             \
        auto r0 = __builtin_amdgcn_permlane32_swap(a0, b0, false, false); auto r1 = __builtin_amdgcn_permlane32_swap(a1, b1, false, false); \
        u32x4 w = {r0[0], r1[0], r0[1], r1[1]}; OUT = __builtin_bit_cast(bf16x8, w); } while (0)
    PK4(p0, 0, pa0); PK4(p0, 8, pa1); PK4(p1, 0, pa2); PK4(p1, 8, pa3);
#undef PK4
}
template <int KB>
DI void qkt(f32x16& p0, f32x16& p1, const LAS char* lds, int r32, int hi, const i32x8* q8, bool act) {
    if (!act) { const float NEG = -__builtin_inff();
#pragma unroll
        for (int r = 0; r < 16; ++r) { p0[r] = NEG; p1[r] = NEG; } return; }
#pragma unroll
    for (int r = 0; r < 16; ++r) { p0[r] = 0.f; p1[r] = 0.f; }
    int kb0 = KSWZ(r32, hi * 32);
    asm volatile("" : "+v"(kb0));
#define QK_LD(s, kb, dst) do { const LAS char* a0_ = lds + OFF_K + KB * SHM_K + (kb0 ^ (64 * ((s) & 1))) + 128 * ((s) >> 1) + (kb) * 32 * 256; const LAS char* a1_ = lds + OFF_K + KB * SHM_K + (kb0 ^ (64 * ((s) & 1) + 16)) + 128 * ((s) >> 1) + (kb) * 32 * 256; \
        dst.lo = *(const LAS i32x4*)a0_; dst.hi = *(const LAS i32x4*)a1_; } while (0)
    { i32x8 ka, kb_; QK_LD(0, 0, ka); QK_LD(0, 1, kb_);
      asm volatile("s_nop 1\n\tv_mfma_f32_32x32x64_f8f6f4 %0, %1, %2, %0" : "+v"(p0) : "v"(ka), "v"(q8[0]));
      asm volatile("s_nop 1\n\tv_mfma_f32_32x32x64_f8f6f4 %0, %1, %2, %0" : "+v"(p1) : "v"(kb_), "v"(q8[0])); }
    { i32x8 ka, kb_; QK_LD(1, 0, ka); QK_LD(1, 1, kb_);
      asm volatile("v_mfma_f32_32x32x64_f8f6f4 %0, %1, %2, %0" : "+v"(p0) : "v"(ka), "v"(q8[1]));
      asm volatile("v_mfma_f32_32x32x64_f8f6f4 %0, %1, %2, %0" : "+v"(p1) : "v"(kb_), "v"(q8[1])); }
    { i32x8 ka, kb_; QK_LD(2, 0, ka); QK_LD(2, 1, kb_);
      asm volatile("v_mfma_f32_32x32x64_f8f6f4 %0, %1, %2, %0" : "+v"(p0) : "v"(ka), "v"(q8[2]));
      asm volatile("v_mfma_f32_32x32x64_f8f6f4 %0, %1, %2, %0\n\ts_nop 15\n\ts_nop 7" : "+v"(p1) : "v"(kb_), "v"(q8[2])); }
#undef QK_LD
}
template <int VB>
DI void pv_tile(f32x16* o, int vb0, bf16x8 pa0, bf16x8 pa1, bf16x8 pa2, bf16x8 pa3, bool act) {
    if (!act) return;
#define TRRD(dst, off) asm volatile("ds_read_b64_tr_b16 %0, %1 offset:%2" : "=&v"(dst) : "v"(vb0), "i"(off) : "memory")
#define PV_RD(d0, S) do { constexpr int b_ = OFF_V + VB * SHM_V + (d0) * 512; \
        TRRD(S##l0, b_); TRRD(S##h0, b_ + 2048); TRRD(S##l1, b_ + 4096); TRRD(S##h1, b_ + 6144); TRRD(S##l2, b_ + 8192); TRRD(S##h2, b_ + 10240); TRRD(S##l3, b_ + 12288); TRRD(S##h3, b_ + 14336); } while (0)
#define PV_MM(d0, S) do { \
        o[d0] = __builtin_amdgcn_mfma_f32_32x32x16_bf16(pa0, (bf16x8){S##l0[0], S##l0[1], S##l0[2], S##l0[3], S##h0[0], S##h0[1], S##h0[2], S##h0[3]}, o[d0], 0, 0, 0);   \
        o[d0] = __builtin_amdgcn_mfma_f32_32x32x16_bf16(pa1, (bf16x8){S##l1[0], S##l1[1], S##l1[2], S##l1[3], S##h1[0], S##h1[1], S##h1[2], S##h1[3]}, o[d0], 0, 0, 0);   \
        o[d0] = __builtin_amdgcn_mfma_f32_32x32x16_bf16(pa2, (bf16x8){S##l2[0], S##l2[1], S##l2[2], S##l2[3], S##h2[0], S##h2[1], S##h2[2], S##h2[3]}, o[d0], 0, 0, 0);   \
        o[d0] = __builtin_amdgcn_mfma_f32_32x32x16_bf16(pa3, (bf16x8){S##l3[0], S##l3[1], S##l3[2], S##l3[3], S##h3[0], S##h3[1], S##h3[2], S##h3[3]}, o[d0], 0, 0, 0); } while (0)
    s16x4 Al0, Al1, Al2, Al3, Ah0, Ah1, Ah2, Ah3, Bl0, Bl1, Bl2, Bl3, Bh0, Bh1, Bh2, Bh3;
    PV_RD(0, A);
    PV_RD(1, B); asm volatile("s_waitcnt lgkmcnt(8)" ::: "memory"); SBAR(); PV_MM(0, A); SBAR();
    PV_RD(2, A); asm volatile("s_waitcnt lgkmcnt(8)" ::: "memory"); SBAR(); PV_MM(1, B); SBAR();
    PV_RD(3, B); asm volatile("s_waitcnt lgkmcnt(8)" ::: "memory"); SBAR(); PV_MM(2, A); SBAR();
    asm volatile("s_waitcnt lgkmcnt(0)" ::: "memory"); SBAR(); PV_MM(3, B);
#undef PV_RD
#undef PV_MM
#undef TRRD
}

DI void attn_unit(int b, int h, int qb, const unsigned char* __restrict__ Q8, const unsigned char* __restrict__ KN8, const unsigned char* __restrict__ KR8, const bf16_t* __restrict__ V, bf16_t* __restrict__ O, LAS char* lds, int wid) {
    const int lane = lane_id(), tid = wid * 64 + lane, r32 = lane & 31, hi = lane >> 5;
    const int NT = 4 * qb + 4, wchunk = 4 * qb + (wid >> 1);
    const size_t krow0 = (size_t)b * SEQ;
    const unsigned char* Kh = KN8 + krow0 * 2048 + h * 128; const bf16_t* Vh = V + krow0 * 2048 + h * 128; const unsigned char* Rh = KR8 + krow0 * ROPE;
    LAS float* wsl = (LAS float*)(lds + OFF_WS) + wid * 64; LAS float* li_l = wsl; LAS float* al_l = wsl + 32;
    float m_reg = -1e30f, l_reg = 0; f32x16 o[4];
#pragma unroll
    for (int d = 0; d < 4; ++d)
#pragma unroll
        for (int r = 0; r < 16; ++r) o[d][r] = 0.f;
    const int sr = tid >> 4, sc = (tid & 15) * 8, vst0 = v_st(sr, sc), vst1 = v_st(32 + sr, sc);
    const int rr_ = tid >> 3, rc = tid & 7, kws = KSWZ(rr_, rc * 16), krws = KSWZ(rr_, 128 + rc * 8);
    const int vb0 = (int)(unsigned)(size_t)(lds) + v_rd_base(lane);
    i32x8 q8[3];
    { const unsigned char* qp = Q8 + ((size_t)b * SEQ + qb * 256 + wid * 32 + r32) * 3072 + h * QH + hi * 32;
#pragma unroll
      for (int s = 0; s < 3; ++s) { q8[s].lo = *(const i32x4*)(qp + 64 * s); q8[s].hi = *(const i32x4*)(qp + 64 * s + 16); } }
    bf16x8 st_v0, st_v1; u32x4 st_k; u32x2 st_kr;
#define SLOAD(k0) do { st_v0 = *(const bf16x8*)(Vh + (size_t)((k0) + sr) * 2048 + sc); st_v1 = *(const bf16x8*)(Vh + (size_t)((k0) + 32 + sr) * 2048 + sc); \
                       st_k = *(const u32x4*)(Kh + (size_t)((k0) + rr_) * 2048 + rc * 16); st_kr = *(const u32x2*)(Rh + (size_t)((k0) + rr_) * ROPE + rc * 8); } while (0)
#define SWRITE(bf) do { *(LAS bf16x8*)(lds + OFF_V + (bf) * SHM_V + vst0) = st_v0; *(LAS bf16x8*)(lds + OFF_V + (bf) * SHM_V + vst1) = st_v1; \
                        *(LAS u32x4*)(lds + OFF_K + (bf) * SHM_K + kws) = st_k; *(LAS u32x2*)(lds + OFF_K + (bf) * SHM_K + krws) = st_kr; } while (0)
#define VMW() asm volatile("s_waitcnt vmcnt(0)" ::: "memory")
#define RESC(a_) do { if (__any((a_) < 1.f)) { if (hi == 0) al_l[r32] = (a_); asm volatile("s_waitcnt lgkmcnt(0)" ::: "memory");              \
                     for (int d_ = 0; d_ < 4; ++d_) for (int r = 0; r < 16; ++r) o[d_][r] *= al_l[crow(r, hi)]; } } while (0)
#define ACT(t) ((t) <= wchunk)
    f32x16 pA0, pA1, pB0, pB1; float mnA, mnB, alA, alB; bf16x8 pa0, pa1, pa2, pa3;
    SLOAD(0); VMW(); SWRITE(0);
    __syncthreads();
    if (NT > 1) SLOAD(64);
    SBAR(); qkt<0>(pA0, pA1, lds, r32, hi, q8, ACT(0));
    partialSM(pA0, pA1, m_reg, mnA, alA);
    if (NT > 1) { VMW(); SWRITE(1); }
    __syncthreads();
#define HALF_STEP(ORD, PX0, PX1, mnX, alX, PY0, PY1, alY, t, KB, VB, SB_) do {                                                      \
        if (ORD == 0) {                                                                                                       \
        SBAR(); qkt<KB>(PX0, PX1, lds, r32, hi, q8, ACT(t));                                             \
        finishSM(PY0, PY1, alY, l_reg, pa0, pa1, pa2, pa3); SBAR();                                                           \
        if ((t) + 1 < NT) { SLOAD(((t) + 1) * 64); SBAR(); }                                               \
        pv_tile<VB>(o, vb0, pa0, pa1, pa2, pa3, ACT((t) - 1)); partialSM(PX0, PX1, m_reg, mnX, alX);                                        \
        } else {                                                                                                              \
        SBAR(); finishSM(PY0, PY1, alY, l_reg, pa0, pa1, pa2, pa3); SBAR();                                                   \
        qkt<KB>(PX0, PX1, lds, r32, hi, q8, ACT(t)); SBAR();                                             \
        if ((t) + 1 < NT) { SLOAD(((t) + 1) * 64); SBAR(); }                                               \
        partialSM(PX0, PX1, m_reg, mnX, alX); pv_tile<VB>(o, vb0, pa0, pa1, pa2, pa3, ACT((t) - 1));                                        \
        }                                                                                                                     \
        __syncthreads();                                                                                                      \
        if ((t) + 1 < NT) { VMW(); SWRITE(SB_); }                                                                          \
        RESC(alX); __syncthreads(); } while (0)
    if (wid < 4) {
        for (int t = 1; t + 1 < NT; t += 2) {
            HALF_STEP(0, pB0, pB1, mnB, alB, pA0, pA1, alA, t, 1, 0, 0);
            HALF_STEP(0, pA0, pA1, mnA, alA, pB0, pB1, alB, t + 1, 0, 1, 1);
        }
    } else {
        for (int t = 1; t + 1 < NT; t += 2) {
            HALF_STEP(1, pB0, pB1, mnB, alB, pA0, pA1, alA, t, 1, 0, 0);
            HALF_STEP(1, pA0, pA1, mnA, alA, pB0, pB1, alB, t + 1, 0, 1, 1);
        }
    }
    SBAR(); qkt<1>(pB0, pB1, lds, r32, hi, q8, ACT(NT - 1)); SBAR();
    finishSM(pA0, pA1, alA, l_reg, pa0, pa1, pa2, pa3); SBAR();
    pv_tile<0>(o, vb0, pa0, pa1, pa2, pa3, ACT(NT - 2));
    partialSM(pB0, pB1, m_reg, mnB, alB); RESC(alB);
    finishSM(pB0, pB1, alB, l_reg, pa0, pa1, pa2, pa3); SBAR(); pv_tile<1>(o, vb0, pa0, pa1, pa2, pa3, ACT(NT - 1));
    if (hi == 0) li_l[r32] = l_reg; asm volatile("s_waitcnt lgkmcnt(0)" ::: "memory");
    float rli[16];
#pragma unroll
    for (int r = 0; r < 16; ++r) rli[r] = __builtin_amdgcn_rcpf(li_l[crow(r, hi)]);
    int r32e = r32, hie = hi; asm volatile("" : "+v"(r32e), "+v"(hie));
    bf16_t* Ow = O + ((size_t)b * SEQ + qb * 256 + wid * 32) * D + h * 128 + r32e;
#pragma unroll
    for (int r = 0; r < 16; ++r) { const int orow = crow(r, hie);
#pragma unroll
        for (int d0 = 0; d0 < 4; ++d0) { const float v = o[d0][r] * rli[r]; const float vn = __shfl_xor(v, 1);
            if ((r32e & 1) == 0) *(unsigned*)(Ow + (size_t)orow * D + d0 * 32) = cvtpk(v, vn); } }
    __syncthreads();
#undef SLOAD
#undef SWRITE
#undef VMW
#undef RESC
#undef ACT
#undef HALF_STEP
}
#undef KSWZ
#undef SBAR
}

namespace hg {
constexpr int P = 136, KP = 72, OP = 132;
constexpr int OFF_QE = 0, OFF_QD = 17408, OFF_KDD = 34816, OFF_KDT = 52224, OFF_V = 70656, OFF_AM = 88064, OFF_T = 97280, OFF_DL = 101376, OFF_OX = OFF_QD, LDS_NEED = 101888;
static_assert(OFF_OX + 64 * OP * 4 <= OFF_KDT && LDS_NEED <= RING_BYTES, "hgrn LDS");
DI bf16x8 mk8(u32x2 a, u32x2 b) { u32x4 w = {a.x, a.y, b.x, b.y}; return __builtin_bit_cast(bf16x8, w); }

DI void hgrn_unit(const Args& a, bool smp, int bb, int h, LAS char* lds, int w) {
    unsigned char* ws = a.ws;
    const int lane = lane_id(), tid = w * 64 + lane, n = lane & 15, g = lane >> 4;
    const int nch = smp ? 1 : SEQ / 64, nrow = smp ? ST : 64;
    const size_t row_base = smp ? (size_t)MP + (size_t)bb * ST : (size_t)bb * SEQ;
    const bf16_t* HQ = (const bf16_t*)(ws + WS_HQ) + h * HGD; const bf16_t* HK = (const bf16_t*)(ws + WS_HK) + h * HGD; const bf16_t* HV = (const bf16_t*)(ws + WS_HV) + h * HGD;
    const bf16_t* HGt = (const bf16_t*)(ws + WS_HG) + h * HGD; const float* LF = (const float*)(ws + WS_LF) + h * HGD;
    f32x4 sacc[8];
    float* sout = a.out + (smp ? O_HGS : O_HGP) + ((size_t)bb * HGH + h) * HGD * HGD;
    if (smp) { const float* s0 = a.in[I_SHG] + ((size_t)bb * HGH + h) * HGD * HGD;
#pragma unroll
        for (int kb = 0; kb < 8; ++kb)
#pragma unroll
            for (int i = 0; i < 4; ++i) sacc[kb][i] = s0[(size_t)(16 * kb + 4 * g + i) * HGD + 16 * w + n]; }
    else {
#pragma unroll
        for (int kb = 0; kb < 8; ++kb) sacc[kb] = (f32x4){0.f, 0.f, 0.f, 0.f}; }
    const int c0 = 2 * lane, vrow = tid >> 3, vg = tid & 7;
    f32x2 lfv[8]; unsigned qv[8], kv[8]; u32x4 vraw[2], graw[2];
#define HG_LOAD(cc) do { const size_t r0_ = row_base + (size_t)(cc) * 64; \
        _Pragma("unroll") for (int j = 0; j < 8; ++j) { const int t_ = 8 * w + j; const bool ok_ = t_ < nrow; const size_t ro_ = (r0_ + (ok_ ? t_ : 0)) * HGW + c0; \
            lfv[j] = ok_ ? *(const f32x2*)(LF + ro_) : (f32x2){0.f, 0.f}; qv[j] = ok_ ? *(const unsigned*)(HQ + ro_) : 0u; kv[j] = ok_ ? *(const unsigned*)(HK + ro_) : 0u; } \
        { const bool ok_ = vrow < nrow; const size_t ro_ = (r0_ + (ok_ ? vrow : 0)) * HGW + 16 * vg; const u32x4 z_ = {0u, 0u, 0u, 0u}; \
          vraw[0] = ok_ ? *(const u32x4*)(HV + ro_) : z_; vraw[1] = ok_ ? *(const u32x4*)(HV + ro_ + 8) : z_; graw[0] = ok_ ? *(const u32x4*)(HGt + ro_) : z_; graw[1] = ok_ ? *(const u32x4*)(HGt + ro_ + 8) : z_; } } while (0)
    f32x2 ghg[8];
#pragma unroll
    for (int e2 = 0; e2 < 8; ++e2) ghg[e2] = *(const f32x2*)(a.in[I_GHG] + 16 * vg + 2 * e2);
    HG_LOAD(0);
    for (int c = 0; c < nch; ++c) {
        float bl0[8], bl1[8]; float run0 = 0.f, run1 = 0.f;
#pragma unroll
        for (int j = 0; j < 8; ++j) { run0 += lfv[j].x; run1 += lfv[j].y; bl0[j] = run0; bl1[j] = run1; }
        *(LAS f32x2*)(lds + OFF_T + (w * 128 + c0) * 4) = (f32x2){run0, run1};
        *(LAS u32x4*)(lds + OFF_V + (vrow * P + 16 * vg) * 2) = vraw[0]; *(LAS u32x4*)(lds + OFF_V + (vrow * P + 16 * vg + 8) * 2) = vraw[1];
        const u32x4 gcur0 = graw[0], gcur1 = graw[1];
        asm volatile("s_waitcnt lgkmcnt(0)" ::: "memory"); __syncthreads();
        float off0 = 0.f, off1 = 0.f, br0 = 0.f, br1 = 0.f, bt0 = 0.f, bt1 = 0.f;
#pragma unroll
        for (int e = 0; e < 8; ++e) { const f32x2 tv = *(const LAS f32x2*)(lds + OFF_T + (e * 128 + c0) * 4); if (e < w) { off0 += tv.x; off1 += tv.y; } if (e < 4) { br0 += tv.x; br1 += tv.y; } bt0 += tv.x; bt1 += tv.y; }
        float kd0[8], kd1[8];
#pragma unroll
        for (int j = 0; j < 8; ++j) { const int t = 8 * w + j; const float b0 = off0 + bl0[j], b1 = off1 + bl1[j];
            const float q0 = bf_lo(qv[j]), q1 = bf_hi(qv[j]), k0 = bf_lo(kv[j]), k1 = bf_hi(kv[j]);
            *(LAS unsigned*)(lds + OFF_QE + (t * P + c0) * 2) = cvtpk(q0 * __expf(b0), q1 * __expf(b1));
            *(LAS unsigned*)(lds + OFF_QD + (t * P + c0) * 2) = cvtpk(q0 * __expf(b0 - br0), q1 * __expf(b1 - br1));
            *(LAS unsigned*)(lds + OFF_KDD + (t * P + c0) * 2) = cvtpk(k0 * __expf(br0 - b0), k1 * __expf(br1 - b1));
            kd0[j] = k0 * __expf(bt0 - b0); kd1[j] = k1 * __expf(bt1 - b1); }
        { u32x4 p0, p1; p0.x = cvtpk(kd0[0], kd0[1]); p0.y = cvtpk(kd0[2], kd0[3]); p0.z = cvtpk(kd0[4], kd0[5]); p0.w = cvtpk(kd0[6], kd0[7]);
          p1.x = cvtpk(kd1[0], kd1[1]); p1.y = cvtpk(kd1[2], kd1[3]); p1.z = cvtpk(kd1[4], kd1[5]); p1.w = cvtpk(kd1[6], kd1[7]);
          *(LAS u32x4*)(lds + OFF_KDT + (c0 * KP + 8 * w) * 2) = p0; *(LAS u32x4*)(lds + OFF_KDT + ((c0 + 1) * KP + 8 * w) * 2) = p1; }
        if (w == 0) *(LAS f32x2*)(lds + OFF_DL + c0 * 4) = (f32x2){__expf(bt0), __expf(bt1)};
        asm volatile("s_waitcnt lgkmcnt(0)" ::: "memory"); __syncthreads();
        if (c + 1 < nch) HG_LOAD(c + 1);
        { const int tb = w >> 1;
#pragma unroll
          for (int sbi = 0; sbi < 2; ++sbi) { const int sb = 2 * (w & 1) + sbi; f32x4 acc = {0.f, 0.f, 0.f, 0.f};
            if (sb <= tb) {
#pragma unroll
                for (int ks = 0; ks < 4; ++ks) { const bf16x8 af = *(const LAS bf16x8*)(lds + OFF_KDD + ((16 * sb + n) * P + 32 * ks + 8 * g) * 2), bfr = *(const LAS bf16x8*)(lds + OFF_QD + ((16 * tb + n) * P + 32 * ks + 8 * g) * 2);
                    acc = __builtin_amdgcn_mfma_f32_16x16x32_bf16(af, bfr, acc, 0, 0, 0); }
                if (sb == tb) {
#pragma unroll
                    for (int i = 0; i < 4; ++i) if (n < 4 * g + i) acc[i] = 0.f; }
            }
            u32x2 pk; pk.x = cvtpk(acc[0], acc[1]); pk.y = cvtpk(acc[2], acc[3]);
            *(LAS u32x2*)(lds + OFF_AM + ((16 * tb + n) * KP + 16 * sb + 4 * g) * 2) = pk; } }
        f32x4 oacc[4];
#pragma unroll
        for (int tb = 0; tb < 4; ++tb) oacc[tb] = (f32x4){0.f, 0.f, 0.f, 0.f};
#pragma unroll
        for (int j = 0; j < 4; ++j) { u32x4 sb4; sb4.x = cvtpk(sacc[2 * j][0], sacc[2 * j][1]); sb4.y = cvtpk(sacc[2 * j][2], sacc[2 * j][3]); sb4.z = cvtpk(sacc[2 * j + 1][0], sacc[2 * j + 1][1]); sb4.w = cvtpk(sacc[2 * j + 1][2], sacc[2 * j + 1][3]);
            const bf16x8 bfr = __builtin_bit_cast(bf16x8, sb4);
#pragma unroll
            for (int tb = 0; tb < 4; ++tb) { const LAS char* qp = lds + OFF_QE + ((16 * tb + n) * P + 32 * j + 4 * g) * 2;
                const bf16x8 af = mk8(*(const LAS u32x2*)qp, *(const LAS u32x2*)(qp + 32));
                oacc[tb] = __builtin_amdgcn_mfma_f32_16x16x32_bf16(af, bfr, oacc[tb], 0, 0, 0); } }
        asm volatile("s_waitcnt lgkmcnt(0)" ::: "memory"); __syncthreads();
        bf16x8 vf[2];
#pragma unroll
        for (int js = 0; js < 2; ++js) { unsigned short e_[8];
#pragma unroll
            for (int i = 0; i < 8; ++i) e_[i] = *(const LAS unsigned short*)(lds + OFF_V + ((32 * js + 8 * g + i) * P + 16 * w + n) * 2);
            u32x4 t_; t_.x = e_[0] | ((unsigned)e_[1] << 16); t_.y = e_[2] | ((unsigned)e_[3] << 16); t_.z = e_[4] | ((unsigned)e_[5] << 16); t_.w = e_[6] | ((unsigned)e_[7] << 16);
            vf[js] = __builtin_bit_cast(bf16x8, t_); }
#pragma unroll
        for (int tb = 0; tb < 4; ++tb)
#pragma unroll
            for (int js = 0; js < 2; ++js) { const bf16x8 af = *(const LAS bf16x8*)(lds + OFF_AM + ((16 * tb + n) * KP + 32 * js + 8 * g) * 2);
                oacc[tb] = __builtin_amdgcn_mfma_f32_16x16x32_bf16(af, vf[js], oacc[tb], 0, 0, 0); }
#pragma unroll
        for (int kb = 0; kb < 8; ++kb) { const f32x4 dl = *(const LAS f32x4*)(lds + OFF_DL + (16 * kb + 4 * g) * 4); sacc[kb] = sacc[kb] * dl;
#pragma unroll
            for (int js = 0; js < 2; ++js) { const bf16x8 af = *(const LAS bf16x8*)(lds + OFF_KDT + ((16 * kb + n) * KP + 32 * js + 8 * g) * 2);
                sacc[kb] = __builtin_amdgcn_mfma_f32_16x16x32_bf16(af, vf[js], sacc[kb], 0, 0, 0); } }
#pragma unroll
        for (int tb = 0; tb < 4; ++tb)
#pragma unroll
            for (int i = 0; i < 4; ++i) *(LAS float*)(lds + OFF_OX + ((16 * tb + 4 * g + i) * OP + 16 * w + n) * 4) = oacc[tb][i];
        asm volatile("s_waitcnt lgkmcnt(0)" ::: "memory"); __syncthreads();
        { f32x4 ov[4];
#pragma unroll
          for (int q4 = 0; q4 < 4; ++q4) ov[q4] = *(const LAS f32x4*)(lds + OFF_OX + (vrow * OP + 16 * vg + 4 * q4) * 4);
          float ss = 0.f;
#pragma unroll
          for (int q4 = 0; q4 < 4; ++q4) ss += (ov[q4][0] * ov[q4][0] + ov[q4][1] * ov[q4][1]) + (ov[q4][2] * ov[q4][2] + ov[q4][3] * ov[q4][3]);
          ss += __shfl_xor(ss, 1); ss += __shfl_xor(ss, 2); ss += __shfl_xor(ss, 4);
          const float rs = rsqrtf(ss * (1.f / HGD) + EPS);
          const unsigned gw_[8] = {gcur0.x, gcur0.y, gcur0.z, gcur0.w, gcur1.x, gcur1.y, gcur1.z, gcur1.w};
          u32x4 o0, o1; unsigned ow[8];
#pragma unroll
          for (int e2 = 0; e2 < 8; ++e2) { const float x0 = ov[e2 >> 1][(e2 & 1) * 2], x1 = ov[e2 >> 1][(e2 & 1) * 2 + 1];
              const f32x2 go = ghg[e2]; ow[e2] = cvtpk(x0 * rs * go.x * bf_lo(gw_[e2]), x1 * rs * go.y * bf_hi(gw_[e2])); }
          o0.x = ow[0]; o0.y = ow[1]; o0.z = ow[2]; o0.w = ow[3]; o1.x = ow[4]; o1.y = ow[5]; o1.z = ow[6]; o1.w = ow[7];
          if (vrow < nrow) { bf16_t* mp = (bf16_t*)(ws + WS_MIX) + (row_base + (size_t)c * 64 + vrow) * D + 2048 + h * HGD + 16 * vg; *(u32x4*)mp = o0; *(u32x4*)(mp + 8) = o1; } }
    }
#undef HG_LOAD
#pragma unroll
    for (int kb = 0; kb < 8; ++kb)
#pragma unroll
        for (int i = 0; i < 4; ++i) sout[(size_t)(16 * kb + 4 * g + i) * HGD + 16 * w + n] = sacc[kb][i];
    __syncthreads();
}
}

DI int q_next(const Frame& F, unsigned* head) {
    volatile LAS unsigned* MISC = (volatile LAS unsigned*)(F.lds + MISC_OFF);
    if ((F.wave * 64 + lane_id()) == 0) MISC[16] = __hip_atomic_fetch_add(head, 1u, RLX_AGENT);
    __syncthreads();
    const int v = (int)MISC[16];
    __syncthreads();
    return v;
}

struct EpiS1 {
    unsigned char* ws; float* Sb; int adj; float sc;
    DI void operator()(ACC_T, const pg8::Unit& u, int wr, int wc, int fr, int fq, int lane) const {
        const int c8 = wc * 32 + 8 * fq, pn17 = u.pn + (adj ? u.pm : 0), ktile = pn17 - 17 * u.pm;
        const float* ssk = (const float*)(ws + WS_SSK) + (size_t)fr * ((size_t)SB * KPAD) + (size_t)pn17 * 256 + c8;
        const bf16_t* kb = (const bf16_t*)(ws + WS_KCAT) + ((size_t)pn17 * 256 + wc * 32 + 8 * (fr >> 2) + (fr & 3)) * KC + KVL + 8 * fq;
        const bf16_t* qb = (const bf16_t*)(ws + WS_QCAT) + ((size_t)u.pm * 256 + wr * 64 + fr) * KC + KVL + 8 * fq;
        bf16_t* S = (bf16_t*)Sb + ((size_t)u.pm * 256 + wr * 64 + fr) * SPITCH + ktile * 256 + c8;
        bf16x8 qf[8][2];
#pragma unroll
        for (int sl = 0; sl < 8; ++sl) { const bf16_t* qp = qb + (size_t)((sl >> 2) * 128 + (sl & 3) * 16) * KC; qf[sl][0] = *(const bf16x8*)qp; qf[sl][1] = *(const bf16x8*)(qp + 32); }
#pragma unroll
        for (int bj = 0; bj < 2; ++bj) {
            if (bj == 1 && ktile == 16) break;
            bf16x8 kf[2][2]; f32x4 rk[2];
#pragma unroll
            for (int n = 0; n < 2; ++n) { const f32x4 sv = *(const f32x4*)(ssk + bj * 128 + 4 * n);
#pragma unroll
                for (int e = 0; e < 4; ++e) rk[n][e] = rsqrtf(sv[e] * (1.f / NOPE) + EPS) * sc;
#pragma unroll
                for (int ks = 0; ks < 2; ++ks) kf[n][ks] = *(const bf16x8*)(kb + (size_t)(bj * 128 + 4 * n) * KC + 32 * ks); }
#pragma unroll
            for (int ai = 0; ai < 2; ++ai)
#pragma unroll
                for (int m = 0; m < 4; ++m) { const bf16x8 q0 = qf[ai * 4 + m][0], q1 = qf[ai * 4 + m][1];
                    f32x4 t0 = acc[ai][bj][m][0] * rk[0], t1 = acc[ai][bj][m][1] * rk[1];
                    t0 = __builtin_amdgcn_mfma_f32_16x16x32_bf16(kf[0][0], q0, t0, 0, 0, 0); t0 = __builtin_amdgcn_mfma_f32_16x16x32_bf16(kf[0][1], q1, t0, 0, 0, 0);
                    t1 = __builtin_amdgcn_mfma_f32_16x16x32_bf16(kf[1][0], q0, t1, 0, 0, 0); t1 = __builtin_amdgcn_mfma_f32_16x16x32_bf16(kf[1][1], q1, t1, 0, 0, 0);
                    st_bf16x8(S + (size_t)(ai * 128 + m * 16) * SPITCH + bj * 128, t0 * ATT_SCALE, t1 * ATT_SCALE); }
        }
    }
};
struct EpiPV {
    unsigned char* ws;
    DI void operator()(ACC_T, const pg8::Unit& u, int wr, int wc, int fr, int fq, int lane) const {
        float* O = (float*)(ws + WS_OLAT) + ((size_t)u.pm * 256 + wr * 64 + fr) * KVL + (u.pn & 1) * 256 + wc * 32 + 8 * fq;
#pragma unroll
        for (int ai = 0; ai < 2; ++ai)
#pragma unroll
            for (int m = 0; m < 4; ++m)
#pragma unroll
                for (int bj = 0; bj < 2; ++bj) st_f32x8(O + (size_t)(ai * 128 + m * 16) * KVL + bj * 128, acc[ai][bj][m][0], acc[ai][bj][m][1]);
    }
};
#define CHAIN_SYNC() do { asm volatile("s_waitcnt vmcnt(0) lgkmcnt(0)" ::: "memory"); __syncthreads(); __builtin_amdgcn_fence(__ATOMIC_ACQUIRE, "agent"); asm volatile("s_waitcnt vmcnt(0)" ::: "memory"); __syncthreads(); } while (0)
DI void sample_chain(const Frame& F, const Args& a, int b) {
    unsigned char* ws = a.ws;
    { pg8::Gemm g{(const bf16_t*)(ws + WS_QCAT), (const bf16_t*)(ws + WS_KCAT), KC, KC, KVL, nullptr}; pg8::OneBatchOrder S{b, 17, KVL / 64, 16}; EpiS1 E{ws, (float*)((unsigned char*)a.out + OS_S), 0, 1.f}; pg8::gemm_phase(F.lds, g, S, E, F.wave); }
    CHAIN_SYNC();
    { const int lane = lane_id();
      for (int r = F.wave; r < 256; r += 16) {
        const bf16_t* s0 = (const bf16_t*)((const unsigned char*)a.out + OS_S) + (size_t)(b * 256 + r) * SPITCH; const bf16_t* s1 = s0 + (size_t)8 * SPITCH;
        bf16_t* p0 = (bf16_t*)(ws + WS_P) + (size_t)(b * 256 + r) * KT; bf16_t* p1 = p0 + (size_t)8 * KT;
        f32x4 v0[17], v1[17]; float m0 = -1e30f, m1 = -1e30f;
#pragma unroll
        for (int j = 0; j < 17; ++j) { const int idx = 4 * lane + 256 * j; if (idx < NKEY) { const u32x2 a0 = *(const u32x2*)(s0 + idx), a1 = *(const u32x2*)(s1 + idx); v0[j] = (f32x4){bf_lo(a0.x), bf_hi(a0.x), bf_lo(a0.y), bf_hi(a0.y)}; v1[j] = (f32x4){bf_lo(a1.x), bf_hi(a1.x), bf_lo(a1.y), bf_hi(a1.y)}; } else { v0[j] = (f32x4){-1e30f, -1e30f, -1e30f, -1e30f}; v1[j] = v0[j]; } }
#pragma unroll
        for (int j = 0; j < 17; ++j) { m0 = fmaxf(m0, fmaxf(fmaxf(v0[j][0], v0[j][1]), fmaxf(v0[j][2], v0[j][3]))); m1 = fmaxf(m1, fmaxf(fmaxf(v1[j][0], v1[j][1]), fmaxf(v1[j][2], v1[j][3]))); }
#pragma unroll
        for (int o = 1; o < 64; o <<= 1) { m0 = fmaxf(m0, __shfl_xor(m0, o)); m1 = fmaxf(m1, __shfl_xor(m1, o)); }
        float sum0 = 0.f, sum1 = 0.f;
#pragma unroll
        for (int j = 0; j < 17; ++j) { const bool ok = 4 * lane + 256 * j < NKEY;
#pragma unroll
            for (int e = 0; e < 4; ++e) { const float e0 = ok ? __expf(v0[j][e] - m0) : 0.f, e1 = ok ? __expf(v1[j][e] - m1) : 0.f; v0[j][e] = e0; v1[j][e] = e1; sum0 += e0; sum1 += e1; } }
#pragma unroll
        for (int o = 1; o < 64; o <<= 1) { sum0 += __shfl_xor(sum0, o); sum1 += __shfl_xor(sum1, o); }
        const float i0 = 1.0f / sum0, i1 = 1.0f / sum1;
#pragma unroll
        for (int j = 0; j < 17; ++j) { const int idx = 4 * lane + 256 * j; if (idx < KT) { u32x2 o; o.x = cvtpk(v0[j][0] * i0, v0[j][1] * i0); o.y = cvtpk(v0[j][2] * i0, v0[j][3] * i0); *(u32x2*)(p0 + idx) = o;
                                                                                 u32x2 q; q.x = cvtpk(v1[j][0] * i1, v1[j][1] * i1); q.y = cvtpk(v1[j][2] * i1, v1[j][3] * i1); *(u32x2*)(p1 + idx) = q; } } } }
    CHAIN_SYNC();
    { pg8::Gemm g{(const bf16_t*)(ws + WS_P), (const bf16_t*)(ws + WS_CKVT), KT, KT, KT, nullptr}; pg8::OneBatchOrder S{b, 2, KT / 64}; EpiPV E{ws}; pg8::gemm_phase(F.lds, g, S, E, F.wave); }
    CHAIN_SYNC();
    {
      const int lane = lane_id(), n = lane & 15, g = lane >> 4;
#pragma unroll 1
      for (int hh = 0; hh < 2; ++hh) { const int h = 2 * F.wave + hh;
        const float* ap = (const float*)(ws + WS_OLAT) + ((size_t)b * 256 + n * 16 + h) * KVL + 8 * g;
        const bf16_t* bp = (const bf16_t*)(ws + WS_WUKVT) + (size_t)(2048 + h * 128 + n) * KVL + 8 * g;
        f32x4 oacc[8];
#pragma unroll
        for (int db = 0; db < 8; ++db) oacc[db] = (f32x4){0.f, 0.f, 0.f, 0.f};
        for (int ks = 0; ks < KVL / 32; ++ks) { const bf16x8 af = __builtin_bit_cast(bf16x8, pack8(*(const f32x4*)(ap + 32 * ks), *(const f32x4*)(ap + 32 * ks + 4)));
#pragma unroll
            for (int db = 0; db < 8; ++db) oacc[db] = __builtin_amdgcn_mfma_f32_16x16x32_bf16(af, *(const bf16x8*)(bp + (size_t)(16 * db) * KVL + 32 * ks), oacc[db], 0, 0, 0); }
#pragma unroll
        for (int db = 0; db < 8; ++db)
#pragma unroll
            for (int i = 0; i < 4; ++i) ((bf16_t*)(ws + WS_MIX))[((size_t)MP + b * 16 + 4 * g + i) * D + h * 128 + 16 * db + n] = f2bf(oacc[db][i]); } }
    __syncthreads();
}

constexpr int MX_HG = 64 + SB * HGH, MX_ATT = 1024, MX_S = SB * 34;
DI void p5_mixer(const Frame& F, const Args& a) {
    unsigned char* ws = a.ws; unsigned* head = (unsigned*)(ws + WS_CTL) + CW_QUEUE;
    for (;;) { const int u = q_next(F, head + 192); if (u >= SB) break; sample_chain(F, a, u); }
#ifndef MX_OFF_HG
    for (;;) { const int u = q_next(F, head); if (u >= MX_HG) break;
        const bool smp = u >= 64; const int v = smp ? u - 64 : u; hg::hgrn_unit(a, smp, v >> 4, v & 15, (LAS char*)F.lds, F.wave); }
#endif
#ifndef MX_OFF_ATT
    for (;;) { const int u = q_next(F, head + 64); if (u >= MX_ATT) break;
        const int qb = 15 - (u >> 6), bh = u & 63;
        att::attn_unit(bh >> 4, bh & 15, qb, ws + WS_Q, ws + WS_KN, ws + WS_KRN, (const bf16_t*)(ws + WS_V), (bf16_t*)(ws + WS_MIX), (LAS char*)F.lds, F.wave); }
#endif
}

DI void p6_late_weights(const Frame& F, const Args& a) {
    unsigned char* ws = a.ws; LAS float* scr = (LAS float*)(F.lds + F.wave * 16384);
    constexpr int I_O = (D / 64) * (D / 32), I_UP = (D / 64) * (FF2 / 32), I_DN = (FF / 64) * (D / 32), NIT = 2 * I_O + I_UP + I_DN;
    for (int it = F.gw; it < NIT; it += F.NGW) { int r = it;
        if (tr_matrix(r, a.in[I_WO], D, D, (bf16_t*)(ws + WS_WOT), D, nullptr, scr, lane_id())) continue;
        if (tr_matrix(r, a.in[I_WUP], D, FF2, (bf16_t*)(ws + WS_WUPT), D, a.in[I_GFFN], scr, lane_id(), 1 << 30, 0, true)) continue;
        if (tr_matrix(r, a.in[I_WD], FF, D, (bf16_t*)(ws + WS_WDT), FF, nullptr, scr, lane_id())) continue;
        tr_matrix(r, a.in[I_WPG], D, D, nullptr, D, a.in[I_GPLE], scr, lane_id(), 1 << 30, 0, false, false, ws + WS_WG8, SC8_G); }
}
struct EpiWo {
    unsigned char* ws; const bf16_t* xb; int s0 = 0, s1 = 8;
    DI void operator()(ACC_T, const pg8::Unit& u, int wr, int wc, int fr, int fq, int lane) const {
        const int row0 = u.pm * 256 + wr * 64 + fr, c8 = wc * 32 + 8 * fq;
#pragma unroll
        for (int ai = 0; ai < 2; ++ai)
#pragma unroll
            for (int m = 0; m < 4; ++m) { if (ai * 4 + m < s0 || ai * 4 + m >= s1) continue; const int row = row0 + ai * 128 + m * 16; const bf16_t* xr = xb + (size_t)row * D; float ss = 0.f;
#pragma unroll
                for (int bj = 0; bj < 2; ++bj) { const int col = u.pn * 256 + bj * 128 + c8; const u32x4 xw = *(const u32x4*)(xr + col); const f32x4 v0 = acc[ai][bj][m][0] + (f32x4){bf_lo(xw.x), bf_hi(xw.x), bf_lo(xw.y), bf_hi(xw.y)}, v1 = acc[ai][bj][m][1] + (f32x4){bf_lo(xw.z), bf_hi(xw.z), bf_lo(xw.w), bf_hi(xw.w)};
                    st_bf16x8((bf16_t*)(ws + WS_X1B) + (size_t)row * D + col, v0, v1); ss += dot8(v0, v1); }
                ss += __shfl_xor(ss, 16); ss += __shfl_xor(ss, 32);
                if (fq == 0) unsafeAtomicAdd((float*)(ws + OFF_SSQ2) + row, ss); }
    }
};
DI float dpp_ror1(float v) { return __int_as_float(__builtin_amdgcn_mov_dpp(__float_as_int(v), 0x121, 0xf, 0xf, false)); }
DI float dpp_ror2(float v) { return __int_as_float(__builtin_amdgcn_mov_dpp(__float_as_int(v), 0x122, 0xf, 0xf, false)); }
struct EpiUp {
    unsigned char* ws; float* out; const float* cw; const float* cb; LAS unsigned char* lds; int s0 = 0, s1 = 8;
    DI void operator()(ACC_T, const pg8::Unit& u, int wr, int wc, int fr, int fq, int lane) const {
        const float* ssq = (const float*)(ws + OFF_SSQ2);
        const int row0 = u.pm * 256 + wr * 64 + fr, ch0 = u.pn * 128 + wc * 32 + 8 * fq;
        if (u.pm >= MP / 256) {
#pragma unroll
            for (int ai = 0; ai < 2; ++ai)
#pragma unroll
                for (int m = 0; m < 4; ++m) { if (ai * 4 + m < s0 || ai * 4 + m >= s1) continue; const int row = row0 + ai * 128 + m * 16; const float rs = rsqrtf(ssq[row] * (1.f / D) + EPS);
                    float* cv = nullptr; { const int sr = row - MP, t = sr & 15; if (t >= ST - 2) cv = out + O_CVS + ((size_t)(sr >> 4) * 2 + (t - (ST - 2))) * FF2; }
#pragma unroll
                    for (int bj = 0; bj < 2; ++bj) { const int col = bj * FF + ch0; const f32x4 v0 = acc[ai][bj][m][0] * rs, v1 = acc[ai][bj][m][1] * rs;
                        st_bf16x8((bf16_t*)(ws + WS_U) + (size_t)row * FF2 + col, v0, v1); if (cv) st_f32x8(cv + col, v0, v1); } }
            return;
        }
        LAS float* halo = (LAS float*)(lds + XCH_OFF);
        float rsv[2][4];
        rsv[0][0] = rsqrtf(ssq[row0] * (1.f / D) + EPS); rsv[0][3] = rsqrtf(ssq[row0 + 48] * (1.f / D) + EPS); rsv[1][3] = rsqrtf(ssq[row0 + 128 + 48] * (1.f / D) + EPS);
        if (wc == 0 && fq == 0) { LAS float* rw = (LAS float*)(lds + XCH_OFF + 8192) + (wr * 16 + fr) * 8;
#pragma unroll
            for (int sl = 0; sl < 8; ++sl) rw[sl] = rsqrtf(ssq[row0 + (sl >> 2) * 128 + (sl & 3) * 16] * (1.f / D) + EPS); }
#pragma unroll
        for (int ai = 0; ai < 2; ++ai) {
            if (fr >= 14) { LAS float* hp = halo + ((((2 * ai + wr) * 4 + wc) * 2 + (fr - 14)) * 4 + fq) * 16;
#pragma unroll
                for (int bj = 0; bj < 2; ++bj) { *(LAS f32x4*)(hp + bj * 8) = acc[ai][bj][3][0] * rsv[ai][3]; *(LAS f32x4*)(hp + bj * 8 + 4) = acc[ai][bj][3][1] * rsv[ai][3]; } } }
        { float* uh = (float*)(ws + WS_UH) + (size_t)u.pm * 4 * FF2;
          if (wr == 0 && fr < 2) {
#pragma unroll
              for (int bj = 0; bj < 2; ++bj) st_f32x8(uh + (size_t)fr * FF2 + bj * FF + ch0, acc[0][bj][0][0] * rsv[0][0], acc[0][bj][0][1] * rsv[0][0]); }
          if (wr == 1 && fr >= 14) { float* cv = ((u.pm & 15) == 15) ? out + O_CVP + ((size_t)(u.pm >> 4) * 2 + (fr - 14)) * FF2 : nullptr;
#pragma unroll
              for (int bj = 0; bj < 2; ++bj) { const f32x4 v0 = acc[1][bj][3][0] * rsv[1][3], v1 = acc[1][bj][3][1] * rsv[1][3];
                  st_f32x8(uh + (size_t)(2 + fr - 14) * FF2 + bj * FF + ch0, v0, v1); if (cv) st_f32x8(cv + bj * FF + ch0, v0, v1); } } }
        asm volatile("s_waitcnt lgkmcnt(0)" ::: "memory"); __builtin_amdgcn_s_barrier(); asm volatile("" ::: "memory");
        bf16_t* actp = (bf16_t*)(ws + WS_ACT) + (size_t)row0 * FF + ch0;
        const bool f1 = fr >= 1, f2 = fr >= 2, e1 = fr == 1;
#pragma unroll
        for (int n = 0; n < 2; ++n) {
            f32x4 w0[2], w1[2], w2[2], bb[2];
#pragma unroll
            for (int s = 0; s < 2; ++s) { const int col = s * FF + ch0 + 4 * n; w0[s] = *(const f32x4*)(cw + col); w1[s] = *(const f32x4*)(cw + FF2 + col); w2[s] = *(const f32x4*)(cw + 2 * FF2 + col); bb[s] = *(const f32x4*)(cb + col); }
#pragma unroll
            for (int ai = 0; ai < 2; ++ai) {
                const int gi = 2 * ai + wr;
                f32x4 q1[2], q2[2];
#pragma unroll
                for (int m = 0; m < 4; ++m) {
                    int ro_ = (wr * 16 + fr) * 32 + XCH_OFF + 8192; asm volatile("" : "+v"(ro_)); const float rsl = *(const LAS float*)(lds + ro_ + (ai * 4 + m) * 4);
                    f32x4 c[2];
#pragma unroll
                    for (int s = 0; s < 2; ++s) {
                        const f32x4 cur = acc[ai][s][m][n] * rsl;
                        f32x4 r1, r2;
#pragma unroll
                        for (int e = 0; e < 4; ++e) { r1[e] = dpp_ror1(cur[e]); r2[e] = dpp_ror2(cur[e]); }
                        if (m == 0) { f32x4 h0 = {0.f, 0.f, 0.f, 0.f}, h1 = h0;
                            if (gi > 0) { const LAS float* hp = halo + ((((gi - 1) * 4 + wc) * 2) * 4 + fq) * 16 + s * 8 + 4 * n; h0 = *(const LAS f32x4*)hp; h1 = *(const LAS f32x4*)(hp + 64); }
#pragma unroll
                            for (int e = 0; e < 4; ++e) { const float p1 = f1 ? r1[e] : h1[e], p2 = f2 ? r2[e] : (e1 ? h1[e] : h0[e]); c[s][e] = bb[s][e] + w0[s][e] * p2 + w1[s][e] * p1 + w2[s][e] * cur[e]; }
                        } else {
#pragma unroll
                            for (int e = 0; e < 4; ++e) { const float p1 = f1 ? r1[e] : q1[s][e], p2 = f2 ? r2[e] : q2[s][e]; c[s][e] = bb[s][e] + w0[s][e] * p2 + w1[s][e] * p1 + w2[s][e] * cur[e]; }
                        }
                        q1[s] = r1; q2[s] = r2;
                    }
                    if (!(gi == 0 && m == 0 && fr < 2)) {
                        float o[4];
#pragma unroll
                        for (int e = 0; e < 4; ++e) o[e] = c[0][e] * __builtin_amdgcn_rcpf(1.0f + __expf(-c[0][e])) * c[1][e];
                        u32x2 ov; ov.x = cvtpk(o[0], o[1]); ov.y = cvtpk(o[2], o[3]);
                        *(u32x2*)(actp + (size_t)(ai * 128 + m * 16) * FF + 4 * n) = ov; }
                }
            }
        }
        asm volatile("s_waitcnt lgkmcnt(0)" ::: "memory"); __builtin_amdgcn_s_barrier(); asm volatile("" ::: "memory");
    }
};
struct EpiUpFin {
    unsigned char* ws; float* out; const float* cw; const float* cb; const float* scv; int s0 = 0, s1 = 8;
    DI void operator()(ACC_T, const pg8::Unit& u, int wr, int wc, int fr, int fq, int lane) const {
        const float* ssq = (const float*)(ws + OFF_SSQ2);
        const int row0 = u.pm * 256 + wr * 64 + fr, ch0 = u.pn * 128 + wc * 32 + 8 * fq;
#pragma unroll
        for (int n = 0; n < 2; ++n) {
            f32x4 w0[2], w1[2], w2[2], bb[2];
#pragma unroll
            for (int s = 0; s < 2; ++s) { const int col = s * FF + ch0 + 4 * n; w0[s] = *(const f32x4*)(cw + col); w1[s] = *(const f32x4*)(cw + FF2 + col); w2[s] = *(const f32x4*)(cw + 2 * FF2 + col); bb[s] = *(const f32x4*)(cb + col); }
#pragma unroll
            for (int ai = 0; ai < 2; ++ai)
#pragma unroll
                for (int m = 0; m < 4; ++m) { if (ai * 4 + m < s0 || ai * 4 + m >= s1) continue;
                    const int row = row0 + ai * 128 + m * 16, sq = (row - MP) >> 4; const float rs = rsqrtf(ssq[row] * (1.f / D) + EPS);
                    f32x4 c[2];
#pragma unroll
                    for (int s = 0; s < 2; ++s) { const int col = s * FF + ch0 + 4 * n;
                        const f32x4 cur = acc[ai][s][m][n] * rs, h2 = *(const f32x4*)(scv + (size_t)(sq * 2) * FF2 + col), h1 = *(const f32x4*)(scv + (size_t)(sq * 2 + 1) * FF2 + col);
#pragma unroll
                        for (int e = 0; e < 4; ++e) { const float r1 = dpp_ror1(cur[e]), r2 = dpp_ror2(cur[e]); const float p1 = fr >= 1 ? r1 : h1[e], p2 = fr >= 2 ? r2 : (fr == 1 ? h1[e] : h2[e]);
                            c[s][e] = bb[s][e] + w0[s][e] * p2 + w1[s][e] * p1 + w2[s][e] * cur[e]; }
                        if (fr >= ST - 2) *(f32x4*)(out + O_CVS + ((size_t)sq * 2 + (fr - (ST - 2))) * FF2 + col) = cur; }
                    float o[4];
#pragma unroll
                    for (int e = 0; e < 4; ++e) o[e] = c[0][e] * __builtin_amdgcn_rcpf(1.0f + __expf(-c[0][e])) * c[1][e];
                    u32x2 ov; ov.x = cvtpk(o[0], o[1]); ov.y = cvtpk(o[2], o[3]);
                    *(u32x2*)((bf16_t*)(ws + WS_ACT) + (size_t)row * FF + ch0 + 4 * n) = ov; }
        }
    }
};
struct EpiDown {
    unsigned char* ws; float* out; int s0 = 0, s1 = 8;
    DI void operator()(ACC_T, const pg8::Unit& u, int wr, int wc, int fr, int fq, int lane) const {
        const int row0 = u.pm * 256 + wr * 64 + fr, c8 = wc * 32 + 8 * fq;
#pragma unroll
        for (int ai = 0; ai < 2; ++ai)
#pragma unroll
            for (int m = 0; m < 4; ++m) { if (ai * 4 + m < s0 || ai * 4 + m >= s1) continue; const int row = row0 + ai * 128 + m * 16; float ss = 0.f;
#pragma unroll
                for (int bj = 0; bj < 2; ++bj) { const int col = u.pn * 256 + bj * 128 + c8; bf16_t* xp_ = (bf16_t*)(ws + WS_X1B) + (size_t)row * D + col; const u32x4 xw = *(const u32x4*)xp_;
                    const f32x4 v0 = acc[ai][bj][m][0] + (f32x4){bf_lo(xw.x), bf_hi(xw.x), bf_lo(xw.y), bf_hi(xw.y)}, v1 = acc[ai][bj][m][1] + (f32x4){bf_lo(xw.z), bf_hi(xw.z), bf_lo(xw.w), bf_hi(xw.w)};
                    st_bf16x8(xp_, v0, v1); ss += dot8(v0, v1);
                    { u32x2 o8; o8.x = pk4_fp8(v0[0] * SC8_X, v0[1] * SC8_X, v0[2] * SC8_X, v0[3] * SC8_X); o8.y = pk4_fp8(v1[0] * SC8_X, v1[1] * SC8_X, v1[2] * SC8_X, v1[3] * SC8_X); *(u32x2*)(ws + WS_X2F8 + (size_t)row * D + col) = o8; } }
                ss += __shfl_xor(ss, 16); ss += __shfl_xor(ss, 32);
                if (fq == 0) unsafeAtomicAdd((float*)(ws + OFF_SSQ3) + row, ss); }
    }
};
struct EpiPle {
    unsigned char* ws;
    DI void operator()(ACC_T, const pg8::Unit& u, int wr, int wc, int fr, int fq, int lane) const {
        const int row0 = u.pm * 256 + wr * 64 + fr, c8 = wc * 32 + 8 * fq;
#pragma unroll
        for (int ai = 0; ai < 2; ++ai)
#pragma unroll
            for (int m = 0; m < 4; ++m)
#pragma unroll
                for (int bj = 0; bj < 2; ++bj) st_bf16x8((bf16_t*)(ws + WS_PW) + (size_t)(row0 + ai * 128 + m * 16) * D + u.pn * 256 + bj * 128 + c8, acc[ai][bj][m][0], acc[ai][bj][m][1]);
    }
};
struct EpiGate {
    unsigned char* ws; float* out; int s0 = 0, s1 = 8;
    DI void operator()(ACC_T, const pg8::Unit& u, int wr, int wc, int fr, int fq, int lane) const {
        const float* ssq = (const float*)(ws + OFF_SSQ3);
        const int row0 = u.pm * 256 + wr * 64 + fr, c8 = wc * 32 + 8 * fq;
#pragma unroll
        for (int ai = 0; ai < 2; ++ai)
#pragma unroll
            for (int m = 0; m < 4; ++m) { if (ai * 4 + m < s0 || ai * 4 + m >= s1) continue; const int row = row0 + ai * 128 + m * 16; const float rs = rsqrtf(ssq[row] * (1.f / D) + EPS) * (1.f / (SC8_X * SC8_G));
#pragma unroll
                for (int bj = 0; bj < 2; ++bj) { const int col = u.pn * 256 + bj * 128 + c8; float* op = out + (size_t)row * D + col;
                    const u32x4 pw = *(const u32x4*)((const bf16_t*)(ws + WS_PW) + (size_t)row * D + col);
                    const u32x4 xw = *(const u32x4*)((const bf16_t*)(ws + WS_X1B) + (size_t)row * D + col); const f32x4 x0 = {bf_lo(xw.x), bf_hi(xw.x), bf_lo(xw.y), bf_hi(xw.y)}, x1 = {bf_lo(xw.z), bf_hi(xw.z), bf_lo(xw.w), bf_hi(xw.w)}; f32x4 v0, v1;
                    const float pwf[8] = {bf_lo(pw.x), bf_hi(pw.x), bf_lo(pw.y), bf_hi(pw.y), bf_lo(pw.z), bf_hi(pw.z), bf_lo(pw.w), bf_hi(pw.w)};
#pragma unroll
                    for (int e = 0; e < 4; ++e) { v0[e] = x0[e] + pwf[e] * sigmoidf_(acc[ai][bj][m][0][e] * rs); v1[e] = x1[e] + pwf[4 + e] * sigmoidf_(acc[ai][bj][m][1][e] * rs); }
                    st_f32x8(op, v0, v1); } }
    }
};
DI void p11_conv(const Frame& F, const Args& a, int lo_r) {
    unsigned char* ws = a.ws; const int lane = lane_id();
    const bf16_t* U = (const bf16_t*)(ws + WS_U); bf16_t* ACTp = (bf16_t*)(ws + WS_ACT);
    constexpr int NCG = FF / 8;
    constexpr int NRC = MS / 16;
    const int ncw = (NCG + 63) / 64;
    for (int it = F.gw; it < NRC * ncw; it += F.NGW) {
        const int rc = it / ncw, cg = (it % ncw) * 64 + lane; if (cg >= NCG) continue;
        const int col = cg * 8, row0 = MP + rc * 16;
        if (2 * (col >> 7) + (rc >> 4) >= lo_r) continue;
        float w[3][2][8], bsv[2][8];
#pragma unroll
        for (int j = 0; j < 3; ++j)
#pragma unroll
            for (int s = 0; s < 2; ++s) { const f32x4 x0 = *(const f32x4*)(a.in[I_CW] + (size_t)j * FF2 + s * FF + col), x1 = *(const f32x4*)(a.in[I_CW] + (size_t)j * FF2 + s * FF + col + 4);
#pragma unroll
                for (int e = 0; e < 4; ++e) { w[j][s][e] = x0[e]; w[j][s][4 + e] = x1[e]; } }
#pragma unroll
        for (int s = 0; s < 2; ++s) { const f32x4 x0 = *(const f32x4*)(a.in[I_CB] + s * FF + col), x1 = *(const f32x4*)(a.in[I_CB] + s * FF + col + 4);
#pragma unroll
            for (int e = 0; e < 4; ++e) { bsv[s][e] = x0[e]; bsv[s][4 + e] = x1[e]; } }
        float h2[2][8], h1[2][8];
        const bool smp = row0 >= MP; const int tseq = smp ? ((row0 - MP) & 15) : (row0 & (SEQ - 1));
#pragma unroll
        for (int s = 0; s < 2; ++s) {
            if (tseq == 0) {
                if (smp) { const float* hs = a.in[I_SCV] + ((size_t)((row0 - MP) >> 4) * 2) * FF2 + s * FF + col;
                    const f32x4 a0 = *(const f32x4*)hs, a1 = *(const f32x4*)(hs + 4), b0 = *(const f32x4*)(hs + FF2), b1 = *(const f32x4*)(hs + FF2 + 4);
#pragma unroll
                    for (int e = 0; e < 4; ++e) { h2[s][e] = a0[e]; h2[s][4 + e] = a1[e]; h1[s][e] = b0[e]; h1[s][4 + e] = b1[e]; } }
                else {
#pragma unroll
                    for (int e = 0; e < 8; ++e) { h2[s][e] = 0.f; h1[s][e] = 0.f; } }
            } else { const u32x4 a_ = *(const u32x4*)(U + (size_t)(row0 - 2) * FF2 + s * FF + col), b_ = *(const u32x4*)(U + (size_t)(row0 - 1) * FF2 + s * FF + col);
                h2[s][0] = bf_lo(a_.x); h2[s][1] = bf_hi(a_.x); h2[s][2] = bf_lo(a_.y); h2[s][3] = bf_hi(a_.y); h2[s][4] = bf_lo(a_.z); h2[s][5] = bf_hi(a_.z); h2[s][6] = bf_lo(a_.w); h2[s][7] = bf_hi(a_.w);
                h1[s][0] = bf_lo(b_.x); h1[s][1] = bf_hi(b_.x); h1[s][2] = bf_lo(b_.y); h1[s][3] = bf_hi(b_.y); h1[s][4] = bf_lo(b_.z); h1[s][5] = bf_hi(b_.z); h1[s][6] = bf_lo(b_.w); h1[s][7] = bf_hi(b_.w); }
        }
#pragma unroll 4
        for (int t = 0; t < 16; ++t) { const size_t row = (size_t)row0 + t; float cur[2][8], c[2][8];
#pragma unroll
            for (int s = 0; s < 2; ++s) { const u32x4 u_ = *(const u32x4*)(U + row * FF2 + s * FF + col);
                cur[s][0] = bf_lo(u_.x); cur[s][1] = bf_hi(u_.x); cur[s][2] = bf_lo(u_.y); cur[s][3] = bf_hi(u_.y); cur[s][4] = bf_lo(u_.z); cur[s][5] = bf_hi(u_.z); cur[s][6] = bf_lo(u_.w); cur[s][7] = bf_hi(u_.w);
#pragma unroll
                for (int e = 0; e < 8; ++e) { c[s][e] = bsv[s][e] + w[0][s][e] * h2[s][e] + w[1][s][e] * h1[s][e] + w[2][s][e] * cur[s][e]; h2[s][e] = h1[s][e]; h1[s][e] = cur[s][e]; } }
            float o[8];
#pragma unroll
            for (int e = 0; e < 8; ++e) o[e] = c[0][e] / (1.0f + __expf(-c[0][e])) * c[1][e];
            u32x4 ov; ov.x = cvtpk(o[0], o[1]); ov.y = cvtpk(o[2], o[3]); ov.z = cvtpk(o[4], o[5]); ov.w = cvtpk(o[6], o[7]);
            *(u32x4*)(ACTp + row * FF + col) = ov; }
    }
    { const float* UH = (const float*)(ws + WS_UH);
      for (int it = (F.gw + F.NGW - NRC * ncw % F.NGW) % F.NGW; it < 64 * 2 * ncw; it += F.NGW) { const int pm = it / (2 * ncw), r = (it / ncw) & 1, cg = (it % ncw) * 64 + lane; if (cg >= NCG) continue; const int col = cg * 8;
          float c[2][8];
#pragma unroll
          for (int s = 0; s < 2; ++s) { const int cc = s * FF + col; const bool first = (pm & 15) == 0;
              const float* cur = UH + ((size_t)pm * 4 + r) * FF2 + cc; const float* p1 = r == 0 ? UH + ((size_t)(pm - 1) * 4 + 3) * FF2 + cc : UH + ((size_t)pm * 4 + 0) * FF2 + cc; const float* p2 = r == 0 ? UH + ((size_t)(pm - 1) * 4 + 2) * FF2 + cc : UH + ((size_t)(pm - 1) * 4 + 3) * FF2 + cc;
              const bool z1 = first && r == 0, z2 = first;
#pragma unroll
              for (int e = 0; e < 8; ++e) c[s][e] = a.in[I_CB][cc + e] + a.in[I_CW][cc + e] * (z2 ? 0.f : p2[e]) + a.in[I_CW][FF2 + cc + e] * (z1 ? 0.f : p1[e]) + a.in[I_CW][2 * FF2 + cc + e] * cur[e]; }
          float o[8];
#pragma unroll
          for (int e = 0; e < 8; ++e) o[e] = c[0][e] / (1.0f + __expf(-c[0][e])) * c[1][e];
          u32x4 ov; ov.x = cvtpk(o[0], o[1]); ov.y = cvtpk(o[2], o[3]); ov.z = cvtpk(o[4], o[5]); ov.w = cvtpk(o[6], o[7]);
          *(u32x4*)(ACTp + ((size_t)pm * 256 + r) * FF + col) = ov; } }

}
constexpr int LAST_PHASE = 15;

constexpr int NPHASE = 15;
#ifndef ALIGN_LIGHT
#define ALIGN_LIGHT true
#endif
__global__ void __launch_bounds__(512, 2) fwd(Args args) {
    extern __shared__ __attribute__((aligned(16))) unsigned char lds_raw[];
    Frame F;
    F.lds = (LAS unsigned char*)lds_raw;
    F.wave = __builtin_amdgcn_readfirstlane(threadIdx.x >> 6);
    F.G = gridDim.x; { const int bx = blockIdx.x; F.vcu = (F.G % 8 == 0) ? (bx % 8) * (F.G / 8) + bx / 8 : bx; }
    F.gw = F.vcu * 8 + F.wave; F.NGW = F.G * 8;
    volatile LAS unsigned* MISC = (volatile LAS unsigned*)(F.lds + MISC_OFF);
    if (F.wave == 0) { const int l0 = lane_id(); if (l0 < 32) MISC[l0] = 0u; }
    __syncthreads();
    unsigned char* ws = args.ws;
    unsigned* ctl = (unsigned*)(ws + WS_CTL);
    const int lo = args.ph_lo, hi = args.ph_hi;
    XcdBarrier bar; bar.bar = ctl + CW_BAR; bar.x = 0; bar.st = nullptr;
    if (hi - lo > 1) bar = xcd_barrier_post(ctl + CW_BAR, MISC + 8, F.wave == 0 && lane_id() == 0);
#define IN(k) (lo <= (k) && (k) < hi)
#ifndef PH_MASK
#define PH_MASK 0xffff
#endif
#define PH_EN(k) (((PH_MASK) >> (k)) & 1)
#define FIN_BAR() do { if (hi - lo > 1) xcd_barrier(bar, F.wave == 0 && lane_id() == 0); } while (0)
#ifdef STAMP
#define SEAM(k) do { if (IN(k) && IN((k) + 1)) xcd_barrier(bar, F.wave == 0 && lane_id() == 0); if (blockIdx.x == 0 && F.wave == 0 && lane_id() == 0) ((unsigned long long*)(ctl + 40960))[(k) + 1] = __builtin_amdgcn_s_memrealtime(); } while (0)
#else
#define SEAM(k) do { if (IN(k) && IN((k) + 1)) xcd_barrier(bar, F.wave == 0 && lane_id() == 0); } while (0)
#endif

#ifdef STAMP
    if (blockIdx.x == 0 && F.wave == 0 && lane_id() == 0) ((unsigned long long*)(ctl + 40960))[0] = __builtin_amdgcn_s_memrealtime();
#endif
    if (PH_EN(0) && IN(0)) { p0_prologue(F, args);
#ifdef ZERO_OUT
        zero16(args.out, (size_t)M * D * 4, F.gw, F.NGW, lane_id()); zero16(args.out + O_HGP, (size_t)(O_CKVS - O_HGP) * 4, F.gw, F.NGW, lane_id()); zero16(args.out + O_HGS, (size_t)(O_END - O_HGS) * 4, F.gw, F.NGW, lane_id());
#endif
    }
    SEAM(0);
    if (PH_EN(1) && IN(1)) {
        const pg8::Gemm gA{(const bf16_t*)((const unsigned char*)args.out + OS_XB), (const bf16_t*)(ws + WS_WINT) + (size_t)QL * D, D, D, D, (float*)(ws + WS_SLAB_EARLY)};
        const pg8::Gemm gB{(const bf16_t*)((const unsigned char*)args.out + OS_XB8), (const bf16_t*)((const unsigned char*)args.out + OS_WIN8), D / 2, D / 2, D / 2, (float*)(ws + WS_SLAB_EARLY) + (size_t)96 * 65536};
        pg8::SplitOrder SA; SA.init(M / 256, NIN / 256 - 4, F.G, (int)blockIdx.x, D); pg8::SplitOrder SBq; SBq.init(M / 256, 4, F.G, (int)blockIdx.x, D / 2);
        EpiInProj EA{ws, 4, 1.f}, EB{ws, 0, 1.f / (SC8_X0 * SC8_WI)};
        pg8::gemm_phase<ALIGN_LIGHT>(F.lds, gA, SA, EA, F.wave);
        pg8::gemm_phase<ALIGN_LIGHT, true>(F.lds, gB, SBq, EB, F.wave);
        { pg8::Gemm g{(const bf16_t*)(ws + WS_KC8), (const bf16_t*)(ws + WS_WUKV8), KVL / 2, KVL / 2, KVL / 2, nullptr};
          pg8::MappedOrder S; S.init(SB * 16, 8, F.G, (int)blockIdx.x, KVL / 2); S.per = 16; S.stride = 16; S.off = 0;
          EpiSumsq E{ws, 1.f / (SC8_K * SC8_K * SC8_W * SC8_W), 1}; pg8::gemm_phase<true, true>(F.lds, g, S, E, F.wave); }
        FIN_BAR();
        pg8::gemm_finalize(gA, SA, EA, F.wave, (int)blockIdx.x); pg8::gemm_finalize(gB, SBq, EB, F.wave, (int)blockIdx.x);
    }
    SEAM(1);
    if (PH_EN(2) && IN(2)) {
        p2_norm_rows(F, args);
        { pg8::Gemm g{(const bf16_t*)(ws + WS_CQ8), (const bf16_t*)(ws + WS_WUQ8), QL / 2, QL / 2, QL / 2, (float*)(ws + WS_SLAB_EARLY)}; pg8::SplitOrder S; S.rot = 2; S.init(M / 256, 3072 / 256, F.G, (int)blockIdx.x, QL / 2);
          EpiUq E{ws, args.in[I_GQN], args.in[I_GQR], F.lds, 1.f / (SC8_K * SC8_Q)}; pg8::gemm_phase<true, true>(F.lds, g, S, E, F.wave); FIN_BAR(); pg8::gemm_finalize(g, S, E, F.wave, (int)blockIdx.x); }
        for (int u = F.G - 1 - (int)blockIdx.x; u < 128; u += F.G) p4_qa_unit(F, args, u);
    }
    SEAM(2);
    if (PH_EN(3) && IN(3)) {
        { pg8::Gemm g{(const bf16_t*)(ws + WS_CKVN8), (const bf16_t*)(ws + WS_WUKV8), KVL / 2, KVL / 2, KVL / 2, nullptr}; pg8::StaticOrder S; S.init(MP / 256, 16, F.G, (int)blockIdx.x, KVL / 2);
          EpiKup E{ws, args.in[I_GKN], F.lds, 1.f / (SC8_K * SC8_W)}; pg8::gemm_phase<true, true>(F.lds, g, S, E, F.wave); }
        { pg8::Gemm g{(const bf16_t*)(ws + WS_KCAT), (const bf16_t*)(ws + WS_WUKVT), KC, KVL, KVL, nullptr}; pg8::MappedOrder S; S.init(SB, 8, F.G, (int)blockIdx.x, KVL); S.per = 1; S.stride = 17; S.off = 16;
          EpiSumsq E{ws, 1.f, 0}; pg8::gemm_phase(F.lds, g, S, E, F.wave); }
        { pg8::Gemm g{(const bf16_t*)(ws + WS_QCAT8), (const bf16_t*)(ws + WS_KC8), KVL / 2, KVL / 2, KVL / 2, nullptr}; pg8::BatchOrder S{SB * 16, F.G, (int)blockIdx.x, 16, 2, 0, KVL / 128};
          EpiS1 E{ws, (float*)((unsigned char*)args.out + OS_S), 1, 1.f / (SC8_QA * SC8_K)}; pg8::gemm_phase<true, true>(F.lds, g, S, E, F.wave); }
    }
    SEAM(3);
    if (PH_EN(5) && IN(5)) { p5_mixer(F, args); }
    SEAM(5);
    if (PH_EN(6) && IN(6)) { p6_late_weights(F, args); }
    SEAM(6);
    if (PH_EN(10) && IN(10)) { pg8::Gemm g{(const bf16_t*)(ws + WS_MIX), (const bf16_t*)(ws + WS_WOT), D, D, D, (float*)(ws + WS_SLAB_LATE)}; pg8::SplitOrder S; S.init(M / 256, D / 256, F.G, (int)blockIdx.x, D);
        EpiWo E{ws, (const bf16_t*)((const unsigned char*)args.out + OS_XB)}; pg8::gemm_phase<ALIGN_LIGHT>(F.lds, g, S, E, F.wave); FIN_BAR(); pg8::gemm_finalize(g, S, E, F.wave, (int)blockIdx.x); }
    SEAM(10);
    if (PH_EN(11) && IN(11)) { pg8::Gemm g{(const bf16_t*)(ws + WS_X1B), (const bf16_t*)(ws + WS_WUPT), D, D, D, (float*)(ws + WS_SLAB_LATE)}; pg8::SplitOrder S; S.nM1 = MP / 256; S.init(M / 256, FF2 / 256, F.G, (int)blockIdx.x, D);
        EpiUp E{ws, args.out, args.in[I_CW], args.in[I_CB], F.lds}; pg8::gemm_phase(F.lds, g, S, E, F.wave); FIN_BAR();
        EpiUpFin E2{ws, args.out, args.in[I_CW], args.in[I_CB], args.in[I_SCV]}; pg8::gemm_finalize(g, S, E2, F.wave, (int)blockIdx.x);
        p11_conv(F, args, S.ns > 1 ? S.R * F.G - (MP / 256) * (FF2 / 256) : 1 << 30); }
    SEAM(11);
    if (PH_EN(13) && IN(13)) {
        { pg8::Gemm g{(const bf16_t*)(ws + WS_ACT), (const bf16_t*)(ws + WS_WDT), FF, FF, FF, (float*)(ws + WS_SLAB_LATE)}; pg8::SplitOrder S; S.init(M / 256, D / 256, F.G, (int)blockIdx.x, FF);
          EpiDown E{ws, args.out}; pg8::gemm_phase<ALIGN_LIGHT>(F.lds, g, S, E, F.wave); FIN_BAR(); pg8::gemm_finalize(g, S, E, F.wave, (int)blockIdx.x); }
        { pg8::Gemm g{(const bf16_t*)(ws + WS_PB), (const bf16_t*)(ws + WS_WPT), PLE, PLE, PLE, nullptr}; pg8::StaticOrder S; S.init(M / 256, D / 256, F.G, (int)blockIdx.x, PLE);
          EpiPle E{ws}; pg8::gemm_phase(F.lds, g, S, E, F.wave); }
    }
    SEAM(13);
    if (PH_EN(14) && IN(14)) { pg8::Gemm g{(const bf16_t*)(ws + WS_X2F8), (const bf16_t*)(ws + WS_WG8), D / 2, D / 2, D / 2, (float*)(ws + WS_SLAB_LATE)}; pg8::SplitOrder S; S.init(M / 256, D / 256, F.G, (int)blockIdx.x, D / 2);
        EpiGate E{ws, args.out}; pg8::gemm_phase<ALIGN_LIGHT, true>(F.lds, g, S, E, F.wave); FIN_BAR(); pg8::gemm_finalize(g, S, E, F.wave, (int)blockIdx.x); }
#ifdef STAMP
    xcd_barrier(bar, F.wave == 0 && lane_id() == 0);
    if (blockIdx.x == 0 && F.wave == 0) { const unsigned long long* ts = (const unsigned long long*)(ctl + 40960); const unsigned long long tend = __builtin_amdgcn_s_memrealtime();
        const size_t offs[10] = {O_Y, O_Y + (size_t)MP * D, O_CKVP, O_KRP, O_HGP, O_CVP, O_CKVS, O_KRS, O_HGS, O_CVS};
        for (int j = 0; j < 10; ++j) { const int ph = STAMP_BASE + j; unsigned long long t0 = ts[ph], t1 = ph + 1 < 15 ? ts[ph + 1] : tend; if (ph >= 15) { t0 = ts[0]; t1 = tend; }
            int n = ph > 15 ? 0 : (int)((t1 - t0) / 1000); if (ph <= 15 && n < 1) n = 1; if (n > 30000) n = 30000;
            for (int i = lane_id(); i < n; i += 64) ((unsigned*)args.out)[offs[j] + i] = 0xAAAAAAAAu; } }
#endif
#undef IN
#undef SEAM
}

extern "C" void kernel_launch(void* const* d_in, const int* in_sizes, int n_in, void* d_out, int out_size, void* d_ws, size_t ws_size, hipStream_t stream) {
    static int grid = 0;
    if (grid == 0) {
        if (n_in != 30 || (size_t)out_size != O_END || ws_size < WS_NEED) { fprintf(stderr, "kernel_launch: unexpected problem: n_in %d out %d ws %zu (need %zu); nothing launched\n", n_in, out_size, ws_size, (size_t)WS_NEED); grid = -1; return; }
        int dev = 0, cus = 0, per_cu = 0;
        if (hipGetDevice(&dev) != hipSuccess || hipDeviceGetAttribute(&cus, hipDeviceAttributeMultiprocessorCount, dev) != hipSuccess) { grid = -1; return; }
        if (hipFuncSetAttribute((const void*)fwd, hipFuncAttributeMaxDynamicSharedMemorySize, LDS_BYTES) != hipSuccess) { fprintf(stderr, "kernel_launch: hipFuncSetAttribute failed\n"); grid = -1; return; }
        if (hipOccupancyMaxActiveBlocksPerMultiprocessor(&per_cu, (const void*)fwd, 512, LDS_BYTES) != hipSuccess || per_cu < 1) fprintf(stderr, "kernel_launch: occupancy query says %d\n", per_cu);
        (void)hipGetLastError();
        grid = cus;
    }
    if (grid < 0) return;
    (void)hipMemsetAsync((char*)d_ws + WS_CTL, 0, CTL_BYTES, stream);
    Args a{};
    for (int i = 0; i < 30; ++i) a.in[i] = (const float*)d_in[i];
    a.out = (float*)d_out; a.ws = (unsigned char*)d_ws;
    for (int i = 0; i < 32; ++i) { const float p = (float)pow(10000.0, (double)i / 32.0); a.inv[i] = 1.0f / p; }
#ifndef N_LAUNCH_SPLIT
#define N_LAUNCH_SPLIT 1
#endif
#if N_LAUNCH_SPLIT
    for (int p = 0; p < LAST_PHASE; ++p) { a.ph_lo = p; a.ph_hi = p + 1; hipLaunchKernelGGL(fwd, dim3(grid), dim3(512), LDS_BYTES, stream, a);
#ifdef SELFCHECK
        hipLaunchKernelGGL(check_kernel, dim3(64), dim3(64), 0, stream, a, p);
        if (p == 5) hipLaunchKernelGGL(check_hgrn, dim3(8), dim3(128), 0, stream, a);
#endif
    }
#ifdef SELFCHECK
    hipLaunchKernelGGL(report_kernel, dim3(1), dim3(64), 0, stream, a);
#endif
#else
    a.ph_lo = 0; a.ph_hi = LAST_PHASE; hipLaunchKernelGGL(fwd, dim3(grid), dim3(512), LDS_BYTES, stream, a);
#endif
}
```

```cpp
#include <hip/hip_runtime.h>
#include <cstdio>
#include <cstdint>
#include <cmath>

#define LAS __attribute__((address_space(3)))
#define GAS __attribute__((address_space(1)))
typedef unsigned short bf16_t;
typedef short bf16x8 __attribute__((ext_vector_type(8)));
typedef short s16x4 __attribute__((ext_vector_type(4)));
typedef float f32x2 __attribute__((ext_vector_type(2)));
typedef float f32x4 __attribute__((ext_vector_type(4)));
typedef float f32x16 __attribute__((ext_vector_type(16)));
typedef unsigned u32x2 __attribute__((ext_vector_type(2)));
typedef unsigned u32x4 __attribute__((ext_vector_type(4)));
typedef __bf16 bf16x2_t __attribute__((ext_vector_type(2)));
typedef GAS unsigned gu32;
#define RLX_AGENT __ATOMIC_RELAXED, __HIP_MEMORY_SCOPE_AGENT
#define DI __device__ __forceinline__

DI unsigned cvtpk(float lo, float hi) { f32x2 v = {lo, hi}; bf16x2_t b = __builtin_convertvector(v, bf16x2_t); return __builtin_bit_cast(unsigned, b); }
DI float bf_lo(unsigned w) { return __uint_as_float(w << 16); }
DI float bf_hi(unsigned w) { return __uint_as_float(w & 0xffff0000u); }
DI float bf2f(bf16_t b) { return __uint_as_float(((unsigned)b) << 16); }
DI bf16_t f2bf(float f) { return (bf16_t)(cvtpk(f, 0.f) & 0xffffu); }
typedef int i32x8 __attribute__((ext_vector_type(8)));
typedef int i32x4 __attribute__((ext_vector_type(4)));
DI unsigned pk4_fp8(float a, float b, float c, float d) { int w = 0; w = __builtin_amdgcn_cvt_pk_fp8_f32(a, b, w, false); w = __builtin_amdgcn_cvt_pk_fp8_f32(c, d, w, true); return (unsigned)w; }
DI u32x4 pack8(f32x4 a, f32x4 b) { u32x4 w; w.x = cvtpk(a[0], a[1]); w.y = cvtpk(a[2], a[3]); w.z = cvtpk(b[0], b[1]); w.w = cvtpk(b[2], b[3]); return w; }
DI float wave_sum(float v) {
#pragma unroll
    for (int o = 1; o < 64; o <<= 1) v += __shfl_xor(v, o);
    return v;
}
DI int lane_id() { int l; asm volatile("v_mbcnt_lo_u32_b32 %0, -1, 0\n\tv_mbcnt_hi_u32_b32 %0, -1, %0" : "=v"(l)); return l; }
DI float sigmoidf_(float x) { return 1.0f / (1.0f + __expf(-x)); }

constexpr int D = 4096, NB = 4, SEQ = 4096, MP = NB * SEQ, SB = 32, ST = 16, MS = SB * ST, M = MP + MS;
constexpr int PAST = 4096, NKEY = PAST + ST  , KPAD = 4352  , KT = 4224  ;
constexpr int QL = 1024, KVL = 512, ROPE = 64, NOPE = 128, NH = 16, QH = NOPE + ROPE  , KC = KVL + ROPE  ;
constexpr int HGW = 2048, HGH = 16, HGD = 128;
constexpr int FF = 11008, FF2 = 22016, PLE = 256;
constexpr int NIN = 9984;
constexpr float EPS = 1e-6f;
constexpr float ATT_SCALE = 0.07216878364870322f;

constexpr size_t O_Y = 0, O_CKVP = (size_t)M * D, O_KRP = O_CKVP + (size_t)MP * KVL, O_HGP = O_KRP + (size_t)MP * ROPE, O_CVP = O_HGP + (size_t)NB * HGH * HGD * HGD,
                 O_CKVS = O_CVP + (size_t)NB * 2 * FF2, O_KRS = O_CKVS + (size_t)MS * KVL, O_HGS = O_KRS + (size_t)MS * ROPE, O_CVS = O_HGS + (size_t)SB * HGH * HGD * HGD, O_END = O_CVS + (size_t)SB * 2 * FF2;
static_assert(O_END == 89960448, "output size");

constexpr float SC8_K = 16.f, SC8_W = 256.f;
constexpr size_t OS_XB = 0  ,
                 OS_S = (size_t)132 << 20  ;
constexpr size_t OS_XB8 = (size_t)132 << 20  , OS_WIN8 = (size_t)200 << 20  ;
constexpr float SC8_X0 = 8.f, SC8_WI = 1024.f;
static_assert(OS_XB8 + (size_t)M * D <= OS_WIN8 && OS_WIN8 + (size_t)QL * D <= (size_t)M * D * 4, "d_out scratch (fp8 in-projection operands)");
constexpr int SPITCH = 4224;
static_assert((size_t)M * D * 2 <= OS_S && OS_S + (size_t)SB * 256 * SPITCH * 4 <= (size_t)M * D * 4 && NKEY <= SPITCH, "d_out scratch");
constexpr size_t MiB = (size_t)1 << 20;
constexpr size_t WS_CTL = 0, CTL_BYTES = 2 * MiB;
constexpr int CW_TMO = 0, CW_BAR = 4096, CW_QUEUE = 16384  ;
constexpr size_t OFF_SSQ1 = 256 * 1024, OFF_SSQQ = 384 * 1024, OFF_SSQ2 = 512 * 1024, OFF_SSQ3 = 640 * 1024, OFF_LB = 768 * 1024;
constexpr size_t WS_WINT = 2 * MiB, WS_XB = 80 * MiB, WS_MIX = 2 * MiB, WS_S = 134 * MiB, WS_P = 270 * MiB, WS_CKVT = 336 * MiB, WS_KCAT = 468 * MiB, WS_OLAT = 621 * MiB, WS_SSK = 637 * MiB,
                 WS_QCAT = 646 * MiB, WS_WUKVT = 655 * MiB, WS_WUKN = 659 * MiB, WS_WUQT = 661 * MiB, WS_ROPE = 667 * MiB, WS_CKVN = 669 * MiB, WS_KRN = 686 * MiB,
                 WS_HQ = 712 * MiB, WS_HK = 778 * MiB, WS_HV = 844 * MiB, WS_HG = 910 * MiB, WS_LF = 976 * MiB, WS_Q = 1108 * MiB, WS_KN = 1207 * MiB, WS_V = 1271 * MiB,
                 WS_CQ = 1335 * MiB, WS_CKVRAW = 1368 * MiB, WS_KRRAW = 1401 * MiB, WS_EARLY_END = 1406 * MiB;
constexpr size_t WS_U = 2 * MiB, WS_ACT = 160 * MiB  , WS_WUPT = 712 * MiB, WS_WOT = 884 * MiB, WS_WDT = 1067 * MiB, WS_WGT = 1153 * MiB, WS_X1B = 1185 * MiB, WS_WPT = 1415 * MiB, WS_PB = 1406 * MiB  , WS_PW = 2 * MiB;
constexpr size_t WS_X2F8 = 916 * MiB  , WS_WG8 = 984 * MiB  ;
constexpr float SC8_X = 8.f, SC8_G = 1024.f;
static_assert(WS_X2F8 >= 916 * MiB && WS_X2F8 + (size_t)M * D <= WS_WG8 && WS_WG8 + (size_t)D * D <= 1067 * MiB, "fp8 gate operands");
constexpr size_t WS_CQ8 = 134 * MiB  , WS_WUQ8 = 152 * MiB  , WS_CKVN8 = 156 * MiB  ,
                 WS_WUKV8 = 166 * MiB  ;
constexpr size_t WS_QCAT8 = 168 * MiB  , WS_KC8 = 270 * MiB  ;
constexpr float SC8_QA = 32.f;
static_assert(WS_WUKV8 + (size_t)4096 * KVL <= WS_QCAT8 && WS_QCAT8 + (size_t)SB * 256 * KVL <= 212 * MiB && WS_KC8 >= 212 * MiB + (size_t)224 * 65536 * 4 && WS_KC8 + (size_t)SB * PAST * KVL <= 336 * MiB, "early fp8 (2)");
constexpr float SC8_Q = 512.f;
constexpr float SC8_A = 16.f;
static_assert(WS_CQ8 + (size_t)M * QL <= WS_WUQ8 && WS_WUQ8 + (size_t)3072 * QL <= WS_CKVN8 && WS_CKVN8 + (size_t)M * KVL <= WS_WUKV8 && WS_WUKV8 + (size_t)4096 * KVL <= 212 * MiB, "early fp8");
constexpr size_t WS_UH = 136 * MiB;
static_assert(WS_UH >= WS_PW + (size_t)M * D * 2 && WS_UH + (size_t)64 * 4 * FF2 * 4 <= WS_ACT, "UH");
constexpr size_t WS_SLAB_EARLY = 212 * MiB, WS_SLAB_LATE = 1328 * MiB;
constexpr size_t WS_NEED = 1417 * MiB;
static_assert(WS_SLAB_EARLY >= WS_XB + (size_t)M * D * 2 && WS_SLAB_EARLY + 64 * MiB <= WS_CKVT && WS_SLAB_LATE + 64 * MiB <= WS_PB, "slabs");
static_assert(WS_WINT + (size_t)NIN * D * 2 <= WS_XB && WS_XB + (size_t)M * D * 2 <= WS_CKVT, "early A region");
static_assert(WS_MIX + (size_t)M * D * 2 <= WS_S && WS_S + (size_t)SB * 256 * KPAD * 4 <= WS_P && WS_P + (size_t)SB * 256 * KT * 2 <= WS_CKVT, "mix/S/P");
static_assert(WS_CKVT + (size_t)SB * KVL * KT * 2 <= WS_KCAT && WS_KCAT + (size_t)SB * KPAD * KC * 2 <= WS_OLAT && WS_OLAT + (size_t)SB * 256 * KVL * 4 <= WS_SSK && WS_SSK + (size_t)SB * KPAD * 16 * 4 <= WS_QCAT, "ckvT/Kcat/OLAT/SSK");
static_assert(WS_QCAT + (size_t)SB * 256 * KC * 2 <= WS_WUKVT && WS_WUKVT + (size_t)4096 * 512 * 2 <= WS_WUKN && WS_WUKN + (size_t)512 * 2048 * 2 <= WS_WUQT && WS_WUQT + (size_t)3072 * 1024 * 2 <= WS_ROPE, "small early");
static_assert(WS_ROPE + (size_t)NKEY * 64 * 4 <= WS_CKVN && WS_CKVN + (size_t)M * KVL * 2 <= WS_KRN && WS_KRN + (size_t)M * ROPE * 2 <= WS_HQ, "rope/ckvn/krn");
static_assert(WS_HQ + (size_t)M * HGW * 2 <= WS_HK && WS_HG + (size_t)M * HGW * 2 <= WS_LF && WS_LF + (size_t)M * HGW * 4 <= WS_Q && WS_Q + (size_t)M * 3072 * 2 <= WS_KN && WS_KN + (size_t)MP * 2048 * 2 <= WS_V && WS_V + (size_t)MP * 2048 * 2 <= WS_CQ, "hgrn/q/k/v");
static_assert(WS_CQ + (size_t)M * QL * 2 <= WS_CKVRAW && WS_CKVRAW + (size_t)M * KVL * 4 <= WS_KRRAW && WS_KRRAW + (size_t)M * ROPE * 4 <= WS_EARLY_END, "cq/raw");
static_assert(WS_U + (size_t)M * FF2 * 2 <= WS_WUPT && WS_ACT + (size_t)M * FF * 2 <= WS_U + (size_t)MP * FF2 * 2 && WS_WUPT + (size_t)FF2 * D * 2 <= WS_WOT && WS_WOT + (size_t)D * D * 2 <= WS_WDT, "late 1");
static_assert(WS_WDT + (size_t)D * FF * 2 <= WS_WGT && WS_WGT + (size_t)D * D * 2 <= WS_X1B && WS_X1B + (size_t)M * D * 2 <= WS_SLAB_LATE && WS_PB >= WS_EARLY_END && WS_PB + (size_t)M * PLE * 2 <= WS_WPT && WS_WPT + (size_t)D * PLE * 2 <= WS_NEED, "late 2");

constexpr int RING_BYTES = 131072;
constexpr int XCH_OFF = RING_BYTES, XCH_BYTES = 12288;
constexpr int MISC_OFF = XCH_OFF + XCH_BYTES;
constexpr int LDS_BYTES = 147456;
static_assert(MISC_OFF + 128 <= LDS_BYTES, "LDS map");
#define N_LAUNCH_SPLIT 0

namespace pg8 {
constexpr int BM = 256, BK = 64, HALF = 128, HTB = HALF * BK * 2  , STAGE_BYTES = 8 * HTB, NXCD = 8, WGM = 8;
static_assert(STAGE_BYTES == RING_BYTES, "stage region");
__host__ __device__ __forceinline__ int lds_byte(int r, int c) { const int st = (r >> 4) * 2 + (c >> 5), rr = r & 15, cc = c & 31, ob = rr * 64 + cc * 2; return st * 1024 + (ob ^ (((ob >> 9) & 1) << 5)); }
__host__ __device__ __forceinline__ void stage_rc(int b, int& R, int& C) { const int st = b / 1024, sb = b % 1024, swz = sb ^ (((sb >> 9) & 1) << 5); R = (st >> 1) * 16 + swz / 64; C = (st & 1) * 32 + (swz % 64) / 2; }
__host__ __device__ __forceinline__ int perm32(int rho) { const int n = rho >> 4, i = rho & 15; return 8 * (i >> 2) + 4 * n + (i & 3); }

struct Unit { int pm, pn, koff, nt, sub; };
struct Gemm { const bf16_t* A; const bf16_t* Bt; int lda, ldb, K; float* slab; };

struct StaticOrder {
    int nM, nN, nwg, G, c, knt, nM1 = 0, rot = 0;
    __host__ __device__ __forceinline__ void init(int nM_, int nN_, int G_, int c_, int K_) { nM = nM_; nN = nN_; nwg = nM * nN; G = G_; c = c_; knt = K_ / BK; }
    __host__ __device__ __forceinline__ void tile(int L, Unit& u) const {
        const int nMa = nM1 > 0 ? nM1 : nM, nwa = nMa * nN;
        if (L >= nwa) { const int r = L - nwa, nr = nM - nMa; u.pm = nMa + r % nr; u.pn = r / nr; u.koff = 0; u.nt = knt; u.sub = -1; return; }
        int wgid = L; { const int q = nwa / NXCD, r = nwa % NXCD, xcd = wgid % NXCD, off = wgid / NXCD; wgid = (xcd < r ? xcd * (q + 1) : r * (q + 1) + (xcd - r) * q) + off; }
        const int nig = WGM * nN, gid = wgid / nig, fm = gid * WGM, gsz = (nMa - fm) < WGM ? (nMa - fm) : WGM;
        u.pm = fm + ((wgid % nig) % gsz); u.pn = (wgid % nig) / gsz; u.koff = 0; u.nt = knt; u.sub = -1;
        if (rot > 0) u.pm = u.pm < rot ? nM - rot + u.pm : u.pm - rot;
    }
    __host__ __device__ __forceinline__ bool next(int i, Unit& u) const { const long L = (long)i * G + c; if (L >= nwg) return false; tile((int)L, u); return true; }
};
struct SplitOrder : StaticOrder {
    int R, Lft, ns, kb;
    __host__ __device__ __forceinline__ void init(int nM_, int nN_, int G_, int c_, int K_) { StaticOrder::init(nM_, nN_, G_, c_, K_); R = nwg / G; Lft = nwg % G; ns = 1; kb = K_ / 128;
        if (Lft > 0) { const int k128 = K_ / 128; int s = G / Lft; if (s > k128 / 2) s = k128 / 2; if (s < 1) s = 1; kb = (k128 + s - 1) / s; if (k128 % kb == 1) ++kb; ns = (k128 + kb - 1) / kb; } }
    __host__ __device__ __forceinline__ bool next(int i, Unit& u) const {
        if (i < R) { tile(i * G + c, u); return true; }
        if (i > R || ns <= 1) { if (i == R && ns <= 1) { const long L = (long)i * G + c; if (L >= nwg) return false; tile((int)L, u); return true; } return false; }
        if (c >= Lft * ns) return false;
        const int l = c / ns, sl = c % ns; tile(R * G + l, u); const int k128 = knt / 2; u.koff = sl * kb * 128; const int nb = (k128 - sl * kb) < kb ? (k128 - sl * kb) : kb; u.nt = nb * 2; u.sub = c; return true; }
};
struct MappedOrder : StaticOrder {
    int per, stride, off;
    __host__ __device__ __forceinline__ bool next(int i, Unit& u) const { if (!StaticOrder::next(i, u)) return false; u.pm = (u.pm / per) * stride + off + (u.pm % per); return true; }
};

struct BatchOrder {
    int n, G, c, per, mode, kslice;
    int knt;
    __host__ __device__ __forceinline__ bool next(int i, Unit& u) const { const int L = i * G + c; if (L >= n) return false; const int b = L / per, r = L % per;
        u.pm = b; u.nt = knt; u.sub = -1; if (mode == 0) { u.pn = b * 17 + r; u.koff = 0; } else if (mode == 2) { u.pn = b * per + r; u.koff = 0; } else { u.pn = 2 * b + r / 3; u.koff = (r % 3) * kslice; } return true; }
};
struct OneBatchOrder {
    int b, per, knt, first = 0;
    __host__ __device__ __forceinline__ bool next(int i, Unit& u) const { if (first + i >= per) return false; u.pm = b; u.pn = b * per + first + i; u.koff = 0; u.nt = knt; u.sub = -1; return true; }
};
template <bool ALIGN_EPI = true, bool FP8 = false, class Epi, class Sched>
__device__ __forceinline__ void gemm_phase(LAS unsigned char* lds, const Gemm g, const Sched& S, const Epi& E, int wid) {
    const int lane = lane_id(), tid = wid * 64 + lane, wr = wid >> 2, wc = wid & 3, fr = lane & 15, fq = lane >> 4;
    unsigned voffA[2], voffB[2];
#pragma unroll
    for (int i = 0; i < 2; ++i) { int R, C; stage_rc(tid * 16 + i * 8192, R, C); const int Rb = (R & ~31) + perm32(R & 31);
        voffA[i] = (unsigned)(R * g.lda + C) * 2u; voffB[i] = (unsigned)(Rb * g.ldb + C) * 2u; }
    const size_t kstep = (size_t)(BK * 2);
    const size_t hstepA = (size_t)HALF * g.lda * 2, hstepB = (size_t)HALF * g.ldb * 2;
    const size_t tstepA = 2 * hstepA, tstepB = 2 * hstepB;
    const unsigned ldsw = (unsigned)wid * 1024u;
    const int aoff = lds_byte(wr * 64 + fr, fq * 8), boff = lds_byte(wc * 32 + fr, fq * 8);
#define PG8_SA(b, h) (((b) * 2 + (h)) * HTB)
#define PG8_SB(b, h) ((4 + (b) * 2 + (h)) * HTB)
#define PG8_STAGE(bufoff, gbase, voff) do { _Pragma("unroll") for (int _i = 0; _i < 2; ++_i) \
        __builtin_amdgcn_global_load_lds((const unsigned*)((const char*)(gbase) + (voff)[_i]), (LAS unsigned*)(lds + (bufoff) + ldsw + _i * 8192), 16, 0, 0); } while (0)
#define PG8_LDA(dst, b, h) do { if constexpr (FP8) { _Pragma("unroll") for (int m = 0; m < 4; ++m) { dst##8[m].lo = *(const LAS i32x4*)(lds + PG8_SA(b, h) + aoff + m * 2048); dst##8[m].hi = *(const LAS i32x4*)(lds + PG8_SA(b, h) + aoff + m * 2048 + 1024); } } else { \
        _Pragma("unroll") for (int m = 0; m < 4; ++m) _Pragma("unroll") for (int k = 0; k < 2; ++k) dst[m][k] = *(const LAS bf16x8*)(lds + PG8_SA(b, h) + aoff + m * 2048 + k * 1024); } } while (0)
#define PG8_LDB(dst, b, h) do { if constexpr (FP8) { _Pragma("unroll") for (int n = 0; n < 2; ++n) { dst##8[n].lo = *(const LAS i32x4*)(lds + PG8_SB(b, h) + boff + n * 2048); dst##8[n].hi = *(const LAS i32x4*)(lds + PG8_SB(b, h) + boff + n * 2048 + 1024); } } else { \
        _Pragma("unroll") for (int n = 0; n < 2; ++n) _Pragma("unroll") for (int k = 0; k < 2; ++k) dst[n][k] = *(const LAS bf16x8*)(lds + PG8_SB(b, h) + boff + n * 2048 + k * 1024); } } while (0)
#define PG8_MMA(ai, bj, At, Bt) do { __builtin_amdgcn_s_setprio(1); if constexpr (FP8) { _Pragma("unroll") for (int m = 0; m < 4; ++m) _Pragma("unroll") for (int n = 0; n < 2; ++n) \
        asm volatile("v_mfma_f32_16x16x128_f8f6f4 %0, %1, %2, %0" : "+v"(acc[ai][bj][m][n]) : "v"(Bt##8[n]), "v"(At##8[m])); } else { \
        _Pragma("unroll") for (int m = 0; m < 4; ++m) _Pragma("unroll") for (int n = 0; n < 2; ++n) _Pragma("unroll") for (int k = 0; k < 2; ++k) \
        acc[ai][bj][m][n] = __builtin_amdgcn_mfma_f32_16x16x32_bf16(Bt[n][k], At[m][k], acc[ai][bj][m][n], 0, 0, 0); } __builtin_amdgcn_s_setprio(0); } while (0)
#define PG8_WAIT_V(n) asm volatile("s_waitcnt vmcnt(" #n ")" ::: "memory")
#define PG8_WAIT_L(n) asm volatile("s_waitcnt lgkmcnt(" #n ")" ::: "memory")
#define PG8_BAR __builtin_amdgcn_s_barrier()
#define PG8_SCHED __builtin_amdgcn_sched_barrier(0)
    Unit cur, nxt; int ui = 0;
    if (!S.next(0, cur)) return;
    f32x4 acc[2][2][4][2];
#pragma unroll
    for (int a = 0; a < 2; ++a)
#pragma unroll
        for (int b = 0; b < 2; ++b)
#pragma unroll
            for (int m = 0; m < 4; ++m)
#pragma unroll
                for (int n = 0; n < 2; ++n) acc[a][b][m][n] = (f32x4){0.f, 0.f, 0.f, 0.f};
    bf16x8 At[4][2], B0[2][2], B1[2][2]; i32x8 At8[4], B08[2], B18[2];
    const char* cA = (const char*)g.A + (size_t)cur.pm * tstepA + (size_t)cur.koff * 2; const char* cB = (const char*)g.Bt + (size_t)cur.pn * tstepB + (size_t)cur.koff * 2;
    PG8_STAGE(PG8_SB(0, 0), cB, voffB); PG8_STAGE(PG8_SB(0, 1), cB + hstepB, voffB); PG8_STAGE(PG8_SA(0, 0), cA, voffA); PG8_STAGE(PG8_SA(0, 1), cA + hstepA, voffA);
    if (wr == 1) PG8_BAR;
    PG8_WAIT_V(2); PG8_BAR;
    PG8_STAGE(PG8_SB(1, 0), cB + kstep, voffB); PG8_STAGE(PG8_SA(1, 0), cA + kstep, voffA); PG8_STAGE(PG8_SB(1, 1), cB + hstepB + kstep, voffB);
    PG8_WAIT_V(6); PG8_BAR;
    for (;;) {
        const bool has_next = S.next(ui + 1, nxt);
        const char* nA = has_next ? (const char*)g.A + (size_t)nxt.pm * tstepA + (size_t)nxt.koff * 2 : cA; const char* nB = has_next ? (const char*)g.Bt + (size_t)nxt.pn * tstepB + (size_t)nxt.koff * 2 : cB;
        const int nt = cur.nt;
        for (int t = 0; t < nt; t += 2) {
            const bool last = (t == nt - 2);
            const char* a1 = cA + (size_t)(t + 1) * kstep;
            const char* a2 = last ? nA : cA + (size_t)(t + 2) * kstep; const char* b2 = last ? nB : cB + (size_t)(t + 2) * kstep;
            const char* a3 = a2 + kstep; const char* b3 = b2 + kstep;
            PG8_LDB(B0, 0, 0); PG8_LDB(B1, 0, 1); PG8_SCHED; PG8_LDA(At, 0, 0); PG8_STAGE(PG8_SA(1, 1), a1 + hstepA, voffA);
            PG8_WAIT_V(8); PG8_WAIT_L(0); PG8_BAR; PG8_MMA(0, 0, At, B0); PG8_MMA(0, 1, At, B1); PG8_BAR; PG8_SCHED;
            PG8_LDA(At, 0, 1); PG8_STAGE(PG8_SB(0, 0), b2, voffB); PG8_STAGE(PG8_SB(0, 1), b2 + hstepB, voffB); PG8_STAGE(PG8_SA(0, 0), a2, voffA);
            PG8_WAIT_V(8); PG8_WAIT_L(0); PG8_BAR; PG8_MMA(1, 0, At, B0); PG8_MMA(1, 1, At, B1); PG8_BAR; PG8_SCHED;
            PG8_LDB(B0, 1, 0); PG8_LDB(B1, 1, 1); PG8_SCHED; PG8_LDA(At, 1, 0); PG8_STAGE(PG8_SA(0, 1), a2 + hstepA, voffA);
            PG8_WAIT_V(8); PG8_WAIT_L(0); PG8_BAR; PG8_MMA(0, 0, At, B0); PG8_MMA(0, 1, At, B1); PG8_BAR; PG8_SCHED;
            PG8_LDA(At, 1, 1); PG8_STAGE(PG8_SB(1, 0), b3, voffB); PG8_STAGE(PG8_SB(1, 1), b3 + hstepB, voffB); PG8_STAGE(PG8_SA(1, 0), a3, voffA);
            PG8_WAIT_V(8); PG8_WAIT_L(0); PG8_BAR; PG8_MMA(1, 0, At, B0); PG8_MMA(1, 1, At, B1); PG8_BAR; PG8_SCHED;
        }
        if constexpr (ALIGN_EPI) { if (wr == 0) PG8_BAR; }
        if constexpr (FP8) asm volatile("s_nop 15\n\ts_nop 15" ::: "memory");
        if (cur.sub >= 0) {
            float* sp = g.slab + (size_t)cur.sub * 65536 + (size_t)(wr * 64 + fr) * 256 + wc * 32 + 8 * fq;
#pragma unroll
            for (int ai = 0; ai < 2; ++ai)
#pragma unroll
                for (int m = 0; m < 4; ++m)
#pragma unroll
                    for (int bj = 0; bj < 2; ++bj) { float* p = sp + (size_t)(ai * 128 + m * 16) * 256 + bj * 128; *(f32x4*)p = acc[ai][bj][m][0]; *(f32x4*)(p + 4) = acc[ai][bj][m][1]; }
        } else E(acc, cur, wr, wc, fr, fq, lane);
        if (!has_next) break;
#pragma unroll
        for (int a = 0; a < 2; ++a)
#pragma unroll
            for (int b = 0; b < 2; ++b)
#pragma unroll
                for (int m = 0; m < 4; ++m)
#pragma unroll
                    for (int n = 0; n < 2; ++n) acc[a][b][m][n] = (f32x4){0.f, 0.f, 0.f, 0.f};
        cur = nxt; cA = nA; cB = nB; ++ui;
        if constexpr (ALIGN_EPI) { if (wr == 1) PG8_BAR; }
    }
    PG8_WAIT_V(0);
    if constexpr (!ALIGN_EPI) { if (wr == 0) PG8_BAR; }
    PG8_BAR;
#undef PG8_SA
#undef PG8_SB
#undef PG8_STAGE
#undef PG8_LDA
#undef PG8_LDB
#undef PG8_MMA
#undef PG8_WAIT_V
#undef PG8_WAIT_L
#undef PG8_BAR
#undef PG8_SCHED
}
template <class Epi>
__device__ __forceinline__ void gemm_finalize(const Gemm g, const SplitOrder& S, Epi E, int wid, int blk) {
    if (S.Lft == 0 || S.ns <= 1 || blk >= S.Lft * S.ns) return;
    const int lane = lane_id(), wr = wid >> 2, wc = wid & 3, fr = lane & 15, fq = lane >> 4;
    const int l = blk / S.ns, j = blk % S.ns, n8 = S.ns < 8 ? S.ns : 8;
    if (j >= n8) return;
    E.s0 = j * 8 / n8; E.s1 = (j + 1) * 8 / n8;
    Unit u; S.tile(S.R * S.G + l, u);
    f32x4 acc[2][2][4][2];
    const float* sp = g.slab + (size_t)(l * S.ns) * 65536 + (size_t)(wr * 64 + fr) * 256 + wc * 32 + 8 * fq;
#pragma unroll
    for (int ai = 0; ai < 2; ++ai)
#pragma unroll
        for (int m = 0; m < 4; ++m)
#pragma unroll
            for (int bj = 0; bj < 2; ++bj) { f32x4 a0 = {0.f, 0.f, 0.f, 0.f}, a1 = {0.f, 0.f, 0.f, 0.f};
                if (ai * 4 + m >= E.s0 && ai * 4 + m < E.s1) { const float* p = sp + (size_t)(ai * 128 + m * 16) * 256 + bj * 128;
                    for (int sl = 0; sl < S.ns; ++sl) { a0 += *(const f32x4*)(p + (size_t)sl * 65536); a1 += *(const f32x4*)(p + (size_t)sl * 65536 + 4); } }
                acc[ai][bj][m][0] = a0; acc[ai][bj][m][1] = a1; }
    E(acc, u, wr, wc, fr, fq, lane);
}
}

#define XB_TMO      128
#define XB_XCNT(j)  (256  + 64 * (j))
#define XB_XSUB(j)  (1280 + 64 * (j))
#define XB_XGEN(j)  (2304 + 64 * (j))
#define XB_TOP      3328
#define XB_TOPGEN   3392
#define XCD_BAR_WORDS 3456
#define XB_SPIN_CAP (1u << 22)

__device__ __forceinline__ unsigned xb_ld(unsigned* p)              { return __hip_atomic_load(p, __ATOMIC_RELAXED, __HIP_MEMORY_SCOPE_AGENT); }
__device__ __forceinline__ unsigned xb_add(unsigned* p, unsigned v) { return __hip_atomic_fetch_add(p, v, __ATOMIC_RELAXED, __HIP_MEMORY_SCOPE_AGENT); }
__device__ __forceinline__ unsigned xb_xcc_id() { return (unsigned)__builtin_amdgcn_s_getreg((3 << 11) | 20) & 0xFu; }
#define XB_SPIN(cond, bar) do { unsigned _sp = 0; while (cond) { __builtin_amdgcn_s_sleep(1); \
    if ((++_sp & 255u) == 0u) { if (xb_ld(&(bar)[XB_TMO])) break; if (_sp > XB_SPIN_CAP) { atomicAdd(&(bar)[XB_TMO], 1u); break; } } } } while (0)

struct XcdBarrier {
    unsigned* bar; unsigned x;
    volatile LAS unsigned* st;
};
__device__ __forceinline__ XcdBarrier xcd_barrier_post(unsigned* bar, volatile LAS unsigned* st, bool leader) {
    XcdBarrier b; b.bar = bar; b.x = xb_xcc_id(); b.st = st;
    if (leader) (void)xb_add(&bar[XB_XCNT(b.x)], 1u);
    return b;
}
__device__ __forceinline__ void xcd_barrier_complete(unsigned* bar, unsigned x, unsigned& nloc, unsigned& nx) {
    const unsigned G = gridDim.x * gridDim.y * gridDim.z;
    unsigned sum, cnt, mine, sp = 0u;
    for (;;) {
        sum = 0u; cnt = 0u; mine = 0u;
#pragma unroll
        for (unsigned j = 0; j < 16; ++j) { const unsigned c = xb_ld(&bar[XB_XCNT(j)]); sum += c; cnt += (c > 0u) ? 1u : 0u; mine = (j == x) ? c : mine; }
        if (sum == G) break;
        __builtin_amdgcn_s_sleep(1);
        if ((++sp & 255u) == 0u) { if (xb_ld(&bar[XB_TMO])) break; if (sp > XB_SPIN_CAP) { atomicAdd(&bar[XB_TMO], 1u); break; } }
    }
    nloc = mine > 0u ? mine : 1u; nx = cnt > 0u ? cnt : 1u;
}
__device__ __forceinline__ void xcd_barrier(const XcdBarrier& b, bool leader) {
    asm volatile("s_waitcnt vmcnt(0)" ::: "memory");
    __syncthreads();
    if (leader) {
        unsigned* bar = b.bar;
        __builtin_amdgcn_s_waitcnt(0);
        unsigned nloc = b.st[0], nx = b.st[1];
        if (nloc == 0u) { xcd_barrier_complete(bar, b.x, nloc, nx); b.st[0] = nloc; b.st[1] = nx; }
        const unsigned old = xb_add(&bar[XB_XSUB(b.x)], 1u);
        const unsigned gen = old / nloc;
        if (old + 1u == (gen + 1u) * nloc) {
            __builtin_amdgcn_fence(__ATOMIC_RELEASE, "agent");
            asm volatile("s_waitcnt vmcnt(0)" ::: "memory");
            const unsigned og = xb_add(&bar[XB_TOP], 1u);
            const unsigned tg = og / nx;
            if (og + 1u == (tg + 1u) * nx) xb_add(&bar[XB_TOPGEN], 1u);
            else XB_SPIN(xb_ld(&bar[XB_TOPGEN]) == tg, bar);
            __builtin_amdgcn_fence(__ATOMIC_ACQUIRE, "agent");
            xb_add(&bar[XB_XGEN(b.x)], 1u);
            asm volatile("s_waitcnt vmcnt(0)" ::: "memory");
        } else {
            XB_SPIN(xb_ld(&bar[XB_XGEN(b.x)]) == gen, bar);
            __builtin_amdgcn_fence(__ATOMIC_ACQUIRE, "agent");
            asm volatile("s_waitcnt vmcnt(0)" ::: "memory");
        }
    }
    __syncthreads();
}

struct Args { const float* in[30]; float* out; unsigned char* ws; float inv[32]; int ph_lo, ph_hi; };
enum { I_XP = 0, I_XS, I_CCKV, I_CKR, I_SHG, I_SCV, I_PP, I_PS, I_GATT, I_WIN, I_GQA, I_WUQ, I_GKVA, I_WUK, I_WUV, I_GQN, I_GQR, I_GKN, I_GKR, I_LB, I_GHG, I_WO, I_GFFN, I_WUP, I_CW, I_CB, I_WD, I_GPLE, I_WPG, I_WPLE };
struct Frame { LAS unsigned char* lds; int wave, vcu, G, gw, NGW; };
#define LDS_WAIT() asm volatile("s_waitcnt lgkmcnt(0)" ::: "memory")
#define VM_WAIT() asm volatile("s_waitcnt vmcnt(0)" ::: "memory")

DI void tr_item(const float* __restrict__ W, size_t ldw, bf16_t* __restrict__ WT, size_t ldt, const float* __restrict__ gain, int k0, int n0, int dst_row0, LAS float* scr, int lane, bf16_t* NAT, size_t ldn, int rope_np = -1, unsigned char* NAT8 = nullptr, size_t ld8 = 0, unsigned char* WT8 = nullptr, float sc8 = 1.f) {
#pragma unroll 8
    for (int i = 0; i < 32; ++i) { const int kk = 2 * i + (lane >> 5); scr[kk * 33 + (lane & 31)] = W[(size_t)(k0 + kk) * ldw + n0 + (lane & 31)]; }
    LDS_WAIT(); asm volatile("" ::: "memory");
    const int c = lane & 7;
    float gv[8];
#pragma unroll
    for (int j = 0; j < 8; ++j) gv[j] = gain ? gain[k0 + 8 * c + j] : 1.0f;
#pragma unroll
    for (int j = 0; j < 4; ++j) { const int n = (lane >> 3) + 8 * j; const LAS float* s = scr + (8 * c) * 33 + n;
        const int nn = rope_np < 0 ? n : 32 * (n >> 4) + 8 * ((n >> 2) & 3) + 4 * rope_np + (n & 3);
        if (WT8) { u32x2 o8; o8.x = pk4_fp8(s[0 * 33] * gv[0] * sc8, s[1 * 33] * gv[1] * sc8, s[2 * 33] * gv[2] * sc8, s[3 * 33] * gv[3] * sc8); o8.y = pk4_fp8(s[4 * 33] * gv[4] * sc8, s[5 * 33] * gv[5] * sc8, s[6 * 33] * gv[6] * sc8, s[7 * 33] * gv[7] * sc8);
            *(u32x2*)(WT8 + (size_t)(dst_row0 + nn) * ldt + k0 + 8 * c) = o8; continue; }
        u32x4 o; o.x = cvtpk(s[0 * 33] * gv[0], s[1 * 33] * gv[1]); o.y = cvtpk(s[2 * 33] * gv[2], s[3 * 33] * gv[3]); o.z = cvtpk(s[4 * 33] * gv[4], s[5 * 33] * gv[5]); o.w = cvtpk(s[6 * 33] * gv[6], s[7 * 33] * gv[7]);
        *(u32x4*)(WT + (size_t)(dst_row0 + nn) * ldt + k0 + 8 * c) = o; }
    if (NAT || NAT8) {
#pragma unroll
        for (int j = 0; j < 4; ++j) { const int r = (lane >> 2) + 16 * j, ch = lane & 3; const LAS float* s = scr + r * 33 + ch * 8;
            if (NAT) { u32x4 o; o.x = cvtpk(s[0], s[1]); o.y = cvtpk(s[2], s[3]); o.z = cvtpk(s[4], s[5]); o.w = cvtpk(s[6], s[7]);
                *(u32x4*)(NAT + (size_t)(k0 + r) * ldn + n0 + ch * 8) = o; }
            if (NAT8) { u32x2 o8; o8.x = pk4_fp8(s[0] * SC8_K, s[1] * SC8_K, s[2] * SC8_K, s[3] * SC8_K); o8.y = pk4_fp8(s[4] * SC8_K, s[5] * SC8_K, s[6] * SC8_K, s[7] * SC8_K); *(u32x2*)(NAT8 + (size_t)(k0 + r) * ld8 + n0 + ch * 8) = o8; } }
    }
    LDS_WAIT(); asm volatile("" ::: "memory");
}
DI bool tr_matrix(int& r, const float* W, int K, int N, bf16_t* WT, size_t ldt, const float* gain, LAS float* scr, int lane, int split_n = 1 << 30, int pad = 0, bool gate_up = false, bool uq = false, unsigned char* WT8 = nullptr, float sc8 = 1.f, int n8_lim = 1 << 30) {
    const int nblk = N / 32, nitems = (K / 64) * nblk;
    if (r >= nitems) { r -= nitems; return false; }
    const int kb = r / nblk, nb = r % nblk, n0 = 32 * nb;
    int dst = n0 < split_n ? n0 : n0 + pad;
    if (gate_up) { const int s = n0 / FF, ch = n0 % FF; dst = (ch / 128) * 256 + s * 128 + (ch % 128); }
    int np = -1;
    if (uq) { const int h = n0 / QH, d0 = n0 % QH; if (d0 < NOPE) dst = h * NOPE + d0; else { dst = 2048 + (h >> 2) * 256 + (h & 3) * 64; np = (d0 - NOPE) >> 5; } }
    tr_item(W, (size_t)N, WT, ldt, gain, 64 * kb, n0, dst, scr, lane, nullptr, 0, np, nullptr, 0, n0 < n8_lim ? WT8 : nullptr, sc8);
    return true;
}
DI void zero16(void* p, size_t bytes, int gw, int NGW, int lane) {
    const size_t n = bytes / 1024;
    for (size_t i = gw; i < n; i += NGW) *(u32x4*)((char*)p + i * 1024 + lane * 16) = (u32x4){0u, 0u, 0u, 0u};
}

DI void p0_prologue(const Frame& F, const Args& a) {
    unsigned char* ws = a.ws;
    LAS float* scr = (LAS float*)(F.lds + F.wave * 16384);
    const int lane = lane_id();
    {
        constexpr int I_IN = (D / 64) * (9792 / 32), I_UQ = (QL / 64) * (3072 / 32), I_UK = (KVL / 64) * (2048 / 32), I_CACHE = SB * (PAST / 64) * (KVL / 32);
        constexpr int NIT = I_IN + I_UQ + 2 * I_UK + I_CACHE;
        for (int it = F.gw; it < NIT; it += F.NGW) {
            int r = it;
            if (tr_matrix(r, a.in[I_WIN], D, 9792, (bf16_t*)(ws + WS_WINT), D, a.in[I_GATT], scr, lane, 1600, 192, false, false, (unsigned char*)a.out + OS_WIN8, SC8_WI, QL)) continue;
            if (tr_matrix(r, a.in[I_WUQ], QL, 3072, nullptr, QL, a.in[I_GQA], scr, lane, 1 << 30, 0, false, true, ws + WS_WUQ8, SC8_Q)) continue;
            if (tr_matrix(r, a.in[I_WUK], KVL, 2048, (bf16_t*)(ws + WS_WUKVT), KVL, nullptr, scr, lane)) continue;
            if (tr_matrix(r, a.in[I_WUV], KVL, 2048, (bf16_t*)(ws + WS_WUKVT) + (size_t)2048 * KVL, KVL, nullptr, scr, lane)) continue;
            { const int b = r / ((PAST / 64) * (KVL / 32)), rr = r % ((PAST / 64) * (KVL / 32)), kb = rr / (KVL / 32), nb = rr % (KVL / 32);
              tr_item(a.in[I_CCKV] + (size_t)b * PAST * KVL, KVL, (bf16_t*)(ws + WS_CKVT) + (size_t)b * KVL * KT, KT, nullptr, 64 * kb, 32 * nb, 32 * nb, scr, lane,
                      nullptr, 0, -1, ws + WS_KC8 + (size_t)b * PAST * KVL, KVL); }
        }
    }
    for (int row = F.gw; row < M; row += F.NGW) {
        const float* src = row < MP ? a.in[I_XP] + (size_t)row * D : a.in[I_XS] + (size_t)(row - MP) * D;
        bf16_t* dst = (bf16_t*)((unsigned char*)a.out + OS_XB) + (size_t)row * D;
        float ss = 0.f;
#pragma unroll 4
        for (int j = 0; j < 16; ++j) { const f32x4 v = *(const f32x4*)(src + j * 256 + lane * 4); ss += v[0] * v[0] + v[1] * v[1] + v[2] * v[2] + v[3] * v[3];
            u32x2 o; o.x = cvtpk(v[0], v[1]); o.y = cvtpk(v[2], v[3]); *(u32x2*)(dst + j * 256 + lane * 4) = o;
            *(unsigned*)((unsigned char*)a.out + OS_XB8 + (size_t)row * D + j * 256 + lane * 4) = pk4_fp8(v[0] * SC8_X0, v[1] * SC8_X0, v[2] * SC8_X0, v[3] * SC8_X0); }
        ss = wave_sum(ss);
        if (lane == 0) ((float*)(ws + OFF_SSQ1))[row] = ss;
    }
    for (int it = F.gw; it < SB * PAST / 8; it += F.NGW) {
        const int kg = it * 8 + (lane >> 3), b = kg / PAST, key = kg % PAST, ch = lane & 7;
        const float* s = a.in[I_CKR] + (size_t)kg * ROPE + ch * 8;
        const f32x4 v0 = *(const f32x4*)s, v1 = *(const f32x4*)(s + 4);
        *(u32x4*)((bf16_t*)(ws + WS_KCAT) + ((size_t)b * KPAD + key) * KC + KVL + ch * 8) = pack8(v0, v1);
    }
    for (int it = F.gw; it < 512 * 2048 / 512; it += F.NGW) {
        const size_t e = (size_t)it * 512 + lane * 8; const int d = (int)(e & 127);
        const f32x4 v0 = *(const f32x4*)(a.in[I_WUK] + e), v1 = *(const f32x4*)(a.in[I_WUK] + e + 4);
        const f32x4 g0 = *(const f32x4*)(a.in[I_GKN] + d), g1 = *(const f32x4*)(a.in[I_GKN] + d + 4);
        *(u32x4*)((bf16_t*)(ws + WS_WUKN) + e) = pack8(v0 * g0, v1 * g1);
    }
    for (int it = F.gw; it < (4096 / 64) * (KVL / 8); it += F.NGW) { const int n = (it >> 6) * 64 + lane, c0 = (it & 63) * 8; float v[8];
        const float* src = n < 2048 ? a.in[I_WUK] + n : a.in[I_WUV] + (n - 2048);
#pragma unroll
        for (int j = 0; j < 8; ++j) v[j] = src[(size_t)(c0 + j) * 2048] * SC8_W;
        u32x2 o8; o8.x = pk4_fp8(v[0], v[1], v[2], v[3]); o8.y = pk4_fp8(v[4], v[5], v[6], v[7]); *(u32x2*)(ws + WS_WUKV8 + (size_t)n * KVL + c0) = o8; }
    for (int it = F.gw; it < NKEY * 32 / 64; it += F.NGW) {
        const int e = it * 64 + lane, pos = e >> 5, i = e & 31;
        const float ang = (float)pos * a.inv[i];
        const double rev = (double)ang * 0.15915494309189535; const float fr = (float)(rev - __builtin_rint(rev));
        ((float*)(ws + WS_ROPE))[e] = __builtin_amdgcn_cosf(fr);
        ((float*)(ws + WS_ROPE))[NKEY * 32 + e] = __builtin_amdgcn_sinf(fr);
    }
    for (int it = F.gw; it < HGW / 64; it += F.NGW) { const int j = it * 64 + lane; const float l0 = a.in[I_LB][j], l1 = a.in[I_LB][HGW + j]; ((float*)(ws + OFF_LB))[j] = 1.0f / (1.0f + __expf(l1 - l0)); }
    for (int row = F.gw; row < M; row += F.NGW) { const float* src = row < MP ? a.in[I_PP] + (size_t)row * PLE : a.in[I_PS] + (size_t)(row - MP) * PLE; const f32x4 v = *(const f32x4*)(src + 4 * lane);
        u32x2 o; o.x = cvtpk(v[0], v[1]); o.y = cvtpk(v[2], v[3]); *(u32x2*)((bf16_t*)(ws + WS_PB) + (size_t)row * PLE + 4 * lane) = o; }
    { constexpr int NITP = (PLE / 64) * (D / 32); for (int it = F.gw; it < NITP; it += F.NGW) { int r = it; tr_matrix(r, a.in[I_WPLE], PLE, D, (bf16_t*)(ws + WS_WPT), PLE, nullptr, scr, lane); } }
    zero16((bf16_t*)(ws + WS_WINT) + (size_t)1600 * D, (size_t)192 * D * 2, F.gw, F.NGW, lane);
    for (int b = 0; b < SB; ++b) zero16((bf16_t*)(ws + WS_KCAT) + ((size_t)b * KPAD + PAST) * KC, (size_t)(KPAD - PAST) * KC * 2, F.gw, F.NGW, lane);
    for (int it = F.gw; it < SB * KVL / 4; it += F.NGW) { const int rowi = it * 4 + (lane >> 4); *(u32x4*)((bf16_t*)(ws + WS_CKVT) + (size_t)rowi * KT + PAST + (lane & 15) * 8) = (u32x4){0u, 0u, 0u, 0u}; }
    zero16(ws + WS_SSK, (size_t)SB * KPAD * 16 * 4, F.gw, F.NGW, lane);
}

#define ACC_T const f32x4 (&acc)[2][2][4][2]
#ifndef NT_STORES
#define NT_STORES 1
#endif
DI void st_bf16x8(bf16_t* p, f32x4 a, f32x4 b) { const u32x4 w = pack8(a, b); if (NT_STORES) __builtin_nontemporal_store(w, (u32x4*)p); else *(u32x4*)p = w; }
DI void st_f32x8(float* p, f32x4 a, f32x4 b) { if (NT_STORES) { __builtin_nontemporal_store(a, (f32x4*)p); __builtin_nontemporal_store(b, (f32x4*)(p + 4)); } else { *(f32x4*)p = a; *(f32x4*)(p + 4) = b; } }
DI float dot8(f32x4 a, f32x4 b) { return (a[0] * a[0] + a[1] * a[1]) + (a[2] * a[2] + a[3] * a[3]) + (b[0] * b[0] + b[1] * b[1]) + (b[2] * b[2] + b[3] * b[3]); }

struct EpiInProj {
    unsigned char* ws; int pn_off; float sc; int s0 = 0, s1 = 8;
    DI void operator()(ACC_T, const pg8::Unit& u, int wr, int wc, int fr, int fq, int lane) const {
        const float* ssq1 = (const float*)(ws + OFF_SSQ1);
        const int row0 = u.pm * 256 + wr * 64 + fr, c8 = wc * 32 + 8 * fq, pn = u.pn + pn_off;
#pragma unroll
        for (int ai = 0; ai < 2; ++ai)
#pragma unroll
            for (int m = 0; m < 4; ++m) { if (ai * 4 + m < s0 || ai * 4 + m >= s1) continue;
                const int row = row0 + ai * 128 + m * 16;
                const float rs = rsqrtf(ssq1[row] * (1.f / D) + EPS) * sc;
                f32x4 v[2][2];
#pragma unroll
                for (int bj = 0; bj < 2; ++bj) { v[bj][0] = acc[ai][bj][m][0] * rs; v[bj][1] = acc[ai][bj][m][1] * rs; }
                if (pn < 4) {
                    float ss = 0.f;
#pragma unroll
                    for (int bj = 0; bj < 2; ++bj) { ss += dot8(v[bj][0], v[bj][1]);
                        u32x2 o8; o8.x = pk4_fp8(v[bj][0][0] * SC8_K, v[bj][0][1] * SC8_K, v[bj][0][2] * SC8_K, v[bj][0][3] * SC8_K); o8.y = pk4_fp8(v[bj][1][0] * SC8_K, v[bj][1][1] * SC8_K, v[bj][1][2] * SC8_K, v[bj][1][3] * SC8_K);
                        *(u32x2*)(ws + WS_CQ8 + (size_t)row * QL + pn * 256 + bj * 128 + c8) = o8; }
                    ss += __shfl_xor(ss, 16); ss += __shfl_xor(ss, 32);
                    if (fq == 0) unsafeAtomicAdd((float*)(ws + OFF_SSQQ) + row, ss);
                } else if (pn < 6) {
#pragma unroll
                    for (int bj = 0; bj < 2; ++bj) st_f32x8((float*)(ws + WS_CKVRAW) + (size_t)row * KVL + (pn - 4) * 256 + bj * 128 + c8, v[bj][0], v[bj][1]);
                } else if (pn == 6) {
                    if (wc < 2) st_f32x8((float*)(ws + WS_KRRAW) + (size_t)row * ROPE + c8, v[0][0], v[0][1]);
                } else if (pn < 15) {
#pragma unroll
                    for (int bj = 0; bj < 2; ++bj) st_bf16x8((bf16_t*)(ws + WS_HQ) + (size_t)row * HGW + (pn - 7) * 256 + bj * 128 + c8, v[bj][0], v[bj][1]);
                } else if (pn < 23) {
#pragma unroll
                    for (int bj = 0; bj < 2; ++bj) { const int col = (pn - 15) * 256 + bj * 128 + c8;
                        const f32x4 l0 = *(const f32x4*)((const float*)(ws + OFF_LB) + col), l1 = *(const f32x4*)((const float*)(ws + OFF_LB) + col + 4);
                        f32x4 lf[2], kk[2];
#pragma unroll
                        for (int n = 0; n < 2; ++n)
#pragma unroll
                            for (int e = 0; e < 4; ++e) { const float lb = n ? l1[e] : l0[e], x = v[bj][n][e], t = __expf(-fabsf(x)), ia = 1.0f / (1.0f + t), ib = t * ia, sg = x >= 0.f ? ia : ib, sgn = x >= 0.f ? ib : ia;
                                lf[n][e] = __logf(lb + (1.0f - lb) * sg); kk[n][e] = (1.0f - lb) * sgn; }
                        st_f32x8((float*)(ws + WS_LF) + (size_t)row * HGW + col, lf[0], lf[1]);
                        st_bf16x8((bf16_t*)(ws + WS_HK) + (size_t)row * HGW + col, kk[0], kk[1]); }
                } else if (pn < 31) {
#pragma unroll
                    for (int bj = 0; bj < 2; ++bj) st_bf16x8((bf16_t*)(ws + WS_HV) + (size_t)row * HGW + (pn - 23) * 256 + bj * 128 + c8, v[bj][0], v[bj][1]);
                } else {
#pragma unroll
                    for (int bj = 0; bj < 2; ++bj) { f32x4 g[2];
#pragma unroll
                        for (int n = 0; n < 2; ++n)
#pragma unroll
                            for (int e = 0; e < 4; ++e) { const float x = v[bj][n][e]; g[n][e] = x / (1.0f + __expf(-x)); }
                        st_bf16x8((bf16_t*)(ws + WS_HG) + (size_t)row * HGW + (pn - 31) * 256 + bj * 128 + c8, g[0], g[1]); }
                }
            }
    }
};
struct EpiSumsq {
    unsigned char* ws; float scale; int fix16;
    DI void operator()(ACC_T, const pg8::Unit& u, int wr, int wc, int fr, int fq, int lane) const {
        const int row0 = (u.pm + (fix16 ? u.pm >> 4 : 0)) * 256 + wr * 64 + fr;
#pragma unroll
        for (int ai = 0; ai < 2; ++ai)
#pragma unroll
            for (int bj = 0; bj < 2; ++bj) {
                float s[4];
#pragma unroll
                for (int m = 0; m < 4; ++m) { float t = dot8(acc[ai][bj][m][0], acc[ai][bj][m][1]); t += __shfl_xor(t, 16); t += __shfl_xor(t, 32); s[m] = t; }
                const float sv = fq == 0 ? s[0] : fq == 1 ? s[1] : fq == 2 ? s[2] : s[3];
                unsafeAtomicAdd((float*)(ws + WS_SSK) + (size_t)(u.pn * 2 + bj) * ((size_t)SB * KPAD) + (row0 + ai * 128 + fq * 16), sv * scale);
            }
    }
};
struct EpiUq {
    unsigned char* ws; const float* gqn; const float* gqr; LAS unsigned char* lds; float sc; int s0 = 0, s1 = 8;
    DI void operator()(ACC_T, const pg8::Unit& u, int wr, int wc, int fr, int fq, int lane) const {
        const float* ssq = (const float*)(ws + OFF_SSQQ);
        const int row0 = u.pm * 256 + wr * 64 + fr, c8 = wc * 32 + 8 * fq;
        LAS float* xs = (LAS float*)(lds + XCH_OFF);
#pragma unroll
        for (int ai = 0; ai < 2; ++ai)
#pragma unroll
            for (int m = 0; m < 4; ++m) { if (ai * 4 + m < s0 || ai * 4 + m >= s1) continue; const float rs = rsqrtf(ssq[row0 + ai * 128 + m * 16] * (1.f / QL) + EPS) * sc;
#pragma unroll
                for (int bj = 0; bj < 2; ++bj) { float s = dot8(acc[ai][bj][m][0] * rs, acc[ai][bj][m][1] * rs); s += __shfl_xor(s, 16); s += __shfl_xor(s, 32);
                    if (fq == 0) xs[((ai * 128 + wr * 64 + m * 16 + fr) * 2 + bj) * 4 + wc] = s; }
                if (fq == 0 && wc == 0) xs[2048 + ai * 128 + wr * 64 + m * 16 + fr] = rs; }
        asm volatile("s_waitcnt lgkmcnt(0)" ::: "memory"); __builtin_amdgcn_s_barrier(); asm volatile("" ::: "memory");
        bf16_t* Q = (bf16_t*)(ws + WS_Q);
        if (u.pn < 8) {
            const f32x4 g0 = *(const f32x4*)(gqn + c8), g1 = *(const f32x4*)(gqn + c8 + 4);
#pragma unroll
            for (int ai = 0; ai < 2; ++ai)
#pragma unroll
                for (int m = 0; m < 4; ++m) { if (ai * 4 + m < s0 || ai * 4 + m >= s1) continue; const int row = row0 + ai * 128 + m * 16; const float rs = xs[2048 + ai * 128 + wr * 64 + m * 16 + fr];
#pragma unroll
                    for (int bj = 0; bj < 2; ++bj) { const f32x4 p = *(const LAS f32x4*)(xs + ((ai * 128 + wr * 64 + m * 16 + fr) * 2 + bj) * 4);
                        const float rn = rsqrtf(((p[0] + p[1]) + (p[2] + p[3])) * (1.f / NOPE) + EPS) * rs;
                        const f32x4 y0 = acc[ai][bj][m][0] * rn * g0, y1 = acc[ai][bj][m][1] * rn * g1;
                        if (u.pm >= MP / 256) st_bf16x8(Q + (size_t)row * 3072 + (u.pn * 2 + bj) * QH + c8, y0, y1);
                        else { u32x2 o8; o8.x = pk4_fp8(y0[0] * SC8_A, y0[1] * SC8_A, y0[2] * SC8_A, y0[3] * SC8_A); o8.y = pk4_fp8(y1[0] * SC8_A, y1[1] * SC8_A, y1[2] * SC8_A, y1[3] * SC8_A);
                            *(u32x2*)(ws + WS_Q + (size_t)row * 3072 + (u.pn * 2 + bj) * QH + c8) = o8; } } }
        } else {
            const int i0 = 16 * (wc & 1) + 4 * fq, hw = wc >> 1; const bool smp = u.pm >= MP / 256;
            const f32x4 ga = *(const f32x4*)(gqr + i0), gb = *(const f32x4*)(gqr + 32 + i0);
            const float* ropec = (const float*)(ws + WS_ROPE); const float* ropes = ropec + NKEY * 32;
#pragma unroll
            for (int ai = 0; ai < 2; ++ai)
#pragma unroll
                for (int m = 0; m < 4; ++m) { if (ai * 4 + m < s0 || ai * 4 + m >= s1) continue; const int row = row0 + ai * 128 + m * 16; const float rs = xs[2048 + ai * 128 + wr * 64 + m * 16 + fr];
                    const int pos = smp ? PAST + ((row - MP) & 15) : (row & (SEQ - 1));
                    const f32x4 c = *(const f32x4*)(ropec + pos * 32 + i0), s = *(const f32x4*)(ropes + pos * 32 + i0);
#pragma unroll
                    for (int bj = 0; bj < 2; ++bj) { const f32x4 p = *(const LAS f32x4*)(xs + ((ai * 128 + wr * 64 + m * 16 + fr) * 2 + bj) * 4);
                        const float rr = rsqrtf((hw ? p[2] + p[3] : p[0] + p[1]) * (1.f / ROPE) + EPS) * rs;
                        const f32x4 y1 = acc[ai][bj][m][0] * rr * ga, y2 = acc[ai][bj][m][1] * rr * gb, o1 = y1 * c - y2 * s, o2 = y2 * c + y1 * s;
                        u32x2 w1, w2; w1.x = cvtpk(o1[0], o1[1]); w1.y = cvtpk(o1[2], o1[3]); w2.x = cvtpk(o2[0], o2[1]); w2.y = cvtpk(o2[2], o2[3]);
                        const int h = 4 * (u.pn - 8) + 2 * bj + hw;
                        if (smp) { bf16_t* qp = Q + (size_t)row * 3072 + h * QH + NOPE + i0; *(u32x2*)qp = w1; *(u32x2*)(qp + 32) = w2; }
                        else { unsigned char* q8 = ws + WS_Q + (size_t)row * 3072 + h * QH + NOPE + i0; *(unsigned*)q8 = pk4_fp8(o1[0] * SC8_A, o1[1] * SC8_A, o1[2] * SC8_A, o1[3] * SC8_A); *(unsigned*)(q8 + 32) = pk4_fp8(o2[0] * SC8_A, o2[1] * SC8_A, o2[2] * SC8_A, o2[3] * SC8_A); }
                        if (smp) { bf16_t* qc = (bf16_t*)(ws + WS_QCAT) + ((size_t)(row - MP) * 16 + h) * KC + KVL + i0; *(u32x2*)qc = w1; *(u32x2*)(qc + 32) = w2; } } }
        }
        asm volatile("s_waitcnt lgkmcnt(0)" ::: "memory"); __builtin_amdgcn_s_barrier(); asm volatile("" ::: "memory");
    }
};

DI void p2_norm_rows(const Frame& F, const Args& a) {
    unsigned char* ws = a.ws; const int lane = lane_id();
    const float* ropec = (const float*)(ws + WS_ROPE); const float* ropes = ropec + NKEY * 32;
    for (int row = F.gw; row < M; row += F.NGW) {
        const bool smp = row >= MP; const int sr = row - MP, sb = sr >> 4, st = sr & 15;
        const float* cr = (const float*)(ws + WS_CKVRAW) + (size_t)row * KVL;
        f32x4 v0 = *(const f32x4*)(cr + 4 * lane), v1 = *(const f32x4*)(cr + 256 + 4 * lane);
        float ss = (v0[0] * v0[0] + v0[1] * v0[1]) + (v0[2] * v0[2] + v0[3] * v0[3]) + (v1[0] * v1[0] + v1[1] * v1[1]) + (v1[2] * v1[2] + v1[3] * v1[3]);
        ss = wave_sum(ss);
        const float rs = rsqrtf(ss * (1.f / KVL) + EPS);
        const f32x4 g0 = *(const f32x4*)(a.in[I_GKVA] + 4 * lane), g1 = *(const f32x4*)(a.in[I_GKVA] + 256 + 4 * lane);
        v0 = v0 * rs * g0; v1 = v1 * rs * g1;
        float* oc = a.out + (smp ? O_CKVS + (size_t)sr * KVL : O_CKVP + (size_t)row * KVL);
        *(f32x4*)(oc + 4 * lane) = v0; *(f32x4*)(oc + 256 + 4 * lane) = v1;
        u32x2 w0, w1; w0.x = cvtpk(v0[0], v0[1]); w0.y = cvtpk(v0[2], v0[3]); w1.x = cvtpk(v1[0], v1[1]); w1.y = cvtpk(v1[2], v1[3]);
        { unsigned char* c8p = ws + WS_CKVN8 + (size_t)row * KVL; *(unsigned*)(c8p + 4 * lane) = pk4_fp8(v0[0] * SC8_K, v0[1] * SC8_K, v0[2] * SC8_K, v0[3] * SC8_K); *(unsigned*)(c8p + 256 + 4 * lane) = pk4_fp8(v1[0] * SC8_K, v1[1] * SC8_K, v1[2] * SC8_K, v1[3] * SC8_K); }
        if (smp) {
            bf16_t* kc = (bf16_t*)(ws + WS_KCAT) + ((size_t)sb * KPAD + PAST + st) * KC;
            *(u32x2*)(kc + 4 * lane) = w0; *(u32x2*)(kc + 256 + 4 * lane) = w1;
            bf16_t* ct = (bf16_t*)(ws + WS_CKVT) + (size_t)sb * KVL * KT + PAST + st;
            const unsigned e0[4] = {w0.x & 0xffffu, w0.x >> 16, w0.y & 0xffffu, w0.y >> 16}, e1[4] = {w1.x & 0xffffu, w1.x >> 16, w1.y & 0xffffu, w1.y >> 16};
#pragma unroll
            for (int e = 0; e < 4; ++e) { ct[(size_t)(4 * lane + e) * KT] = (bf16_t)e0[e]; ct[(size_t)(256 + 4 * lane + e) * KT] = (bf16_t)e1[e]; }
        }
        const float kv = ((const float*)(ws + WS_KRRAW))[(size_t)row * ROPE + lane];
        const float s2 = wave_sum(kv * kv);
        const float y = kv * rsqrtf(s2 * (1.f / ROPE) + EPS) * a.in[I_GKR][lane];
        const float yo = __shfl_xor(y, 32);
        const int pos = smp ? PAST + st : (row & (SEQ - 1)), i = lane & 31;
        const float c = ropec[pos * 32 + i], s = ropes[pos * 32 + i];
        const float o = lane < 32 ? y * c - yo * s : y * c + yo * s;
        (a.out + (smp ? O_KRS + (size_t)sr * ROPE : O_KRP + (size_t)row * ROPE))[lane] = o;
        const bf16_t ob = f2bf(o);
        if (!smp) (ws + WS_KRN)[(size_t)row * ROPE + lane] = (unsigned char)(pk4_fp8(o * SC8_A, 0.f, 0.f, 0.f) & 0xffu);
        if (smp) ((bf16_t*)(ws + WS_KCAT))[((size_t)sb * KPAD + PAST + st) * KC + KVL + lane] = ob;
    }
}

struct EpiKup {
    unsigned char* ws; const float* gkn; LAS unsigned char* lds; float sc;
    DI void operator()(ACC_T, const pg8::Unit& u, int wr, int wc, int fr, int fq, int lane) const {
        const int row0 = u.pm * 256 + wr * 64 + fr, c8 = wc * 32 + 8 * fq;
        if (u.pn >= 8) { bf16_t* base = (bf16_t*)(ws + WS_V) + (u.pn & 7) * 256 + c8;
#pragma unroll
            for (int ai = 0; ai < 2; ++ai)
#pragma unroll
                for (int m = 0; m < 4; ++m)
#pragma unroll
                    for (int bj = 0; bj < 2; ++bj) st_bf16x8(base + (size_t)(row0 + ai * 128 + m * 16) * 2048 + bj * 128, acc[ai][bj][m][0] * sc, acc[ai][bj][m][1] * sc);
            return; }
        LAS float* xs = (LAS float*)(lds + XCH_OFF);
#pragma unroll
        for (int ai = 0; ai < 2; ++ai)
#pragma unroll
            for (int m = 0; m < 4; ++m)
#pragma unroll
                for (int bj = 0; bj < 2; ++bj) { float s = dot8(acc[ai][bj][m][0] * sc, acc[ai][bj][m][1] * sc); s += __shfl_xor(s, 16); s += __shfl_xor(s, 32);
                    if (fq == 0) xs[((ai * 128 + wr * 64 + m * 16 + fr) * 2 + bj) * 4 + wc] = s; }
        asm volatile("s_waitcnt lgkmcnt(0)" ::: "memory"); __builtin_amdgcn_s_barrier(); asm volatile("" ::: "memory");
        const f32x4 g0 = *(const f32x4*)(gkn + c8), g1 = *(const f32x4*)(gkn + c8 + 4);
        unsigned char* base = ws + WS_KN + (u.pn & 7) * 256 + c8;
#pragma unroll
        for (int ai = 0; ai < 2; ++ai)
#pragma unroll
            for (int m = 0; m < 4; ++m)
#pragma unroll
                for (int bj = 0; bj < 2; ++bj) { const f32x4 p = *(const LAS f32x4*)(xs + ((ai * 128 + wr * 64 + m * 16 + fr) * 2 + bj) * 4);
                    const float rn = rsqrtf(((p[0] + p[1]) + (p[2] + p[3])) * (1.f / NOPE) + EPS) * sc;
                    const f32x4 y0 = acc[ai][bj][m][0] * (rn * SC8_A) * g0, y1 = acc[ai][bj][m][1] * (rn * SC8_A) * g1;
                    u32x2 o8; o8.x = pk4_fp8(y0[0], y0[1], y0[2], y0[3]); o8.y = pk4_fp8(y1[0], y1[1], y1[2], y1[3]); *(u32x2*)(base + (size_t)(row0 + ai * 128 + m * 16) * 2048 + bj * 128) = o8; }
        asm volatile("s_waitcnt lgkmcnt(0)" ::: "memory"); __builtin_amdgcn_s_barrier(); asm volatile("" ::: "memory");
    }
};
DI int crow(int r, int hi) { return (r & 3) + 8 * (r >> 2) + 4 * hi; }
template <int NJ, bool AF32, class Mid>
DI void sgemm_tile(const void* Av, size_t lda, const bf16_t* Bt, size_t ldb, int K, int mid_k, const Mid& mid, f32x16 (&acc)[2][NJ], int wave, int lane) {
    const int wm = wave >> 2, wn = wave & 3, r32 = lane & 31, hi = lane >> 5;
#pragma unroll
    for (int i = 0; i < 2; ++i)
#pragma unroll
        for (int j = 0; j < NJ; ++j)
#pragma unroll
            for (int r = 0; r < 16; ++r) acc[i][j][r] = 0.f;
    const bf16_t* bp[NJ];
#pragma unroll
    for (int j = 0; j < NJ; ++j) bp[j] = Bt + (size_t)(wn * 32 * NJ + j * 32 + r32) * ldb + hi * 8;
    if constexpr (AF32) {
        for (int k0 = 0; k0 < K; k0 += 16) {
            bf16x8 af[2], bf_[NJ];
#pragma unroll
            for (int i = 0; i < 2; ++i) { const float* p = (const float*)Av + (size_t)(wm * 64 + i * 32 + r32) * lda + hi * 8 + k0; af[i] = __builtin_bit_cast(bf16x8, pack8(*(const f32x4*)p, *(const f32x4*)(p + 4))); }
#pragma unroll
            for (int j = 0; j < NJ; ++j) bf_[j] = *(const bf16x8*)(bp[j] + k0);
#pragma unroll
            for (int i = 0; i < 2; ++i)
#pragma unroll
                for (int j = 0; j < NJ; ++j) acc[i][j] = __builtin_amdgcn_mfma_f32_32x32x16_bf16(af[i], bf_[j], acc[i][j], 0, 0, 0);
        }
    } else {
    for (int k0 = 0; k0 < K; k0 += 64) {
        bf16x8 af[2][4], bf_[NJ][4];
#pragma unroll
        for (int i = 0; i < 2; ++i)
#pragma unroll
            for (int ks = 0; ks < 4; ++ks) af[i][ks] = *(const bf16x8*)((const bf16_t*)Av + (size_t)(wm * 64 + i * 32 + r32) * lda + hi * 8 + k0 + ks * 16);
#pragma unroll
        for (int j = 0; j < NJ; ++j)
#pragma unroll
            for (int ks = 0; ks < 4; ++ks) bf_[j][ks] = *(const bf16x8*)(bp[j] + k0 + ks * 16);
        if (k0 == mid_k) mid(acc);
#pragma unroll
        for (int ks = 0; ks < 4; ++ks)
#pragma unroll
            for (int i = 0; i < 2; ++i)
#pragma unroll
                for (int j = 0; j < NJ; ++j) acc[i][j] = __builtin_amdgcn_mfma_f32_32x32x16_bf16(af[i][ks], bf_[j][ks], acc[i][j], 0, 0, 0);
    }
    }
}
struct NoMid { template <class T> DI void operator()(T&) const {} };

DI void p4_qa_unit(const Frame& F, const Args& a, int unit) {
    unsigned char* ws = a.ws; const int h = unit >> 3, mt = (unit >> 1) & 3, nt = unit & 1;
    f32x16 acc[2][2];
    sgemm_tile<2, false>((const bf16_t*)(ws + WS_Q) + (size_t)(MP + mt * 128) * 3072 + h * QH, 3072, (const bf16_t*)(ws + WS_WUKN) + (size_t)(nt * 256) * 2048 + h * 128, 2048, NOPE, -1, NoMid(), acc, F.wave, lane_id());
    const int wm = F.wave >> 2, wn = F.wave & 3, r32 = lane_id() & 31, hi = lane_id() >> 5;
#pragma unroll
    for (int i = 0; i < 2; ++i)
#pragma unroll
        for (int j = 0; j < 2; ++j)
#pragma unroll
            for (int r = 0; r < 16; ++r) { const int t = mt * 128 + wm * 64 + i * 32 + crow(r, hi), c = nt * 256 + wn * 64 + j * 32 + r32;
                ((bf16_t*)(ws + WS_QCAT))[((size_t)t * 16 + h) * KC + c] = f2bf(acc[i][j][r]); }
    __builtin_amdgcn_sched_barrier(0);
#pragma unroll
    for (int i = 0; i < 2; ++i)
#pragma unroll
        for (int j = 0; j < 2; ++j)
#pragma unroll
            for (int r4 = 0; r4 < 4; ++r4) {
#pragma unroll
                for (int e = 0; e < 4; ++e) { const int r = 4 * r4 + e, t = mt * 128 + wm * 64 + i * 32 + crow(r, hi), c = nt * 256 + wn * 64 + j * 32 + r32;
                    (ws + WS_QCAT8)[((size_t)t * 16 + h) * KVL + c] = (unsigned char)(pk4_fp8(acc[i][j][r] * SC8_QA, 0.f, 0.f, 0.f) & 0xffu); }
                __builtin_amdgcn_sched_barrier(0); }
}

namespace att {
constexpr int SHM_K = 64 * 256  , SHM_V = 64 * 128 * 2;
constexpr int OFF_V = 0, OFF_K = 2 * SHM_V, OFF_WS = OFF_K + 2 * SHM_K, LDS_NEED = OFF_WS + 8 * 64 * 4;
static_assert(LDS_NEED <= RING_BYTES, "attention LDS");
#define KSWZ(row, colB) ((row) * 256 + ((colB) ^ (((row) & 7) << 4)))
#define SBAR() __builtin_amdgcn_sched_barrier(0)
DI int v_st(int k, int c) { const int kk = (k & ~0xC) | ((k & 4) << 1) | ((k & 8) >> 1); return ((kk >> 3) * 4 + (c >> 5)) * 512 + ((kk & 7) * 32 + (c & 31)) * 2; }
DI int v_rd_base(int lane) { return ((lane & 3) << 3) | (((lane >> 2) & 3) << 6) | (((lane >> 4) & 1) << 5) | (((lane >> 5) & 1) << 8); }
constexpr float THR = 8.f;
constexpr float ASC = ATT_SCALE / (SC8_A * SC8_A);
constexpr float C2 = 1.4426950408889634f * ASC;

DI void partialSM(f32x16& p0, f32x16& p1, float& m_reg, float& mn, float& alpha) {
    float pmax = p0[0];
#pragma unroll
    for (int r = 1; r < 16; ++r) pmax = fmaxf(pmax, p0[r]);
#pragma unroll
    for (int r = 0; r < 16; ++r) pmax = fmaxf(pmax, p1[r]);
    { auto rr = __builtin_amdgcn_permlane32_swap(__float_as_uint(pmax), __float_as_uint(pmax), false, false);
      pmax = fmaxf(__uint_as_float(rr[0]), __uint_as_float(rr[1])); }
    if (__builtin_expect(__all((pmax - m_reg) * ASC <= THR), 1)) { mn = m_reg; alpha = 1.f; }
    else { mn = fmaxf(m_reg, pmax); alpha = __builtin_amdgcn_exp2f((m_reg - mn) * C2); m_reg = mn; }
    const float mnL = -mn * C2;
#pragma unroll
    for (int r = 0; r < 16; ++r) p0[r] = fmaf(p0[r], C2, mnL);
#pragma unroll
    for (int r = 0; r < 16; ++r) p1[r] = fmaf(p1[r], C2, mnL);
#pragma unroll
    for (int r = 0; r < 16; ++r) p0[r] = __builtin_amdgcn_exp2f(p0[r]);
}
DI void finishSM(f32x16& p0, f32x16& p1, float alpha, float& l_reg, bf16x8& pa0, bf16x8& pa1, bf16x8& pa2, bf16x8& pa3) {
#pragma unroll
    for (int r = 0; r < 16; ++r) p1[r] = __builtin_amdgcn_exp2f(p1[r]);
    float ps = 0;
#pragma unroll
    for (int r = 0; r < 16; ++r) ps += p0[r];
#pragma unroll
    for (int r = 0; r < 16; ++r) ps += p1[r];
    { auto rr = __builtin_amdgcn_permlane32_swap(__float_as_uint(ps), __float_as_uint(ps), false, false);
      ps = __uint_as_float(rr[0]) + __uint_as_float(rr[1]); }
    l_reg = l_reg * alpha + ps;
#define PK4(P, B_, OUT) do { unsigned a0 = cvtpk(P[B_+0], P[B_+1]), a1 = cvtpk(P[B_+2], P[B_+3]);                          \
        unsigned b0 = cvtpk(P[B_+4], P[B_+5]), b1 = cvtpk(P[B_+6], P[B_+7]);                                             \
        auto r0 = __builtin_amdgcn_permlane32_swap(a0, b0, false, false); auto r1 = __builtin_amdgcn_permlane32_swap(a1, b1, false, false); \
        u32x4 w = {r0[0], r1[0], r0[1], r1[1]}; OUT = __builtin_bit_cast(bf16x8, w); } while (0)
    PK4(p0, 0, pa0); PK4(p0, 8, pa1); PK4(p1, 0, pa2); PK4(p1, 8, pa3);
#undef PK4
}
template <int KB>
DI void qkt(f32x16& p0, f32x16& p1, const LAS char* lds, int r32, int hi, const i32x8* q8, bool act) {
    if (!act) { const float NEG = -__builtin_inff();
#pragma unroll
        for (int r = 0; r < 16; ++r) { p0[r] = NEG; p1[r] = NEG; } return; }
#pragma unroll
    for (int r = 0; r < 16; ++r) { p0[r] = 0.f; p1[r] = 0.f; }
    int kb0 = KSWZ(r32, hi * 32);
    asm volatile("" : "+v"(kb0));
#define QK_LD(s, kb, dst) do { const LAS char* a0_ = lds + OFF_K + KB * SHM_K + (kb0 ^ (64 * ((s) & 1))) + 128 * ((s) >> 1) + (kb) * 32 * 256; const LAS char* a1_ = lds + OFF_K + KB * SHM_K + (kb0 ^ (64 * ((s) & 1) + 16)) + 128 * ((s) >> 1) + (kb) * 32 * 256; \
        dst.lo = *(const LAS i32x4*)a0_; dst.hi = *(const LAS i32x4*)a1_; } while (0)
    { i32x8 ka, kb_; QK_LD(0, 0, ka); QK_LD(0, 1, kb_);
      asm volatile("s_nop 1\n\tv_mfma_f32_32x32x64_f8f6f4 %0, %1, %2, %0" : "+v"(p0) : "v"(ka), "v"(q8[0]));
      asm volatile("s_nop 1\n\tv_mfma_f32_32x32x64_f8f6f4 %0, %1, %2, %0" : "+v"(p1) : "v"(kb_), "v"(q8[0])); }
    { i32x8 ka, kb_; QK_LD(1, 0, ka); QK_LD(1, 1, kb_);
      asm volatile("v_mfma_f32_32x32x64_f8f6f4 %0, %1, %2, %0" : "+v"(p0) : "v"(ka), "v"(q8[1]));
      asm volatile("v_mfma_f32_32x32x64_f8f6f4 %0, %1, %2, %0" : "+v"(p1) : "v"(kb_), "v"(q8[1])); }
    { i32x8 ka, kb_; QK_LD(2, 0, ka); QK_LD(2, 1, kb_);
      asm volatile("v_mfma_f32_32x32x64_f8f6f4 %0, %1, %2, %0" : "+v"(p0) : "v"(ka), "v"(q8[2]));
      asm volatile("v_mfma_f32_32x32x64_f8f6f4 %0, %1, %2, %0\n\ts_nop 15\n\ts_nop 7" : "+v"(p1) : "v"(kb_), "v"(q8[2])); }
#undef QK_LD
}
template <int VB>
DI void pv_tile(f32x16* o, int vb0, bf16x8 pa0, bf16x8 pa1, bf16x8 pa2, bf16x8 pa3, bool act) {
    if (!act) return;
#define TRRD(dst, off) asm volatile("ds_read_b64_tr_b16 %0, %1 offset:%2" : "=&v"(dst) : "v"(vb0), "i"(off) : "memory")
#define PV_RD(d0, S) do { constexpr int b_ = OFF_V + VB * SHM_V + (d0) * 512; \
        TRRD(S##l0, b_); TRRD(S##h0, b_ + 2048); TRRD(S##l1, b_ + 4096); TRRD(S##h1, b_ + 6144); TRRD(S##l2, b_ + 8192); TRRD(S##h2, b_ + 10240); TRRD(S##l3, b_ + 12288); TRRD(S##h3, b_ + 14336); } while (0)
#define PV_MM(d0, S) do { \
        o[d0] = __builtin_amdgcn_mfma_f32_32x32x16_bf16(pa0, (bf16x8){S##l0[0], S##l0[1], S##l0[2], S##l0[3], S##h0[0], S##h0[1], S##h0[2], S##h0[3]}, o[d0], 0, 0, 0);   \
        o[d0] = __builtin_amdgcn_mfma_f32_32x32x16_bf16(pa1, (bf16x8){S##l1[0], S##l1[1], S##l1[2], S##l1[3], S##h1[0], S##h1[1], S##h1[2], S##h1[3]}, o[d0], 0, 0, 0);   \
        o[d0] = __builtin_amdgcn_mfma_f32_32x32x16_bf16(pa2, (bf16x8){S##l2[0], S##l2[1], S##l2[2], S##l2[3], S##h2[0], S##h2[1], S##h2[2], S##h2[3]}, o[d0], 0, 0, 0);   \
        o[d0] = __builtin_amdgcn_mfma_f32_32x32x16_bf16(pa3, (bf16x8){S##l3[0], S##l3[1], S##l3[2], S##l3[3], S##h3[0], S##h3[1], S##h3[2], S##h3[3]}, o[d0], 0, 0, 0); } while (0)
    s16x4 Al0, Al1, Al2, Al3, Ah0, Ah1, Ah2, Ah3, Bl0, Bl1, Bl2, Bl3, Bh0, Bh1, Bh2, Bh3;
    PV_RD(0, A);
    PV_RD(1, B); asm volatile("s_waitcnt lgkmcnt(8)" ::: "memory"); SBAR(); PV_MM(0, A); SBAR();
    PV_RD(2, A); asm volatile("s_waitcnt lgkmcnt(8)" ::: "memory"); SBAR(); PV_MM(1, B); SBAR();
    PV_RD(3, B); asm volatile("s_waitcnt lgkmcnt(8)" ::: "memory"); SBAR(); PV_MM(2, A); SBAR();
    asm volatile("s_waitcnt lgkmcnt(0)" ::: "memory"); SBAR(); PV_MM(3, B);
#undef PV_RD
#undef PV_MM
#undef TRRD
}

DI void attn_unit(int b, int h, int qb, const unsigned char* __restrict__ Q8, const unsigned char* __restrict__ KN8, const unsigned char* __restrict__ KR8, const bf16_t* __restrict__ V, bf16_t* __restrict__ O, LAS char* lds, int wid) {
    const int lane = lane_id(), tid = wid * 64 + lane, r32 = lane & 31, hi = lane >> 5;
    const int NT = 4 * qb + 4, wchunk = 4 * qb + (wid >> 1);
    const size_t krow0 = (size_t)b * SEQ;
    const unsigned char* Kh = KN8 + krow0 * 2048 + h * 128; const bf16_t* Vh = V + krow0 * 2048 + h * 128; const unsigned char* Rh = KR8 + krow0 * ROPE;
    LAS float* wsl = (LAS float*)(lds + OFF_WS) + wid * 64; LAS float* li_l = wsl; LAS float* al_l = wsl + 32;
    float m_reg = -1e30f, l_reg = 0; f32x16 o[4];
#pragma unroll
    for (int d = 0; d < 4; ++d)
#pragma unroll
        for (int r = 0; r < 16; ++r) o[d][r] = 0.f;
    const int sr = tid >> 4, sc = (tid & 15) * 8, vst0 = v_st(sr, sc), vst1 = v_st(32 + sr, sc);
    const int rr_ = tid >> 3, rc = tid & 7, kws = KSWZ(rr_, rc * 16), krws = KSWZ(rr_, 128 + rc * 8);
    const int vb0 = (int)(unsigned)(size_t)(lds) + v_rd_base(lane);
    i32x8 q8[3];
    { const unsigned char* qp = Q8 + ((size_t)b * SEQ + qb * 256 + wid * 32 + r32) * 3072 + h * QH + hi * 32;
#pragma unroll
      for (int s = 0; s < 3; ++s) { q8[s].lo = *(const i32x4*)(qp + 64 * s); q8[s].hi = *(const i32x4*)(qp + 64 * s + 16); } }
    bf16x8 st_v0, st_v1; u32x4 st_k; u32x2 st_kr;
#define SLOAD(k0) do { st_v0 = *(const bf16x8*)(Vh + (size_t)((k0) + sr) * 2048 + sc); st_v1 = *(const bf16x8*)(Vh + (size_t)((k0) + 32 + sr) * 2048 + sc); \
                       st_k = *(const u32x4*)(Kh + (size_t)((k0) + rr_) * 2048 + rc * 16); st_kr = *(const u32x2*)(Rh + (size_t)((k0) + rr_) * ROPE + rc * 8); } while (0)
#define SWRITE(bf) do { *(LAS bf16x8*)(lds + OFF_V + (bf) * SHM_V + vst0) = st_v0; *(LAS bf16x8*)(lds + OFF_V + (bf) * SHM_V + vst1) = st_v1; \
                        *(LAS u32x4*)(lds + OFF_K + (bf) * SHM_K + kws) = st_k; *(LAS u32x2*)(lds + OFF_K + (bf) * SHM_K + krws) = st_kr; } while (0)
#define VMW() asm volatile("s_waitcnt vmcnt(0)" ::: "memory")
#define RESC(a_) do { if (__any((a_) < 1.f)) { if (hi == 0) al_l[r32] = (a_); asm volatile("s_waitcnt lgkmcnt(0)" ::: "memory");              \
                     for (int d_ = 0; d_ < 4; ++d_) for (int r = 0; r < 16; ++r) o[d_][r] *= al_l[crow(r, hi)]; } } while (0)
#define ACT(t) ((t) <= wchunk)
    f32x16 pA0, pA1, pB0, pB1; float mnA, mnB, alA, alB; bf16x8 pa0, pa1, pa2, pa3;
    SLOAD(0); VMW(); SWRITE(0);
    __syncthreads();
    if (NT > 1) SLOAD(64);
    SBAR(); qkt<0>(pA0, pA1, lds, r32, hi, q8, ACT(0));
    partialSM(pA0, pA1, m_reg, mnA, alA);
    if (NT > 1) { VMW(); SWRITE(1); }
    __syncthreads();
#define HALF_STEP(ORD, PX0, PX1, mnX, alX, PY0, PY1, alY, t, KB, VB, SB_) do {                                                      \
        if (ORD == 0) {                                                                                                       \
        SBAR(); qkt<KB>(PX0, PX1, lds, r32, hi, q8, ACT(t));                                             \
        finishSM(PY0, PY1, alY, l_reg, pa0, pa1, pa2, pa3); SBAR();                                                           \
        if ((t) + 1 < NT) { SLOAD(((t) + 1) * 64); SBAR(); }                                               \
        pv_tile<VB>(o, vb0, pa0, pa1, pa2, pa3, ACT((t) - 1)); partialSM(PX0, PX1, m_reg, mnX, alX);                                        \
        } else {                                                                                                              \
        SBAR(); finishSM(PY0, PY1, alY, l_reg, pa0, pa1, pa2, pa3); SBAR();                                                   \
        qkt<KB>(PX0, PX1, lds, r32, hi, q8, ACT(t)); SBAR();                                             \
        if ((t) + 1 < NT) { SLOAD(((t) + 1) * 64); SBAR(); }                                               \
        partialSM(PX0, PX1, m_reg, mnX, alX); pv_tile<VB>(o, vb0, pa0, pa1, pa2, pa3, ACT((t) - 1));                                        \
        }                                                                                                                     \
        __syncthreads();                                                                                                      \
        if ((t) + 1 < NT) { VMW(); SWRITE(SB_); }                                                                          \
        RESC(alX); __syncthreads(); } while (0)
    if (wid < 4) {
        for (int t = 1; t + 1 < NT; t += 2) {
            HALF_STEP(0, pB0, pB1, mnB, alB, pA0, pA1, alA, t, 1, 0, 0);
            HALF_STEP(0, pA0, pA1, mnA, alA, pB0, pB1, alB, t + 1, 0, 1, 1);
        }
    } else {
        for (int t = 1; t + 1 < NT; t += 2) {
            HALF_STEP(1, pB0, pB1, mnB, alB, pA0, pA1, alA, t, 1, 0, 0);
            HALF_STEP(1, pA0, pA1, mnA, alA, pB0, pB1, alB, t + 1, 0, 1, 1);
        }
    }
    SBAR(); qkt<1>(pB0, pB1, lds, r32, hi, q8, ACT(NT - 1)); SBAR();
    finishSM(pA0, pA1, alA, l_reg, pa0, pa1, pa2, pa3); SBAR();
    pv_tile<0>(o, vb0, pa0, pa1, pa2, pa3, ACT(NT - 2));
    partialSM(pB0, pB1, m_reg, mnB, alB); RESC(alB);
    finishSM(pB0, pB1, alB, l_reg, pa0, pa1, pa2, pa3); SBAR(); pv_tile<1>(o, vb0, pa0, pa1, pa2, pa3, ACT(NT - 1));
    if (hi == 0) li_l[r32] = l_reg; asm volatile("s_waitcnt lgkmcnt(0)" ::: "memory");
    float rli[16];
#pragma unroll
    for (int r = 0; r < 16; ++r) rli[r] = __builtin_amdgcn_rcpf(li_l[crow(r, hi)]);
    int r32e = r32, hie = hi; asm volatile("" : "+v"(r32e), "+v"(hie));
    bf16_t* Ow = O + ((size_t)b * SEQ + qb * 256 + wid * 32) * D + h * 128 + r32e;
#pragma unroll
    for (int r = 0; r < 16; ++r) { const int orow = crow(r, hie);
#pragma unroll
        for (int d0 = 0; d0 < 4; ++d0) { const float v = o[d0][r] * rli[r]; const float vn = __shfl_xor(v, 1);
            if ((r32e & 1) == 0) *(unsigned*)(Ow + (size_t)orow * D + d0 * 32) = cvtpk(v, vn); } }
    __syncthreads();
#undef SLOAD
#undef SWRITE
#undef VMW
#undef RESC
#undef ACT
#undef HALF_STEP
}
#undef KSWZ
#undef SBAR
}

namespace hg {
constexpr int P = 136, KP = 72, OP = 132;
constexpr int OFF_QE = 0, OFF_QD = 17408, OFF_KDD = 34816, OFF_KDT = 52224, OFF_V = 70656, OFF_AM = 88064, OFF_T = 97280, OFF_DL = 101376, OFF_OX = OFF_QD, LDS_NEED = 101888;
static_assert(OFF_OX + 64 * OP * 4 <= OFF_KDT && LDS_NEED <= RING_BYTES, "hgrn LDS");
DI bf16x8 mk8(u32x2 a, u32x2 b) { u32x4 w = {a.x, a.y, b.x, b.y}; return __builtin_bit_cast(bf16x8, w); }

DI void hgrn_unit(const Args& a, bool smp, int bb, int h, LAS char* lds, int w) {
    unsigned char* ws = a.ws;
    const int lane = lane_id(), tid = w * 64 + lane, n = lane & 15, g = lane >> 4;
    const int nch = smp ? 1 : SEQ / 64, nrow = smp ? ST : 64;
    const size_t row_base = smp ? (size_t)MP + (size_t)bb * ST : (size_t)bb * SEQ;
    const bf16_t* HQ = (const bf16_t*)(ws + WS_HQ) + h * HGD; const bf16_t* HK = (const bf16_t*)(ws + WS_HK) + h * HGD; const bf16_t* HV = (const bf16_t*)(ws + WS_HV) + h * HGD;
    const bf16_t* HGt = (const bf16_t*)(ws + WS_HG) + h * HGD; const float* LF = (const float*)(ws + WS_LF) + h * HGD;
    f32x4 sacc[8];
    float* sout = a.out + (smp ? O_HGS : O_HGP) + ((size_t)bb * HGH + h) * HGD * HGD;
    if (smp) { const float* s0 = a.in[I_SHG] + ((size_t)bb * HGH + h) * HGD * HGD;
#pragma unroll
        for (int kb = 0; kb < 8; ++kb)
#pragma unroll
            for (int i = 0; i < 4; ++i) sacc[kb][i] = s0[(size_t)(16 * kb + 4 * g + i) * HGD + 16 * w + n]; }
    else {
#pragma unroll
        for (int kb = 0; kb < 8; ++kb) sacc[kb] = (f32x4){0.f, 0.f, 0.f, 0.f}; }
    const int c0 = 2 * lane, vrow = tid >> 3, vg = tid & 7;
    f32x2 lfv[8]; unsigned qv[8], kv[8]; u32x4 vraw[2], graw[2];
#define HG_LOAD(cc) do { const size_t r0_ = row_base + (size_t)(cc) * 64; \
        _Pragma("unroll") for (int j = 0; j < 8; ++j) { const int t_ = 8 * w + j; const bool ok_ = t_ < nrow; const size_t ro_ = (r0_ + (ok_ ? t_ : 0)) * HGW + c0; \
            lfv[j] = ok_ ? *(const f32x2*)(LF + ro_) : (f32x2){0.f, 0.f}; qv[j] = ok_ ? *(const unsigned*)(HQ + ro_) : 0u; kv[j] = ok_ ? *(const unsigned*)(HK + ro_) : 0u; } \
        { const bool ok_ = vrow < nrow; const size_t ro_ = (r0_ + (ok_ ? vrow : 0)) * HGW + 16 * vg; const u32x4 z_ = {0u, 0u, 0u, 0u}; \
          vraw[0] = ok_ ? *(const u32x4*)(HV + ro_) : z_; vraw[1] = ok_ ? *(const u32x4*)(HV + ro_ + 8) : z_; graw[0] = ok_ ? *(const u32x4*)(HGt + ro_) : z_; graw[1] = ok_ ? *(const u32x4*)(HGt + ro_ + 8) : z_; } } while (0)
    f32x2 ghg[8];
#pragma unroll
    for (int e2 = 0; e2 < 8; ++e2) ghg[e2] = *(const f32x2*)(a.in[I_GHG] + 16 * vg + 2 * e2);
    HG_LOAD(0);
    for (int c = 0; c < nch; ++c) {
        float bl0[8], bl1[8]; float run0 = 0.f, run1 = 0.f;
#pragma unroll
        for (int j = 0; j < 8; ++j) { run0 += lfv[j].x; run1 += lfv[j].y; bl0[j] = run0; bl1[j] = run1; }
        *(LAS f32x2*)(lds + OFF_T + (w * 128 + c0) * 4) = (f32x2){run0, run1};
        *(LAS u32x4*)(lds + OFF_V + (vrow * P + 16 * vg) * 2) = vraw[0]; *(LAS u32x4*)(lds + OFF_V + (vrow * P + 16 * vg + 8) * 2) = vraw[1];
        const u32x4 gcur0 = graw[0], gcur1 = graw[1];
        asm volatile("s_waitcnt lgkmcnt(0)" ::: "memory"); __syncthreads();
        float off0 = 0.f, off1 = 0.f, br0 = 0.f, br1 = 0.f, bt0 = 0.f, bt1 = 0.f;
#pragma unroll
        for (int e = 0; e < 8; ++e) { const f32x2 tv = *(const LAS f32x2*)(lds + OFF_T + (e * 128 + c0) * 4); if (e < w) { off0 += tv.x; off1 += tv.y; } if (e < 4) { br0 += tv.x; br1 += tv.y; } bt0 += tv.x; bt1 += tv.y; }
        float kd0[8], kd1[8];
#pragma unroll
        for (int j = 0; j < 8; ++j) { const int t = 8 * w + j; const float b0 = off0 + bl0[j], b1 = off1 + bl1[j];
            const float q0 = bf_lo(qv[j]), q1 = bf_hi(qv[j]), k0 = bf_lo(kv[j]), k1 = bf_hi(kv[j]);
            *(LAS unsigned*)(lds + OFF_QE + (t * P + c0) * 2) = cvtpk(q0 * __expf(b0), q1 * __expf(b1));
            *(LAS unsigned*)(lds + OFF_QD + (t * P + c0) * 2) = cvtpk(q0 * __expf(b0 - br0), q1 * __expf(b1 - br1));
            *(LAS unsigned*)(lds + OFF_KDD + (t * P + c0) * 2) = cvtpk(k0 * __expf(br0 - b0), k1 * __expf(br1 - b1));
            kd0[j] = k0 * __expf(bt0 - b0); kd1[j] = k1 * __expf(bt1 - b1); }
        { u32x4 p0, p1; p0.x = cvtpk(kd0[0], kd0[1]); p0.y = cvtpk(kd0[2], kd0[3]); p0.z = cvtpk(kd0[4], kd0[5]); p0.w = cvtpk(kd0[6], kd0[7]);
          p1.x = cvtpk(kd1[0], kd1[1]); p1.y = cvtpk(kd1[2], kd1[3]); p1.z = cvtpk(kd1[4], kd1[5]); p1.w = cvtpk(kd1[6], kd1[7]);
          *(LAS u32x4*)(lds + OFF_KDT + (c0 * KP + 8 * w) * 2) = p0; *(LAS u32x4*)(lds + OFF_KDT + ((c0 + 1) * KP + 8 * w) * 2) = p1; }
        if (w == 0) *(LAS f32x2*)(lds + OFF_DL + c0 * 4) = (f32x2){__expf(bt0), __expf(bt1)};
        asm volatile("s_waitcnt lgkmcnt(0)" ::: "memory"); __syncthreads();
        if (c + 1 < nch) HG_LOAD(c + 1);
        { const int tb = w >> 1;
#pragma unroll
          for (int sbi = 0; sbi < 2; ++sbi) { const int sb = 2 * (w & 1) + sbi; f32x4 acc = {0.f, 0.f, 0.f, 0.f};
            if (sb <= tb) {
#pragma unroll
                for (int ks = 0; ks < 4; ++ks) { const bf16x8 af = *(const LAS bf16x8*)(lds + OFF_KDD + ((16 * sb + n) * P + 32 * ks + 8 * g) * 2), bfr = *(const LAS bf16x8*)(lds + OFF_QD + ((16 * tb + n) * P + 32 * ks + 8 * g) * 2);
                    acc = __builtin_amdgcn_mfma_f32_16x16x32_bf16(af, bfr, acc, 0, 0, 0); }
                if (sb == tb) {
#pragma unroll
                    for (int i = 0; i < 4; ++i) if (n < 4 * g + i) acc[i] = 0.f; }
            }
            u32x2 pk; pk.x = cvtpk(acc[0], acc[1]); pk.y = cvtpk(acc[2], acc[3]);
            *(LAS u32x2*)(lds + OFF_AM + ((16 * tb + n) * KP + 16 * sb + 4 * g) * 2) = pk; } }
        f32x4 oacc[4];
#pragma unroll
        for (int tb = 0; tb < 4; ++tb) oacc[tb] = (f32x4){0.f, 0.f, 0.f, 0.f};
#pragma unroll
        for (int j = 0; j < 4; ++j) { u32x4 sb4; sb4.x = cvtpk(sacc[2 * j][0], sacc[2 * j][1]); sb4.y = cvtpk(sacc[2 * j][2], sacc[2 * j][3]); sb4.z = cvtpk(sacc[2 * j + 1][0], sacc[2 * j + 1][1]); sb4.w = cvtpk(sacc[2 * j + 1][2], sacc[2 * j + 1][3]);
            const bf16x8 bfr = __builtin_bit_cast(bf16x8, sb4);
#pragma unroll
            for (int tb = 0; tb < 4; ++tb) { const LAS char* qp = lds + OFF_QE + ((16 * tb + n) * P + 32 * j + 4 * g) * 2;
                const bf16x8 af = mk8(*(const LAS u32x2*)qp, *(const LAS u32x2*)(qp + 32));
                oacc[tb] = __builtin_amdgcn_mfma_f32_16x16x32_bf16(af, bfr, oacc[tb], 0, 0, 0); } }
        asm volatile("s_waitcnt lgkmcnt(0)" ::: "memory"); __syncthreads();
        bf16x8 vf[2];
#pragma unroll
        for (int js = 0; js < 2; ++js) { unsigned short e_[8];
#pragma unroll
            for (int i = 0; i < 8; ++i) e_[i] = *(const LAS unsigned short*)(lds + OFF_V + ((32 * js + 8 * g + i) * P + 16 * w + n) * 2);
            u32x4 t_; t_.x = e_[0] | ((unsigned)e_[1] << 16); t_.y = e_[2] | ((unsigned)e_[3] << 16); t_.z = e_[4] | ((unsigned)e_[5] << 16); t_.w = e_[6] | ((unsigned)e_[7] << 16);
            vf[js] = __builtin_bit_cast(bf16x8, t_); }
#pragma unroll
        for (int tb = 0; tb < 4; ++tb)
#pragma unroll
            for (int js = 0; js < 2; ++js) { const bf16x8 af = *(const LAS bf16x8*)(lds + OFF_AM + ((16 * tb + n) * KP + 32 * js + 8 * g) * 2);
                oacc[tb] = __builtin_amdgcn_mfma_f32_16x16x32_bf16(af, vf[js], oacc[tb], 0, 0, 0); }
#pragma unroll
        for (int kb = 0; kb < 8; ++kb) { const f32x4 dl = *(const LAS f32x4*)(lds + OFF_DL + (16 * kb + 4 * g) * 4); sacc[kb] = sacc[kb] * dl;
#pragma unroll
            for (int js = 0; js < 2; ++js) { const bf16x8 af = *(const LAS bf16x8*)(lds + OFF_KDT + ((16 * kb + n) * KP + 32 * js + 8 * g) * 2);
                sacc[kb] = __builtin_amdgcn_mfma_f32_16x16x32_bf16(af, vf[js], sacc[kb], 0, 0, 0); } }
#pragma unroll
        for (int tb = 0; tb < 4; ++tb)
#pragma unroll
            for (int i = 0; i < 4; ++i) *(LAS float*)(lds + OFF_OX + ((16 * tb + 4 * g + i) * OP + 16 * w + n) * 4) = oacc[tb][i];
        asm volatile("s_waitcnt lgkmcnt(0)" ::: "memory"); __syncthreads();
        { f32x4 ov[4];
#pragma unroll
          for (int q4 = 0; q4 < 4; ++q4) ov[q4] = *(const LAS f32x4*)(lds + OFF_OX + (vrow * OP + 16 * vg + 4 * q4) * 4);
          float ss = 0.f;
#pragma unroll
          for (int q4 = 0; q4 < 4; ++q4) ss += (ov[q4][0] * ov[q4][0] + ov[q4][1] * ov[q4][1]) + (ov[q4][2] * ov[q4][2] + ov[q4][3] * ov[q4][3]);
          ss += __shfl_xor(ss, 1); ss += __shfl_xor(ss, 2); ss += __shfl_xor(ss, 4);
          const float rs = rsqrtf(ss * (1.f / HGD) + EPS);
          const unsigned gw_[8] = {gcur0.x, gcur0.y, gcur0.z, gcur0.w, gcur1.x, gcur1.y, gcur1.z, gcur1.w};
          u32x4 o0, o1; unsigned ow[8];
#pragma unroll
          for (int e2 = 0; e2 < 8; ++e2) { const float x0 = ov[e2 >> 1][(e2 & 1) * 2], x1 = ov[e2 >> 1][(e2 & 1) * 2 + 1];
              const f32x2 go = ghg[e2]; ow[e2] = cvtpk(x0 * rs * go.x * bf_lo(gw_[e2]), x1 * rs * go.y * bf_hi(gw_[e2])); }
          o0.x = ow[0]; o0.y = ow[1]; o0.z = ow[2]; o0.w = ow[3]; o1.x = ow[4]; o1.y = ow[5]; o1.z = ow[6]; o1.w = ow[7];
          if (vrow < nrow) { bf16_t* mp = (bf16_t*)(ws + WS_MIX) + (row_base + (size_t)c * 64 + vrow) * D + 2048 + h * HGD + 16 * vg; *(u32x4*)mp = o0; *(u32x4*)(mp + 8) = o1; } }
    }
#undef HG_LOAD
#pragma unroll
    for (int kb = 0; kb < 8; ++kb)
#pragma unroll
        for (int i = 0; i < 4; ++i) sout[(size_t)(16 * kb + 4 * g + i) * HGD + 16 * w + n] = sacc[kb][i];
    __syncthreads();
}
}

DI int q_next(const Frame& F, unsigned* head) {
    volatile LAS unsigned* MISC = (volatile LAS unsigned*)(F.lds + MISC_OFF);
    if ((F.wave * 64 + lane_id()) == 0) MISC[16] = __hip_atomic_fetch_add(head, 1u, RLX_AGENT);
    __syncthreads();
    const int v = (int)MISC[16];
    __syncthreads();
    return v;
}

struct EpiS1 {
    unsigned char* ws; float* Sb; int adj; float sc;
    DI void operator()(ACC_T, const pg8::Unit& u, int wr, int wc, int fr, int fq, int lane) const {
        const int c8 = wc * 32 + 8 * fq, pn17 = u.pn + (adj ? u.pm : 0), ktile = pn17 - 17 * u.pm;
        const float* ssk = (const float*)(ws + WS_SSK) + (size_t)fr * ((size_t)SB * KPAD) + (size_t)pn17 * 256 + c8;
        const bf16_t* kb = (const bf16_t*)(ws + WS_KCAT) + ((size_t)pn17 * 256 + wc * 32 + 8 * (fr >> 2) + (fr & 3)) * KC + KVL + 8 * fq;
        const bf16_t* qb = (const bf16_t*)(ws + WS_QCAT) + ((size_t)u.pm * 256 + wr * 64 + fr) * KC + KVL + 8 * fq;
        bf16_t* S = (bf16_t*)Sb + ((size_t)u.pm * 256 + wr * 64 + fr) * SPITCH + ktile * 256 + c8;
#pragma unroll
        for (int bj = 0; bj < 2; ++bj) {
            if (bj == 1 && ktile == 16) break;
            bf16x8 kf[2][2]; f32x4 rk[2];
#pragma unroll
            for (int n = 0; n < 2; ++n) { const f32x4 sv = *(const f32x4*)(ssk + bj * 128 + 4 * n);
#pragma unroll
                for (int e = 0; e < 4; ++e) rk[n][e] = rsqrtf(sv[e] * (1.f / NOPE) + EPS) * sc;
#pragma unroll
                for (int ks = 0; ks < 2; ++ks) kf[n][ks] = *(const bf16x8*)(kb + (size_t)(bj * 128 + 4 * n) * KC + 32 * ks); }
#pragma unroll
            for (int ai = 0; ai < 2; ++ai)
#pragma unroll
                for (int m = 0; m < 4; ++m) { const bf16_t* qp = qb + (size_t)(ai * 128 + m * 16) * KC; const bf16x8 q0 = *(const bf16x8*)qp, q1 = *(const bf16x8*)(qp + 32);
                    f32x4 t0 = acc[ai][bj][m][0] * rk[0], t1 = acc[ai][bj][m][1] * rk[1];
                    t0 = __builtin_amdgcn_mfma_f32_16x16x32_bf16(kf[0][0], q0, t0, 0, 0, 0); t0 = __builtin_amdgcn_mfma_f32_16x16x32_bf16(kf[0][1], q1, t0, 0, 0, 0);
                    t1 = __builtin_amdgcn_mfma_f32_16x16x32_bf16(kf[1][0], q0, t1, 0, 0, 0); t1 = __builtin_amdgcn_mfma_f32_16x16x32_bf16(kf[1][1], q1, t1, 0, 0, 0);
                    st_bf16x8(S + (size_t)(ai * 128 + m * 16) * SPITCH + bj * 128, t0 * ATT_SCALE, t1 * ATT_SCALE); }
        }
    }
};
struct EpiPV {
    unsigned char* ws;
    DI void operator()(ACC_T, const pg8::Unit& u, int wr, int wc, int fr, int fq, int lane) const {
        float* O = (float*)(ws + WS_OLAT) + ((size_t)u.pm * 256 + wr * 64 + fr) * KVL + (u.pn & 1) * 256 + wc * 32 + 8 * fq;
#pragma unroll
        for (int ai = 0; ai < 2; ++ai)
#pragma unroll
            for (int m = 0; m < 4; ++m)
#pragma unroll
                for (int bj = 0; bj < 2; ++bj) st_f32x8(O + (size_t)(ai * 128 + m * 16) * KVL + bj * 128, acc[ai][bj][m][0], acc[ai][bj][m][1]);
    }
};
#define CHAIN_SYNC() do { asm volatile("s_waitcnt vmcnt(0) lgkmcnt(0)" ::: "memory"); __syncthreads(); __builtin_amdgcn_fence(__ATOMIC_ACQUIRE, "agent"); asm volatile("s_waitcnt vmcnt(0)" ::: "memory"); __syncthreads(); } while (0)
DI void sample_chain(const Frame& F, const Args& a, int b) {
    unsigned char* ws = a.ws;
    { pg8::Gemm g{(const bf16_t*)(ws + WS_QCAT), (const bf16_t*)(ws + WS_KCAT), KC, KC, KVL, nullptr}; pg8::OneBatchOrder S{b, 17, KVL / 64, 16}; EpiS1 E{ws, (float*)((unsigned char*)a.out + OS_S), 0, 1.f}; pg8::gemm_phase(F.lds, g, S, E, F.wave); }
    CHAIN_SYNC();
    { const int lane = lane_id();
      for (int r = F.wave; r < 256; r += 16) {
        const bf16_t* s0 = (const bf16_t*)((const unsigned char*)a.out + OS_S) + (size_t)(b * 256 + r) * SPITCH; const bf16_t* s1 = s0 + (size_t)8 * SPITCH;
        bf16_t* p0 = (bf16_t*)(ws + WS_P) + (size_t)(b * 256 + r) * KT; bf16_t* p1 = p0 + (size_t)8 * KT;
        f32x4 v0[17], v1[17]; float m0 = -1e30f, m1 = -1e30f;
#pragma unroll
        for (int j = 0; j < 17; ++j) { const int idx = 4 * lane + 256 * j; if (idx < NKEY) { const u32x2 a0 = *(const u32x2*)(s0 + idx), a1 = *(const u32x2*)(s1 + idx); v0[j] = (f32x4){bf_lo(a0.x), bf_hi(a0.x), bf_lo(a0.y), bf_hi(a0.y)}; v1[j] = (f32x4){bf_lo(a1.x), bf_hi(a1.x), bf_lo(a1.y), bf_hi(a1.y)}; } else { v0[j] = (f32x4){-1e30f, -1e30f, -1e30f, -1e30f}; v1[j] = v0[j]; } }
#pragma unroll
        for (int j = 0; j < 17; ++j) { m0 = fmaxf(m0, fmaxf(fmaxf(v0[j][0], v0[j][1]), fmaxf(v0[j][2], v0[j][3]))); m1 = fmaxf(m1, fmaxf(fmaxf(v1[j][0], v1[j][1]), fmaxf(v1[j][2], v1[j][3]))); }
#pragma unroll
        for (int o = 1; o < 64; o <<= 1) { m0 = fmaxf(m0, __shfl_xor(m0, o)); m1 = fmaxf(m1, __shfl_xor(m1, o)); }
        float sum0 = 0.f, sum1 = 0.f;
#pragma unroll
        for (int j = 0; j < 17; ++j) { const bool ok = 4 * lane + 256 * j < NKEY;
#pragma unroll
            for (int e = 0; e < 4; ++e) { const float e0 = ok ? __expf(v0[j][e] - m0) : 0.f, e1 = ok ? __expf(v1[j][e] - m1) : 0.f; v0[j][e] = e0; v1[j][e] = e1; sum0 += e0; sum1 += e1; } }
#pragma unroll
        for (int o = 1; o < 64; o <<= 1) { sum0 += __shfl_xor(sum0, o); sum1 += __shfl_xor(sum1, o); }
        const float i0 = 1.0f / sum0, i1 = 1.0f / sum1;
#pragma unroll
        for (int j = 0; j < 17; ++j) { const int idx = 4 * lane + 256 * j; if (idx < KT) { u32x2 o; o.x = cvtpk(v0[j][0] * i0, v0[j][1] * i0); o.y = cvtpk(v0[j][2] * i0, v0[j][3] * i0); *(u32x2*)(p0 + idx) = o;
                                                                                 u32x2 q; q.x = cvtpk(v1[j][0] * i1, v1[j][1] * i1); q.y = cvtpk(v1[j][2] * i1, v1[j][3] * i1); *(u32x2*)(p1 + idx) = q; } } } }
    CHAIN_SYNC();
    { pg8::Gemm g{(const bf16_t*)(ws + WS_P), (const bf16_t*)(ws + WS_CKVT), KT, KT, KT, nullptr}; pg8::OneBatchOrder S{b, 2, KT / 64}; EpiPV E{ws}; pg8::gemm_phase(F.lds, g, S, E, F.wave); }
    CHAIN_SYNC();
    {
      const int lane = lane_id(), n = lane & 15, g = lane >> 4;
#pragma unroll 1
      for (int hh = 0; hh < 2; ++hh) { const int h = 2 * F.wave + hh;
        const float* ap = (const float*)(ws + WS_OLAT) + ((size_t)b * 256 + n * 16 + h) * KVL + 8 * g;
        const bf16_t* bp = (const bf16_t*)(ws + WS_WUKVT) + (size_t)(2048 + h * 128 + n) * KVL + 8 * g;
        f32x4 oacc[8];
#pragma unroll
        for (int db = 0; db < 8; ++db) oacc[db] = (f32x4){0.f, 0.f, 0.f, 0.f};
        for (int ks = 0; ks < KVL / 32; ++ks) { const bf16x8 af = __builtin_bit_cast(bf16x8, pack8(*(const f32x4*)(ap + 32 * ks), *(const f32x4*)(ap + 32 * ks + 4)));
#pragma unroll
            for (int db = 0; db < 8; ++db) oacc[db] = __builtin_amdgcn_mfma_f32_16x16x32_bf16(af, *(const bf16x8*)(bp + (size_t)(16 * db) * KVL + 32 * ks), oacc[db], 0, 0, 0); }
#pragma unroll
        for (int db = 0; db < 8; ++db)
#pragma unroll
            for (int i = 0; i < 4; ++i) ((bf16_t*)(ws + WS_MIX))[((size_t)MP + b * 16 + 4 * g + i) * D + h * 128 + 16 * db + n] = f2bf(oacc[db][i]); } }
    __syncthreads();
}

constexpr int MX_HG = 64 + SB * HGH, MX_ATT = 1024, MX_S = SB * 34;
DI void p5_mixer(const Frame& F, const Args& a) {
    unsigned char* ws = a.ws; unsigned* head = (unsigned*)(ws + WS_CTL) + CW_QUEUE;
    for (;;) { const int u = q_next(F, head + 192); if (u >= SB) break; sample_chain(F, a, u); }
#ifndef MX_OFF_HG
    for (;;) { const int u = q_next(F, head); if (u >= MX_HG) break;
        const bool smp = u >= 64; const int v = smp ? u - 64 : u; hg::hgrn_unit(a, smp, v >> 4, v & 15, (LAS char*)F.lds, F.wave); }
#endif
#ifndef MX_OFF_ATT
    for (;;) { const int u = q_next(F, head + 64); if (u >= MX_ATT) break;
        const int qb = 15 - (u >> 6), bh = u & 63;
        att::attn_unit(bh >> 4, bh & 15, qb, ws + WS_Q, ws + WS_KN, ws + WS_KRN, (const bf16_t*)(ws + WS_V), (bf16_t*)(ws + WS_MIX), (LAS char*)F.lds, F.wave); }
#endif
}

DI void p6_late_weights(const Frame& F, const Args& a) {
    unsigned char* ws = a.ws; LAS float* scr = (LAS float*)(F.lds + F.wave * 16384);
    constexpr int I_O = (D / 64) * (D / 32), I_UP = (D / 64) * (FF2 / 32), I_DN = (FF / 64) * (D / 32), NIT = 2 * I_O + I_UP + I_DN;
    for (int it = F.gw; it < NIT; it += F.NGW) { int r = it;
        if (tr_matrix(r, a.in[I_WO], D, D, (bf16_t*)(ws + WS_WOT), D, nullptr, scr, lane_id())) continue;
        if (tr_matrix(r, a.in[I_WUP], D, FF2, (bf16_t*)(ws + WS_WUPT), D, a.in[I_GFFN], scr, lane_id(), 1 << 30, 0, true)) continue;
        if (tr_matrix(r, a.in[I_WD], FF, D, (bf16_t*)(ws + WS_WDT), FF, nullptr, scr, lane_id())) continue;
        tr_matrix(r, a.in[I_WPG], D, D, nullptr, D, a.in[I_GPLE], scr, lane_id(), 1 << 30, 0, false, false, ws + WS_WG8, SC8_G); }
}
struct EpiWo {
    unsigned char* ws; const bf16_t* xb; int s0 = 0, s1 = 8;
    DI void operator()(ACC_T, const pg8::Unit& u, int wr, int wc, int fr, int fq, int lane) const {
        const int row0 = u.pm * 256 + wr * 64 + fr, c8 = wc * 32 + 8 * fq;
#pragma unroll
        for (int ai = 0; ai < 2; ++ai)
#pragma unroll
            for (int m = 0; m < 4; ++m) { if (ai * 4 + m < s0 || ai * 4 + m >= s1) continue; const int row = row0 + ai * 128 + m * 16; const bf16_t* xr = xb + (size_t)row * D; float ss = 0.f;
#pragma unroll
                for (int bj = 0; bj < 2; ++bj) { const int col = u.pn * 256 + bj * 128 + c8; const u32x4 xw = *(const u32x4*)(xr + col); const f32x4 v0 = acc[ai][bj][m][0] + (f32x4){bf_lo(xw.x), bf_hi(xw.x), bf_lo(xw.y), bf_hi(xw.y)}, v1 = acc[ai][bj][m][1] + (f32x4){bf_lo(xw.z), bf_hi(xw.z), bf_lo(xw.w), bf_hi(xw.w)};
                    st_bf16x8((bf16_t*)(ws + WS_X1B) + (size_t)row * D + col, v0, v1); ss += dot8(v0, v1); }
                ss += __shfl_xor(ss, 16); ss += __shfl_xor(ss, 32);
                if (fq == 0) unsafeAtomicAdd((float*)(ws + OFF_SSQ2) + row, ss); }
    }
};
DI float dpp_ror1(float v) { return __int_as_float(__builtin_amdgcn_mov_dpp(__float_as_int(v), 0x121, 0xf, 0xf, false)); }
DI float dpp_ror2(float v) { return __int_as_float(__builtin_amdgcn_mov_dpp(__float_as_int(v), 0x122, 0xf, 0xf, false)); }
struct EpiUp {
    unsigned char* ws; float* out; const float* cw; const float* cb; LAS unsigned char* lds; int s0 = 0, s1 = 8;
    DI void operator()(ACC_T, const pg8::Unit& u, int wr, int wc, int fr, int fq, int lane) const {
        const float* ssq = (const float*)(ws + OFF_SSQ2);
        const int row0 = u.pm * 256 + wr * 64 + fr, ch0 = u.pn * 128 + wc * 32 + 8 * fq;
        if (u.pm >= MP / 256) {
#pragma unroll
            for (int ai = 0; ai < 2; ++ai)
#pragma unroll
                for (int m = 0; m < 4; ++m) { if (ai * 4 + m < s0 || ai * 4 + m >= s1) continue; const int row = row0 + ai * 128 + m * 16; const float rs = rsqrtf(ssq[row] * (1.f / D) + EPS);
                    float* cv = nullptr; { const int sr = row - MP, t = sr & 15; if (t >= ST - 2) cv = out + O_CVS + ((size_t)(sr >> 4) * 2 + (t - (ST - 2))) * FF2; }
#pragma unroll
                    for (int bj = 0; bj < 2; ++bj) { const int col = bj * FF + ch0; const f32x4 v0 = acc[ai][bj][m][0] * rs, v1 = acc[ai][bj][m][1] * rs;
                        st_bf16x8((bf16_t*)(ws + WS_U) + (size_t)row * FF2 + col, v0, v1); if (cv) st_f32x8(cv + col, v0, v1); } }
            return;
        }
        LAS float* halo = (LAS float*)(lds + XCH_OFF);
        float rsv[2][4];
        rsv[0][0] = rsqrtf(ssq[row0] * (1.f / D) + EPS); rsv[0][3] = rsqrtf(ssq[row0 + 48] * (1.f / D) + EPS); rsv[1][3] = rsqrtf(ssq[row0 + 128 + 48] * (1.f / D) + EPS);
        if (wc == 0 && fq == 0) { LAS float* rw = (LAS float*)(lds + XCH_OFF + 8192) + (wr * 16 + fr) * 8;
#pragma unroll
            for (int sl = 0; sl < 8; ++sl) rw[sl] = rsqrtf(ssq[row0 + (sl >> 2) * 128 + (sl & 3) * 16] * (1.f / D) + EPS); }
#pragma unroll
        for (int ai = 0; ai < 2; ++ai) {
            if (fr >= 14) { LAS float* hp = halo + ((((2 * ai + wr) * 4 + wc) * 2 + (fr - 14)) * 4 + fq) * 16;
#pragma unroll
                for (int bj = 0; bj < 2; ++bj) { *(LAS f32x4*)(hp + bj * 8) = acc[ai][bj][3][0] * rsv[ai][3]; *(LAS f32x4*)(hp + bj * 8 + 4) = acc[ai][bj][3][1] * rsv[ai][3]; } } }
        { float* uh = (float*)(ws + WS_UH) + (size_t)u.pm * 4 * FF2;
          if (wr == 0 && fr < 2) {
#pragma unroll
              for (int bj = 0; bj < 2; ++bj) st_f32x8(uh + (size_t)fr * FF2 + bj * FF + ch0, acc[0][bj][0][0] * rsv[0][0], acc[0][bj][0][1] * rsv[0][0]); }
          if (wr == 1 && fr >= 14) { float* cv = ((u.pm & 15) == 15) ? out + O_CVP + ((size_t)(u.pm >> 4) * 2 + (fr - 14)) * FF2 : nullptr;
#pragma unroll
              for (int bj = 0; bj < 2; ++bj) { const f32x4 v0 = acc[1][bj][3][0] * rsv[1][3], v1 = acc[1][bj][3][1] * rsv[1][3];
                  st_f32x8(uh + (size_t)(2 + fr - 14) * FF2 + bj * FF + ch0, v0, v1); if (cv) st_f32x8(cv + bj * FF + ch0, v0, v1); } } }
        asm volatile("s_waitcnt lgkmcnt(0)" ::: "memory"); __builtin_amdgcn_s_barrier(); asm volatile("" ::: "memory");
        bf16_t* actp = (bf16_t*)(ws + WS_ACT) + (size_t)row0 * FF + ch0;
        const bool f1 = fr >= 1, f2 = fr >= 2, e1 = fr == 1;
#pragma unroll
        for (int n = 0; n < 2; ++n) {
            f32x4 w0[2], w1[2], w2[2], bb[2];
#pragma unroll
            for (int s = 0; s < 2; ++s) { const int col = s * FF + ch0 + 4 * n; w0[s] = *(const f32x4*)(cw + col); w1[s] = *(const f32x4*)(cw + FF2 + col); w2[s] = *(const f32x4*)(cw + 2 * FF2 + col); bb[s] = *(const f32x4*)(cb + col); }
#pragma unroll
            for (int ai = 0; ai < 2; ++ai) {
                const int gi = 2 * ai + wr;
                f32x4 q1[2], q2[2];
#pragma unroll
                for (int m = 0; m < 4; ++m) {
                    int ro_ = (wr * 16 + fr) * 32 + XCH_OFF + 8192; asm volatile("" : "+v"(ro_)); const float rsl = *(const LAS float*)(lds + ro_ + (ai * 4 + m) * 4);
                    f32x4 c[2];
#pragma unroll
                    for (int s = 0; s < 2; ++s) {
                        const f32x4 cur = acc[ai][s][m][n] * rsl;
                        f32x4 r1, r2;
#pragma unroll
                        for (int e = 0; e < 4; ++e) { r1[e] = dpp_ror1(cur[e]); r2[e] = dpp_ror2(cur[e]); }
                        if (m == 0) { f32x4 h0 = {0.f, 0.f, 0.f, 0.f}, h1 = h0;
                            if (gi > 0) { const LAS float* hp = halo + ((((gi - 1) * 4 + wc) * 2) * 4 + fq) * 16 + s * 8 + 4 * n; h0 = *(const LAS f32x4*)hp; h1 = *(const LAS f32x4*)(hp + 64); }
#pragma unroll
                            for (int e = 0; e < 4; ++e) { const float p1 = f1 ? r1[e] : h1[e], p2 = f2 ? r2[e] : (e1 ? h1[e] : h0[e]); c[s][e] = bb[s][e] + w0[s][e] * p2 + w1[s][e] * p1 + w2[s][e] * cur[e]; }
                        } else {
#pragma unroll
                            for (int e = 0; e < 4; ++e) { const float p1 = f1 ? r1[e] : q1[s][e], p2 = f2 ? r2[e] : q2[s][e]; c[s][e] = bb[s][e] + w0[s][e] * p2 + w1[s][e] * p1 + w2[s][e] * cur[e]; }
                        }
                        q1[s] = r1; q2[s] = r2;
                    }
                    if (!(gi == 0 && m == 0 && fr < 2)) {
                        float o[4];
#pragma unroll
                        for (int e = 0; e < 4; ++e) o[e] = c[0][e] * __builtin_amdgcn_rcpf(1.0f + __expf(-c[0][e])) * c[1][e];
                        u32x2 ov; ov.x = cvtpk(o[0], o[1]); ov.y = cvtpk(o[2], o[3]);
                        *(u32x2*)(actp + (size_t)(ai * 128 + m * 16) * FF + 4 * n) = ov; }
                }
            }
        }
        asm volatile("s_waitcnt lgkmcnt(0)" ::: "memory"); __builtin_amdgcn_s_barrier(); asm volatile("" ::: "memory");
    }
};
struct EpiUpFin {
    unsigned char* ws; float* out; const float* cw; const float* cb; const float* scv; int s0 = 0, s1 = 8;
    DI void operator()(ACC_T, const pg8::Unit& u, int wr, int wc, int fr, int fq, int lane) const {
        const float* ssq = (const float*)(ws + OFF_SSQ2);
        const int row0 = u.pm * 256 + wr * 64 + fr, ch0 = u.pn * 128 + wc * 32 + 8 * fq;
#pragma unroll
        for (int n = 0; n < 2; ++n) {
            f32x4 w0[2], w1[2], w2[2], bb[2];
#pragma unroll
            for (int s = 0; s < 2; ++s) { const int col = s * FF + ch0 + 4 * n; w0[s] = *(const f32x4*)(cw + col); w1[s] = *(const f32x4*)(cw + FF2 + col); w2[s] = *(const f32x4*)(cw + 2 * FF2 + col); bb[s] = *(const f32x4*)(cb + col); }
#pragma unroll
            for (int ai = 0; ai < 2; ++ai)
#pragma unroll
                for (int m = 0; m < 4; ++m) { if (ai * 4 + m < s0 || ai * 4 + m >= s1) continue;
                    const int row = row0 + ai * 128 + m * 16, sq = (row - MP) >> 4; const float rs = rsqrtf(ssq[row] * (1.f / D) + EPS);
                    f32x4 c[2];
#pragma unroll
                    for (int s = 0; s < 2; ++s) { const int col = s * FF + ch0 + 4 * n;
                        const f32x4 cur = acc[ai][s][m][n] * rs, h2 = *(const f32x4*)(scv + (size_t)(sq * 2) * FF2 + col), h1 = *(const f32x4*)(scv + (size_t)(sq * 2 + 1) * FF2 + col);
#pragma unroll
                        for (int e = 0; e < 4; ++e) { const float r1 = dpp_ror1(cur[e]), r2 = dpp_ror2(cur[e]); const float p1 = fr >= 1 ? r1 : h1[e], p2 = fr >= 2 ? r2 : (fr == 1 ? h1[e] : h2[e]);
                            c[s][e] = bb[s][e] + w0[s][e] * p2 + w1[s][e] * p1 + w2[s][e] * cur[e]; }
                        if (fr >= ST - 2) *(f32x4*)(out + O_CVS + ((size_t)sq * 2 + (fr - (ST - 2))) * FF2 + col) = cur; }
                    float o[4];
#pragma unroll
                    for (int e = 0; e < 4; ++e) o[e] = c[0][e] * __builtin_amdgcn_rcpf(1.0f + __expf(-c[0][e])) * c[1][e];
                    u32x2 ov; ov.x = cvtpk(o[0], o[1]); ov.y = cvtpk(o[2], o[3]);
                    *(u32x2*)((bf16_t*)(ws + WS_ACT) + (size_t)row * FF + ch0 + 4 * n) = ov; }
        }
    }
};
struct EpiDown {
    unsigned char* ws; float* out; int s0 = 0, s1 = 8;
    DI void operator()(ACC_T, const pg8::Unit& u, int wr, int wc, int fr, int fq, int lane) const {
        const int row0 = u.pm * 256 + wr * 64 + fr, c8 = wc * 32 + 8 * fq;
#pragma unroll
        for (int ai = 0; ai < 2; ++ai)
#pragma unroll
            for (int m = 0; m < 4; ++m) { if (ai * 4 + m < s0 || ai * 4 + m >= s1) continue; const int row = row0 + ai * 128 + m * 16; float ss = 0.f;
#pragma unroll
                for (int bj = 0; bj < 2; ++bj) { const int col = u.pn * 256 + bj * 128 + c8; bf16_t* xp_ = (bf16_t*)(ws + WS_X1B) + (size_t)row * D + col; const u32x4 xw = *(const u32x4*)xp_;
                    const f32x4 v0 = acc[ai][bj][m][0] + (f32x4){bf_lo(xw.x), bf_hi(xw.x), bf_lo(xw.y), bf_hi(xw.y)}, v1 = acc[ai][bj][m][1] + (f32x4){bf_lo(xw.z), bf_hi(xw.z), bf_lo(xw.w), bf_hi(xw.w)};
                    st_bf16x8(xp_, v0, v1); ss += dot8(v0, v1);
                    { u32x2 o8; o8.x = pk4_fp8(v0[0] * SC8_X, v0[1] * SC8_X, v0[2] * SC8_X, v0[3] * SC8_X); o8.y = pk4_fp8(v1[0] * SC8_X, v1[1] * SC8_X, v1[2] * SC8_X, v1[3] * SC8_X); *(u32x2*)(ws + WS_X2F8 + (size_t)row * D + col) = o8; } }
                ss += __shfl_xor(ss, 16); ss += __shfl_xor(ss, 32);
                if (fq == 0) unsafeAtomicAdd((float*)(ws + OFF_SSQ3) + row, ss); }
    }
};
struct EpiPle {
    unsigned char* ws;
    DI void operator()(ACC_T, const pg8::Unit& u, int wr, int wc, int fr, int fq, int lane) const {
        const int row0 = u.pm * 256 + wr * 64 + fr, c8 = wc * 32 + 8 * fq;
#pragma unroll
        for (int ai = 0; ai < 2; ++ai)
#pragma unroll
            for (int m = 0; m < 4; ++m)
#pragma unroll
                for (int bj = 0; bj < 2; ++bj) st_bf16x8((bf16_t*)(ws + WS_PW) + (size_t)(row0 + ai * 128 + m * 16) * D + u.pn * 256 + bj * 128 + c8, acc[ai][bj][m][0], acc[ai][bj][m][1]);
    }
};
struct EpiGate {
    unsigned char* ws; float* out; int s0 = 0, s1 = 8;
    DI void operator()(ACC_T, const pg8::Unit& u, int wr, int wc, int fr, int fq, int lane) const {
        const float* ssq = (const float*)(ws + OFF_SSQ3);
        const int row0 = u.pm * 256 + wr * 64 + fr, c8 = wc * 32 + 8 * fq;
#pragma unroll
        for (int ai = 0; ai < 2; ++ai)
#pragma unroll
            for (int m = 0; m < 4; ++m) { if (ai * 4 + m < s0 || ai * 4 + m >= s1) continue; const int row = row0 + ai * 128 + m * 16; const float rs = rsqrtf(ssq[row] * (1.f / D) + EPS) * (1.f / (SC8_X * SC8_G));
#pragma unroll
                for (int bj = 0; bj < 2; ++bj) { const int col = u.pn * 256 + bj * 128 + c8; float* op = out + (size_t)row * D + col;
                    const u32x4 pw = *(const u32x4*)((const bf16_t*)(ws + WS_PW) + (size_t)row * D + col);
                    const u32x4 xw = *(const u32x4*)((const bf16_t*)(ws + WS_X1B) + (size_t)row * D + col); const f32x4 x0 = {bf_lo(xw.x), bf_hi(xw.x), bf_lo(xw.y), bf_hi(xw.y)}, x1 = {bf_lo(xw.z), bf_hi(xw.z), bf_lo(xw.w), bf_hi(xw.w)}; f32x4 v0, v1;
                    const float pwf[8] = {bf_lo(pw.x), bf_hi(pw.x), bf_lo(pw.y), bf_hi(pw.y), bf_lo(pw.z), bf_hi(pw.z), bf_lo(pw.w), bf_hi(pw.w)};
#pragma unroll
                    for (int e = 0; e < 4; ++e) { v0[e] = x0[e] + pwf[e] * sigmoidf_(acc[ai][bj][m][0][e] * rs); v1[e] = x1[e] + pwf[4 + e] * sigmoidf_(acc[ai][bj][m][1][e] * rs); }
                    st_f32x8(op, v0, v1); } }
    }
};
DI void p11_conv(const Frame& F, const Args& a, int lo_r) {
    unsigned char* ws = a.ws; const int lane = lane_id();
    const bf16_t* U = (const bf16_t*)(ws + WS_U); bf16_t* ACTp = (bf16_t*)(ws + WS_ACT);
    constexpr int NCG = FF / 8;
    constexpr int NRC = MS / 16;
    const int ncw = (NCG + 63) / 64;
    for (int it = F.gw; it < NRC * ncw; it += F.NGW) {
        const int rc = it / ncw, cg = (it % ncw) * 64 + lane; if (cg >= NCG) continue;
        const int col = cg * 8, row0 = MP + rc * 16;
        if (2 * (col >> 7) + (rc >> 4) >= lo_r) continue;
        float w[3][2][8], bsv[2][8];
#pragma unroll
        for (int j = 0; j < 3; ++j)
#pragma unroll
            for (int s = 0; s < 2; ++s) { const f32x4 x0 = *(const f32x4*)(a.in[I_CW] + (size_t)j * FF2 + s * FF + col), x1 = *(const f32x4*)(a.in[I_CW] + (size_t)j * FF2 + s * FF + col + 4);
#pragma unroll
                for (int e = 0; e < 4; ++e) { w[j][s][e] = x0[e]; w[j][s][4 + e] = x1[e]; } }
#pragma unroll
        for (int s = 0; s < 2; ++s) { const f32x4 x0 = *(const f32x4*)(a.in[I_CB] + s * FF + col), x1 = *(const f32x4*)(a.in[I_CB] + s * FF + col + 4);
#pragma unroll
            for (int e = 0; e < 4; ++e) { bsv[s][e] = x0[e]; bsv[s][4 + e] = x1[e]; } }
        float h2[2][8], h1[2][8];
        const bool smp = row0 >= MP; const int tseq = smp ? ((row0 - MP) & 15) : (row0 & (SEQ - 1));
#pragma unroll
        for (int s = 0; s < 2; ++s) {
            if (tseq == 0) {
                if (smp) { const float* hs = a.in[I_SCV] + ((size_t)((row0 - MP) >> 4) * 2) * FF2 + s * FF + col;
                    const f32x4 a0 = *(const f32x4*)hs, a1 = *(const f32x4*)(hs + 4), b0 = *(const f32x4*)(hs + FF2), b1 = *(const f32x4*)(hs + FF2 + 4);
#pragma unroll
                    for (int e = 0; e < 4; ++e) { h2[s][e] = a0[e]; h2[s][4 + e] = a1[e]; h1[s][e] = b0[e]; h1[s][4 + e] = b1[e]; } }
                else {
#pragma unroll
                    for (int e = 0; e < 8; ++e) { h2[s][e] = 0.f; h1[s][e] = 0.f; } }
            } else { const u32x4 a_ = *(const u32x4*)(U + (size_t)(row0 - 2) * FF2 + s * FF + col), b_ = *(const u32x4*)(U + (size_t)(row0 - 1) * FF2 + s * FF + col);
                h2[s][0] = bf_lo(a_.x); h2[s][1] = bf_hi(a_.x); h2[s][2] = bf_lo(a_.y); h2[s][3] = bf_hi(a_.y); h2[s][4] = bf_lo(a_.z); h2[s][5] = bf_hi(a_.z); h2[s][6] = bf_lo(a_.w); h2[s][7] = bf_hi(a_.w);
                h1[s][0] = bf_lo(b_.x); h1[s][1] = bf_hi(b_.x); h1[s][2] = bf_lo(b_.y); h1[s][3] = bf_hi(b_.y); h1[s][4] = bf_lo(b_.z); h1[s][5] = bf_hi(b_.z); h1[s][6] = bf_lo(b_.w); h1[s][7] = bf_hi(b_.w); }
        }
#pragma unroll 4
        for (int t = 0; t < 16; ++t) { const size_t row = (size_t)row0 + t; float cur[2][8], c[2][8];
#pragma unroll
            for (int s = 0; s < 2; ++s) { const u32x4 u_ = *(const u32x4*)(U + row * FF2 + s * FF + col);
                cur[s][0] = bf_lo(u_.x); cur[s][1] = bf_hi(u_.x); cur[s][2] = bf_lo(u_.y); cur[s][3] = bf_hi(u_.y); cur[s][4] = bf_lo(u_.z); cur[s][5] = bf_hi(u_.z); cur[s][6] = bf_lo(u_.w); cur[s][7] = bf_hi(u_.w);
#pragma unroll
                for (int e = 0; e < 8; ++e) { c[s][e] = bsv[s][e] + w[0][s][e] * h2[s][e] + w[1][s][e] * h1[s][e] + w[2][s][e] * cur[s][e]; h2[s][e] = h1[s][e]; h1[s][e] = cur[s][e]; } }
            float o[8];
#pragma unroll
            for (int e = 0; e < 8; ++e) o[e] = c[0][e] / (1.0f + __expf(-c[0][e])) * c[1][e];
            u32x4 ov; ov.x = cvtpk(o[0], o[1]); ov.y = cvtpk(o[2], o[3]); ov.z = cvtpk(o[4], o[5]); ov.w = cvtpk(o[6], o[7]);
            *(u32x4*)(ACTp + row * FF + col) = ov; }
    }
    { const float* UH = (const float*)(ws + WS_UH);
      for (int it = (F.gw + F.NGW - NRC * ncw % F.NGW) % F.NGW; it < 64 * 2 * ncw; it += F.NGW) { const int pm = it / (2 * ncw), r = (it / ncw) & 1, cg = (it % ncw) * 64 + lane; if (cg >= NCG) continue; const int col = cg * 8;
          float c[2][8];
#pragma unroll
          for (int s = 0; s < 2; ++s) { const int cc = s * FF + col; const bool first = (pm & 15) == 0;
              const float* cur = UH + ((size_t)pm * 4 + r) * FF2 + cc; const float* p1 = r == 0 ? UH + ((size_t)(pm - 1) * 4 + 3) * FF2 + cc : UH + ((size_t)pm * 4 + 0) * FF2 + cc; const float* p2 = r == 0 ? UH + ((size_t)(pm - 1) * 4 + 2) * FF2 + cc : UH + ((size_t)(pm - 1) * 4 + 3) * FF2 + cc;
              const bool z1 = first && r == 0, z2 = first;
#pragma unroll
              for (int e = 0; e < 8; ++e) c[s][e] = a.in[I_CB][cc + e] + a.in[I_CW][cc + e] * (z2 ? 0.f : p2[e]) + a.in[I_CW][FF2 + cc + e] * (z1 ? 0.f : p1[e]) + a.in[I_CW][2 * FF2 + cc + e] * cur[e]; }
          float o[8];
#pragma unroll
          for (int e = 0; e < 8; ++e) o[e] = c[0][e] / (1.0f + __expf(-c[0][e])) * c[1][e];
          u32x4 ov; ov.x = cvtpk(o[0], o[1]); ov.y = cvtpk(o[2], o[3]); ov.z = cvtpk(o[4], o[5]); ov.w = cvtpk(o[6], o[7]);
          *(u32x4*)(ACTp + ((size_t)pm * 256 + r) * FF + col) = ov; } }

}
constexpr int LAST_PHASE = 15;

constexpr int NPHASE = 15;
#ifndef ALIGN_LIGHT
#define ALIGN_LIGHT true
#endif
__global__ void __launch_bounds__(512, 2) fwd(Args args) {
    extern __shared__ __attribute__((aligned(16))) unsigned char lds_raw[];
    Frame F;
    F.lds = (LAS unsigned char*)lds_raw;
    F.wave = __builtin_amdgcn_readfirstlane(threadIdx.x >> 6);
    F.G = gridDim.x; { const int bx = blockIdx.x; F.vcu = (F.G % 8 == 0) ? (bx % 8) * (F.G / 8) + bx / 8 : bx; }
    F.gw = F.vcu * 8 + F.wave; F.NGW = F.G * 8;
    volatile LAS unsigned* MISC = (volatile LAS unsigned*)(F.lds + MISC_OFF);
    if (F.wave == 0) { const int l0 = lane_id(); if (l0 < 32) MISC[l0] = 0u; }
    __syncthreads();
    unsigned char* ws = args.ws;
    unsigned* ctl = (unsigned*)(ws + WS_CTL);
    const int lo = args.ph_lo, hi = args.ph_hi;
    XcdBarrier bar; bar.bar = ctl + CW_BAR; bar.x = 0; bar.st = nullptr;
    if (hi - lo > 1) bar = xcd_barrier_post(ctl + CW_BAR, MISC + 8, F.wave == 0 && lane_id() == 0);
#define IN(k) (lo <= (k) && (k) < hi)
#ifndef PH_MASK
#define PH_MASK 0xffff
#endif
#define PH_EN(k) (((PH_MASK) >> (k)) & 1)
#define FIN_BAR() do { if (hi - lo > 1) xcd_barrier(bar, F.wave == 0 && lane_id() == 0); } while (0)
#ifdef STAMP
#define SEAM(k) do { if (IN(k) && IN((k) + 1)) xcd_barrier(bar, F.wave == 0 && lane_id() == 0); if (blockIdx.x == 0 && F.wave == 0 && lane_id() == 0) ((unsigned long long*)(ctl + 40960))[(k) + 1] = __builtin_amdgcn_s_memrealtime(); } while (0)
#else
#define SEAM(k) do { if (IN(k) && IN((k) + 1)) xcd_barrier(bar, F.wave == 0 && lane_id() == 0); } while (0)
#endif

#ifdef STAMP
    if (blockIdx.x == 0 && F.wave == 0 && lane_id() == 0) ((unsigned long long*)(ctl + 40960))[0] = __builtin_amdgcn_s_memrealtime();
#endif
    if (PH_EN(0) && IN(0)) { p0_prologue(F, args);
#ifdef ZERO_OUT
        zero16(args.out, (size_t)M * D * 4, F.gw, F.NGW, lane_id()); zero16(args.out + O_HGP, (size_t)(O_CKVS - O_HGP) * 4, F.gw, F.NGW, lane_id()); zero16(args.out + O_HGS, (size_t)(O_END - O_HGS) * 4, F.gw, F.NGW, lane_id());
#endif
    }
    SEAM(0);
    if (PH_EN(1) && IN(1)) {
        const pg8::Gemm gA{(const bf16_t*)((const unsigned char*)args.out + OS_XB), (const bf16_t*)(ws + WS_WINT) + (size_t)QL * D, D, D, D, (float*)(ws + WS_SLAB_EARLY)};
        const pg8::Gemm gB{(const bf16_t*)((const unsigned char*)args.out + OS_XB8), (const bf16_t*)((const unsigned char*)args.out + OS_WIN8), D / 2, D / 2, D / 2, (float*)(ws + WS_SLAB_EARLY) + (size_t)96 * 65536};
        pg8::SplitOrder SA; SA.init(M / 256, NIN / 256 - 4, F.G, (int)blockIdx.x, D); pg8::SplitOrder SBq; SBq.init(M / 256, 4, F.G, (int)blockIdx.x, D / 2);
        EpiInProj EA{ws, 4, 1.f}, EB{ws, 0, 1.f / (SC8_X0 * SC8_WI)};
        pg8::gemm_phase<ALIGN_LIGHT>(F.lds, gA, SA, EA, F.wave);
        pg8::gemm_phase<ALIGN_LIGHT, true>(F.lds, gB, SBq, EB, F.wave);
        { pg8::Gemm g{(const bf16_t*)(ws + WS_KC8), (const bf16_t*)(ws + WS_WUKV8), KVL / 2, KVL / 2, KVL / 2, nullptr};
          pg8::MappedOrder S; S.init(SB * 16, 8, F.G, (int)blockIdx.x, KVL / 2); S.per = 16; S.stride = 16; S.off = 0;
          EpiSumsq E{ws, 1.f / (SC8_K * SC8_K * SC8_W * SC8_W), 1}; pg8::gemm_phase<true, true>(F.lds, g, S, E, F.wave); }
        FIN_BAR();
        pg8::gemm_finalize(gA, SA, EA, F.wave, (int)blockIdx.x); pg8::gemm_finalize(gB, SBq, EB, F.wave, (int)blockIdx.x);
    }
    SEAM(1);
    if (PH_EN(2) && IN(2)) {
        p2_norm_rows(F, args);
        { pg8::Gemm g{(const bf16_t*)(ws + WS_CQ8), (const bf16_t*)(ws + WS_WUQ8), QL / 2, QL / 2, QL / 2, (float*)(ws + WS_SLAB_EARLY)}; pg8::SplitOrder S; S.rot = 2; S.init(M / 256, 3072 / 256, F.G, (int)blockIdx.x, QL / 2);
          EpiUq E{ws, args.in[I_GQN], args.in[I_GQR], F.lds, 1.f / (SC8_K * SC8_Q)}; pg8::gemm_phase<true, true>(F.lds, g, S, E, F.wave); FIN_BAR(); pg8::gemm_finalize(g, S, E, F.wave, (int)blockIdx.x); }
        for (int u = F.G - 1 - (int)blockIdx.x; u < 128; u += F.G) p4_qa_unit(F, args, u);
    }
    SEAM(2);
    if (PH_EN(3) && IN(3)) {
        { pg8::Gemm g{(const bf16_t*)(ws + WS_CKVN8), (const bf16_t*)(ws + WS_WUKV8), KVL / 2, KVL / 2, KVL / 2, nullptr}; pg8::StaticOrder S; S.init(MP / 256, 16, F.G, (int)blockIdx.x, KVL / 2);
          EpiKup E{ws, args.in[I_GKN], F.lds, 1.f / (SC8_K * SC8_W)}; pg8::gemm_phase<true, true>(F.lds, g, S, E, F.wave); }
        { pg8::Gemm g{(const bf16_t*)(ws + WS_KCAT), (const bf16_t*)(ws + WS_WUKVT), KC, KVL, KVL, nullptr}; pg8::MappedOrder S; S.init(SB, 8, F.G, (int)blockIdx.x, KVL); S.per = 1; S.stride = 17; S.off = 16;
          EpiSumsq E{ws, 1.f, 0}; pg8::gemm_phase(F.lds, g, S, E, F.wave); }
        { pg8::Gemm g{(const bf16_t*)(ws + WS_QCAT8), (const bf16_t*)(ws + WS_KC8), KVL / 2, KVL / 2, KVL / 2, nullptr}; pg8::BatchOrder S{SB * 16, F.G, (int)blockIdx.x, 16, 2, 0, KVL / 128};
          EpiS1 E{ws, (float*)((unsigned char*)args.out + OS_S), 1, 1.f / (SC8_QA * SC8_K)}; pg8::gemm_phase<true, true>(F.lds, g, S, E, F.wave); }
    }
    SEAM(3);
    if (PH_EN(5) && IN(5)) { p5_mixer(F, args); }
    SEAM(5);
    if (PH_EN(6) && IN(6)) { p6_late_weights(F, args); }
    SEAM(6);
    if (PH_EN(10) && IN(10)) { pg8::Gemm g{(const bf16_t*)(ws + WS_MIX), (const bf16_t*)(ws + WS_WOT), D, D, D, (float*)(ws + WS_SLAB_LATE)}; pg8::SplitOrder S; S.init(M / 256, D / 256, F.G, (int)blockIdx.x, D);
        EpiWo E{ws, (const bf16_t*)((const unsigned char*)args.out + OS_XB)}; pg8::gemm_phase<ALIGN_LIGHT>(F.lds, g, S, E, F.wave); FIN_BAR(); pg8::gemm_finalize(g, S, E, F.wave, (int)blockIdx.x); }
    SEAM(10);
    if (PH_EN(11) && IN(11)) { pg8::Gemm g{(const bf16_t*)(ws + WS_X1B), (const bf16_t*)(ws + WS_WUPT), D, D, D, (float*)(ws + WS_SLAB_LATE)}; pg8::SplitOrder S; S.nM1 = MP / 256; S.init(M / 256, FF2 / 256, F.G, (int)blockIdx.x, D);
        EpiUp E{ws, args.out, args.in[I_CW], args.in[I_CB], F.lds}; pg8::gemm_phase(F.lds, g, S, E, F.wave); FIN_BAR();
        EpiUpFin E2{ws, args.out, args.in[I_CW], args.in[I_CB], args.in[I_SCV]}; pg8::gemm_finalize(g, S, E2, F.wave, (int)blockIdx.x);
        p11_conv(F, args, S.ns > 1 ? S.R * F.G - (MP / 256) * (FF2 / 256) : 1 << 30); }
    SEAM(11);
    if (PH_EN(13) && IN(13)) {
        { pg8::Gemm g{(const bf16_t*)(ws + WS_ACT), (const bf16_t*)(ws + WS_WDT), FF, FF, FF, (float*)(ws + WS_SLAB_LATE)}; pg8::SplitOrder S; S.init(M / 256, D / 256, F.G, (int)blockIdx.x, FF);
          EpiDown E{ws, args.out}; pg8::gemm_phase<ALIGN_LIGHT>(F.lds, g, S, E, F.wave); FIN_BAR(); pg8::gemm_finalize(g, S, E, F.wave, (int)blockIdx.x); }
        { pg8::Gemm g{(const bf16_t*)(ws + WS_PB), (const bf16_t*)(ws + WS_WPT), PLE, PLE, PLE, nullptr}; pg8::StaticOrder S; S.init(M / 256, D / 256, F.G, (int)blockIdx.x, PLE);
          EpiPle E{ws}; pg8::gemm_phase(F.lds, g, S, E, F.wave); }
    }
    SEAM(13);
    if (PH_EN(14) && IN(14)) { pg8::Gemm g{(const bf16_t*)(ws + WS_X2F8), (const bf16_t*)(ws + WS_WG8), D / 2, D / 2, D / 2, (float*)(ws + WS_SLAB_LATE)}; pg8::SplitOrder S; S.init(M / 256, D / 256, F.G, (int)blockIdx.x, D / 2);
        EpiGate E{ws, args.out}; pg8::gemm_phase<ALIGN_LIGHT, true>(F.lds, g, S, E, F.wave); FIN_BAR(); pg8::gemm_finalize(g, S, E, F.wave, (int)blockIdx.x); }
#ifdef STAMP
    xcd_barrier(bar, F.wave == 0 && lane_id() == 0);
    if (blockIdx.x == 0 && F.wave == 0) { const unsigned long long* ts = (const unsigned long long*)(ctl + 40960); const unsigned long long tend = __builtin_amdgcn_s_memrealtime();
        const size_t offs[10] = {O_Y, O_Y + (size_t)MP * D, O_CKVP, O_KRP, O_HGP, O_CVP, O_CKVS, O_KRS, O_HGS, O_CVS};
        for (int j = 0; j < 10; ++j) { const int ph = STAMP_BASE + j; unsigned long long t0 = ts[ph], t1 = ph + 1 < 15 ? ts[ph + 1] : tend; if (ph >= 15) { t0 = ts[0]; t1 = tend; }
            int n = ph > 15 ? 0 : (int)((t1 - t0) / 1000); if (ph <= 15 && n < 1) n = 1; if (n > 30000) n = 30000;
            for (int i = lane_id(); i < n; i += 64) ((unsigned*)args.out)[offs[j] + i] = 0xAAAAAAAAu; } }
#endif
#undef IN
#undef SEAM
}

extern "C" void kernel_launch(void* const* d_in, const int* in_sizes, int n_in, void* d_out, int out_size, void* d_ws, size_t ws_size, hipStream_t stream) {
    static int grid = 0;
    if (grid == 0) {
        if (n_in != 30 || (size_t)out_size != O_END || ws_size < WS_NEED) { fprintf(stderr, "kernel_launch: unexpected problem: n_in %d out %d ws %zu (need %zu); nothing launched\n", n_in, out_size, ws_size, (size_t)WS_NEED); grid = -1; return; }
        int dev = 0, cus = 0, per_cu = 0;
        if (hipGetDevice(&dev) != hipSuccess || hipDeviceGetAttribute(&cus, hipDeviceAttributeMultiprocessorCount, dev) != hipSuccess) { grid = -1; return; }
        if (hipFuncSetAttribute((const void*)fwd, hipFuncAttributeMaxDynamicSharedMemorySize, LDS_BYTES) != hipSuccess) { fprintf(stderr, "kernel_launch: hipFuncSetAttribute failed\n"); grid = -1; return; }
        if (hipOccupancyMaxActiveBlocksPerMultiprocessor(&per_cu, (const void*)fwd, 512, LDS_BYTES) != hipSuccess || per_cu < 1) fprintf(stderr, "kernel_launch: occupancy query says %d\n", per_cu);
        (void)hipGetLastError();
        grid = cus;
    }
    if (grid < 0) return;
    (void)hipMemsetAsync((char*)d_ws + WS_CTL, 0, CTL_BYTES, stream);
    Args a{};
    for (int i = 0; i < 30; ++i) a.in[i] = (const float*)d_in[i];
    a.out = (float*)d_out; a.ws = (unsigned char*)d_ws;
    for (int i = 0; i < 32; ++i) { const float p = (float)pow(10000.0, (double)i / 32.0); a.inv[i] = 1.0f / p; }
#ifndef N_LAUNCH_SPLIT
#define N_LAUNCH_SPLIT 1
#endif
#if N_LAUNCH_SPLIT
    for (int p = 0; p < LAST_PHASE; ++p) { a.ph_lo = p; a.ph_hi = p + 1; hipLaunchKernelGGL(fwd, dim3(grid), dim3(512), LDS_BYTES, stream, a);
#ifdef SELFCHECK
        hipLaunchKernelGGL(check_kernel, dim3(64), dim3(64), 0, stream, a, p);
        if (p == 5) hipLaunchKernelGGL(check_hgrn, dim3(8), dim3(128), 0, stream, a);
#endif
    }
#ifdef SELFCHECK
    hipLaunchKernelGGL(report_kernel, dim3(1), dim3(64), 0, stream, a);
#endif
#else
    a.ph_lo = 0; a.ph_hi = LAST_PHASE; hipLaunchKernelGGL(fwd, dim3(grid), dim3(512), LDS_BYTES, stream, a);
#endif
}
```

```cpp
#include <hip/hip_runtime.h>
#include <cstdio>
#include <cstdint>
#include <cmath>

#define LAS __attribute__((address_space(3)))
#define GAS __attribute__((address_space(1)))
typedef unsigned short bf16_t;
typedef short bf16x8 __attribute__((ext_vector_type(8)));
typedef short s16x4 __attribute__((ext_vector_type(4)));
typedef float f32x2 __attribute__((ext_vector_type(2)));
typedef float f32x4 __attribute__((ext_vector_type(4)));
typedef float f32x16 __attribute__((ext_vector_type(16)));
typedef unsigned u32x2 __attribute__((ext_vector_type(2)));
typedef unsigned u32x4 __attribute__((ext_vector_type(4)));
typedef __bf16 bf16x2_t __attribute__((ext_vector_type(2)));
typedef GAS unsigned gu32;
#define RLX_AGENT __ATOMIC_RELAXED, __HIP_MEMORY_SCOPE_AGENT
#define DI __device__ __forceinline__

DI unsigned cvtpk(float lo, float hi) { f32x2 v = {lo, hi}; bf16x2_t b = __builtin_convertvector(v, bf16x2_t); return __builtin_bit_cast(unsigned, b); }
DI float bf_lo(unsigned w) { return __uint_as_float(w << 16); }
DI float bf_hi(unsigned w) { return __uint_as_float(w & 0xffff0000u); }
DI float bf2f(bf16_t b) { return __uint_as_float(((unsigned)b) << 16); }
DI bf16_t f2bf(float f) { return (bf16_t)(cvtpk(f, 0.f) & 0xffffu); }
typedef int i32x8 __attribute__((ext_vector_type(8)));
typedef int i32x4 __attribute__((ext_vector_type(4)));
DI unsigned pk4_fp8(float a, float b, float c, float d) { int w = 0; w = __builtin_amdgcn_cvt_pk_fp8_f32(a, b, w, false); w = __builtin_amdgcn_cvt_pk_fp8_f32(c, d, w, true); return (unsigned)w; }
DI u32x4 pack8(f32x4 a, f32x4 b) { u32x4 w; w.x = cvtpk(a[0], a[1]); w.y = cvtpk(a[2], a[3]); w.z = cvtpk(b[0], b[1]); w.w = cvtpk(b[2], b[3]); return w; }
DI float wave_sum(float v) {
#pragma unroll
    for (int o = 1; o < 64; o <<= 1) v += __shfl_xor(v, o);
    return v;
}
DI int lane_id() { int l; asm volatile("v_mbcnt_lo_u32_b32 %0, -1, 0\n\tv_mbcnt_hi_u32_b32 %0, -1, %0" : "=v"(l)); return l; }
DI float sigmoidf_(float x) { return 1.0f / (1.0f + __expf(-x)); }

constexpr int D = 4096, NB = 4, SEQ = 4096, MP = NB * SEQ, SB = 32, ST = 16, MS = SB * ST, M = MP + MS;
constexpr int PAST = 4096, NKEY = PAST + ST  , KPAD = 4352  , KT = 4224  ;
constexpr int QL = 1024, KVL = 512, ROPE = 64, NOPE = 128, NH = 16, QH = NOPE + ROPE  , KC = KVL + ROPE  ;
constexpr int HGW = 2048, HGH = 16, HGD = 128;
constexpr int FF = 11008, FF2 = 22016, PLE = 256;
constexpr int NIN = 9984;
constexpr float EPS = 1e-6f;
constexpr float ATT_SCALE = 0.07216878364870322f;

constexpr size_t O_Y = 0, O_CKVP = (size_t)M * D, O_KRP = O_CKVP + (size_t)MP * KVL, O_HGP = O_KRP + (size_t)MP * ROPE, O_CVP = O_HGP + (size_t)NB * HGH * HGD * HGD,
                 O_CKVS = O_CVP + (size_t)NB * 2 * FF2, O_KRS = O_CKVS + (size_t)MS * KVL, O_HGS = O_KRS + (size_t)MS * ROPE, O_CVS = O_HGS + (size_t)SB * HGH * HGD * HGD, O_END = O_CVS + (size_t)SB * 2 * FF2;
static_assert(O_END == 89960448, "output size");

constexpr float SC8_K = 16.f, SC8_W = 256.f;
constexpr size_t OS_XB = 0  ,
                 OS_S = (size_t)132 << 20  ;
constexpr size_t OS_XB8 = (size_t)132 << 20  , OS_WIN8 = (size_t)200 << 20  ;
constexpr float SC8_X0 = 8.f, SC8_WI = 1024.f;
static_assert(OS_XB8 + (size_t)M * D <= OS_WIN8 && OS_WIN8 + (size_t)QL * D <= (size_t)M * D * 4, "d_out scratch (fp8 in-projection operands)");
constexpr int SPITCH = 4224;
static_assert((size_t)M * D * 2 <= OS_S && OS_S + (size_t)SB * 256 * SPITCH * 4 <= (size_t)M * D * 4 && NKEY <= SPITCH, "d_out scratch");
constexpr size_t MiB = (size_t)1 << 20;
constexpr size_t WS_CTL = 0, CTL_BYTES = 2 * MiB;
constexpr int CW_TMO = 0, CW_BAR = 4096, CW_QUEUE = 16384  ;
constexpr size_t OFF_SSQ1 = 256 * 1024, OFF_SSQQ = 384 * 1024, OFF_SSQ2 = 512 * 1024, OFF_SSQ3 = 640 * 1024, OFF_LB = 768 * 1024;
constexpr size_t WS_WINT = 2 * MiB, WS_XB = 80 * MiB, WS_MIX = 2 * MiB, WS_S = 134 * MiB, WS_P = 270 * MiB, WS_CKVT = 336 * MiB, WS_KCAT = 468 * MiB, WS_OLAT = 621 * MiB, WS_SSK = 637 * MiB,
                 WS_QCAT = 646 * MiB, WS_WUKVT = 655 * MiB, WS_WUKN = 659 * MiB, WS_WUQT = 661 * MiB, WS_ROPE = 667 * MiB, WS_CKVN = 669 * MiB, WS_KRN = 686 * MiB,
                 WS_HQ = 712 * MiB, WS_HK = 778 * MiB, WS_HV = 844 * MiB, WS_HG = 910 * MiB, WS_LF = 976 * MiB, WS_Q = 1108 * MiB, WS_KN = 1207 * MiB, WS_V = 1271 * MiB,
                 WS_CQ = 1335 * MiB, WS_CKVRAW = 1368 * MiB, WS_KRRAW = 1401 * MiB, WS_EARLY_END = 1406 * MiB;
constexpr size_t WS_U = 2 * MiB, WS_ACT = 160 * MiB  , WS_WUPT = 712 * MiB, WS_WOT = 884 * MiB, WS_WDT = 1067 * MiB, WS_WGT = 1153 * MiB, WS_X1B = 1185 * MiB, WS_WPT = 1415 * MiB, WS_PB = 1406 * MiB  , WS_PW = 2 * MiB;
constexpr size_t WS_X2F8 = 916 * MiB  , WS_WG8 = 984 * MiB  ;
constexpr float SC8_X = 8.f, SC8_G = 1024.f;
static_assert(WS_X2F8 >= 916 * MiB && WS_X2F8 + (size_t)M * D <= WS_WG8 && WS_WG8 + (size_t)D * D <= 1067 * MiB, "fp8 gate operands");
constexpr size_t WS_CQ8 = 134 * MiB  , WS_WUQ8 = 152 * MiB  , WS_CKVN8 = 156 * MiB  ,
                 WS_WUKV8 = 166 * MiB  ;
constexpr size_t WS_QCAT8 = 168 * MiB  , WS_KC8 = 270 * MiB  ;
constexpr float SC8_QA = 32.f;
static_assert(WS_WUKV8 + (size_t)4096 * KVL <= WS_QCAT8 && WS_QCAT8 + (size_t)SB * 256 * KVL <= 212 * MiB && WS_KC8 >= 212 * MiB + (size_t)224 * 65536 * 4 && WS_KC8 + (size_t)SB * PAST * KVL <= 336 * MiB, "early fp8 (2)");
constexpr float SC8_Q = 512.f;
constexpr float SC8_A = 16.f;
static_assert(WS_CQ8 + (size_t)M * QL <= WS_WUQ8 && WS_WUQ8 + (size_t)3072 * QL <= WS_CKVN8 && WS_CKVN8 + (size_t)M * KVL <= WS_WUKV8 && WS_WUKV8 + (size_t)4096 * KVL <= 212 * MiB, "early fp8");
constexpr size_t WS_UH = 136 * MiB;
static_assert(WS_UH >= WS_PW + (size_t)M * D * 2 && WS_UH + (size_t)64 * 4 * FF2 * 4 <= WS_ACT, "UH");
constexpr size_t WS_SLAB_EARLY = 212 * MiB, WS_SLAB_LATE = 1328 * MiB;
constexpr size_t WS_NEED = 1417 * MiB;
static_assert(WS_SLAB_EARLY >= WS_XB + (size_t)M * D * 2 && WS_SLAB_EARLY + 64 * MiB <= WS_CKVT && WS_SLAB_LATE + 64 * MiB <= WS_PB, "slabs");
static_assert(WS_WINT + (size_t)NIN * D * 2 <= WS_XB && WS_XB + (size_t)M * D * 2 <= WS_CKVT, "early A region");
static_assert(WS_MIX + (size_t)M * D * 2 <= WS_S && WS_S + (size_t)SB * 256 * KPAD * 4 <= WS_P && WS_P + (size_t)SB * 256 * KT * 2 <= WS_CKVT, "mix/S/P");
static_assert(WS_CKVT + (size_t)SB * KVL * KT * 2 <= WS_KCAT && WS_KCAT + (size_t)SB * KPAD * KC * 2 <= WS_OLAT && WS_OLAT + (size_t)SB * 256 * KVL * 4 <= WS_SSK && WS_SSK + (size_t)SB * KPAD * 16 * 4 <= WS_QCAT, "ckvT/Kcat/OLAT/SSK");
static_assert(WS_QCAT + (size_t)SB * 256 * KC * 2 <= WS_WUKVT && WS_WUKVT + (size_t)4096 * 512 * 2 <= WS_WUKN && WS_WUKN + (size_t)512 * 2048 * 2 <= WS_WUQT && WS_WUQT + (size_t)3072 * 1024 * 2 <= WS_ROPE, "small early");
static_assert(WS_ROPE + (size_t)NKEY * 64 * 4 <= WS_CKVN && WS_CKVN + (size_t)M * KVL * 2 <= WS_KRN && WS_KRN + (size_t)M * ROPE * 2 <= WS_HQ, "rope/ckvn/krn");
static_assert(WS_HQ + (size_t)M * HGW * 2 <= WS_HK && WS_HG + (size_t)M * HGW * 2 <= WS_LF && WS_LF + (size_t)M * HGW * 4 <= WS_Q && WS_Q + (size_t)M * 3072 * 2 <= WS_KN && WS_KN + (size_t)MP * 2048 * 2 <= WS_V && WS_V + (size_t)MP * 2048 * 2 <= WS_CQ, "hgrn/q/k/v");
static_assert(WS_CQ + (size_t)M * QL * 2 <= WS_CKVRAW && WS_CKVRAW + (size_t)M * KVL * 4 <= WS_KRRAW && WS_KRRAW + (size_t)M * ROPE * 4 <= WS_EARLY_END, "cq/raw");
static_assert(WS_U + (size_t)M * FF2 * 2 <= WS_WUPT && WS_ACT + (size_t)M * FF * 2 <= WS_U + (size_t)MP * FF2 * 2 && WS_WUPT + (size_t)FF2 * D * 2 <= WS_WOT && WS_WOT + (size_t)D * D * 2 <= WS_WDT, "late 1");
static_assert(WS_WDT + (size_t)D * FF * 2 <= WS_WGT && WS_WGT + (size_t)D * D * 2 <= WS_X1B && WS_X1B + (size_t)M * D * 2 <= WS_SLAB_LATE && WS_PB >= WS_EARLY_END && WS_PB + (size_t)M * PLE * 2 <= WS_WPT && WS_WPT + (size_t)D * PLE * 2 <= WS_NEED, "late 2");

constexpr int RING_BYTES = 131072;
constexpr int XCH_OFF = RING_BYTES, XCH_BYTES = 12288;
constexpr int MISC_OFF = XCH_OFF + XCH_BYTES;
constexpr int LDS_BYTES = 147456;
static_assert(MISC_OFF + 128 <= LDS_BYTES, "LDS map");
#define N_LAUNCH_SPLIT 0

namespace pg8 {
constexpr int BM = 256, BK = 64, HALF = 128, HTB = HALF * BK * 2  , STAGE_BYTES = 8 * HTB, NXCD = 8, WGM = 8;
static_assert(STAGE_BYTES == RING_BYTES, "stage region");
__host__ __device__ __forceinline__ int lds_byte(int r, int c) { const int st = (r >> 4) * 2 + (c >> 5), rr = r & 15, cc = c & 31, ob = rr * 64 + cc * 2; return st * 1024 + (ob ^ (((ob >> 9) & 1) << 5)); }
__host__ __device__ __forceinline__ void stage_rc(int b, int& R, int& C) { const int st = b / 1024, sb = b % 1024, swz = sb ^ (((sb >> 9) & 1) << 5); R = (st >> 1) * 16 + swz / 64; C = (st & 1) * 32 + (swz % 64) / 2; }
__host__ __device__ __forceinline__ int perm32(int rho) { const int n = rho >> 4, i = rho & 15; return 8 * (i >> 2) + 4 * n + (i & 3); }

struct Unit { int pm, pn, koff, nt, sub; };
struct Gemm { const bf16_t* A; const bf16_t* Bt; int lda, ldb, K; float* slab; };

struct StaticOrder {
    int nM, nN, nwg, G, c, knt, nM1 = 0, rot = 0;
    __host__ __device__ __forceinline__ void init(int nM_, int nN_, int G_, int c_, int K_) { nM = nM_; nN = nN_; nwg = nM * nN; G = G_; c = c_; knt = K_ / BK; }
    __host__ __device__ __forceinline__ void tile(int L, Unit& u) const {
        const int nMa = nM1 > 0 ? nM1 : nM, nwa = nMa * nN;
        if (L >= nwa) { const int r = L - nwa, nr = nM - nMa; u.pm = nMa + r % nr; u.pn = r / nr; u.koff = 0; u.nt = knt; u.sub = -1; return; }
        int wgid = L; { const int q = nwa / NXCD, r = nwa % NXCD, xcd = wgid % NXCD, off = wgid / NXCD; wgid = (xcd < r ? xcd * (q + 1) : r * (q + 1) + (xcd - r) * q) + off; }
        const int nig = WGM * nN, gid = wgid / nig, fm = gid * WGM, gsz = (nMa - fm) < WGM ? (nMa - fm) : WGM;
        u.pm = fm + ((wgid % nig) % gsz); u.pn = (wgid % nig) / gsz; u.koff = 0; u.nt = knt; u.sub = -1;
        if (rot > 0) u.pm = u.pm < rot ? nM - rot + u.pm : u.pm - rot;
    }
    __host__ __device__ __forceinline__ bool next(int i, Unit& u) const { const long L = (long)i * G + c; if (L >= nwg) return false; tile((int)L, u); return true; }
};
struct SplitOrder : StaticOrder {
    int R, Lft, ns, kb;
    __host__ __device__ __forceinline__ void init(int nM_, int nN_, int G_, int c_, int K_) { StaticOrder::init(nM_, nN_, G_, c_, K_); R = nwg / G; Lft = nwg % G; ns = 1; kb = K_ / 128;
        if (Lft > 0) { const int k128 = K_ / 128; int s = G / Lft; if (s > k128 / 2) s = k128 / 2; if (s < 1) s = 1; kb = (k128 + s - 1) / s; if (k128 % kb == 1) ++kb; ns = (k128 + kb - 1) / kb; } }
    __host__ __device__ __forceinline__ bool next(int i, Unit& u) const {
        if (i < R) { tile(i * G + c, u); return true; }
        if (i > R || ns <= 1) { if (i == R && ns <= 1) { const long L = (long)i * G + c; if (L >= nwg) return false; tile((int)L, u); return true; } return false; }
        if (c >= Lft * ns) return false;
        const int l = c / ns, sl = c % ns; tile(R * G + l, u); const int k128 = knt / 2; u.koff = sl * kb * 128; const int nb = (k128 - sl * kb) < kb ? (k128 - sl * kb) : kb; u.nt = nb * 2; u.sub = c; return true; }
};
struct MappedOrder : StaticOrder {
    int per, stride, off;
    __host__ __device__ __forceinline__ bool next(int i, Unit& u) const { if (!StaticOrder::next(i, u)) return false; u.pm = (u.pm / per) * stride + off + (u.pm % per); return true; }
};

struct BatchOrder {
    int n, G, c, per, mode, kslice;
    int knt;
    __host__ __device__ __forceinline__ bool next(int i, Unit& u) const { const int L = i * G + c; if (L >= n) return false; const int b = L / per, r = L % per;
        u.pm = b; u.nt = knt; u.sub = -1; if (mode == 0) { u.pn = b * 17 + r; u.koff = 0; } else if (mode == 2) { u.pn = b * per + r; u.koff = 0; } else { u.pn = 2 * b + r / 3; u.koff = (r % 3) * kslice; } return true; }
};
struct OneBatchOrder {
    int b, per, knt, first = 0;
    __host__ __device__ __forceinline__ bool next(int i, Unit& u) const { if (first + i >= per) return false; u.pm = b; u.pn = b * per + first + i; u.koff = 0; u.nt = knt; u.sub = -1; return true; }
};
template <bool ALIGN_EPI = true, bool FP8 = false, class Epi, class Sched>
__device__ __forceinline__ void gemm_phase(LAS unsigned char* lds, const Gemm g, const Sched& S, const Epi& E, int wid) {
    const int lane = lane_id(), tid = wid * 64 + lane, wr = wid >> 2, wc = wid & 3, fr = lane & 15, fq = lane >> 4;
    unsigned voffA[2], voffB[2];
#pragma unroll
    for (int i = 0; i < 2; ++i) { int R, C; stage_rc(tid * 16 + i * 8192, R, C); const int Rb = (R & ~31) + perm32(R & 31);
        voffA[i] = (unsigned)(R * g.lda + C) * 2u; voffB[i] = (unsigned)(Rb * g.ldb + C) * 2u; }
    const size_t kstep = (size_t)(BK * 2);
    const size_t hstepA = (size_t)HALF * g.lda * 2, hstepB = (size_t)HALF * g.ldb * 2;
    const size_t tstepA = 2 * hstepA, tstepB = 2 * hstepB;
    const unsigned ldsw = (unsigned)wid * 1024u;
    const int aoff = lds_byte(wr * 64 + fr, fq * 8), boff = lds_byte(wc * 32 + fr, fq * 8);
#define PG8_SA(b, h) (((b) * 2 + (h)) * HTB)
#define PG8_SB(b, h) ((4 + (b) * 2 + (h)) * HTB)
#define PG8_STAGE(bufoff, gbase, voff) do { _Pragma("unroll") for (int _i = 0; _i < 2; ++_i) \
        __builtin_amdgcn_global_load_lds((const unsigned*)((const char*)(gbase) + (voff)[_i]), (LAS unsigned*)(lds + (bufoff) + ldsw + _i * 8192), 16, 0, 0); } while (0)
#define PG8_LDA(dst, b, h) do { if constexpr (FP8) { _Pragma("unroll") for (int m = 0; m < 4; ++m) { dst##8[m].lo = *(const LAS i32x4*)(lds + PG8_SA(b, h) + aoff + m * 2048); dst##8[m].hi = *(const LAS i32x4*)(lds + PG8_SA(b, h) + aoff + m * 2048 + 1024); } } else { \
        _Pragma("unroll") for (int m = 0; m < 4; ++m) _Pragma("unroll") for (int k = 0; k < 2; ++k) dst[m][k] = *(const LAS bf16x8*)(lds + PG8_SA(b, h) + aoff + m * 2048 + k * 1024); } } while (0)
#define PG8_LDB(dst, b, h) do { if constexpr (FP8) { _Pragma("unroll") for (int n = 0; n < 2; ++n) { dst##8[n].lo = *(const LAS i32x4*)(lds + PG8_SB(b, h) + boff + n * 2048); dst##8[n].hi = *(const LAS i32x4*)(lds + PG8_SB(b, h) + boff + n * 2048 + 1024); } } else { \
        _Pragma("unroll") for (int n = 0; n < 2; ++n) _Pragma("unroll") for (int k = 0; k < 2; ++k) dst[n][k] = *(const LAS bf16x8*)(lds + PG8_SB(b, h) + boff + n * 2048 + k * 1024); } } while (0)
#define PG8_MMA(ai, bj, At, Bt) do { __builtin_amdgcn_s_setprio(1); if constexpr (FP8) { _Pragma("unroll") for (int m = 0; m < 4; ++m) _Pragma("unroll") for (int n = 0; n < 2; ++n) \
        asm volatile("v_mfma_f32_16x16x128_f8f6f4 %0, %1, %2, %0" : "+v"(acc[ai][bj][m][n]) : "v"(Bt##8[n]), "v"(At##8[m])); } else { \
        _Pragma("unroll") for (int m = 0; m < 4; ++m) _Pragma("unroll") for (int n = 0; n < 2; ++n) _Pragma("unroll") for (int k = 0; k < 2; ++k) \
        acc[ai][bj][m][n] = __builtin_amdgcn_mfma_f32_16x16x32_bf16(Bt[n][k], At[m][k], acc[ai][bj][m][n], 0, 0, 0); } __builtin_amdgcn_s_setprio(0); } while (0)
#define PG8_WAIT_V(n) asm volatile("s_waitcnt vmcnt(" #n ")" ::: "memory")
#define PG8_WAIT_L(n) asm volatile("s_waitcnt lgkmcnt(" #n ")" ::: "memory")
#define PG8_BAR __builtin_amdgcn_s_barrier()
#define PG8_SCHED __builtin_amdgcn_sched_barrier(0)
    Unit cur, nxt; int ui = 0;
    if (!S.next(0, cur)) return;
    f32x4 acc[2][2][4][2];
#pragma unroll
    for (int a = 0; a < 2; ++a)
#pragma unroll
        for (int b = 0; b < 2; ++b)
#pragma unroll
            for (int m = 0; m < 4; ++m)
#pragma unroll
                for (int n = 0; n < 2; ++n) acc[a][b][m][n] = (f32x4){0.f, 0.f, 0.f, 0.f};
    bf16x8 At[4][2], B0[2][2], B1[2][2]; i32x8 At8[4], B08[2], B18[2];
    const char* cA = (const char*)g.A + (size_t)cur.pm * tstepA + (size_t)cur.koff * 2; const char* cB = (const char*)g.Bt + (size_t)cur.pn * tstepB + (size_t)cur.koff * 2;
    PG8_STAGE(PG8_SB(0, 0), cB, voffB); PG8_STAGE(PG8_SB(0, 1), cB + hstepB, voffB); PG8_STAGE(PG8_SA(0, 0), cA, voffA); PG8_STAGE(PG8_SA(0, 1), cA + hstepA, voffA);
    if (wr == 1) PG8_BAR;
    PG8_WAIT_V(2); PG8_BAR;
    PG8_STAGE(PG8_SB(1, 0), cB + kstep, voffB); PG8_STAGE(PG8_SA(1, 0), cA + kstep, voffA); PG8_STAGE(PG8_SB(1, 1), cB + hstepB + kstep, voffB);
    PG8_WAIT_V(6); PG8_BAR;
    for (;;) {
        const bool has_next = S.next(ui + 1, nxt);
        const char* nA = has_next ? (const char*)g.A + (size_t)nxt.pm * tstepA + (size_t)nxt.koff * 2 : cA; const char* nB = has_next ? (const char*)g.Bt + (size_t)nxt.pn * tstepB + (size_t)nxt.koff * 2 : cB;
        const int nt = cur.nt;
        for (int t = 0; t < nt; t += 2) {
            const bool last = (t == nt - 2);
            const char* a1 = cA + (size_t)(t + 1) * kstep;
            const char* a2 = last ? nA : cA + (size_t)(t + 2) * kstep; const char* b2 = last ? nB : cB + (size_t)(t + 2) * kstep;
            const char* a3 = a2 + kstep; const char* b3 = b2 + kstep;
            PG8_LDB(B0, 0, 0); PG8_LDB(B1, 0, 1); PG8_SCHED; PG8_LDA(At, 0, 0); PG8_STAGE(PG8_SA(1, 1), a1 + hstepA, voffA);
            PG8_WAIT_V(8); PG8_WAIT_L(0); PG8_BAR; PG8_MMA(0, 0, At, B0); PG8_MMA(0, 1, At, B1); PG8_BAR; PG8_SCHED;
            PG8_LDA(At, 0, 1); PG8_STAGE(PG8_SB(0, 0), b2, voffB); PG8_STAGE(PG8_SB(0, 1), b2 + hstepB, voffB); PG8_STAGE(PG8_SA(0, 0), a2, voffA);
            PG8_WAIT_V(8); PG8_WAIT_L(0); PG8_BAR; PG8_MMA(1, 0, At, B0); PG8_MMA(1, 1, At, B1); PG8_BAR; PG8_SCHED;
            PG8_LDB(B0, 1, 0); PG8_LDB(B1, 1, 1); PG8_SCHED; PG8_LDA(At, 1, 0); PG8_STAGE(PG8_SA(0, 1), a2 + hstepA, voffA);
            PG8_WAIT_V(8); PG8_WAIT_L(0); PG8_BAR; PG8_MMA(0, 0, At, B0); PG8_MMA(0, 1, At, B1); PG8_BAR; PG8_SCHED;
            PG8_LDA(At, 1, 1); PG8_STAGE(PG8_SB(1, 0), b3, voffB); PG8_STAGE(PG8_SB(1, 1), b3 + hstepB, voffB); PG8_STAGE(PG8_SA(1, 0), a3, voffA);
            PG8_WAIT_V(8); PG8_WAIT_L(0); PG8_BAR; PG8_MMA(1, 0, At, B0); PG8_MMA(1, 1, At, B1); PG8_BAR; PG8_SCHED;
        }
        if constexpr (ALIGN_EPI) { if (wr == 0) PG8_BAR; }
        if constexpr (FP8) asm volatile("s_nop 15\n\ts_nop 15" ::: "memory");
        if (cur.sub >= 0) {
            float* sp = g.slab + (size_t)cur.sub * 65536 + (size_t)(wr * 64 + fr) * 256 + wc * 32 + 8 * fq;
#pragma unroll
            for (int ai = 0; ai < 2; ++ai)
#pragma unroll
                for (int m = 0; m < 4; ++m)
#pragma unroll
                    for (int bj = 0; bj < 2; ++bj) { float* p = sp + (size_t)(ai * 128 + m * 16) * 256 + bj * 128; *(f32x4*)p = acc[ai][bj][m][0]; *(f32x4*)(p + 4) = acc[ai][bj][m][1]; }
        } else E(acc, cur, wr, wc, fr, fq, lane);
        if (!has_next) break;
#pragma unroll
        for (int a = 0; a < 2; ++a)
#pragma unroll
            for (int b = 0; b < 2; ++b)
#pragma unroll
                for (int m = 0; m < 4; ++m)
#pragma unroll
                    for (int n = 0; n < 2; ++n) acc[a][b][m][n] = (f32x4){0.f, 0.f, 0.f, 0.f};
        cur = nxt; cA = nA; cB = nB; ++ui;
        if constexpr (ALIGN_EPI) { if (wr == 1) PG8_BAR; }
    }
    PG8_WAIT_V(0);
    if constexpr (!ALIGN_EPI) { if (wr == 0) PG8_BAR; }
    PG8_BAR;
#undef PG8_SA
#undef PG8_SB
#undef PG8_STAGE
#undef PG8_LDA
#undef PG8_LDB
#undef PG8_MMA
#undef PG8_WAIT_V
#undef PG8_WAIT_L
#undef PG8_BAR
#undef PG8_SCHED
}
template <class Epi>
__device__ __forceinline__ void gemm_finalize(const Gemm g, const SplitOrder& S, Epi E, int wid, int blk) {
    if (S.Lft == 0 || S.ns <= 1 || blk >= S.Lft * S.ns) return;
    const int lane = lane_id(), wr = wid >> 2, wc = wid & 3, fr = lane & 15, fq = lane >> 4;
    const int l = blk / S.ns, j = blk % S.ns, n8 = S.ns < 8 ? S.ns : 8;
    if (j >= n8) return;
    E.s0 = j * 8 / n8; E.s1 = (j + 1) * 8 / n8;
    Unit u; S.tile(S.R * S.G + l, u);
    f32x4 acc[2][2][4][2];
    const float* sp = g.slab + (size_t)(l * S.ns) * 65536 + (size_t)(wr * 64 + fr) * 256 + wc * 32 + 8 * fq;
#pragma unroll
    for (int ai = 0; ai < 2; ++ai)
#pragma unroll
        for (int m = 0; m < 4; ++m)
#pragma unroll
            for (int bj = 0; bj < 2; ++bj) { f32x4 a0 = {0.f, 0.f, 0.f, 0.f}, a1 = {0.f, 0.f, 0.f, 0.f};
                if (ai * 4 + m >= E.s0 && ai * 4 + m < E.s1) { const float* p = sp + (size_t)(ai * 128 + m * 16) * 256 + bj * 128;
                    for (int sl = 0; sl < S.ns; ++sl) { a0 += *(const f32x4*)(p + (size_t)sl * 65536); a1 += *(const f32x4*)(p + (size_t)sl * 65536 + 4); } }
                acc[ai][bj][m][0] = a0; acc[ai][bj][m][1] = a1; }
    E(acc, u, wr, wc, fr, fq, lane);
}
}

#define XB_TMO      128
#define XB_XCNT(j)  (256  + 64 * (j))
#define XB_XSUB(j)  (1280 + 64 * (j))
#define XB_XGEN(j)  (2304 + 64 * (j))
#define XB_TOP      3328
#define XB_TOPGEN   3392
#define XCD_BAR_WORDS 3456
#define XB_SPIN_CAP (1u << 22)

__device__ __forceinline__ unsigned xb_ld(unsigned* p)              { return __hip_atomic_load(p, __ATOMIC_RELAXED, __HIP_MEMORY_SCOPE_AGENT); }
__device__ __forceinline__ unsigned xb_add(unsigned* p, unsigned v) { return __hip_atomic_fetch_add(p, v, __ATOMIC_RELAXED, __HIP_MEMORY_SCOPE_AGENT); }
__device__ __forceinline__ unsigned xb_xcc_id() { return (unsigned)__builtin_amdgcn_s_getreg((3 << 11) | 20) & 0xFu; }
#define XB_SPIN(cond, bar) do { unsigned _sp = 0; while (cond) { __builtin_amdgcn_s_sleep(1); \
    if ((++_sp & 255u) == 0u) { if (xb_ld(&(bar)[XB_TMO])) break; if (_sp > XB_SPIN_CAP) { atomicAdd(&(bar)[XB_TMO], 1u); break; } } } } while (0)

struct XcdBarrier {
    unsigned* bar; unsigned x;
    volatile LAS unsigned* st;
};
__device__ __forceinline__ XcdBarrier xcd_barrier_post(unsigned* bar, volatile LAS unsigned* st, bool leader) {
    XcdBarrier b; b.bar = bar; b.x = xb_xcc_id(); b.st = st;
    if (leader) (void)xb_add(&bar[XB_XCNT(b.x)], 1u);
    return b;
}
__device__ __forceinline__ void xcd_barrier_complete(unsigned* bar, unsigned x, unsigned& nloc, unsigned& nx) {
    const unsigned G = gridDim.x * gridDim.y * gridDim.z;
    unsigned sum, cnt, mine, sp = 0u;
    for (;;) {
        sum = 0u; cnt = 0u; mine = 0u;
#pragma unroll
        for (unsigned j = 0; j < 16; ++j) { const unsigned c = xb_ld(&bar[XB_XCNT(j)]); sum += c; cnt += (c > 0u) ? 1u : 0u; mine = (j == x) ? c : mine; }
        if (sum == G) break;
        __builtin_amdgcn_s_sleep(1);
        if ((++sp & 255u) == 0u) { if (xb_ld(&bar[XB_TMO])) break; if (sp > XB_SPIN_CAP) { atomicAdd(&bar[XB_TMO], 1u); break; } }
    }
    nloc = mine > 0u ? mine : 1u; nx = cnt > 0u ? cnt : 1u;
}
__device__ __forceinline__ void xcd_barrier(const XcdBarrier& b, bool leader) {
    asm volatile("s_waitcnt vmcnt(0)" ::: "memory");
    __syncthreads();
    if (leader) {
        unsigned* bar = b.bar;
        __builtin_amdgcn_s_waitcnt(0);
        unsigned nloc = b.st[0], nx = b.st[1];
        if (nloc == 0u) { xcd_barrier_complete(bar, b.x, nloc, nx); b.st[0] = nloc; b.st[1] = nx; }
        const unsigned old = xb_add(&bar[XB_XSUB(b.x)], 1u);
        const unsigned gen = old / nloc;
        if (old + 1u == (gen + 1u) * nloc) {
            __builtin_amdgcn_fence(__ATOMIC_RELEASE, "agent");
            asm volatile("s_waitcnt vmcnt(0)" ::: "memory");
            const unsigned og = xb_add(&bar[XB_TOP], 1u);
            const unsigned tg = og / nx;
            if (og + 1u == (tg + 1u) * nx) xb_add(&bar[XB_TOPGEN], 1u);
            else XB_SPIN(xb_ld(&bar[XB_TOPGEN]) == tg, bar);
            __builtin_amdgcn_fence(__ATOMIC_ACQUIRE, "agent");
            xb_add(&bar[XB_XGEN(b.x)], 1u);
            asm volatile("s_waitcnt vmcnt(0)" ::: "memory");
        } else {
            XB_SPIN(xb_ld(&bar[XB_XGEN(b.x)]) == gen, bar);
            __builtin_amdgcn_fence(__ATOMIC_ACQUIRE, "agent");
            asm volatile("s_waitcnt vmcnt(0)" ::: "memory");
        }
    }
    __syncthreads();
}

struct Args { const float* in[30]; float* out; unsigned char* ws; float inv[32]; int ph_lo, ph_hi; };
enum { I_XP = 0, I_XS, I_CCKV, I_CKR, I_SHG, I_SCV, I_PP, I_PS, I_GATT, I_WIN, I_GQA, I_WUQ, I_GKVA, I_WUK, I_WUV, I_GQN, I_GQR, I_GKN, I_GKR, I_LB, I_GHG, I_WO, I_GFFN, I_WUP, I_CW, I_CB, I_WD, I_GPLE, I_WPG, I_WPLE };
struct Frame { LAS unsigned char* lds; int wave, vcu, G, gw, NGW; };
#define LDS_WAIT() asm volatile("s_waitcnt lgkmcnt(0)" ::: "memory")
#define VM_WAIT() asm volatile("s_waitcnt vmcnt(0)" ::: "memory")

DI void tr_item(const float* __restrict__ W, size_t ldw, bf16_t* __restrict__ WT, size_t ldt, const float* __restrict__ gain, int k0, int n0, int dst_row0, LAS float* scr, int lane, bf16_t* NAT, size_t ldn, int rope_np = -1, unsigned char* NAT8 = nullptr, size_t ld8 = 0, unsigned char* WT8 = nullptr, float sc8 = 1.f) {
#pragma unroll 8
    for (int i = 0; i < 32; ++i) { const int kk = 2 * i + (lane >> 5); scr[kk * 33 + (lane & 31)] = W[(size_t)(k0 + kk) * ldw + n0 + (lane & 31)]; }
    LDS_WAIT(); asm volatile("" ::: "memory");
    const int c = lane & 7;
    float gv[8];
#pragma unroll
    for (int j = 0; j < 8; ++j) gv[j] = gain ? gain[k0 + 8 * c + j] : 1.0f;
#pragma unroll
    for (int j = 0; j < 4; ++j) { const int n = (lane >> 3) + 8 * j; const LAS float* s = scr + (8 * c) * 33 + n;
        const int nn = rope_np < 0 ? n : 32 * (n >> 4) + 8 * ((n >> 2) & 3) + 4 * rope_np + (n & 3);
        if (WT8) { u32x2 o8; o8.x = pk4_fp8(s[0 * 33] * gv[0] * sc8, s[1 * 33] * gv[1] * sc8, s[2 * 33] * gv[2] * sc8, s[3 * 33] * gv[3] * sc8); o8.y = pk4_fp8(s[4 * 33] * gv[4] * sc8, s[5 * 33] * gv[5] * sc8, s[6 * 33] * gv[6] * sc8, s[7 * 33] * gv[7] * sc8);
            *(u32x2*)(WT8 + (size_t)(dst_row0 + nn) * ldt + k0 + 8 * c) = o8; continue; }
        u32x4 o; o.x = cvtpk(s[0 * 33] * gv[0], s[1 * 33] * gv[1]); o.y = cvtpk(s[2 * 33] * gv[2], s[3 * 33] * gv[3]); o.z = cvtpk(s[4 * 33] * gv[4], s[5 * 33] * gv[5]); o.w = cvtpk(s[6 * 33] * gv[6], s[7 * 33] * gv[7]);
        *(u32x4*)(WT + (size_t)(dst_row0 + nn) * ldt + k0 + 8 * c) = o; }
    if (NAT || NAT8) {
#pragma unroll
        for (int j = 0; j < 4; ++j) { const int r = (lane >> 2) + 16 * j, ch = lane & 3; const LAS float* s = scr + r * 33 + ch * 8;
            if (NAT) { u32x4 o; o.x = cvtpk(s[0], s[1]); o.y = cvtpk(s[2], s[3]); o.z = cvtpk(s[4], s[5]); o.w = cvtpk(s[6], s[7]);
                *(u32x4*)(NAT + (size_t)(k0 + r) * ldn + n0 + ch * 8) = o; }
            if (NAT8) { u32x2 o8; o8.x = pk4_fp8(s[0] * SC8_K, s[1] * SC8_K, s[2] * SC8_K, s[3] * SC8_K); o8.y = pk4_fp8(s[4] * SC8_K, s[5] * SC8_K, s[6] * SC8_K, s[7] * SC8_K); *(u32x2*)(NAT8 + (size_t)(k0 + r) * ld8 + n0 + ch * 8) = o8; } }
    }
    LDS_WAIT(); asm volatile("" ::: "memory");
}
DI bool tr_matrix(int& r, const float* W, int K, int N, bf16_t* WT, size_t ldt, const float* gain, LAS float* scr, int lane, int split_n = 1 << 30, int pad = 0, bool gate_up = false, bool uq = false, unsigned char* WT8 = nullptr, float sc8 = 1.f, int n8_lim = 1 << 30) {
    const int nblk = N / 32, nitems = (K / 64) * nblk;
    if (r >= nitems) { r -= nitems; return false; }
    const int kb = r / nblk, nb = r % nblk, n0 = 32 * nb;
    int dst = n0 < split_n ? n0 : n0 + pad;
    if (gate_up) { const int s = n0 / FF, ch = n0 % FF; dst = (ch / 128) * 256 + s * 128 + (ch % 128); }
    int np = -1;
    if (uq) { const int h = n0 / QH, d0 = n0 % QH; if (d0 < NOPE) dst = h * NOPE + d0; else { dst = 2048 + (h >> 2) * 256 + (h & 3) * 64; np = (d0 - NOPE) >> 5; } }
    tr_item(W, (size_t)N, WT, ldt, gain, 64 * kb, n0, dst, scr, lane, nullptr, 0, np, nullptr, 0, n0 < n8_lim ? WT8 : nullptr, sc8);
    return true;
}
DI void zero16(void* p, size_t bytes, int gw, int NGW, int lane) {
    const size_t n = bytes / 1024;
    for (size_t i = gw; i < n; i += NGW) *(u32x4*)((char*)p + i * 1024 + lane * 16) = (u32x4){0u, 0u, 0u, 0u};
}

DI void p0_prologue(const Frame& F, const Args& a) {
    unsigned char* ws = a.ws;
    LAS float* scr = (LAS float*)(F.lds + F.wave * 16384);
    const int lane = lane_id();
    {
        constexpr int I_IN = (D / 64) * (9792 / 32), I_UQ = (QL / 64) * (3072 / 32), I_UK = (KVL / 64) * (2048 / 32), I_CACHE = SB * (PAST / 64) * (KVL / 32);
        constexpr int NIT = I_IN + I_UQ + 2 * I_UK + I_CACHE;
        for (int it = F.gw; it < NIT; it += F.NGW) {
            int r = it;
            if (tr_matrix(r, a.in[I_WIN], D, 9792, (bf16_t*)(ws + WS_WINT), D, a.in[I_GATT], scr, lane, 1600, 192, false, false, (unsigned char*)a.out + OS_WIN8, SC8_WI, QL)) continue;
            if (tr_matrix(r, a.in[I_WUQ], QL, 3072, nullptr, QL, a.in[I_GQA], scr, lane, 1 << 30, 0, false, true, ws + WS_WUQ8, SC8_Q)) continue;
            if (tr_matrix(r, a.in[I_WUK], KVL, 2048, (bf16_t*)(ws + WS_WUKVT), KVL, nullptr, scr, lane)) continue;
            if (tr_matrix(r, a.in[I_WUV], KVL, 2048, (bf16_t*)(ws + WS_WUKVT) + (size_t)2048 * KVL, KVL, nullptr, scr, lane)) continue;
            { const int b = r / ((PAST / 64) * (KVL / 32)), rr = r % ((PAST / 64) * (KVL / 32)), kb = rr / (KVL / 32), nb = rr % (KVL / 32);
              tr_item(a.in[I_CCKV] + (size_t)b * PAST * KVL, KVL, (bf16_t*)(ws + WS_CKVT) + (size_t)b * KVL * KT, KT, nullptr, 64 * kb, 32 * nb, 32 * nb, scr, lane,
                      nullptr, 0, -1, ws + WS_KC8 + (size_t)b * PAST * KVL, KVL); }
        }
    }
    for (int row = F.gw; row < M; row += F.NGW) {
        const float* src = row < MP ? a.in[I_XP] + (size_t)row * D : a.in[I_XS] + (size_t)(row - MP) * D;
        bf16_t* dst = (bf16_t*)((unsigned char*)a.out + OS_XB) + (size_t)row * D;
        float ss = 0.f;
#pragma unroll 4
        for (int j = 0; j < 16; ++j) { const f32x4 v = *(const f32x4*)(src + j * 256 + lane * 4); ss += v[0] * v[0] + v[1] * v[1] + v[2] * v[2] + v[3] * v[3];
            u32x2 o; o.x = cvtpk(v[0], v[1]); o.y = cvtpk(v[2], v[3]); *(u32x2*)(dst + j * 256 + lane * 4) = o;
            *(unsigned*)((unsigned char*)a.out + OS_XB8 + (size_t)row * D + j * 256 + lane * 4) = pk4_fp8(v[0] * SC8_X0, v[1] * SC8_X0, v[2] * SC8_X0, v[3] * SC8_X0); }
        ss = wave_sum(ss);
        if (lane == 0) ((float*)(ws + OFF_SSQ1))[row] = ss;
    }
    for (int it = F.gw; it < SB * PAST / 8; it += F.NGW) {
        const int kg = it * 8 + (lane >> 3), b = kg / PAST, key = kg % PAST, ch = lane & 7;
        const float* s = a.in[I_CKR] + (size_t)kg * ROPE + ch * 8;
        const f32x4 v0 = *(const f32x4*)s, v1 = *(const f32x4*)(s + 4);
        *(u32x4*)((bf16_t*)(ws + WS_KCAT) + ((size_t)b * KPAD + key) * KC + KVL + ch * 8) = pack8(v0, v1);
    }
    for (int it = F.gw; it < 512 * 2048 / 512; it += F.NGW) {
        const size_t e = (size_t)it * 512 + lane * 8; const int d = (int)(e & 127);
        const f32x4 v0 = *(const f32x4*)(a.in[I_WUK] + e), v1 = *(const f32x4*)(a.in[I_WUK] + e + 4);
        const f32x4 g0 = *(const f32x4*)(a.in[I_GKN] + d), g1 = *(const f32x4*)(a.in[I_GKN] + d + 4);
        *(u32x4*)((bf16_t*)(ws + WS_WUKN) + e) = pack8(v0 * g0, v1 * g1);
    }
    for (int it = F.gw; it < (4096 / 64) * (KVL / 8); it += F.NGW) { const int n = (it >> 6) * 64 + lane, c0 = (it & 63) * 8; float v[8];
        const float* src = n < 2048 ? a.in[I_WUK] + n : a.in[I_WUV] + (n - 2048);
#pragma unroll
        for (int j = 0; j < 8; ++j) v[j] = src[(size_t)(c0 + j) * 2048] * SC8_W;
        u32x2 o8; o8.x = pk4_fp8(v[0], v[1], v[2], v[3]); o8.y = pk4_fp8(v[4], v[5], v[6], v[7]); *(u32x2*)(ws + WS_WUKV8 + (size_t)n * KVL + c0) = o8; }
    for (int it = F.gw; it < NKEY * 32 / 64; it += F.NGW) {
        const int e = it * 64 + lane, pos = e >> 5, i = e & 31;
        const float ang = (float)pos * a.inv[i];
        const double rev = (double)ang * 0.15915494309189535; const float fr = (float)(rev - __builtin_rint(rev));
        ((float*)(ws + WS_ROPE))[e] = __builtin_amdgcn_cosf(fr);
        ((float*)(ws + WS_ROPE))[NKEY * 32 + e] = __builtin_amdgcn_sinf(fr);
    }
    for (int it = F.gw; it < HGW / 64; it += F.NGW) { const int j = it * 64 + lane; const float l0 = a.in[I_LB][j], l1 = a.in[I_LB][HGW + j]; ((float*)(ws + OFF_LB))[j] = 1.0f / (1.0f + __expf(l1 - l0)); }
    for (int row = F.gw; row < M; row += F.NGW) { const float* src = row < MP ? a.in[I_PP] + (size_t)row * PLE : a.in[I_PS] + (size_t)(row - MP) * PLE; const f32x4 v = *(const f32x4*)(src + 4 * lane);
        u32x2 o; o.x = cvtpk(v[0], v[1]); o.y = cvtpk(v[2], v[3]); *(u32x2*)((bf16_t*)(ws + WS_PB) + (size_t)row * PLE + 4 * lane) = o; }
    { constexpr int NITP = (PLE / 64) * (D / 32); for (int it = F.gw; it < NITP; it += F.NGW) { int r = it; tr_matrix(r, a.in[I_WPLE], PLE, D, (bf16_t*)(ws + WS_WPT), PLE, nullptr, scr, lane); } }
    zero16((bf16_t*)(ws + WS_WINT) + (size_t)1600 * D, (size_t)192 * D * 2, F.gw, F.NGW, lane);
    for (int b = 0; b < SB; ++b) zero16((bf16_t*)(ws + WS_KCAT) + ((size_t)b * KPAD + PAST) * KC, (size_t)(KPAD - PAST) * KC * 2, F.gw, F.NGW, lane);
    for (int it = F.gw; it < SB * KVL / 4; it += F.NGW) { const int rowi = it * 4 + (lane >> 4); *(u32x4*)((bf16_t*)(ws + WS_CKVT) + (size_t)rowi * KT + PAST + (lane & 15) * 8) = (u32x4){0u, 0u, 0u, 0u}; }
    zero16(ws + WS_SSK, (size_t)SB * KPAD * 16 * 4, F.gw, F.NGW, lane);
}

#define ACC_T const f32x4 (&acc)[2][2][4][2]
#ifndef NT_STORES
#define NT_STORES 1
#endif
DI void st_bf16x8(bf16_t* p, f32x4 a, f32x4 b) { const u32x4 w = pack8(a, b); if (NT_STORES) __builtin_nontemporal_store(w, (u32x4*)p); else *(u32x4*)p = w; }
DI void st_f32x8(float* p, f32x4 a, f32x4 b) { if (NT_STORES) { __builtin_nontemporal_store(a, (f32x4*)p); __builtin_nontemporal_store(b, (f32x4*)(p + 4)); } else { *(f32x4*)p = a; *(f32x4*)(p + 4) = b; } }
DI float dot8(f32x4 a, f32x4 b) { return (a[0] * a[0] + a[1] * a[1]) + (a[2] * a[2] + a[3] * a[3]) + (b[0] * b[0] + b[1] * b[1]) + (b[2] * b[2] + b[3] * b[3]); }

struct EpiInProj {
    unsigned char* ws; int pn_off; float sc; int s0 = 0, s1 = 8;
    DI void operator()(ACC_T, const pg8::Unit& u, int wr, int wc, int fr, int fq, int lane) const {
        const float* ssq1 = (const float*)(ws + OFF_SSQ1);
        const int row0 = u.pm * 256 + wr * 64 + fr, c8 = wc * 32 + 8 * fq, pn = u.pn + pn_off;
#pragma unroll
        for (int ai = 0; ai < 2; ++ai)
#pragma unroll
            for (int m = 0; m < 4; ++m) { if (ai * 4 + m < s0 || ai * 4 + m >= s1) continue;
                const int row = row0 + ai * 128 + m * 16;
                const float rs = rsqrtf(ssq1[row] * (1.f / D) + EPS) * sc;
                f32x4 v[2][2];
#pragma unroll
                for (int bj = 0; bj < 2; ++bj) { v[bj][0] = acc[ai][bj][m][0] * rs; v[bj][1] = acc[ai][bj][m][1] * rs; }
                if (pn < 4) {
                    float ss = 0.f;
#pragma unroll
                    for (int bj = 0; bj < 2; ++bj) { ss += dot8(v[bj][0], v[bj][1]);
                        u32x2 o8; o8.x = pk4_fp8(v[bj][0][0] * SC8_K, v[bj][0][1] * SC8_K, v[bj][0][2] * SC8_K, v[bj][0][3] * SC8_K); o8.y = pk4_fp8(v[bj][1][0] * SC8_K, v[bj][1][1] * SC8_K, v[bj][1][2] * SC8_K, v[bj][1][3] * SC8_K);
                        *(u32x2*)(ws + WS_CQ8 + (size_t)row * QL + pn * 256 + bj * 128 + c8) = o8; }
                    ss += __shfl_xor(ss, 16); ss += __shfl_xor(ss, 32);
                    if (fq == 0) unsafeAtomicAdd((float*)(ws + OFF_SSQQ) + row, ss);
                } else if (pn < 6) {
#pragma unroll
                    for (int bj = 0; bj < 2; ++bj) st_f32x8((float*)(ws + WS_CKVRAW) + (size_t)row * KVL + (pn - 4) * 256 + bj * 128 + c8, v[bj][0], v[bj][1]);
                } else if (pn == 6) {
                    if (wc < 2) st_f32x8((float*)(ws + WS_KRRAW) + (size_t)row * ROPE + c8, v[0][0], v[0][1]);
                } else if (pn < 15) {
#pragma unroll
                    for (int bj = 0; bj < 2; ++bj) st_bf16x8((bf16_t*)(ws + WS_HQ) + (size_t)row * HGW + (pn - 7) * 256 + bj * 128 + c8, v[bj][0], v[bj][1]);
                } else if (pn < 23) {
#pragma unroll
                    for (int bj = 0; bj < 2; ++bj) { const int col = (pn - 15) * 256 + bj * 128 + c8;
                        const f32x4 l0 = *(const f32x4*)((const float*)(ws + OFF_LB) + col), l1 = *(const f32x4*)((const float*)(ws + OFF_LB) + col + 4);
                        f32x4 lf[2], kk[2];
#pragma unroll
                        for (int n = 0; n < 2; ++n)
#pragma unroll
                            for (int e = 0; e < 4; ++e) { const float lb = n ? l1[e] : l0[e], x = v[bj][n][e], t = __expf(-fabsf(x)), ia = 1.0f / (1.0f + t), ib = t * ia, sg = x >= 0.f ? ia : ib, sgn = x >= 0.f ? ib : ia;
                                lf[n][e] = __logf(lb + (1.0f - lb) * sg); kk[n][e] = (1.0f - lb) * sgn; }
                        st_f32x8((float*)(ws + WS_LF) + (size_t)row * HGW + col, lf[0], lf[1]);
                        st_bf16x8((bf16_t*)(ws + WS_HK) + (size_t)row * HGW + col, kk[0], kk[1]); }
                } else if (pn < 31) {
#pragma unroll
                    for (int bj = 0; bj < 2; ++bj) st_bf16x8((bf16_t*)(ws + WS_HV) + (size_t)row * HGW + (pn - 23) * 256 + bj * 128 + c8, v[bj][0], v[bj][1]);
                } else {
#pragma unroll
                    for (int bj = 0; bj < 2; ++bj) { f32x4 g[2];
#pragma unroll
                        for (int n = 0; n < 2; ++n)
#pragma unroll
                            for (int e = 0; e < 4; ++e) { const float x = v[bj][n][e]; g[n][e] = x / (1.0f + __expf(-x)); }
                        st_bf16x8((bf16_t*)(ws + WS_HG) + (size_t)row * HGW + (pn - 31) * 256 + bj * 128 + c8, g[0], g[1]); }
                }
            }
    }
};
struct EpiSumsq {
    unsigned char* ws; float scale; int fix16;
    DI void operator()(ACC_T, const pg8::Unit& u, int wr, int wc, int fr, int fq, int lane) const {
        const int row0 = (u.pm + (fix16 ? u.pm >> 4 : 0)) * 256 + wr * 64 + fr;
#pragma unroll
        for (int ai = 0; ai < 2; ++ai)
#pragma unroll
            for (int bj = 0; bj < 2; ++bj) {
                float s[4];
#pragma unroll
                for (int m = 0; m < 4; ++m) { float t = dot8(acc[ai][bj][m][0], acc[ai][bj][m][1]); t += __shfl_xor(t, 16); t += __shfl_xor(t, 32); s[m] = t; }
                const float sv = fq == 0 ? s[0] : fq == 1 ? s[1] : fq == 2 ? s[2] : s[3];
                unsafeAtomicAdd((float*)(ws + WS_SSK) + (size_t)(u.pn * 2 + bj) * ((size_t)SB * KPAD) + (row0 + ai * 128 + fq * 16), sv * scale);
            }
    }
};
struct EpiUq {
    unsigned char* ws; const float* gqn; const float* gqr; LAS unsigned char* lds; float sc; int s0 = 0, s1 = 8;
    DI void operator()(ACC_T, const pg8::Unit& u, int wr, int wc, int fr, int fq, int lane) const {
        const float* ssq = (const float*)(ws + OFF_SSQQ);
        const int row0 = u.pm * 256 + wr * 64 + fr, c8 = wc * 32 + 8 * fq;
        LAS float* xs = (LAS float*)(lds + XCH_OFF);
#pragma unroll
        for (int ai = 0; ai < 2; ++ai)
#pragma unroll
            for (int m = 0; m < 4; ++m) { if (ai * 4 + m < s0 || ai * 4 + m >= s1) continue; const float rs = rsqrtf(ssq[row0 + ai * 128 + m * 16] * (1.f / QL) + EPS) * sc;
#pragma unroll
                for (int bj = 0; bj < 2; ++bj) { float s = dot8(acc[ai][bj][m][0] * rs, acc[ai][bj][m][1] * rs); s += __shfl_xor(s, 16); s += __shfl_xor(s, 32);
                    if (fq == 0) xs[((ai * 128 + wr * 64 + m * 16 + fr) * 2 + bj) * 4 + wc] = s; } }
        asm volatile("s_waitcnt lgkmcnt(0)" ::: "memory"); __builtin_amdgcn_s_barrier(); asm volatile("" ::: "memory");
        bf16_t* Q = (bf16_t*)(ws + WS_Q);
        if (u.pn < 8) {
            const f32x4 g0 = *(const f32x4*)(gqn + c8), g1 = *(const f32x4*)(gqn + c8 + 4);
#pragma unroll
            for (int ai = 0; ai < 2; ++ai)
#pragma unroll
                for (int m = 0; m < 4; ++m) { if (ai * 4 + m < s0 || ai * 4 + m >= s1) continue; const int row = row0 + ai * 128 + m * 16; const float rs = rsqrtf(ssq[row] * (1.f / QL) + EPS) * sc;
#pragma unroll
                    for (int bj = 0; bj < 2; ++bj) { const f32x4 p = *(const LAS f32x4*)(xs + ((ai * 128 + wr * 64 + m * 16 + fr) * 2 + bj) * 4);
                        const float rn = rsqrtf(((p[0] + p[1]) + (p[2] + p[3])) * (1.f / NOPE) + EPS) * rs;
                        const f32x4 y0 = acc[ai][bj][m][0] * rn * g0, y1 = acc[ai][bj][m][1] * rn * g1;
                        if (u.pm >= MP / 256) st_bf16x8(Q + (size_t)row * 3072 + (u.pn * 2 + bj) * QH + c8, y0, y1);
                        else { u32x2 o8; o8.x = pk4_fp8(y0[0] * SC8_A, y0[1] * SC8_A, y0[2] * SC8_A, y0[3] * SC8_A); o8.y = pk4_fp8(y1[0] * SC8_A, y1[1] * SC8_A, y1[2] * SC8_A, y1[3] * SC8_A);
                            *(u32x2*)(ws + WS_Q + (size_t)row * 3072 + (u.pn * 2 + bj) * QH + c8) = o8; } } }
        } else {
            const int i0 = 16 * (wc & 1) + 4 * fq, hw = wc >> 1; const bool smp = u.pm >= MP / 256;
            const f32x4 ga = *(const f32x4*)(gqr + i0), gb = *(const f32x4*)(gqr + 32 + i0);
            const float* ropec = (const float*)(ws + WS_ROPE); const float* ropes = ropec + NKEY * 32;
#pragma unroll
            for (int ai = 0; ai < 2; ++ai)
#pragma unroll
                for (int m = 0; m < 4; ++m) { if (ai * 4 + m < s0 || ai * 4 + m >= s1) continue; const int row = row0 + ai * 128 + m * 16; const float rs = rsqrtf(ssq[row] * (1.f / QL) + EPS) * sc;
                    const int pos = smp ? PAST + ((row - MP) & 15) : (row & (SEQ - 1));
                    const f32x4 c = *(const f32x4*)(ropec + pos * 32 + i0), s = *(const f32x4*)(ropes + pos * 32 + i0);
#pragma unroll
                    for (int bj = 0; bj < 2; ++bj) { const f32x4 p = *(const LAS f32x4*)(xs + ((ai * 128 + wr * 64 + m * 16 + fr) * 2 + bj) * 4);
                        const float rr = rsqrtf((hw ? p[2] + p[3] : p[0] + p[1]) * (1.f / ROPE) + EPS) * rs;
                        const f32x4 y1 = acc[ai][bj][m][0] * rr * ga, y2 = acc[ai][bj][m][1] * rr * gb, o1 = y1 * c - y2 * s, o2 = y2 * c + y1 * s;
                        u32x2 w1, w2; w1.x = cvtpk(o1[0], o1[1]); w1.y = cvtpk(o1[2], o1[3]); w2.x = cvtpk(o2[0], o2[1]); w2.y = cvtpk(o2[2], o2[3]);
                        const int h = 4 * (u.pn - 8) + 2 * bj + hw;
                        if (smp) { bf16_t* qp = Q + (size_t)row * 3072 + h * QH + NOPE + i0; *(u32x2*)qp = w1; *(u32x2*)(qp + 32) = w2; }
                        else { unsigned char* q8 = ws + WS_Q + (size_t)row * 3072 + h * QH + NOPE + i0; *(unsigned*)q8 = pk4_fp8(o1[0] * SC8_A, o1[1] * SC8_A, o1[2] * SC8_A, o1[3] * SC8_A); *(unsigned*)(q8 + 32) = pk4_fp8(o2[0] * SC8_A, o2[1] * SC8_A, o2[2] * SC8_A, o2[3] * SC8_A); }
                        if (smp) { bf16_t* qc = (bf16_t*)(ws + WS_QCAT) + ((size_t)(row - MP) * 16 + h) * KC + KVL + i0; *(u32x2*)qc = w1; *(u32x2*)(qc + 32) = w2; } } }
        }
        asm volatile("s_waitcnt lgkmcnt(0)" ::: "memory"); __builtin_amdgcn_s_barrier(); asm volatile("" ::: "memory");
    }
};

DI void p2_norm_rows(const Frame& F, const Args& a) {
    unsigned char* ws = a.ws; const int lane = lane_id();
    const float* ropec = (const float*)(ws + WS_ROPE); const float* ropes = ropec + NKEY * 32;
    for (int row = F.gw; row < M; row += F.NGW) {
        const bool smp = row >= MP; const int sr = row - MP, sb = sr >> 4, st = sr & 15;
        const float* cr = (const float*)(ws + WS_CKVRAW) + (size_t)row * KVL;
        f32x4 v0 = *(const f32x4*)(cr + 4 * lane), v1 = *(const f32x4*)(cr + 256 + 4 * lane);
        float ss = (v0[0] * v0[0] + v0[1] * v0[1]) + (v0[2] * v0[2] + v0[3] * v0[3]) + (v1[0] * v1[0] + v1[1] * v1[1]) + (v1[2] * v1[2] + v1[3] * v1[3]);
        ss = wave_sum(ss);
        const float rs = rsqrtf(ss * (1.f / KVL) + EPS);
        const f32x4 g0 = *(const f32x4*)(a.in[I_GKVA] + 4 * lane), g1 = *(const f32x4*)(a.in[I_GKVA] + 256 + 4 * lane);
        v0 = v0 * rs * g0; v1 = v1 * rs * g1;
        float* oc = a.out + (smp ? O_CKVS + (size_t)sr * KVL : O_CKVP + (size_t)row * KVL);
        *(f32x4*)(oc + 4 * lane) = v0; *(f32x4*)(oc + 256 + 4 * lane) = v1;
        u32x2 w0, w1; w0.x = cvtpk(v0[0], v0[1]); w0.y = cvtpk(v0[2], v0[3]); w1.x = cvtpk(v1[0], v1[1]); w1.y = cvtpk(v1[2], v1[3]);
        { unsigned char* c8p = ws + WS_CKVN8 + (size_t)row * KVL; *(unsigned*)(c8p + 4 * lane) = pk4_fp8(v0[0] * SC8_K, v0[1] * SC8_K, v0[2] * SC8_K, v0[3] * SC8_K); *(unsigned*)(c8p + 256 + 4 * lane) = pk4_fp8(v1[0] * SC8_K, v1[1] * SC8_K, v1[2] * SC8_K, v1[3] * SC8_K); }
        if (smp) {
            bf16_t* kc = (bf16_t*)(ws + WS_KCAT) + ((size_t)sb * KPAD + PAST + st) * KC;
            *(u32x2*)(kc + 4 * lane) = w0; *(u32x2*)(kc + 256 + 4 * lane) = w1;
            bf16_t* ct = (bf16_t*)(ws + WS_CKVT) + (size_t)sb * KVL * KT + PAST + st;
            const unsigned e0[4] = {w0.x & 0xffffu, w0.x >> 16, w0.y & 0xffffu, w0.y >> 16}, e1[4] = {w1.x & 0xffffu, w1.x >> 16, w1.y & 0xffffu, w1.y >> 16};
#pragma unroll
            for (int e = 0; e < 4; ++e) { ct[(size_t)(4 * lane + e) * KT] = (bf16_t)e0[e]; ct[(size_t)(256 + 4 * lane + e) * KT] = (bf16_t)e1[e]; }
        }
        const float kv = ((const float*)(ws + WS_KRRAW))[(size_t)row * ROPE + lane];
        const float s2 = wave_sum(kv * kv);
        const float y = kv * rsqrtf(s2 * (1.f / ROPE) + EPS) * a.in[I_GKR][lane];
        const float yo = __shfl_xor(y, 32);
        const int pos = smp ? PAST + st : (row & (SEQ - 1)), i = lane & 31;
        const float c = ropec[pos * 32 + i], s = ropes[pos * 32 + i];
        const float o = lane < 32 ? y * c - yo * s : y * c + yo * s;
        (a.out + (smp ? O_KRS + (size_t)sr * ROPE : O_KRP + (size_t)row * ROPE))[lane] = o;
        const bf16_t ob = f2bf(o);
        if (!smp) (ws + WS_KRN)[(size_t)row * ROPE + lane] = (unsigned char)(pk4_fp8(o * SC8_A, 0.f, 0.f, 0.f) & 0xffu);
        if (smp) ((bf16_t*)(ws + WS_KCAT))[((size_t)sb * KPAD + PAST + st) * KC + KVL + lane] = ob;
    }
}

struct EpiKup {
    unsigned char* ws; const float* gkn; LAS unsigned char* lds; float sc;
    DI void operator()(ACC_T, const pg8::Unit& u, int wr, int wc, int fr, int fq, int lane) const {
        const int row0 = u.pm * 256 + wr * 64 + fr, c8 = wc * 32 + 8 * fq;
        if (u.pn >= 8) { bf16_t* base = (bf16_t*)(ws + WS_V) + (u.pn & 7) * 256 + c8;
#pragma unroll
            for (int ai = 0; ai < 2; ++ai)
#pragma unroll
                for (int m = 0; m < 4; ++m)
#pragma unroll
                    for (int bj = 0; bj < 2; ++bj) st_bf16x8(base + (size_t)(row0 + ai * 128 + m * 16) * 2048 + bj * 128, acc[ai][bj][m][0] * sc, acc[ai][bj][m][1] * sc);
            return; }
        LAS float* xs = (LAS float*)(lds + XCH_OFF);
#pragma unroll
        for (int ai = 0; ai < 2; ++ai)
#pragma unroll
            for (int m = 0; m < 4; ++m)
#pragma unroll
                for (int bj = 0; bj < 2; ++bj) { float s = dot8(acc[ai][bj][m][0] * sc, acc[ai][bj][m][1] * sc); s += __shfl_xor(s, 16); s += __shfl_xor(s, 32);
                    if (fq == 0) xs[((ai * 128 + wr * 64 + m * 16 + fr) * 2 + bj) * 4 + wc] = s; }
        asm volatile("s_waitcnt lgkmcnt(0)" ::: "memory"); __builtin_amdgcn_s_barrier(); asm volatile("" ::: "memory");
        const f32x4 g0 = *(const f32x4*)(gkn + c8), g1 = *(const f32x4*)(gkn + c8 + 4);
        unsigned char* base = ws + WS_KN + (u.pn & 7) * 256 + c8;
#pragma unroll
        for (int ai = 0; ai < 2; ++ai)
#pragma unroll
            for (int m = 0; m < 4; ++m)
#pragma unroll
                for (int bj = 0; bj < 2; ++bj) { const f32x4 p = *(const LAS f32x4*)(xs + ((ai * 128 + wr * 64 + m * 16 + fr) * 2 + bj) * 4);
                    const float rn = rsqrtf(((p[0] + p[1]) + (p[2] + p[3])) * (1.f / NOPE) + EPS) * sc;
                    const f32x4 y0 = acc[ai][bj][m][0] * (rn * SC8_A) * g0, y1 = acc[ai][bj][m][1] * (rn * SC8_A) * g1;
                    u32x2 o8; o8.x = pk4_fp8(y0[0], y0[1], y0[2], y0[3]); o8.y = pk4_fp8(y1[0], y1[1], y1[2], y1[3]); *(u32x2*)(base + (size_t)(row0 + ai * 128 + m * 16) * 2048 + bj * 128) = o8; }
        asm volatile("s_waitcnt lgkmcnt(0)" ::: "memory"); __builtin_amdgcn_s_barrier(); asm volatile("" ::: "memory");
    }
};
DI int crow(int r, int hi) { return (r & 3) + 8 * (r >> 2) + 4 * hi; }
template <int NJ, bool AF32, class Mid>
DI void sgemm_tile(const void* Av, size_t lda, const bf16_t* Bt, size_t ldb, int K, int mid_k, const Mid& mid, f32x16 (&acc)[2][NJ], int wave, int lane) {
    const int wm = wave >> 2, wn = wave & 3, r32 = lane & 31, hi = lane >> 5;
#pragma unroll
    for (int i = 0; i < 2; ++i)
#pragma unroll
        for (int j = 0; j < NJ; ++j)
#pragma unroll
            for (int r = 0; r < 16; ++r) acc[i][j][r] = 0.f;
    const bf16_t* bp[NJ];
#pragma unroll
    for (int j = 0; j < NJ; ++j) bp[j] = Bt + (size_t)(wn * 32 * NJ + j * 32 + r32) * ldb + hi * 8;
    if constexpr (AF32) {
        for (int k0 = 0; k0 < K; k0 += 16) {
            bf16x8 af[2], bf_[NJ];
#pragma unroll
            for (int i = 0; i < 2; ++i) { const float* p = (const float*)Av + (size_t)(wm * 64 + i * 32 + r32) * lda + hi * 8 + k0; af[i] = __builtin_bit_cast(bf16x8, pack8(*(const f32x4*)p, *(const f32x4*)(p + 4))); }
#pragma unroll
            for (int j = 0; j < NJ; ++j) bf_[j] = *(const bf16x8*)(bp[j] + k0);
#pragma unroll
            for (int i = 0; i < 2; ++i)
#pragma unroll
                for (int j = 0; j < NJ; ++j) acc[i][j] = __builtin_amdgcn_mfma_f32_32x32x16_bf16(af[i], bf_[j], acc[i][j], 0, 0, 0);
        }
    } else {
    for (int k0 = 0; k0 < K; k0 += 64) {
        bf16x8 af[2][4], bf_[NJ][4];
#pragma unroll
        for (int i = 0; i < 2; ++i)
#pragma unroll
            for (int ks = 0; ks < 4; ++ks) af[i][ks] = *(const bf16x8*)((const bf16_t*)Av + (size_t)(wm * 64 + i * 32 + r32) * lda + hi * 8 + k0 + ks * 16);
#pragma unroll
        for (int j = 0; j < NJ; ++j)
#pragma unroll
            for (int ks = 0; ks < 4; ++ks) bf_[j][ks] = *(const bf16x8*)(bp[j] + k0 + ks * 16);
        if (k0 == mid_k) mid(acc);
#pragma unroll
        for (int ks = 0; ks < 4; ++ks)
#pragma unroll
            for (int i = 0; i < 2; ++i)
#pragma unroll
                for (int j = 0; j < NJ; ++j) acc[i][j] = __builtin_amdgcn_mfma_f32_32x32x16_bf16(af[i][ks], bf_[j][ks], acc[i][j], 0, 0, 0);
    }
    }
}
struct NoMid { template <class T> DI void operator()(T&) const {} };

DI void p4_qa_unit(const Frame& F, const Args& a, int unit) {
    unsigned char* ws = a.ws; const int h = unit >> 3, mt = (unit >> 1) & 3, nt = unit & 1;
    f32x16 acc[2][2];
    sgemm_tile<2, false>((const bf16_t*)(ws + WS_Q) + (size_t)(MP + mt * 128) * 3072 + h * QH, 3072, (const bf16_t*)(ws + WS_WUKN) + (size_t)(nt * 256) * 2048 + h * 128, 2048, NOPE, -1, NoMid(), acc, F.wave, lane_id());
    const int wm = F.wave >> 2, wn = F.wave & 3, r32 = lane_id() & 31, hi = lane_id() >> 5;
#pragma unroll
    for (int i = 0; i < 2; ++i)
#pragma unroll
        for (int j = 0; j < 2; ++j)
#pragma unroll
            for (int r = 0; r < 16; ++r) { const int t = mt * 128 + wm * 64 + i * 32 + crow(r, hi), c = nt * 256 + wn * 64 + j * 32 + r32;
                ((bf16_t*)(ws + WS_QCAT))[((size_t)t * 16 + h) * KC + c] = f2bf(acc[i][j][r]); }
    __builtin_amdgcn_sched_barrier(0);
#pragma unroll
    for (int i = 0; i < 2; ++i)
#pragma unroll
        for (int j = 0; j < 2; ++j)
#pragma unroll
            for (int r4 = 0; r4 < 4; ++r4) {
#pragma unroll
                for (int e = 0; e < 4; ++e) { const int r = 4 * r4 + e, t = mt * 128 + wm * 64 + i * 32 + crow(r, hi), c = nt * 256 + wn * 64 + j * 32 + r32;
                    (ws + WS_QCAT8)[((size_t)t * 16 + h) * KVL + c] = (unsigned char)(pk4_fp8(acc[i][j][r] * SC8_QA, 0.f, 0.f, 0.f) & 0xffu); }
                __builtin_amdgcn_sched_barrier(0); }
}

namespace att {
constexpr int SHM_K = 64 * 256  , SHM_V = 64 * 128 * 2;
constexpr int OFF_V = 0, OFF_K = 2 * SHM_V, OFF_WS = OFF_K + 2 * SHM_K, LDS_NEED = OFF_WS + 8 * 64 * 4;
static_assert(LDS_NEED <= RING_BYTES, "attention LDS");
#define KSWZ(row, colB) ((row) * 256 + ((colB) ^ (((row) & 7) << 4)))
#define SBAR() __builtin_amdgcn_sched_barrier(0)
DI int v_st(int k, int c) { const int kk = (k & ~0xC) | ((k & 4) << 1) | ((k & 8) >> 1); return ((kk >> 3) * 4 + (c >> 5)) * 512 + ((kk & 7) * 32 + (c & 31)) * 2; }
DI int v_rd_base(int lane) { return ((lane & 3) << 3) | (((lane >> 2) & 3) << 6) | (((lane >> 4) & 1) << 5) | (((lane >> 5) & 1) << 8); }
constexpr float THR = 8.f;
constexpr float ASC = ATT_SCALE / (SC8_A * SC8_A);
constexpr float C2 = 1.4426950408889634f * ASC;

DI void partialSM(f32x16& p0, f32x16& p1, float& m_reg, float& mn, float& alpha) {
    float pmax = p0[0];
#pragma unroll
    for (int r = 1; r < 16; ++r) pmax = fmaxf(pmax, p0[r]);
#pragma unroll
    for (int r = 0; r < 16; ++r) pmax = fmaxf(pmax, p1[r]);
    { auto rr = __builtin_amdgcn_permlane32_swap(__float_as_uint(pmax), __float_as_uint(pmax), false, false);
      pmax = fmaxf(__uint_as_float(rr[0]), __uint_as_float(rr[1])); }
    if (__builtin_expect(__all((pmax - m_reg) * ASC <= THR), 1)) { mn = m_reg; alpha = 1.f; }
    else { mn = fmaxf(m_reg, pmax); alpha = __builtin_amdgcn_exp2f((m_reg - mn) * C2); m_reg = mn; }
    const float mnL = -mn * C2;
#pragma unroll
    for (int r = 0; r < 16; ++r) p0[r] = fmaf(p0[r], C2, mnL);
#pragma unroll
    for (int r = 0; r < 16; ++r) p1[r] = fmaf(p1[r], C2, mnL);
#pragma unroll
    for (int r = 0; r < 16; ++r) p0[r] = __builtin_amdgcn_exp2f(p0[r]);
}
DI void finishSM(f32x16& p0, f32x16& p1, float alpha, float& l_reg, bf16x8& pa0, bf16x8& pa1, bf16x8& pa2, bf16x8& pa3) {
#pragma unroll
    for (int r = 0; r < 16; ++r) p1[r] = __builtin_amdgcn_exp2f(p1[r]);
    float ps = 0;
#pragma unroll
    for (int r = 0; r < 16; ++r) ps += p0[r];
#pragma unroll
    for (int r = 0; r < 16; ++r) ps += p1[r];
    { auto rr = __builtin_amdgcn_permlane32_swap(__float_as_uint(ps), __float_as_uint(ps), false, false);
      ps = __uint_as_float(rr[0]) + __uint_as_float(rr[1]); }
    l_reg = l_reg * alpha + ps;
#define PK4(P, B_, OUT) do { unsigned a0 = cvtpk(P[B_+0], P[B_+1]), a1 = cvtpk(P[B_+2], P[B_+3]);                          \
        unsigned b0 = cvtpk(P[B_+4], P[B_+5]), b1 = cvtpk(P[B_+6], P[B_+7]);                                             \
        auto r0 = __builtin_amdgcn_permlane32_swap(a0, b0, false, false); auto r1 = __builtin_amdgcn_permlane32_swap(a1, b1, false, false); \
        u32x4 w = {r0[0], r1[0], r0[1], r1[1]}; OUT = __builtin_bit_cast(bf16x8, w); } while (0)
    PK4(p0, 0, pa0); PK4(p0, 8, pa1); PK4(p1, 0, pa2); PK4(p1, 8, pa3);
#undef PK4
}
template <int KB>
DI void qkt(f32x16& p0, f32x16& p1, const LAS char* lds, int r32, int hi, const i32x8* q8, bool act) {
    if (!act) { const float NEG = -__builtin_inff();
#pragma unroll
        for (int r = 0; r < 16; ++r) { p0[r] = NEG; p1[r] = NEG; } return; }
#pragma unroll
    for (int r = 0; r < 16; ++r) { p0[r] = 0.f; p1[r] = 0.f; }
    int kb0 = KSWZ(r32, hi * 32);
    asm volatile("" : "+v"(kb0));
#define QK_LD(s, kb, dst) do { const LAS char* a0_ = lds + OFF_K + KB * SHM_K + (kb0 ^ (64 * ((s) & 1))) + 128 * ((s) >> 1) + (kb) * 32 * 256; const LAS char* a1_ = lds + OFF_K + KB * SHM_K + (kb0 ^ (64 * ((s) & 1) + 16)) + 128 * ((s) >> 1) + (kb) * 32 * 256; \
        dst.lo = *(const LAS i32x4*)a0_; dst.hi = *(const LAS i32x4*)a1_; } while (0)
    { i32x8 ka, kb_; QK_LD(0, 0, ka); QK_LD(0, 1, kb_);
      asm volatile("s_nop 1\n\tv_mfma_f32_32x32x64_f8f6f4 %0, %1, %2, %0" : "+v"(p0) : "v"(ka), "v"(q8[0]));
      asm volatile("s_nop 1\n\tv_mfma_f32_32x32x64_f8f6f4 %0, %1, %2, %0" : "+v"(p1) : "v"(kb_), "v"(q8[0])); }
    { i32x8 ka, kb_; QK_LD(1, 0, ka); QK_LD(1, 1, kb_);
      asm volatile("v_mfma_f32_32x32x64_f8f6f4 %0, %1, %2, %0" : "+v"(p0) : "v"(ka), "v"(q8[1]));
      asm volatile("v_mfma_f32_32x32x64_f8f6f4 %0, %1, %2, %0" : "+v"(p1) : "v"(kb_), "v"(q8[1])); }
    { i32x8 ka, kb_; QK_LD(2, 0, ka); QK_LD(2, 1, kb_);
      asm volatile("v_mfma_f32_32x32x64_f8f6f4 %0, %1, %2, %0" : "+v"(p0) : "v"(ka), "v"(q8[2]));
      asm volatile("v_mfma_f32_32x32x64_f8f6f4 %0, %1, %2, %0\n\ts_nop 15\n\ts_nop 7" : "+v"(p1) : "v"(kb_), "v"(q8[2])); }
#undef QK_LD
}
template <int VB>
DI void pv_tile(f32x16* o, int vb0, bf16x8 pa0, bf16x8 pa1, bf16x8 pa2, bf16x8 pa3, bool act) {
    if (!act) return;
#define TRRD(dst, off) asm volatile("ds_read_b64_tr_b16 %0, %1 offset:%2" : "=&v"(dst) : "v"(vb0), "i"(off) : "memory")
#define PV_RD(d0, S) do { constexpr int b_ = OFF_V + VB * SHM_V + (d0) * 512; \
        TRRD(S##l0, b_); TRRD(S##h0, b_ + 2048); TRRD(S##l1, b_ + 4096); TRRD(S##h1, b_ + 6144); TRRD(S##l2, b_ + 8192); TRRD(S##h2, b_ + 10240); TRRD(S##l3, b_ + 12288); TRRD(S##h3, b_ + 14336); } while (0)
#define PV_MM(d0, S) do { \
        o[d0] = __builtin_amdgcn_mfma_f32_32x32x16_bf16(pa0, (bf16x8){S##l0[0], S##l0[1], S##l0[2], S##l0[3], S##h0[0], S##h0[1], S##h0[2], S##h0[3]}, o[d0], 0, 0, 0);   \
        o[d0] = __builtin_amdgcn_mfma_f32_32x32x16_bf16(pa1, (bf16x8){S##l1[0], S##l1[1], S##l1[2], S##l1[3], S##h1[0], S##h1[1], S##h1[2], S##h1[3]}, o[d0], 0, 0, 0);   \
        o[d0] = __builtin_amdgcn_mfma_f32_32x32x16_bf16(pa2, (bf16x8){S##l2[0], S##l2[1], S##l2[2], S##l2[3], S##h2[0], S##h2[1], S##h2[2], S##h2[3]}, o[d0], 0, 0, 0);   \
        o[d0] = __builtin_amdgcn_mfma_f32_32x32x16_bf16(pa3, (bf16x8){S##l3[0], S##l3[1], S##l3[2], S##l3[3], S##h3[0], S##h3[1], S##h3[2], S##h3[3]}, o[d0], 0, 0, 0); } while (0)
    s16x4 Al0, Al1, Al2, Al3, Ah0, Ah1, Ah2, Ah3, Bl0, Bl1, Bl2, Bl3, Bh0, Bh1, Bh2, Bh3;
    PV_RD(0, A);
    PV_RD(1, B); asm volatile("s_waitcnt lgkmcnt(8)" ::: "memory"); SBAR(); PV_MM(0, A); SBAR();
    PV_RD(2, A); asm volatile("s_waitcnt lgkmcnt(8)" ::: "memory"); SBAR(); PV_MM(1, B); SBAR();
    PV_RD(3, B); asm volatile("s_waitcnt lgkmcnt(8)" ::: "memory"); SBAR(); PV_MM(2, A); SBAR();
    asm volatile("s_waitcnt lgkmcnt(0)" ::: "memory"); SBAR(); PV_MM(3, B);
#undef PV_RD
#undef PV_MM
#undef TRRD
}

DI void attn_unit(int b, int h, int qb, const unsigned char* __restrict__ Q8, const unsigned char* __restrict__ KN8, const unsigned char* __restrict__ KR8, const bf16_t* __restrict__ V, bf16_t* __restrict__ O, LAS char* lds, int wid) {
    const int lane = lane_id(), tid = wid * 64 + lane, r32 = lane & 31, hi = lane >> 5;
    const int NT = 4 * qb + 4, wchunk = 4 * qb + (wid >> 1);
    const size_t krow0 = (size_t)b * SEQ;
    const unsigned char* Kh = KN8 + krow0 * 2048 + h * 128; const bf16_t* Vh = V + krow0 * 2048 + h * 128; const unsigned char* Rh = KR8 + krow0 * ROPE;
    LAS float* wsl = (LAS float*)(lds + OFF_WS) + wid * 64; LAS float* li_l = wsl; LAS float* al_l = wsl + 32;
    float m_reg = -1e30f, l_reg = 0; f32x16 o[4];
#pragma unroll
    for (int d = 0; d < 4; ++d)
#pragma unroll
        for (int r = 0; r < 16; ++r) o[d][r] = 0.f;
    const int sr = tid >> 4, sc = (tid & 15) * 8, vst0 = v_st(sr, sc), vst1 = v_st(32 + sr, sc);
    const int rr_ = tid >> 3, rc = tid & 7, kws = KSWZ(rr_, rc * 16), krws = KSWZ(rr_, 128 + rc * 8);
    const int vb0 = (int)(unsigned)(size_t)(lds) + v_rd_base(lane);
    i32x8 q8[3];
    { const unsigned char* qp = Q8 + ((size_t)b * SEQ + qb * 256 + wid * 32 + r32) * 3072 + h * QH + hi * 32;
#pragma unroll
      for (int s = 0; s < 3; ++s) { q8[s].lo = *(const i32x4*)(qp + 64 * s); q8[s].hi = *(const i32x4*)(qp + 64 * s + 16); } }
    bf16x8 st_v0, st_v1; u32x4 st_k; u32x2 st_kr;
#define SLOAD(k0) do { st_v0 = *(const bf16x8*)(Vh + (size_t)((k0) + sr) * 2048 + sc); st_v1 = *(const bf16x8*)(Vh + (size_t)((k0) + 32 + sr) * 2048 + sc); \
                       st_k = *(const u32x4*)(Kh + (size_t)((k0) + rr_) * 2048 + rc * 16); st_kr = *(const u32x2*)(Rh + (size_t)((k0) + rr_) * ROPE + rc * 8); } while (0)
#define SWRITE(bf) do { *(LAS bf16x8*)(lds + OFF_V + (bf) * SHM_V + vst0) = st_v0; *(LAS bf16x8*)(lds + OFF_V + (bf) * SHM_V + vst1) = st_v1; \
                        *(LAS u32x4*)(lds + OFF_K + (bf) * SHM_K + kws) = st_k; *(LAS u32x2*)(lds + OFF_K + (bf) * SHM_K + krws) = st_kr; } while (0)
#define VMW() asm volatile("s_waitcnt vmcnt(0)" ::: "memory")
#define RESC(a_) do { if (__any((a_) < 1.f)) { if (hi == 0) al_l[r32] = (a_); asm volatile("s_waitcnt lgkmcnt(0)" ::: "memory");              \
                     for (int d_ = 0; d_ < 4; ++d_) for (int r = 0; r < 16; ++r) o[d_][r] *= al_l[crow(r, hi)]; } } while (0)
#define ACT(t) ((t) <= wchunk)
    f32x16 pA0, pA1, pB0, pB1; float mnA, mnB, alA, alB; bf16x8 pa0, pa1, pa2, pa3;
    SLOAD(0); VMW(); SWRITE(0);
    __syncthreads();
    if (NT > 1) SLOAD(64);
    SBAR(); qkt<0>(pA0, pA1, lds, r32, hi, q8, ACT(0));
    partialSM(pA0, pA1, m_reg, mnA, alA);
    if (NT > 1) { VMW(); SWRITE(1); }
    __syncthreads();
#define HALF_STEP(ORD, PX0, PX1, mnX, alX, PY0, PY1, alY, t, KB, VB, SB_) do {                                                      \
        if (ORD == 0) {                                                                                                       \
        SBAR(); qkt<KB>(PX0, PX1, lds, r32, hi, q8, ACT(t));                                             \
        finishSM(PY0, PY1, alY, l_reg, pa0, pa1, pa2, pa3); SBAR();                                                           \
        if ((t) + 1 < NT) { SLOAD(((t) + 1) * 64); SBAR(); }                                               \
        pv_tile<VB>(o, vb0, pa0, pa1, pa2, pa3, ACT((t) - 1)); partialSM(PX0, PX1, m_reg, mnX, alX);                                        \
        } else {                                                                                                              \
        SBAR(); finishSM(PY0, PY1, alY, l_reg, pa0, pa1, pa2, pa3); SBAR();                                                   \
        qkt<KB>(PX0, PX1, lds, r32, hi, q8, ACT(t)); SBAR();                                             \
        if ((t) + 1 < NT) { SLOAD(((t) + 1) * 64); SBAR(); }                                               \
        partialSM(PX0, PX1, m_reg, mnX, alX); pv_tile<VB>(o, vb0, pa0, pa1, pa2, pa3, ACT((t) - 1));                                        \
        }                                                                                                                     \
        __syncthreads();                                                                                                      \
        if ((t) + 1 < NT) { VMW(); SWRITE(SB_); }                                                                          \
        RESC(alX); __syncthreads(); } while (0)
    if (wid < 4) {
        for (int t = 1; t + 1 < NT; t += 2) {
            HALF_STEP(0, pB0, pB1, mnB, alB, pA0, pA1, alA, t, 1, 0, 0);
            HALF_STEP(0, pA0, pA1, mnA, alA, pB0, pB1, alB, t + 1, 0, 1, 1);
        }
    } else {
        for (int t = 1; t + 1 < NT; t += 2) {
            HALF_STEP(1, pB0, pB1, mnB, alB, pA0, pA1, alA, t, 1, 0, 0);
            HALF_STEP(1, pA0, pA1, mnA, alA, pB0, pB1, alB, t + 1, 0, 1, 1);
        }
    }
    SBAR(); qkt<1>(pB0, pB1, lds, r32, hi, q8, ACT(NT - 1)); SBAR();
    finishSM(pA0, pA1, alA, l_reg, pa0, pa1, pa2, pa3); SBAR();
    pv_tile<0>(o, vb0, pa0, pa1, pa2, pa3, ACT(NT - 2));
    partialSM(pB0, pB1, m_reg, mnB, alB); RESC(alB);
    finishSM(pB0, pB1, alB, l_reg, pa0, pa1, pa2, pa3); SBAR(); pv_tile<1>(o, vb0, pa0, pa1, pa2, pa3, ACT(NT - 1));
    if (hi == 0) li_l[r32] = l_reg; asm volatile("s_waitcnt lgkmcnt(0)" ::: "memory");
    float rli[16];
#pragma unroll
    for (int r = 0; r < 16; ++r) rli[r] = __builtin_amdgcn_rcpf(li_l[crow(r, hi)]);
    int r32e = r32, hie = hi; asm volatile("" : "+v"(r32e), "+v"(hie));
    bf16_t* Ow = O + ((size_t)b * SEQ + qb * 256 + wid * 32) * D + h * 128 + r32e;
#pragma unroll
    for (int r = 0; r < 16; ++r) { const int orow = crow(r, hie);
#pragma unroll
        for (int d0 = 0; d0 < 4; ++d0) { const float v = o[d0][r] * rli[r]; const float vn = __shfl_xor(v, 1);
            if ((r32e & 1) == 0) *(unsigned*)(Ow + (size_t)orow * D + d0 * 32) = cvtpk(v, vn); } }
    __syncthreads();
#undef SLOAD
#undef SWRITE
#undef VMW
#undef RESC
#undef ACT
#undef HALF_STEP
}
#undef KSWZ
#undef SBAR
}

namespace hg {
constexpr int P = 136, KP = 72, OP = 132;
constexpr int OFF_QE = 0, OFF_QD = 17408, OFF_KDD = 34816, OFF_KDT = 52224, OFF_V = 70656, OFF_AM = 88064, OFF_T = 97280, OFF_DL = 101376, OFF_OX = OFF_QD, LDS_NEED = 101888;
static_assert(OFF_OX + 64 * OP * 4 <= OFF_KDT && LDS_NEED <= RING_BYTES, "hgrn LDS");
DI bf16x8 mk8(u32x2 a, u32x2 b) { u32x4 w = {a.x, a.y, b.x, b.y}; return __builtin_bit_cast(bf16x8, w); }

DI void hgrn_unit(const Args& a, bool smp, int bb, int h, LAS char* lds, int w) {
    unsigned char* ws = a.ws;
    const int lane = lane_id(), tid = w * 64 + lane, n = lane & 15, g = lane >> 4;
    const int nch = smp ? 1 : SEQ / 64, nrow = smp ? ST : 64;
    const size_t row_base = smp ? (size_t)MP + (size_t)bb * ST : (size_t)bb * SEQ;
    const bf16_t* HQ = (const bf16_t*)(ws + WS_HQ) + h * HGD; const bf16_t* HK = (const bf16_t*)(ws + WS_HK) + h * HGD; const bf16_t* HV = (const bf16_t*)(ws + WS_HV) + h * HGD;
    const bf16_t* HGt = (const bf16_t*)(ws + WS_HG) + h * HGD; const float* LF = (const float*)(ws + WS_LF) + h * HGD;
    f32x4 sacc[8];
    float* sout = a.out + (smp ? O_HGS : O_HGP) + ((size_t)bb * HGH + h) * HGD * HGD;
    if (smp) { const float* s0 = a.in[I_SHG] + ((size_t)bb * HGH + h) * HGD * HGD;
#pragma unroll
        for (int kb = 0; kb < 8; ++kb)
#pragma unroll
            for (int i = 0; i < 4; ++i) sacc[kb][i] = s0[(size_t)(16 * kb + 4 * g + i) * HGD + 16 * w + n]; }
    else {
#pragma unroll
        for (int kb = 0; kb < 8; ++kb) sacc[kb] = (f32x4){0.f, 0.f, 0.f, 0.f}; }
    const int c0 = 2 * lane, vrow = tid >> 3, vg = tid & 7;
    f32x2 lfv[8]; unsigned qv[8], kv[8]; u32x4 vraw[2], graw[2];
#define HG_LOAD(cc) do { const size_t r0_ = row_base + (size_t)(cc) * 64; \
        _Pragma("unroll") for (int j = 0; j < 8; ++j) { const int t_ = 8 * w + j; const bool ok_ = t_ < nrow; const size_t ro_ = (r0_ + (ok_ ? t_ : 0)) * HGW + c0; \
            lfv[j] = ok_ ? *(const f32x2*)(LF + ro_) : (f32x2){0.f, 0.f}; qv[j] = ok_ ? *(const unsigned*)(HQ + ro_) : 0u; kv[j] = ok_ ? *(const unsigned*)(HK + ro_) : 0u; } \
        { const bool ok_ = vrow < nrow; const size_t ro_ = (r0_ + (ok_ ? vrow : 0)) * HGW + 16 * vg; const u32x4 z_ = {0u, 0u, 0u, 0u}; \
          vraw[0] = ok_ ? *(const u32x4*)(HV + ro_) : z_; vraw[1] = ok_ ? *(const u32x4*)(HV + ro_ + 8) : z_; graw[0] = ok_ ? *(const u32x4*)(HGt + ro_) : z_; graw[1] = ok_ ? *(const u32x4*)(HGt + ro_ + 8) : z_; } } while (0)
    f32x2 ghg[8];
#pragma unroll
    for (int e2 = 0; e2 < 8; ++e2) ghg[e2] = *(const f32x2*)(a.in[I_GHG] + 16 * vg + 2 * e2);
    HG_LOAD(0);
    for (int c = 0; c < nch; ++c) {
        float bl0[8], bl1[8]; float run0 = 0.f, run1 = 0.f;
#pragma unroll
        for (int j = 0; j < 8; ++j) { run0 += lfv[j].x; run1 += lfv[j].y; bl0[j] = run0; bl1[j] = run1; }
        *(LAS f32x2*)(lds + OFF_T + (w * 128 + c0) * 4) = (f32x2){run0, run1};
        *(LAS u32x4*)(lds + OFF_V + (vrow * P + 16 * vg) * 2) = vraw[0]; *(LAS u32x4*)(lds + OFF_V + (vrow * P + 16 * vg + 8) * 2) = vraw[1];
        const u32x4 gcur0 = graw[0], gcur1 = graw[1];
        asm volatile("s_waitcnt lgkmcnt(0)" ::: "memory"); __builtin_amdgcn_s_barrier(); asm volatile("" ::: "memory");
        float off0 = 0.f, off1 = 0.f, br0 = 0.f, br1 = 0.f, bt0 = 0.f, bt1 = 0.f;
#pragma unroll
        for (int e = 0; e < 8; ++e) { const f32x2 tv = *(const LAS f32x2*)(lds + OFF_T + (e * 128 + c0) * 4); if (e < w) { off0 += tv.x; off1 += tv.y; } if (e < 4) { br0 += tv.x; br1 += tv.y; } bt0 += tv.x; bt1 += tv.y; }
        float kd0[8], kd1[8];
#pragma unroll
        for (int j = 0; j < 8; ++j) { const int t = 8 * w + j; const float b0 = off0 + bl0[j], b1 = off1 + bl1[j];
            const float q0 = bf_lo(qv[j]), q1 = bf_hi(qv[j]), k0 = bf_lo(kv[j]), k1 = bf_hi(kv[j]);
            *(LAS unsigned*)(lds + OFF_QE + (t * P + c0) * 2) = cvtpk(q0 * __expf(b0), q1 * __expf(b1));
            *(LAS unsigned*)(lds + OFF_QD + (t * P + c0) * 2) = cvtpk(q0 * __expf(b0 - br0), q1 * __expf(b1 - br1));
            *(LAS unsigned*)(lds + OFF_KDD + (t * P + c0) * 2) = cvtpk(k0 * __expf(br0 - b0), k1 * __expf(br1 - b1));
            kd0[j] = k0 * __expf(bt0 - b0); kd1[j] = k1 * __expf(bt1 - b1); }
        { u32x4 p0, p1; p0.x = cvtpk(kd0[0], kd0[1]); p0.y = cvtpk(kd0[2], kd0[3]); p0.z = cvtpk(kd0[4], kd0[5]); p0.w = cvtpk(kd0[6], kd0[7]);
          p1.x = cvtpk(kd1[0], kd1[1]); p1.y = cvtpk(kd1[2], kd1[3]); p1.z = cvtpk(kd1[4], kd1[5]); p1.w = cvtpk(kd1[6], kd1[7]);
          *(LAS u32x4*)(lds + OFF_KDT + (c0 * KP + 8 * w) * 2) = p0; *(LAS u32x4*)(lds + OFF_KDT + ((c0 + 1) * KP + 8 * w) * 2) = p1; }
        if (w == 0) *(LAS f32x2*)(lds + OFF_DL + c0 * 4) = (f32x2){__expf(bt0), __expf(bt1)};
        asm volatile("s_waitcnt lgkmcnt(0)" ::: "memory"); __builtin_amdgcn_s_barrier(); asm volatile("" ::: "memory");
        if (c + 1 < nch) HG_LOAD(c + 1);
        { const int tb = w >> 1;
#pragma unroll
          for (int sbi = 0; sbi < 2; ++sbi) { const int sb = 2 * (w & 1) + sbi; f32x4 acc = {0.f, 0.f, 0.f, 0.f};
            if (sb <= tb) {
#pragma unroll
                for (int ks = 0; ks < 4; ++ks) { const bf16x8 af = *(const LAS bf16x8*)(lds + OFF_KDD + ((16 * sb + n) * P + 32 * ks + 8 * g) * 2), bfr = *(const LAS bf16x8*)(lds + OFF_QD + ((16 * tb + n) * P + 32 * ks + 8 * g) * 2);
                    acc = __builtin_amdgcn_mfma_f32_16x16x32_bf16(af, bfr, acc, 0, 0, 0); }
                if (sb == tb) {
#pragma unroll
                    for (int i = 0; i < 4; ++i) if (n < 4 * g + i) acc[i] = 0.f; }
            }
            u32x2 pk; pk.x = cvtpk(acc[0], acc[1]); pk.y = cvtpk(acc[2], acc[3]);
            *(LAS u32x2*)(lds + OFF_AM + ((16 * tb + n) * KP + 16 * sb + 4 * g) * 2) = pk; } }
        f32x4 oacc[4];
#pragma unroll
        for (int tb = 0; tb < 4; ++tb) oacc[tb] = (f32x4){0.f, 0.f, 0.f, 0.f};
#pragma unroll
        for (int j = 0; j < 4; ++j) { u32x4 sb4; sb4.x = cvtpk(sacc[2 * j][0], sacc[2 * j][1]); sb4.y = cvtpk(sacc[2 * j][2], sacc[2 * j][3]); sb4.z = cvtpk(sacc[2 * j + 1][0], sacc[2 * j + 1][1]); sb4.w = cvtpk(sacc[2 * j + 1][2], sacc[2 * j + 1][3]);
            const bf16x8 bfr = __builtin_bit_cast(bf16x8, sb4);
#pragma unroll
            for (int tb = 0; tb < 4; ++tb) { const LAS char* qp = lds + OFF_QE + ((16 * tb + n) * P + 32 * j + 4 * g) * 2;
                const bf16x8 af = mk8(*(const LAS u32x2*)qp, *(const LAS u32x2*)(qp + 32));
                oacc[tb] = __builtin_amdgcn_mfma_f32_16x16x32_bf16(af, bfr, oacc[tb], 0, 0, 0); } }
        asm volatile("s_waitcnt lgkmcnt(0)" ::: "memory"); __builtin_amdgcn_s_barrier(); asm volatile("" ::: "memory");
        bf16x8 vf[2];
#pragma unroll
        for (int js = 0; js < 2; ++js) { unsigned short e_[8];
#pragma unroll
            for (int i = 0; i < 8; ++i) e_[i] = *(const LAS unsigned short*)(lds + OFF_V + ((32 * js + 8 * g + i) * P + 16 * w + n) * 2);
            u32x4 t_; t_.x = e_[0] | ((unsigned)e_[1] << 16); t_.y = e_[2] | ((unsigned)e_[3] << 16); t_.z = e_[4] | ((unsigned)e_[5] << 16); t_.w = e_[6] | ((unsigned)e_[7] << 16);
            vf[js] = __builtin_bit_cast(bf16x8, t_); }
#pragma unroll
        for (int tb = 0; tb < 4; ++tb)
#pragma unroll
            for (int js = 0; js < 2; ++js) { const bf16x8 af = *(const LAS bf16x8*)(lds + OFF_AM + ((16 * tb + n) * KP + 32 * js + 8 * g) * 2);
                oacc[tb] = __builtin_amdgcn_mfma_f32_16x16x32_bf16(af, vf[js], oacc[tb], 0, 0, 0); }
#pragma unroll
        for (int kb = 0; kb < 8; ++kb) { const f32x4 dl = *(const LAS f32x4*)(lds + OFF_DL + (16 * kb + 4 * g) * 4); sacc[kb] = sacc[kb] * dl;
#pragma unroll
            for (int js = 0; js < 2; ++js) { const bf16x8 af = *(const LAS bf16x8*)(lds + OFF_KDT + ((16 * kb + n) * KP + 32 * js + 8 * g) * 2);
                sacc[kb] = __builtin_amdgcn_mfma_f32_16x16x32_bf16(af, vf[js], sacc[kb], 0, 0, 0); } }
#pragma unroll
        for (int tb = 0; tb < 4; ++tb)
#pragma unroll
            for (int i = 0; i < 4; ++i) *(LAS float*)(lds + OFF_OX + ((16 * tb + 4 * g + i) * OP + 16 * w + n) * 4) = oacc[tb][i];
        asm volatile("s_waitcnt lgkmcnt(0)" ::: "memory"); __builtin_amdgcn_s_barrier(); asm volatile("" ::: "memory");
        { f32x4 ov[4];
#pragma unroll
          for (int q4 = 0; q4 < 4; ++q4) ov[q4] = *(const LAS f32x4*)(lds + OFF_OX + (vrow * OP + 16 * vg + 4 * q4) * 4);
          float ss = 0.f;
#pragma unroll
          for (int q4 = 0; q4 < 4; ++q4) ss += (ov[q4][0] * ov[q4][0] + ov[q4][1] * ov[q4][1]) + (ov[q4][2] * ov[q4][2] + ov[q4][3] * ov[q4][3]);
          ss += __shfl_xor(ss, 1); ss += __shfl_xor(ss, 2); ss += __shfl_xor(ss, 4);
          const float rs = rsqrtf(ss * (1.f / HGD) + EPS);
          const unsigned gw_[8] = {gcur0.x, gcur0.y, gcur0.z, gcur0.w, gcur1.x, gcur1.y, gcur1.z, gcur1.w};
          u32x4 o0, o1; unsigned ow[8];
#pragma unroll
          for (int e2 = 0; e2 < 8; ++e2) { const float x0 = ov[e2 >> 1][(e2 & 1) * 2], x1 = ov[e2 >> 1][(e2 & 1) * 2 + 1];
              const f32x2 go = ghg[e2]; ow[e2] = cvtpk(x0 * rs * go.x * bf_lo(gw_[e2]), x1 * rs * go.y * bf_hi(gw_[e2])); }
          o0.x = ow[0]; o0.y = ow[1]; o0.z = ow[2]; o0.w = ow[3]; o1.x = ow[4]; o1.y = ow[5]; o1.z = ow[6]; o1.w = ow[7];
          if (vrow < nrow) { bf16_t* mp = (bf16_t*)(ws + WS_MIX) + (row_base + (size_t)c * 64 + vrow) * D + 2048 + h * HGD + 16 * vg; *(u32x4*)mp = o0; *(u32x4*)(mp + 8) = o1; } }
    }
#undef HG_LOAD
#pragma unroll
    for (int kb = 0; kb < 8; ++kb)
#pragma unroll
        for (int i = 0; i < 4; ++i) sout[(size_t)(16 * kb + 4 * g + i) * HGD + 16 * w + n] = sacc[kb][i];
    __syncthreads();
}
}

DI int q_next(const Frame& F, unsigned* head) {
    volatile LAS unsigned* MISC = (volatile LAS unsigned*)(F.lds + MISC_OFF);
    if ((F.wave * 64 + lane_id()) == 0) MISC[16] = __hip_atomic_fetch_add(head, 1u, RLX_AGENT);
    __syncthreads();
    const int v = (int)MISC[16];
    __syncthreads();
    return v;
}

struct EpiS1 {
    unsigned char* ws; float* Sb; int adj; float sc;
    DI void operator()(ACC_T, const pg8::Unit& u, int wr, int wc, int fr, int fq, int lane) const {
        const int c8 = wc * 32 + 8 * fq, pn17 = u.pn + (adj ? u.pm : 0), ktile = pn17 - 17 * u.pm;
        const float* ssk = (const float*)(ws + WS_SSK) + (size_t)fr * ((size_t)SB * KPAD) + (size_t)pn17 * 256 + c8;
        const bf16_t* kb = (const bf16_t*)(ws + WS_KCAT) + ((size_t)pn17 * 256 + wc * 32 + 8 * (fr >> 2) + (fr & 3)) * KC + KVL + 8 * fq;
        const bf16_t* qb = (const bf16_t*)(ws + WS_QCAT) + ((size_t)u.pm * 256 + wr * 64 + fr) * KC + KVL + 8 * fq;
        bf16_t* S = (bf16_t*)Sb + ((size_t)u.pm * 256 + wr * 64 + fr) * SPITCH + ktile * 256 + c8;
#pragma unroll
        for (int bj = 0; bj < 2; ++bj) {
            if (bj == 1 && ktile == 16) break;
            bf16x8 kf[2][2]; f32x4 rk[2];
#pragma unroll
            for (int n = 0; n < 2; ++n) { const f32x4 sv = *(const f32x4*)(ssk + bj * 128 + 4 * n);
#pragma unroll
                for (int e = 0; e < 4; ++e) rk[n][e] = rsqrtf(sv[e] * (1.f / NOPE) + EPS) * sc;
#pragma unroll
                for (int ks = 0; ks < 2; ++ks) kf[n][ks] = *(const bf16x8*)(kb + (size_t)(bj * 128 + 4 * n) * KC + 32 * ks); }
#pragma unroll
            for (int ai = 0; ai < 2; ++ai)
#pragma unroll
                for (int m = 0; m < 4; ++m) { const bf16_t* qp = qb + (size_t)(ai * 128 + m * 16) * KC; const bf16x8 q0 = *(const bf16x8*)qp, q1 = *(const bf16x8*)(qp + 32);
                    f32x4 t0 = acc[ai][bj][m][0] * rk[0], t1 = acc[ai][bj][m][1] * rk[1];
                    t0 = __builtin_amdgcn_mfma_f32_16x16x32_bf16(kf[0][0], q0, t0, 0, 0, 0); t0 = __builtin_amdgcn_mfma_f32_16x16x32_bf16(kf[0][1], q1, t0, 0, 0, 0);
                    t1 = __builtin_amdgcn_mfma_f32_16x16x32_bf16(kf[1][0], q0, t1, 0, 0, 0); t1 = __builtin_amdgcn_mfma_f32_16x16x32_bf16(kf[1][1], q1, t1, 0, 0, 0);
                    st_bf16x8(S + (size_t)(ai * 128 + m * 16) * SPITCH + bj * 128, t0 * ATT_SCALE, t1 * ATT_SCALE); }
        }
    }
};
struct EpiPV {
    unsigned char* ws;
    DI void operator()(ACC_T, const pg8::Unit& u, int wr, int wc, int fr, int fq, int lane) const {
        float* O = (float*)(ws + WS_OLAT) + ((size_t)u.pm * 256 + wr * 64 + fr) * KVL + (u.pn & 1) * 256 + wc * 32 + 8 * fq;
#pragma unroll
        for (int ai = 0; ai < 2; ++ai)
#pragma unroll
            for (int m = 0; m < 4; ++m)
#pragma unroll
                for (int bj = 0; bj < 2; ++bj) st_f32x8(O + (size_t)(ai * 128 + m * 16) * KVL + bj * 128, acc[ai][bj][m][0], acc[ai][bj][m][1]);
    }
};
#define CHAIN_SYNC() do { asm volatile("s_waitcnt vmcnt(0) lgkmcnt(0)" ::: "memory"); __syncthreads(); __builtin_amdgcn_fence(__ATOMIC_ACQUIRE, "agent"); asm volatile("s_waitcnt vmcnt(0)" ::: "memory"); __syncthreads(); } while (0)
DI void sample_chain(const Frame& F, const Args& a, int b) {
    unsigned char* ws = a.ws;
    { pg8::Gemm g{(const bf16_t*)(ws + WS_QCAT), (const bf16_t*)(ws + WS_KCAT), KC, KC, KVL, nullptr}; pg8::OneBatchOrder S{b, 17, KVL / 64, 16}; EpiS1 E{ws, (float*)((unsigned char*)a.out + OS_S), 0, 1.f}; pg8::gemm_phase(F.lds, g, S, E, F.wave); }
    CHAIN_SYNC();
    { const int lane = lane_id();
      for (int r = F.wave; r < 256; r += 16) {
        const bf16_t* s0 = (const bf16_t*)((const unsigned char*)a.out + OS_S) + (size_t)(b * 256 + r) * SPITCH; const bf16_t* s1 = s0 + (size_t)8 * SPITCH;
        bf16_t* p0 = (bf16_t*)(ws + WS_P) + (size_t)(b * 256 + r) * KT; bf16_t* p1 = p0 + (size_t)8 * KT;
        f32x4 v0[17], v1[17]; float m0 = -1e30f, m1 = -1e30f;
#pragma unroll
        for (int j = 0; j < 17; ++j) { const int idx = 4 * lane + 256 * j; if (idx < NKEY) { const u32x2 a0 = *(const u32x2*)(s0 + idx), a1 = *(const u32x2*)(s1 + idx); v0[j] = (f32x4){bf_lo(a0.x), bf_hi(a0.x), bf_lo(a0.y), bf_hi(a0.y)}; v1[j] = (f32x4){bf_lo(a1.x), bf_hi(a1.x), bf_lo(a1.y), bf_hi(a1.y)}; } else { v0[j] = (f32x4){-1e30f, -1e30f, -1e30f, -1e30f}; v1[j] = v0[j]; } }
#pragma unroll
        for (int j = 0; j < 17; ++j) { m0 = fmaxf(m0, fmaxf(fmaxf(v0[j][0], v0[j][1]), fmaxf(v0[j][2], v0[j][3]))); m1 = fmaxf(m1, fmaxf(fmaxf(v1[j][0], v1[j][1]), fmaxf(v1[j][2], v1[j][3]))); }
#pragma unroll
        for (int o = 1; o < 64; o <<= 1) { m0 = fmaxf(m0, __shfl_xor(m0, o)); m1 = fmaxf(m1, __shfl_xor(m1, o)); }
        float sum0 = 0.f, sum1 = 0.f;
#pragma unroll
        for (int j = 0; j < 17; ++j) { const bool ok = 4 * lane + 256 * j < NKEY;
#pragma unroll
            for (int e = 0; e < 4; ++e) { const float e0 = ok ? __expf(v0[j][e] - m0) : 0.f, e1 = ok ? __expf(v1[j][e] - m1) : 0.f; v0[j][e] = e0; v1[j][e] = e1; sum0 += e0; sum1 += e1; } }
#pragma unroll
        for (int o = 1; o < 64; o <<= 1) { sum0 += __shfl_xor(sum0, o); sum1 += __shfl_xor(sum1, o); }
        const float i0 = 1.0f / sum0, i1 = 1.0f / sum1;
#pragma unroll
        for (int j = 0; j < 17; ++j) { const int idx = 4 * lane + 256 * j; if (idx < KT) { u32x2 o; o.x = cvtpk(v0[j][0] * i0, v0[j][1] * i0); o.y = cvtpk(v0[j][2] * i0, v0[j][3] * i0); *(u32x2*)(p0 + idx) = o;
                                                                                 u32x2 q; q.x = cvtpk(v1[j][0] * i1, v1[j][1] * i1); q.y = cvtpk(v1[j][2] * i1, v1[j][3] * i1); *(u32x2*)(p1 + idx) = q; } } } }
    CHAIN_SYNC();
    { pg8::Gemm g{(const bf16_t*)(ws + WS_P), (const bf16_t*)(ws + WS_CKVT), KT, KT, KT, nullptr}; pg8::OneBatchOrder S{b, 2, KT / 64}; EpiPV E{ws}; pg8::gemm_phase(F.lds, g, S, E, F.wave); }
    CHAIN_SYNC();
    {
      const int lane = lane_id(), n = lane & 15, g = lane >> 4;
#pragma unroll 1
      for (int hh = 0; hh < 2; ++hh) { const int h = 2 * F.wave + hh;
        const float* ap = (const float*)(ws + WS_OLAT) + ((size_t)b * 256 + n * 16 + h) * KVL + 8 * g;
        const bf16_t* bp = (const bf16_t*)(ws + WS_WUKVT) + (size_t)(2048 + h * 128 + n) * KVL + 8 * g;
        f32x4 oacc[8];
#pragma unroll
        for (int db = 0; db < 8; ++db) oacc[db] = (f32x4){0.f, 0.f, 0.f, 0.f};
        for (int ks = 0; ks < KVL / 32; ++ks) { const bf16x8 af = __builtin_bit_cast(bf16x8, pack8(*(const f32x4*)(ap + 32 * ks), *(const f32x4*)(ap + 32 * ks + 4)));
#pragma unroll
            for (int db = 0; db < 8; ++db) oacc[db] = __builtin_amdgcn_mfma_f32_16x16x32_bf16(af, *(const bf16x8*)(bp + (size_t)(16 * db) * KVL + 32 * ks), oacc[db], 0, 0, 0); }
#pragma unroll
        for (int db = 0; db < 8; ++db)
#pragma unroll
            for (int i = 0; i < 4; ++i) ((bf16_t*)(ws + WS_MIX))[((size_t)MP + b * 16 + 4 * g + i) * D + h * 128 + 16 * db + n] = f2bf(oacc[db][i]); } }
    __syncthreads();
}

constexpr int MX_HG = 64 + SB * HGH, MX_ATT = 1024, MX_S = SB * 34;
DI void p5_mixer(const Frame& F, const Args& a) {
    unsigned char* ws = a.ws; unsigned* head = (unsigned*)(ws + WS_CTL) + CW_QUEUE;
    for (;;) { const int u = q_next(F, head + 192); if (u >= SB) break; sample_chain(F, a, u); }
#ifndef MX_OFF_HG
    for (;;) { const int u = q_next(F, head); if (u >= MX_HG) break;
        const bool smp = u >= 64; const int v = smp ? u - 64 : u; hg::hgrn_unit(a, smp, v >> 4, v & 15, (LAS char*)F.lds, F.wave); }
#endif
#ifndef MX_OFF_ATT
    for (;;) { const int u = q_next(F, head + 64); if (u >= MX_ATT) break;
        const int qb = 15 - (u >> 6), bh = u & 63;
        att::attn_unit(bh >> 4, bh & 15, qb, ws + WS_Q, ws + WS_KN, ws + WS_KRN, (const bf16_t*)(ws + WS_V), (bf16_t*)(ws + WS_MIX), (LAS char*)F.lds, F.wave); }
#endif
}

DI void p6_late_weights(const Frame& F, const Args& a) {
    unsigned char* ws = a.ws; LAS float* scr = (LAS float*)(F.lds + F.wave * 16384);
    constexpr int I_O = (D / 64) * (D / 32), I_UP = (D / 64) * (FF2 / 32), I_DN = (FF / 64) * (D / 32), NIT = 2 * I_O + I_UP + I_DN;
    for (int it = F.gw; it < NIT; it += F.NGW) { int r = it;
        if (tr_matrix(r, a.in[I_WO], D, D, (bf16_t*)(ws + WS_WOT), D, nullptr, scr, lane_id())) continue;
        if (tr_matrix(r, a.in[I_WUP], D, FF2, (bf16_t*)(ws + WS_WUPT), D, a.in[I_GFFN], scr, lane_id(), 1 << 30, 0, true)) continue;
        if (tr_matrix(r, a.in[I_WD], FF, D, (bf16_t*)(ws + WS_WDT), FF, nullptr, scr, lane_id())) continue;
        tr_matrix(r, a.in[I_WPG], D, D, nullptr, D, a.in[I_GPLE], scr, lane_id(), 1 << 30, 0, false, false, ws + WS_WG8, SC8_G); }
}
struct EpiWo {
    unsigned char* ws; const bf16_t* xb; int s0 = 0, s1 = 8;
    DI void operator()(ACC_T, const pg8::Unit& u, int wr, int wc, int fr, int fq, int lane) const {
        const int row0 = u.pm * 256 + wr * 64 + fr, c8 = wc * 32 + 8 * fq;
#pragma unroll
        for (int ai = 0; ai < 2; ++ai)
#pragma unroll
            for (int m = 0; m < 4; ++m) { if (ai * 4 + m < s0 || ai * 4 + m >= s1) continue; const int row = row0 + ai * 128 + m * 16; const bf16_t* xr = xb + (size_t)row * D; float ss = 0.f;
#pragma unroll
                for (int bj = 0; bj < 2; ++bj) { const int col = u.pn * 256 + bj * 128 + c8; const u32x4 xw = *(const u32x4*)(xr + col); const f32x4 v0 = acc[ai][bj][m][0] + (f32x4){bf_lo(xw.x), bf_hi(xw.x), bf_lo(xw.y), bf_hi(xw.y)}, v1 = acc[ai][bj][m][1] + (f32x4){bf_lo(xw.z), bf_hi(xw.z), bf_lo(xw.w), bf_hi(xw.w)};
                    st_bf16x8((bf16_t*)(ws + WS_X1B) + (size_t)row * D + col, v0, v1); ss += dot8(v0, v1); }
                ss += __shfl_xor(ss, 16); ss += __shfl_xor(ss, 32);
                if (fq == 0) unsafeAtomicAdd((float*)(ws + OFF_SSQ2) + row, ss); }
    }
};
DI float dpp_ror1(float v) { return __int_as_float(__builtin_amdgcn_mov_dpp(__float_as_int(v), 0x121, 0xf, 0xf, false)); }
DI float dpp_ror2(float v) { return __int_as_float(__builtin_amdgcn_mov_dpp(__float_as_int(v), 0x122, 0xf, 0xf, false)); }
struct EpiUp {
    unsigned char* ws; float* out; const float* cw; const float* cb; LAS unsigned char* lds; int s0 = 0, s1 = 8;
    DI void operator()(ACC_T, const pg8::Unit& u, int wr, int wc, int fr, int fq, int lane) const {
        const float* ssq = (const float*)(ws + OFF_SSQ2);
        const int row0 = u.pm * 256 + wr * 64 + fr, ch0 = u.pn * 128 + wc * 32 + 8 * fq;
        if (u.pm >= MP / 256) {
#pragma unroll
            for (int ai = 0; ai < 2; ++ai)
#pragma unroll
                for (int m = 0; m < 4; ++m) { if (ai * 4 + m < s0 || ai * 4 + m >= s1) continue; const int row = row0 + ai * 128 + m * 16; const float rs = rsqrtf(ssq[row] * (1.f / D) + EPS);
                    float* cv = nullptr; { const int sr = row - MP, t = sr & 15; if (t >= ST - 2) cv = out + O_CVS + ((size_t)(sr >> 4) * 2 + (t - (ST - 2))) * FF2; }
#pragma unroll
                    for (int bj = 0; bj < 2; ++bj) { const int col = bj * FF + ch0; const f32x4 v0 = acc[ai][bj][m][0] * rs, v1 = acc[ai][bj][m][1] * rs;
                        st_bf16x8((bf16_t*)(ws + WS_U) + (size_t)row * FF2 + col, v0, v1); if (cv) st_f32x8(cv + col, v0, v1); } }
            return;
        }
        LAS float* halo = (LAS float*)(lds + XCH_OFF);
        float rsv[2][4];
        rsv[0][0] = rsqrtf(ssq[row0] * (1.f / D) + EPS); rsv[0][3] = rsqrtf(ssq[row0 + 48] * (1.f / D) + EPS); rsv[1][3] = rsqrtf(ssq[row0 + 128 + 48] * (1.f / D) + EPS);
        if (wc == 0 && fq == 0) { LAS float* rw = (LAS float*)(lds + XCH_OFF + 8192) + (wr * 16 + fr) * 8;
#pragma unroll
            for (int sl = 0; sl < 8; ++sl) rw[sl] = rsqrtf(ssq[row0 + (sl >> 2) * 128 + (sl & 3) * 16] * (1.f / D) + EPS); }
#pragma unroll
        for (int ai = 0; ai < 2; ++ai) {
            if (fr >= 14) { LAS float* hp = halo + ((((2 * ai + wr) * 4 + wc) * 2 + (fr - 14)) * 4 + fq) * 16;
#pragma unroll
                for (int bj = 0; bj < 2; ++bj) { *(LAS f32x4*)(hp + bj * 8) = acc[ai][bj][3][0] * rsv[ai][3]; *(LAS f32x4*)(hp + bj * 8 + 4) = acc[ai][bj][3][1] * rsv[ai][3]; } } }
        { float* uh = (float*)(ws + WS_UH) + (size_t)u.pm * 4 * FF2;
          if (wr == 0 && fr < 2) {
#pragma unroll
              for (int bj = 0; bj < 2; ++bj) st_f32x8(uh + (size_t)fr * FF2 + bj * FF + ch0, acc[0][bj][0][0] * rsv[0][0], acc[0][bj][0][1] * rsv[0][0]); }
          if (wr == 1 && fr >= 14) { float* cv = ((u.pm & 15) == 15) ? out + O_CVP + ((size_t)(u.pm >> 4) * 2 + (fr - 14)) * FF2 : nullptr;
#pragma unroll
              for (int bj = 0; bj < 2; ++bj) { const f32x4 v0 = acc[1][bj][3][0] * rsv[1][3], v1 = acc[1][bj][3][1] * rsv[1][3];
                  st_f32x8(uh + (size_t)(2 + fr - 14) * FF2 + bj * FF + ch0, v0, v1); if (cv) st_f32x8(cv + bj * FF + ch0, v0, v1); } } }
        asm volatile("s_waitcnt lgkmcnt(0)" ::: "memory"); __builtin_amdgcn_s_barrier(); asm volatile("" ::: "memory");
        bf16_t* actp = (bf16_t*)(ws + WS_ACT) + (size_t)row0 * FF + ch0;
        const bool f1 = fr >= 1, f2 = fr >= 2, e1 = fr == 1;
#pragma unroll
        for (int n = 0; n < 2; ++n) {
            f32x4 w0[2], w1[2], w2[2], bb[2];
#pragma unroll
            for (int s = 0; s < 2; ++s) { const int col = s * FF + ch0 + 4 * n; w0[s] = *(const f32x4*)(cw + col); w1[s] = *(const f32x4*)(cw + FF2 + col); w2[s] = *(const f32x4*)(cw + 2 * FF2 + col); bb[s] = *(const f32x4*)(cb + col); }
#pragma unroll
            for (int ai = 0; ai < 2; ++ai) {
                const int gi = 2 * ai + wr;
                f32x4 q1[2], q2[2];
#pragma unroll
                for (int m = 0; m < 4; ++m) {
                    int ro_ = (wr * 16 + fr) * 32 + XCH_OFF + 8192; asm volatile("" : "+v"(ro_)); const float rsl = *(const LAS float*)(lds + ro_ + (ai * 4 + m) * 4);
                    f32x4 c[2];
#pragma unroll
                    for (int s = 0; s < 2; ++s) {
                        const f32x4 cur = acc[ai][s][m][n] * rsl;
                        f32x4 r1, r2;
#pragma unroll
                        for (int e = 0; e < 4; ++e) { r1[e] = dpp_ror1(cur[e]); r2[e] = dpp_ror2(cur[e]); }
                        if (m == 0) { f32x4 h0 = {0.f, 0.f, 0.f, 0.f}, h1 = h0;
                            if (gi > 0) { const LAS float* hp = halo + ((((gi - 1) * 4 + wc) * 2) * 4 + fq) * 16 + s * 8 + 4 * n; h0 = *(const LAS f32x4*)hp; h1 = *(const LAS f32x4*)(hp + 64); }
#pragma unroll
                            for (int e = 0; e < 4; ++e) { const float p1 = f1 ? r1[e] : h1[e], p2 = f2 ? r2[e] : (e1 ? h1[e] : h0[e]); c[s][e] = bb[s][e] + w0[s][e] * p2 + w1[s][e] * p1 + w2[s][e] * cur[e]; }
                        } else {
#pragma unroll
                            for (int e = 0; e < 4; ++e) { const float p1 = f1 ? r1[e] : q1[s][e], p2 = f2 ? r2[e] : q2[s][e]; c[s][e] = bb[s][e] + w0[s][e] * p2 + w1[s][e] * p1 + w2[s][e] * cur[e]; }
                        }
                        q1[s] = r1; q2[s] = r2;
                    }
                    if (!(gi == 0 && m == 0 && fr < 2)) {
                        float o[4];
#pragma unroll
                        for (int e = 0; e < 4; ++e) o[e] = c[0][e] * __builtin_amdgcn_rcpf(1.0f + __expf(-c[0][e])) * c[1][e];
                        u32x2 ov; ov.x = cvtpk(o[0], o[1]); ov.y = cvtpk(o[2], o[3]);
                        *(u32x2*)(actp + (size_t)(ai * 128 + m * 16) * FF + 4 * n) = ov; }
                }
            }
        }
        asm volatile("s_waitcnt lgkmcnt(0)" ::: "memory"); __builtin_amdgcn_s_barrier(); asm volatile("" ::: "memory");
    }
};
struct EpiUpFin {
    unsigned char* ws; float* out; const float* cw; const float* cb; const float* scv; int s0 = 0, s1 = 8;
    DI void operator()(ACC_T, const pg8::Unit& u, int wr, int wc, int fr, int fq, int lane) const {
        const float* ssq = (const float*)(ws + OFF_SSQ2);
        const int row0 = u.pm * 256 + wr * 64 + fr, ch0 = u.pn * 128 + wc * 32 + 8 * fq;
#pragma unroll
        for (int n = 0; n < 2; ++n) {
            f32x4 w0[2], w1[2], w2[2], bb[2];
#pragma unroll
            for (int s = 0; s < 2; ++s) { const int col = s * FF + ch0 + 4 * n; w0[s] = *(const f32x4*)(cw + col); w1[s] = *(const f32x4*)(cw + FF2 + col); w2[s] = *(const f32x4*)(cw + 2 * FF2 + col); bb[s] = *(const f32x4*)(cb + col); }
#pragma unroll
            for (int ai = 0; ai < 2; ++ai)
#pragma unroll
                for (int m = 0; m < 4; ++m) { if (ai * 4 + m < s0 || ai * 4 + m >= s1) continue;
                    const int row = row0 + ai * 128 + m * 16, sq = (row - MP) >> 4; const float rs = rsqrtf(ssq[row] * (1.f / D) + EPS);
                    f32x4 c[2];
#pragma unroll
                    for (int s = 0; s < 2; ++s) { const int col = s * FF + ch0 + 4 * n;
                        const f32x4 cur = acc[ai][s][m][n] * rs, h2 = *(const f32x4*)(scv + (size_t)(sq * 2) * FF2 + col), h1 = *(const f32x4*)(scv + (size_t)(sq * 2 + 1) * FF2 + col);
#pragma unroll
                        for (int e = 0; e < 4; ++e) { const float r1 = dpp_ror1(cur[e]), r2 = dpp_ror2(cur[e]); const float p1 = fr >= 1 ? r1 : h1[e], p2 = fr >= 2 ? r2 : (fr == 1 ? h1[e] : h2[e]);
                            c[s][e] = bb[s][e] + w0[s][e] * p2 + w1[s][e] * p1 + w2[s][e] * cur[e]; }
                        if (fr >= ST - 2) *(f32x4*)(out + O_CVS + ((size_t)sq * 2 + (fr - (ST - 2))) * FF2 + col) = cur; }
                    float o[4];
#pragma unroll
                    for (int e = 0; e < 4; ++e) o[e] = c[0][e] * __builtin_amdgcn_rcpf(1.0f + __expf(-c[0][e])) * c[1][e];
                    u32x2 ov; ov.x = cvtpk(o[0], o[1]); ov.y = cvtpk(o[2], o[3]);
                    *(u32x2*)((bf16_t*)(ws + WS_ACT) + (size_t)row * FF + ch0 + 4 * n) = ov; }
        }
    }
};
struct EpiDown {
    unsigned char* ws; float* out; int s0 = 0, s1 = 8;
    DI void operator()(ACC_T, const pg8::Unit& u, int wr, int wc, int fr, int fq, int lane) const {
        const int row0 = u.pm * 256 + wr * 64 + fr, c8 = wc * 32 + 8 * fq;
#pragma unroll
        for (int ai = 0; ai < 2; ++ai)
#pragma unroll
            for (int m = 0; m < 4; ++m) { if (ai * 4 + m < s0 || ai * 4 + m >= s1) continue; const int row = row0 + ai * 128 + m * 16; float ss = 0.f;
#pragma unroll
                for (int bj = 0; bj < 2; ++bj) { const int col = u.pn * 256 + bj * 128 + c8; bf16_t* xp_ = (bf16_t*)(ws + WS_X1B) + (size_t)row * D + col; const u32x4 xw = *(const u32x4*)xp_;
                    const f32x4 v0 = acc[ai][bj][m][0] + (f32x4){bf_lo(xw.x), bf_hi(xw.x), bf_lo(xw.y), bf_hi(xw.y)}, v1 = acc[ai][bj][m][1] + (f32x4){bf_lo(xw.z), bf_hi(xw.z), bf_lo(xw.w), bf_hi(xw.w)};
                    st_bf16x8(xp_, v0, v1); ss += dot8(v0, v1);
                    { u32x2 o8; o8.x = pk4_fp8(v0[0] * SC8_X, v0[1] * SC8_X, v0[2] * SC8_X, v0[3] * SC8_X); o8.y = pk4_fp8(v1[0] * SC8_X, v1[1] * SC8_X, v1[2] * SC8_X, v1[3] * SC8_X); *(u32x2*)(ws + WS_X2F8 + (size_t)row * D + col) = o8; } }
                ss += __shfl_xor(ss, 16); ss += __shfl_xor(ss, 32);
                if (fq == 0) unsafeAtomicAdd((float*)(ws + OFF_SSQ3) + row, ss); }
    }
};
struct EpiPle {
    unsigned char* ws;
    DI void operator()(ACC_T, const pg8::Unit& u, int wr, int wc, int fr, int fq, int lane) const {
        const int row0 = u.pm * 256 + wr * 64 + fr, c8 = wc * 32 + 8 * fq;
#pragma unroll
        for (int ai = 0; ai < 2; ++ai)
#pragma unroll
            for (int m = 0; m < 4; ++m)
#pragma unroll
                for (int bj = 0; bj < 2; ++bj) st_bf16x8((bf16_t*)(ws + WS_PW) + (size_t)(row0 + ai * 128 + m * 16) * D + u.pn * 256 + bj * 128 + c8, acc[ai][bj][m][0], acc[ai][bj][m][1]);
    }
};
struct EpiGate {
    unsigned char* ws; float* out; int s0 = 0, s1 = 8;
    DI void operator()(ACC_T, const pg8::Unit& u, int wr, int wc, int fr, int fq, int lane) const {
        const float* ssq = (const float*)(ws + OFF_SSQ3);
        const int row0 = u.pm * 256 + wr * 64 + fr, c8 = wc * 32 + 8 * fq;
#pragma unroll
        for (int ai = 0; ai < 2; ++ai)
#pragma unroll
            for (int m = 0; m < 4; ++m) { if (ai * 4 + m < s0 || ai * 4 + m >= s1) continue; const int row = row0 + ai * 128 + m * 16; const float rs = rsqrtf(ssq[row] * (1.f / D) + EPS) * (1.f / (SC8_X * SC8_G));
#pragma unroll
                for (int bj = 0; bj < 2; ++bj) { const int col = u.pn * 256 + bj * 128 + c8; float* op = out + (size_t)row * D + col;
                    const u32x4 pw = *(const u32x4*)((const bf16_t*)(ws + WS_PW) + (size_t)row * D + col);
                    const u32x4 xw = *(const u32x4*)((const bf16_t*)(ws + WS_X1B) + (size_t)row * D + col); const f32x4 x0 = {bf_lo(xw.x), bf_hi(xw.x), bf_lo(xw.y), bf_hi(xw.y)}, x1 = {bf_lo(xw.z), bf_hi(xw.z), bf_lo(xw.w), bf_hi(xw.w)}; f32x4 v0, v1;
                    const float pwf[8] = {bf_lo(pw.x), bf_hi(pw.x), bf_lo(pw.y), bf_hi(pw.y), bf_lo(pw.z), bf_hi(pw.z), bf_lo(pw.w), bf_hi(pw.w)};
#pragma unroll
                    for (int e = 0; e < 4; ++e) { v0[e] = x0[e] + pwf[e] * sigmoidf_(acc[ai][bj][m][0][e] * rs); v1[e] = x1[e] + pwf[4 + e] * sigmoidf_(acc[ai][bj][m][1][e] * rs); }
                    st_f32x8(op, v0, v1); } }
    }
};
DI void p11_conv(const Frame& F, const Args& a, int lo_r) {
    unsigned char* ws = a.ws; const int lane = lane_id();
    const bf16_t* U = (const bf16_t*)(ws + WS_U); bf16_t* ACTp = (bf16_t*)(ws + WS_ACT);
    constexpr int NCG = FF / 8;
    constexpr int NRC = MS / 16;
    const int ncw = (NCG + 63) / 64;
    for (int it = F.gw; it < NRC * ncw; it += F.NGW) {
        const int rc = it / ncw, cg = (it % ncw) * 64 + lane; if (cg >= NCG) continue;
        const int col = cg * 8, row0 = MP + rc * 16;
        if (2 * (col >> 7) + (rc >> 4) >= lo_r) continue;
        float w[3][2][8], bsv[2][8];
#pragma unroll
        for (int j = 0; j < 3; ++j)
#pragma unroll
            for (int s = 0; s < 2; ++s) { const f32x4 x0 = *(const f32x4*)(a.in[I_CW] + (size_t)j * FF2 + s * FF + col), x1 = *(const f32x4*)(a.in[I_CW] + (size_t)j * FF2 + s * FF + col + 4);
#pragma unroll
                for (int e = 0; e < 4; ++e) { w[j][s][e] = x0[e]; w[j][s][4 + e] = x1[e]; } }
#pragma unroll
        for (int s = 0; s < 2; ++s) { const f32x4 x0 = *(const f32x4*)(a.in[I_CB] + s * FF + col), x1 = *(const f32x4*)(a.in[I_CB] + s * FF + col + 4);
#pragma unroll
            for (int e = 0; e < 4; ++e) { bsv[s][e] = x0[e]; bsv[s][4 + e] = x1[e]; } }
        float h2[2][8], h1[2][8];
        const bool smp = row0 >= MP; const int tseq = smp ? ((row0 - MP) & 15) : (row0 & (SEQ - 1));
#pragma unroll
        for (int s = 0; s < 2; ++s) {
            if (tseq == 0) {
                if (smp) { const float* hs = a.in[I_SCV] + ((size_t)((row0 - MP) >> 4) * 2) * FF2 + s * FF + col;
                    const f32x4 a0 = *(const f32x4*)hs, a1 = *(const f32x4*)(hs + 4), b0 = *(const f32x4*)(hs + FF2), b1 = *(const f32x4*)(hs + FF2 + 4);
#pragma unroll
                    for (int e = 0; e < 4; ++e) { h2[s][e] = a0[e]; h2[s][4 + e] = a1[e]; h1[s][e] = b0[e]; h1[s][4 + e] = b1[e]; } }
                else {
#pragma unroll
                    for (int e = 0; e < 8; ++e) { h2[s][e] = 0.f; h1[s][e] = 0.f; } }
            } else { const u32x4 a_ = *(const u32x4*)(U + (size_t)(row0 - 2) * FF2 + s * FF + col), b_ = *(const u32x4*)(U + (size_t)(row0 - 1) * FF2 + s * FF + col);
                h2[s][0] = bf_lo(a_.x); h2[s][1] = bf_hi(a_.x); h2[s][2] = bf_lo(a_.y); h2[s][3] = bf_hi(a_.y); h2[s][4] = bf_lo(a_.z); h2[s][5] = bf_hi(a_.z); h2[s][6] = bf_lo(a_.w); h2[s][7] = bf_hi(a_.w);
                h1[s][0] = bf_lo(b_.x); h1[s][1] = bf_hi(b_.x); h1[s][2] = bf_lo(b_.y); h1[s][3] = bf_hi(b_.y); h1[s][4] = bf_lo(b_.z); h1[s][5] = bf_hi(b_.z); h1[s][6] = bf_lo(b_.w); h1[s][7] = bf_hi(b_.w); }
        }
#pragma unroll 4
        for (int t = 0; t < 16; ++t) { const size_t row = (size_t)row0 + t; float cur[2][8], c[2][8];
#pragma unroll
            for (int s = 0; s < 2; ++s) { const u32x4 u_ = *(const u32x4*)(U + row * FF2 + s * FF + col);
                cur[s][0] = bf_lo(u_.x); cur[s][1] = bf_hi(u_.x); cur[s][2] = bf_lo(u_.y); cur[s][3] = bf_hi(u_.y); cur[s][4] = bf_lo(u_.z); cur[s][5] = bf_hi(u_.z); cur[s][6] = bf_lo(u_.w); cur[s][7] = bf_hi(u_.w);
#pragma unroll
                for (int e = 0; e < 8; ++e) { c[s][e] = bsv[s][e] + w[0][s][e] * h2[s][e] + w[1][s][e] * h1[s][e] + w[2][s][e] * cur[s][e]; h2[s][e] = h1[s][e]; h1[s][e] = cur[s][e]; } }
            float o[8];
#pragma unroll
            for (int e = 0; e < 8; ++e) o[e] = c[0][e] / (1.0f + __expf(-c[0][e])) * c[1][e];
            u32x4 ov; ov.x = cvtpk(o[0], o[1]); ov.y = cvtpk(o[2], o[3]); ov.z = cvtpk(o[4], o[5]); ov.w = cvtpk(o[6], o[7]);
            *(u32x4*)(ACTp + row * FF + col) = ov; }
    }
    { const float* UH = (const float*)(ws + WS_UH);
      for (int it = (F.gw + F.NGW - NRC * ncw % F.NGW) % F.NGW; it < 64 * 2 * ncw; it += F.NGW) { const int pm = it / (2 * ncw), r = (it / ncw) & 1, cg = (it % ncw) * 64 + lane; if (cg >= NCG) continue; const int col = cg * 8;
          float c[2][8];
#pragma unroll
          for (int s = 0; s < 2; ++s) { const int cc = s * FF + col; const bool first = (pm & 15) == 0;
              const float* cur = UH + ((size_t)pm * 4 + r) * FF2 + cc; const float* p1 = r == 0 ? UH + ((size_t)(pm - 1) * 4 + 3) * FF2 + cc : UH + ((size_t)pm * 4 + 0) * FF2 + cc; const float* p2 = r == 0 ? UH + ((size_t)(pm - 1) * 4 + 2) * FF2 + cc : UH + ((size_t)(pm - 1) * 4 + 3) * FF2 + cc;
              const bool z1 = first && r == 0, z2 = first;
#pragma unroll
              for (int e = 0; e < 8; ++e) c[s][e] = a.in[I_CB][cc + e] + a.in[I_CW][cc + e] * (z2 ? 0.f : p2[e]) + a.in[I_CW][FF2 + cc + e] * (z1 ? 0.f : p1[e]) + a.in[I_CW][2 * FF2 + cc + e] * cur[e]; }
          float o[8];
#pragma unroll
          for (int e = 0; e < 8; ++e) o[e] = c[0][e] / (1.0f + __expf(-c[0][e])) * c[1][e];
          u32x4 ov; ov.x = cvtpk(o[0], o[1]); ov.y = cvtpk(o[2], o[3]); ov.z = cvtpk(o[4], o[5]); ov.w = cvtpk(o[6], o[7]);
          *(u32x4*)(ACTp + ((size_t)pm * 256 + r) * FF + col) = ov; } }

}
constexpr int LAST_PHASE = 15;

constexpr int NPHASE = 15;
#ifndef ALIGN_LIGHT
#define ALIGN_LIGHT true
#endif
__global__ void __launch_bounds__(512, 2) fwd(Args args) {
    extern __shared__ __attribute__((aligned(16))) unsigned char lds_raw[];
    Frame F;
    F.lds = (LAS unsigned char*)lds_raw;
    F.wave = __builtin_amdgcn_readfirstlane(threadIdx.x >> 6);
    F.G = gridDim.x; { const int bx = blockIdx.x; F.vcu = (F.G % 8 == 0) ? (bx % 8) * (F.G / 8) + bx / 8 : bx; }
    F.gw = F.vcu * 8 + F.wave; F.NGW = F.G * 8;
    volatile LAS unsigned* MISC = (volatile LAS unsigned*)(F.lds + MISC_OFF);
    if (F.wave == 0) { const int l0 = lane_id(); if (l0 < 32) MISC[l0] = 0u; }
    __syncthreads();
    unsigned char* ws = args.ws;
    unsigned* ctl = (unsigned*)(ws + WS_CTL);
    const int lo = args.ph_lo, hi = args.ph_hi;
    XcdBarrier bar; bar.bar = ctl + CW_BAR; bar.x = 0; bar.st = nullptr;
    if (hi - lo > 1) bar = xcd_barrier_post(ctl + CW_BAR, MISC + 8, F.wave == 0 && lane_id() == 0);
#define IN(k) (lo <= (k) && (k) < hi)
#ifndef PH_MASK
#define PH_MASK 0xffff
#endif
#define PH_EN(k) (((PH_MASK) >> (k)) & 1)
#define FIN_BAR() do { if (hi - lo > 1) xcd_barrier(bar, F.wave == 0 && lane_id() == 0); } while (0)
#ifdef STAMP
#define SEAM(k) do { if (IN(k) && IN((k) + 1)) xcd_barrier(bar, F.wave == 0 && lane_id() == 0); if (blockIdx.x == 0 && F.wave == 0 && lane_id() == 0) ((unsigned long long*)(ctl + 40960))[(k) + 1] = __builtin_amdgcn_s_memrealtime(); } while (0)
#else
#define SEAM(k) do { if (IN(k) && IN((k) + 1)) xcd_barrier(bar, F.wave == 0 && lane_id() == 0); } while (0)
#endif

#ifdef STAMP
    if (blockIdx.x == 0 && F.wave == 0 && lane_id() == 0) ((unsigned long long*)(ctl + 40960))[0] = __builtin_amdgcn_s_memrealtime();
#endif
    if (PH_EN(0) && IN(0)) { p0_prologue(F, args);
#ifdef ZERO_OUT
        zero16(args.out, (size_t)M * D * 4, F.gw, F.NGW, lane_id()); zero16(args.out + O_HGP, (size_t)(O_CKVS - O_HGP) * 4, F.gw, F.NGW, lane_id()); zero16(args.out + O_HGS, (size_t)(O_END - O_HGS) * 4, F.gw, F.NGW, lane_id());
#endif
    }
    SEAM(0);
    if (PH_EN(1) && IN(1)) {
        const pg8::Gemm gA{(const bf16_t*)((const unsigned char*)args.out + OS_XB), (const bf16_t*)(ws + WS_WINT) + (size_t)QL * D, D, D, D, (float*)(ws + WS_SLAB_EARLY)};
        const pg8::Gemm gB{(const bf16_t*)((const unsigned char*)args.out + OS_XB8), (const bf16_t*)((const unsigned char*)args.out + OS_WIN8), D / 2, D / 2, D / 2, (float*)(ws + WS_SLAB_EARLY) + (size_t)96 * 65536};
        pg8::SplitOrder SA; SA.init(M / 256, NIN / 256 - 4, F.G, (int)blockIdx.x, D); pg8::SplitOrder SBq; SBq.init(M / 256, 4, F.G, (int)blockIdx.x, D / 2);
        EpiInProj EA{ws, 4, 1.f}, EB{ws, 0, 1.f / (SC8_X0 * SC8_WI)};
        pg8::gemm_phase<ALIGN_LIGHT>(F.lds, gA, SA, EA, F.wave);
        pg8::gemm_phase<ALIGN_LIGHT, true>(F.lds, gB, SBq, EB, F.wave);
        { pg8::Gemm g{(const bf16_t*)(ws + WS_KC8), (const bf16_t*)(ws + WS_WUKV8), KVL / 2, KVL / 2, KVL / 2, nullptr};
          pg8::MappedOrder S; S.init(SB * 16, 8, F.G, (int)blockIdx.x, KVL / 2); S.per = 16; S.stride = 16; S.off = 0;
          EpiSumsq E{ws, 1.f / (SC8_K * SC8_K * SC8_W * SC8_W), 1}; pg8::gemm_phase<true, true>(F.lds, g, S, E, F.wave); }
        FIN_BAR();
        pg8::gemm_finalize(gA, SA, EA, F.wave, (int)blockIdx.x); pg8::gemm_finalize(gB, SBq, EB, F.wave, (int)blockIdx.x);
    }
    SEAM(1);
    if (PH_EN(2) && IN(2)) {
        p2_norm_rows(F, args);
        { pg8::Gemm g{(const bf16_t*)(ws + WS_CQ8), (const bf16_t*)(ws + WS_WUQ8), QL / 2, QL / 2, QL / 2, (float*)(ws + WS_SLAB_EARLY)}; pg8::SplitOrder S; S.rot = 2; S.init(M / 256, 3072 / 256, F.G, (int)blockIdx.x, QL / 2);
          EpiUq E{ws, args.in[I_GQN], args.in[I_GQR], F.lds, 1.f / (SC8_K * SC8_Q)}; pg8::gemm_phase<true, true>(F.lds, g, S, E, F.wave); FIN_BAR(); pg8::gemm_finalize(g, S, E, F.wave, (int)blockIdx.x); }
        for (int u = F.G - 1 - (int)blockIdx.x; u < 128; u += F.G) p4_qa_unit(F, args, u);
    }
    SEAM(2);
    if (PH_EN(3) && IN(3)) {
        { pg8::Gemm g{(const bf16_t*)(ws + WS_CKVN8), (const bf16_t*)(ws + WS_WUKV8), KVL / 2, KVL / 2, KVL / 2, nullptr}; pg8::StaticOrder S; S.init(MP / 256, 16, F.G, (int)blockIdx.x, KVL / 2);
          EpiKup E{ws, args.in[I_GKN], F.lds, 1.f / (SC8_K * SC8_W)}; pg8::gemm_phase<true, true>(F.lds, g, S, E, F.wave); }
        { pg8::Gemm g{(const bf16_t*)(ws + WS_KCAT), (const bf16_t*)(ws + WS_WUKVT), KC, KVL, KVL, nullptr}; pg8::MappedOrder S; S.init(SB, 8, F.G, (int)blockIdx.x, KVL); S.per = 1; S.stride = 17; S.off = 16;
          EpiSumsq E{ws, 1.f, 0}; pg8::gemm_phase(F.lds, g, S, E, F.wave); }
        { pg8::Gemm g{(const bf16_t*)(ws + WS_QCAT8), (const bf16_t*)(ws + WS_KC8), KVL / 2, KVL / 2, KVL / 2, nullptr}; pg8::BatchOrder S{SB * 16, F.G, (int)blockIdx.x, 16, 2, 0, KVL / 128};
          EpiS1 E{ws, (float*)((unsigned char*)args.out + OS_S), 1, 1.f / (SC8_QA * SC8_K)}; pg8::gemm_phase<true, true>(F.lds, g, S, E, F.wave); }
    }
    SEAM(3);
    if (PH_EN(5) && IN(5)) { p5_mixer(F, args); }
    SEAM(5);
    if (PH_EN(6) && IN(6)) { p6_late_weights(F, args); }
    SEAM(6);
    if (PH_EN(10) && IN(10)) { pg8::Gemm g{(const bf16_t*)(ws + WS_MIX), (const bf16_t*)(ws + WS_WOT), D, D, D, (float*)(ws + WS_SLAB_LATE)}; pg8::SplitOrder S; S.init(M / 256, D / 256, F.G, (int)blockIdx.x, D);
        EpiWo E{ws, (const bf16_t*)((const unsigned char*)args.out + OS_XB)}; pg8::gemm_phase<ALIGN_LIGHT>(F.lds, g, S, E, F.wave); FIN_BAR(); pg8::gemm_finalize(g, S, E, F.wave, (int)blockIdx.x); }
    SEAM(10);
    if (PH_EN(11) && IN(11)) { pg8::Gemm g{(const bf16_t*)(ws + WS_X1B), (const bf16_t*)(ws + WS_WUPT), D, D, D, (float*)(ws + WS_SLAB_LATE)}; pg8::SplitOrder S; S.nM1 = MP / 256; S.init(M / 256, FF2 / 256, F.G, (int)blockIdx.x, D);
        EpiUp E{ws, args.out, args.in[I_CW], args.in[I_CB], F.lds}; pg8::gemm_phase(F.lds, g, S, E, F.wave); FIN_BAR();
        EpiUpFin E2{ws, args.out, args.in[I_CW], args.in[I_CB], args.in[I_SCV]}; pg8::gemm_finalize(g, S, E2, F.wave, (int)blockIdx.x);
        p11_conv(F, args, S.ns > 1 ? S.R * F.G - (MP / 256) * (FF2 / 256) : 1 << 30); }
    SEAM(11);
    if (PH_EN(13) && IN(13)) {
        { pg8::Gemm g{(const bf16_t*)(ws + WS_ACT), (const bf16_t*)(ws + WS_WDT), FF, FF, FF, (float*)(ws + WS_SLAB_LATE)}; pg8::SplitOrder S; S.init(M / 256, D / 256, F.G, (int)blockIdx.x, FF);
          EpiDown E{ws, args.out}; pg8::gemm_phase<ALIGN_LIGHT>(F.lds, g, S, E, F.wave); FIN_BAR(); pg8::gemm_finalize(g, S, E, F.wave, (int)blockIdx.x); }
        { pg8::Gemm g{(const bf16_t*)(ws + WS_PB), (const bf16_t*)(ws + WS_WPT), PLE, PLE, PLE, nullptr}; pg8::StaticOrder S; S.init(M / 256, D / 256, F.G, (int)blockIdx.x, PLE);
          EpiPle E{ws}; pg8::gemm_phase(F.lds, g, S, E, F.wave); }
    }
    SEAM(13);
    if (PH_EN(14) && IN(14)) { pg8::Gemm g{(const bf16_t*)(ws + WS_X2F8), (const bf16_t*)(ws + WS_WG8), D / 2, D / 2, D / 2, (float*)(ws + WS_SLAB_LATE)}; pg8::SplitOrder S; S.init(M / 256, D / 256, F.G, (int)blockIdx.x, D / 2);
        EpiGate E{ws, args.out}; pg8::gemm_phase<ALIGN_LIGHT, true>(F.lds, g, S, E, F.wave); FIN_BAR(); pg8::gemm_finalize(g, S, E, F.wave, (int)blockIdx.x); }
#ifdef STAMP
    xcd_barrier(bar, F.wave == 0 && lane_id() == 0);
    if (blockIdx.x == 0 && F.wave == 0) { const unsigned long long* ts = (const unsigned long long*)(ctl + 40960); const unsigned long long tend = __builtin_amdgcn_s_memrealtime();
        const size_t offs[10] = {O_Y, O_Y + (size_t)MP * D, O_CKVP, O_KRP, O_HGP, O_CVP, O_CKVS, O_KRS, O_HGS, O_CVS};
        for (int j = 0; j < 10; ++j) { const int ph = STAMP_BASE + j; unsigned long long t0 = ts[ph], t1 = ph + 1 < 15 ? ts[ph + 1] : tend; if (ph >= 15) { t0 = ts[0]; t1 = tend; }
            int n = ph > 15 ? 0 : (int)((t1 - t0) / 1000); if (ph <= 15 && n < 1) n = 1; if (n > 30000) n = 30000;
            for (int i = lane_id(); i < n; i += 64) ((unsigned*)args.out)[offs[j] + i] = 0xAAAAAAAAu; } }
#endif
#undef IN
#undef SEAM
}

extern "C" void kernel_launch(void* const* d_in, const int* in_sizes, int n_in, void* d_out, int out_size, void* d_ws, size_t ws_size, hipStream_t stream) {
    static int grid = 0;
    if (grid == 0) {
        if (n_in != 30 || (size_t)out_size != O_END || ws_size < WS_NEED) { fprintf(stderr, "kernel_launch: unexpected problem: n_in %d out %d ws %zu (need %zu); nothing launched\n", n_in, out_size, ws_size, (size_t)WS_NEED); grid = -1; return; }
        int dev = 0, cus = 0, per_cu = 0;
        if (hipGetDevice(&dev) != hipSuccess || hipDeviceGetAttribute(&cus, hipDeviceAttributeMultiprocessorCount, dev) != hipSuccess) { grid = -1; return; }
        if (hipFuncSetAttribute((const void*)fwd, hipFuncAttributeMaxDynamicSharedMemorySize, LDS_BYTES) != hipSuccess) { fprintf(stderr, "kernel_launch: hipFuncSetAttribute failed\n"); grid = -1; return; }
        if (hipOccupancyMaxActiveBlocksPerMultiprocessor(&per_cu, (const void*)fwd, 512, LDS_BYTES) != hipSuccess || per_cu < 1) fprintf(stderr, "kernel_launch: occupancy query says %d\n", per_cu);
        (void)hipGetLastError();
        grid = cus;
    }
    if (grid < 0) return;
    (void)hipMemsetAsync((char*)d_ws + WS_CTL, 0, CTL_BYTES, stream);
    Args a{};
    for (int i = 0; i < 30; ++i) a.in[i] = (const float*)d_in[i];
    a.out = (float*)d_out; a.ws = (unsigned char*)d_ws;
    for (int i = 0; i < 32; ++i) { const float p = (float)pow(10000.0, (double)i / 32.0); a.inv[i] = 1.0f / p; }
#ifndef N_LAUNCH_SPLIT
#define N_LAUNCH_SPLIT 1
#endif
#if N_LAUNCH_SPLIT
    for (int p = 0; p < LAST_PHASE; ++p) { a.ph_lo = p; a.ph_hi = p + 1; hipLaunchKernelGGL(fwd, dim3(grid), dim3(512), LDS_BYTES, stream, a);
#ifdef SELFCHECK
        hipLaunchKernelGGL(check_kernel, dim3(64), dim3(64), 0, stream, a, p);
        if (p == 5) hipLaunchKernelGGL(check_hgrn, dim3(8), dim3(128), 0, stream, a);
#endif
    }
#ifdef SELFCHECK
    hipLaunchKernelGGL(report_kernel, dim3(1), dim3(64), 0, stream, a);
#endif
#else
    a.ph_lo = 0; a.ph_hi = LAST_PHASE; hipLaunchKernelGGL(fwd, dim3(grid), dim3(512), LDS_BYTES, stream, a);
#endif
}
```

```cpp
#include <hip/hip_runtime.h>
#include <cstdio>
#include <cstdint>
#include <cmath>

#define LAS __attribute__((address_space(3)))
#define GAS __attribute__((address_space(1)))
typedef unsigned short bf16_t;
typedef short bf16x8 __attribute__((ext_vector_type(8)));
typedef short s16x4 __attribute__((ext_vector_type(4)));
typedef float f32x2 __attribute__((ext_vector_type(2)));
typedef float f32x4 __attribute__((ext_vector_type(4)));
typedef float f32x16 __attribute__((ext_vector_type(16)));
typedef unsigned u32x2 __attribute__((ext_vector_type(2)));
typedef unsigned u32x4 __attribute__((ext_vector_type(4)));
typedef __bf16 bf16x2_t __attribute__((ext_vector_type(2)));
typedef GAS unsigned gu32;
#define RLX_AGENT __ATOMIC_RELAXED, __HIP_MEMORY_SCOPE_AGENT
#define DI __device__ __forceinline__

DI unsigned cvtpk(float lo, float hi) { f32x2 v = {lo, hi}; bf16x2_t b = __builtin_convertvector(v, bf16x2_t); return __builtin_bit_cast(unsigned, b); }
DI float bf_lo(unsigned w) { return __uint_as_float(w << 16); }
DI float bf_hi(unsigned w) { return __uint_as_float(w & 0xffff0000u); }
DI float bf2f(bf16_t b) { return __uint_as_float(((unsigned)b) << 16); }
DI bf16_t f2bf(float f) { return (bf16_t)(cvtpk(f, 0.f) & 0xffffu); }
typedef int i32x8 __attribute__((ext_vector_type(8)));
typedef int i32x4 __attribute__((ext_vector_type(4)));
DI unsigned pk4_fp8(float a, float b, float c, float d) { int w = 0; w = __builtin_amdgcn_cvt_pk_fp8_f32(a, b, w, false); w = __builtin_amdgcn_cvt_pk_fp8_f32(c, d, w, true); return (unsigned)w; }
DI u32x4 pack8(f32x4 a, f32x4 b) { u32x4 w; w.x = cvtpk(a[0], a[1]); w.y = cvtpk(a[2], a[3]); w.z = cvtpk(b[0], b[1]); w.w = cvtpk(b[2], b[3]); return w; }
DI float wave_sum(float v) {
#pragma unroll
    for (int o = 1; o < 64; o <<= 1) v += __shfl_xor(v, o);
    return v;
}
DI int lane_id() { int l; asm volatile("v_mbcnt_lo_u32_b32 %0, -1, 0\n\tv_mbcnt_hi_u32_b32 %0, -1, %0" : "=v"(l)); return l; }
DI float sigmoidf_(float x) { return 1.0f / (1.0f + __expf(-x)); }

constexpr int D = 4096, NB = 4, SEQ = 4096, MP = NB * SEQ, SB = 32, ST = 16, MS = SB * ST, M = MP + MS;
constexpr int PAST = 4096, NKEY = PAST + ST  , KPAD = 4352  , KT = 4224  ;
constexpr int QL = 1024, KVL = 512, ROPE = 64, NOPE = 128, NH = 16, QH = NOPE + ROPE  , KC = KVL + ROPE  ;
constexpr int HGW = 2048, HGH = 16, HGD = 128;
constexpr int FF = 11008, FF2 = 22016, PLE = 256;
constexpr int NIN = 9984;
constexpr float EPS = 1e-6f;
constexpr float ATT_SCALE = 0.07216878364870322f;

constexpr size_t O_Y = 0, O_CKVP = (size_t)M * D, O_KRP = O_CKVP + (size_t)MP * KVL, O_HGP = O_KRP + (size_t)MP * ROPE, O_CVP = O_HGP + (size_t)NB * HGH * HGD * HGD,
                 O_CKVS = O_CVP + (size_t)NB * 2 * FF2, O_KRS = O_CKVS + (size_t)MS * KVL, O_HGS = O_KRS + (size_t)MS * ROPE, O_CVS = O_HGS + (size_t)SB * HGH * HGD * HGD, O_END = O_CVS + (size_t)SB * 2 * FF2;
static_assert(O_END == 89960448, "output size");

constexpr float SC8_K = 16.f, SC8_W = 256.f;
constexpr size_t OS_XB = 0  ,
                 OS_S = (size_t)132 << 20  ;
constexpr size_t OS_XB8 = (size_t)132 << 20  , OS_WIN8 = (size_t)200 << 20  ;
constexpr float SC8_X0 = 8.f, SC8_WI = 1024.f;
static_assert(OS_XB8 + (size_t)M * D <= OS_WIN8 && OS_WIN8 + (size_t)QL * D <= (size_t)M * D * 4, "d_out scratch (fp8 in-projection operands)");
constexpr int SPITCH = 4224;
static_assert((size_t)M * D * 2 <= OS_S && OS_S + (size_t)SB * 256 * SPITCH * 4 <= (size_t)M * D * 4 && NKEY <= SPITCH, "d_out scratch");
constexpr size_t MiB = (size_t)1 << 20;
constexpr size_t WS_CTL = 0, CTL_BYTES = 2 * MiB;
constexpr int CW_TMO = 0, CW_BAR = 4096, CW_QUEUE = 16384  ;
constexpr size_t OFF_SSQ1 = 256 * 1024, OFF_SSQQ = 384 * 1024, OFF_SSQ2 = 512 * 1024, OFF_SSQ3 = 640 * 1024, OFF_LB = 768 * 1024;
constexpr size_t WS_WINT = 2 * MiB, WS_XB = 80 * MiB, WS_MIX = 2 * MiB, WS_S = 134 * MiB, WS_P = 270 * MiB, WS_CKVT = 336 * MiB, WS_KCAT = 468 * MiB, WS_OLAT = 621 * MiB, WS_SSK = 637 * MiB,
                 WS_QCAT = 646 * MiB, WS_WUKVT = 655 * MiB, WS_WUKN = 659 * MiB, WS_WUQT = 661 * MiB, WS_ROPE = 667 * MiB, WS_CKVN = 669 * MiB, WS_KRN = 686 * MiB,
                 WS_HQ = 712 * MiB, WS_HK = 778 * MiB, WS_HV = 844 * MiB, WS_HG = 910 * MiB, WS_LF = 976 * MiB, WS_Q = 1108 * MiB, WS_KN = 1207 * MiB, WS_V = 1271 * MiB,
                 WS_CQ = 1335 * MiB, WS_CKVRAW = 1368 * MiB, WS_KRRAW = 1401 * MiB, WS_EARLY_END = 1406 * MiB;
constexpr size_t WS_U = 2 * MiB, WS_ACT = 160 * MiB  , WS_WUPT = 712 * MiB, WS_WOT = 884 * MiB, WS_WDT = 1067 * MiB, WS_WGT = 1153 * MiB, WS_X1B = 1185 * MiB, WS_WPT = 1415 * MiB, WS_PB = 1406 * MiB  , WS_PW = 2 * MiB;
constexpr size_t WS_X2F8 = 916 * MiB  , WS_WG8 = 984 * MiB  ;
constexpr float SC8_X = 8.f, SC8_G = 1024.f;
static_assert(WS_X2F8 >= 916 * MiB && WS_X2F8 + (size_t)M * D <= WS_WG8 && WS_WG8 + (size_t)D * D <= 1067 * MiB, "fp8 gate operands");
constexpr size_t WS_CQ8 = 134 * MiB  , WS_WUQ8 = 152 * MiB  , WS_CKVN8 = 156 * MiB  ,
                 WS_WUKV8 = 166 * MiB  ;
constexpr size_t WS_QCAT8 = 168 * MiB  , WS_KC8 = 270 * MiB  ;
constexpr float SC8_QA = 32.f;
static_assert(WS_WUKV8 + (size_t)4096 * KVL <= WS_QCAT8 && WS_QCAT8 + (size_t)SB * 256 * KVL <= 212 * MiB && WS_KC8 >= 212 * MiB + (size_t)224 * 65536 * 4 && WS_KC8 + (size_t)SB * PAST * KVL <= 336 * MiB, "early fp8 (2)");
constexpr float SC8_Q = 512.f;
constexpr float SC8_A = 16.f;
static_assert(WS_CQ8 + (size_t)M * QL <= WS_WUQ8 && WS_WUQ8 + (size_t)3072 * QL <= WS_CKVN8 && WS_CKVN8 + (size_t)M * KVL <= WS_WUKV8 && WS_WUKV8 + (size_t)4096 * KVL <= 212 * MiB, "early fp8");
constexpr size_t WS_UH = 136 * MiB;
static_assert(WS_UH >= WS_PW + (size_t)M * D * 2 && WS_UH + (size_t)64 * 4 * FF2 * 4 <= WS_ACT, "UH");
constexpr size_t WS_SLAB_EARLY = 212 * MiB, WS_SLAB_LATE = 1328 * MiB;
constexpr size_t WS_NEED = 1417 * MiB;
static_assert(WS_SLAB_EARLY >= WS_XB + (size_t)M * D * 2 && WS_SLAB_EARLY + 64 * MiB <= WS_CKVT && WS_SLAB_LATE + 64 * MiB <= WS_PB, "slabs");
static_assert(WS_WINT + (size_t)NIN * D * 2 <= WS_XB && WS_XB + (size_t)M * D * 2 <= WS_CKVT, "early A region");
static_assert(WS_MIX + (size_t)M * D * 2 <= WS_S && WS_S + (size_t)SB * 256 * KPAD * 4 <= WS_P && WS_P + (size_t)SB * 256 * KT * 2 <= WS_CKVT, "mix/S/P");
static_assert(WS_CKVT + (size_t)SB * KVL * KT * 2 <= WS_KCAT && WS_KCAT + (size_t)SB * KPAD * KC * 2 <= WS_OLAT && WS_OLAT + (size_t)SB * 256 * KVL * 4 <= WS_SSK && WS_SSK + (size_t)SB * KPAD * 16 * 4 <= WS_QCAT, "ckvT/Kcat/OLAT/SSK");
static_assert(WS_QCAT + (size_t)SB * 256 * KC * 2 <= WS_WUKVT && WS_WUKVT + (size_t)4096 * 512 * 2 <= WS_WUKN && WS_WUKN + (size_t)512 * 2048 * 2 <= WS_WUQT && WS_WUQT + (size_t)3072 * 1024 * 2 <= WS_ROPE, "small early");
static_assert(WS_ROPE + (size_t)NKEY * 64 * 4 <= WS_CKVN && WS_CKVN + (size_t)M * KVL * 2 <= WS_KRN && WS_KRN + (size_t)M * ROPE * 2 <= WS_HQ, "rope/ckvn/krn");
static_assert(WS_HQ + (size_t)M * HGW * 2 <= WS_HK && WS_HG + (size_t)M * HGW * 2 <= WS_LF && WS_LF + (size_t)M * HGW * 4 <= WS_Q && WS_Q + (size_t)M * 3072 * 2 <= WS_KN && WS_KN + (size_t)MP * 2048 * 2 <= WS_V && WS_V + (size_t)MP * 2048 * 2 <= WS_CQ, "hgrn/q/k/v");
static_assert(WS_CQ + (size_t)M * QL * 2 <= WS_CKVRAW && WS_CKVRAW + (size_t)M * KVL * 4 <= WS_KRRAW && WS_KRRAW + (size_t)M * ROPE * 4 <= WS_EARLY_END, "cq/raw");
static_assert(WS_U + (size_t)M * FF2 * 2 <= WS_WUPT && WS_ACT + (size_t)M * FF * 2 <= WS_U + (size_t)MP * FF2 * 2 && WS_WUPT + (size_t)FF2 * D * 2 <= WS_WOT && WS_WOT + (size_t)D * D * 2 <= WS_WDT, "late 1");
static_assert(WS_WDT + (size_t)D * FF * 2 <= WS_WGT && WS_WGT + (size_t)D * D * 2 <= WS_X1B && WS_X1B + (size_t)M * D * 2 <= WS_SLAB_LATE && WS_PB >= WS_EARLY_END && WS_PB + (size_t)M * PLE * 2 <= WS_WPT && WS_WPT + (size_t)D * PLE * 2 <= WS_NEED, "late 2");

constexpr int RING_BYTES = 131072;
constexpr int XCH_OFF = RING_BYTES, XCH_BYTES = 12288;
constexpr int MISC_OFF = XCH_OFF + XCH_BYTES;
constexpr int LDS_BYTES = 147456;
static_assert(MISC_OFF + 128 <= LDS_BYTES, "LDS map");
#define N_LAUNCH_SPLIT 0

namespace pg8 {
constexpr int BM = 256, BK = 64, HALF = 128, HTB = HALF * BK * 2  , STAGE_BYTES = 8 * HTB, NXCD = 8, WGM = 8;
static_assert(STAGE_BYTES == RING_BYTES, "stage region");
__host__ __device__ __forceinline__ int lds_byte(int r, int c) { const int st = (r >> 4) * 2 + (c >> 5), rr = r & 15, cc = c & 31, ob = rr * 64 + cc * 2; return st * 1024 + (ob ^ (((ob >> 9) & 1) << 5)); }
__host__ __device__ __forceinline__ void stage_rc(int b, int& R, int& C) { const int st = b / 1024, sb = b % 1024, swz = sb ^ (((sb >> 9) & 1) << 5); R = (st >> 1) * 16 + swz / 64; C = (st & 1) * 32 + (swz % 64) / 2; }
__host__ __device__ __forceinline__ int perm32(int rho) { const int n = rho >> 4, i = rho & 15; return 8 * (i >> 2) + 4 * n + (i & 3); }

struct Unit { int pm, pn, koff, nt, sub; };
struct Gemm { const bf16_t* A; const bf16_t* Bt; int lda, ldb, K; float* slab; };

struct StaticOrder {
    int nM, nN, nwg, G, c, knt, nM1 = 0, rot = 0;
    __host__ __device__ __forceinline__ void init(int nM_, int nN_, int G_, int c_, int K_) { nM = nM_; nN = nN_; nwg = nM * nN; G = G_; c = c_; knt = K_ / BK; }
    __host__ __device__ __forceinline__ void tile(int L, Unit& u) const {
        const int nMa = nM1 > 0 ? nM1 : nM, nwa = nMa * nN;
        if (L >= nwa) { const int r = L - nwa, nr = nM - nMa; u.pm = nMa + r % nr; u.pn = r / nr; u.koff = 0; u.nt = knt; u.sub = -1; return; }
        int wgid = L; { const int q = nwa / NXCD, r = nwa % NXCD, xcd = wgid % NXCD, off = wgid / NXCD; wgid = (xcd < r ? xcd * (q + 1) : r * (q + 1) + (xcd - r) * q) + off; }
        const int nig = WGM * nN, gid = wgid / nig, fm = gid * WGM, gsz = (nMa - fm) < WGM ? (nMa - fm) : WGM;
        u.pm = fm + ((wgid % nig) % gsz); u.pn = (wgid % nig) / gsz; u.koff = 0; u.nt = knt; u.sub = -1;
        if (rot > 0) u.pm = u.pm < rot ? nM - rot + u.pm : u.pm - rot;
    }
    __host__ __device__ __forceinline__ bool next(int i, Unit& u) const { const long L = (long)i * G + c; if (L >= nwg) return false; tile((int)L, u); return true; }
};
struct SplitOrder : StaticOrder {
    int R, Lft, ns, kb;
    __host__ __device__ __forceinline__ void init(int nM_, int nN_, int G_, int c_, int K_) { StaticOrder::init(nM_, nN_, G_, c_, K_); R = nwg / G; Lft = nwg % G; ns = 1; kb = K_ / 128;
        if (Lft > 0) { const int k128 = K_ / 128; int s = G / Lft; if (s > k128 / 2) s = k128 / 2; if (s < 1) s = 1; kb = (k128 + s - 1) / s; if (k128 % kb == 1) ++kb; ns = (k128 + kb - 1) / kb; } }
    __host__ __device__ __forceinline__ bool next(int i, Unit& u) const {
        if (i < R) { tile(i * G + c, u); return true; }
        if (i > R || ns <= 1) { if (i == R && ns <= 1) { const long L = (long)i * G + c; if (L >= nwg) return false; tile((int)L, u); return true; } return false; }
        if (c >= Lft * ns) return false;
        const int l = c / ns, sl = c % ns; tile(R * G + l, u); const int k128 = knt / 2; u.koff = sl * kb * 128; const int nb = (k128 - sl * kb) < kb ? (k128 - sl * kb) : kb; u.nt = nb * 2; u.sub = c; return true; }
};
struct MappedOrder : StaticOrder {
    int per, stride, off;
    __host__ __device__ __forceinline__ bool next(int i, Unit& u) const { if (!StaticOrder::next(i, u)) return false; u.pm = (u.pm / per) * stride + off + (u.pm % per); return true; }
};

struct BatchOrder {
    int n, G, c, per, mode, kslice;
    int knt;
    __host__ __device__ __forceinline__ bool next(int i, Unit& u) const { const int L = i * G + c; if (L >= n) return false; const int b = L / per, r = L % per;
        u.pm = b; u.nt = knt; u.sub = -1; if (mode == 0) { u.pn = b * 17 + r; u.koff = 0; } else if (mode == 2) { u.pn = b * per + r; u.koff = 0; } else { u.pn = 2 * b + r / 3; u.koff = (r % 3) * kslice; } return true; }
};
struct OneBatchOrder {
    int b, per, knt, first = 0;
    __host__ __device__ __forceinline__ bool next(int i, Unit& u) const { if (first + i >= per) return false; u.pm = b; u.pn = b * per + first + i; u.koff = 0; u.nt = knt; u.sub = -1; return true; }
};
template <bool ALIGN_EPI = true, bool FP8 = false, class Epi, class Sched>
__device__ __forceinline__ void gemm_phase(LAS unsigned char* lds, const Gemm g, const Sched& S, const Epi& E, int wid) {
    const int lane = lane_id(), tid = wid * 64 + lane, wr = wid >> 2, wc = wid & 3, fr = lane & 15, fq = lane >> 4;
    unsigned voffA[2], voffB[2];
#pragma unroll
    for (int i = 0; i < 2; ++i) { int R, C; stage_rc(tid * 16 + i * 8192, R, C); const int Rb = (R & ~31) + perm32(R & 31);
        voffA[i] = (unsigned)(R * g.lda + C) * 2u; voffB[i] = (unsigned)(Rb * g.ldb + C) * 2u; }
    const size_t kstep = (size_t)(BK * 2);
    const size_t hstepA = (size_t)HALF * g.lda * 2, hstepB = (size_t)HALF * g.ldb * 2;
    const size_t tstepA = 2 * hstepA, tstepB = 2 * hstepB;
    const unsigned ldsw = (unsigned)wid * 1024u;
    const int aoff = lds_byte(wr * 64 + fr, fq * 8), boff = lds_byte(wc * 32 + fr, fq * 8);
#define PG8_SA(b, h) (((b) * 2 + (h)) * HTB)
#define PG8_SB(b, h) ((4 + (b) * 2 + (h)) * HTB)
#define PG8_STAGE(bufoff, gbase, voff) do { _Pragma("unroll") for (int _i = 0; _i < 2; ++_i) \
        __builtin_amdgcn_global_load_lds((const unsigned*)((const char*)(gbase) + (voff)[_i]), (LAS unsigned*)(lds + (bufoff) + ldsw + _i * 8192), 16, 0, 0); } while (0)
#define PG8_LDA(dst, b, h) do { if constexpr (FP8) { _Pragma("unroll") for (int m = 0; m < 4; ++m) { dst##8[m].lo = *(const LAS i32x4*)(lds + PG8_SA(b, h) + aoff + m * 2048); dst##8[m].hi = *(const LAS i32x4*)(lds + PG8_SA(b, h) + aoff + m * 2048 + 1024); } } else { \
        _Pragma("unroll") for (int m = 0; m < 4; ++m) _Pragma("unroll") for (int k = 0; k < 2; ++k) dst[m][k] = *(const LAS bf16x8*)(lds + PG8_SA(b, h) + aoff + m * 2048 + k * 1024); } } while (0)
#define PG8_LDB(dst, b, h) do { if constexpr (FP8) { _Pragma("unroll") for (int n = 0; n < 2; ++n) { dst##8[n].lo = *(const LAS i32x4*)(lds + PG8_SB(b, h) + boff + n * 2048); dst##8[n].hi = *(const LAS i32x4*)(lds + PG8_SB(b, h) + boff + n * 2048 + 1024); } } else { \
        _Pragma("unroll") for (int n = 0; n < 2; ++n) _Pragma("unroll") for (int k = 0; k < 2; ++k) dst[n][k] = *(const LAS bf16x8*)(lds + PG8_SB(b, h) + boff + n * 2048 + k * 1024); } } while (0)
#define PG8_MMA(ai, bj, At, Bt) do { __builtin_amdgcn_s_setprio(1); if constexpr (FP8) { _Pragma("unroll") for (int m = 0; m < 4; ++m) _Pragma("unroll") for (int n = 0; n < 2; ++n) \
        asm volatile("v_mfma_f32_16x16x128_f8f6f4 %0, %1, %2, %0" : "+v"(acc[ai][bj][m][n]) : "v"(Bt##8[n]), "v"(At##8[m])); } else { \
        _Pragma("unroll") for (int m = 0; m < 4; ++m) _Pragma("unroll") for (int n = 0; n < 2; ++n) _Pragma("unroll") for (int k = 0; k < 2; ++k) \
        acc[ai][bj][m][n] = __builtin_amdgcn_mfma_f32_16x16x32_bf16(Bt[n][k], At[m][k], acc[ai][bj][m][n], 0, 0, 0); } __builtin_amdgcn_s_setprio(0); } while (0)
#define PG8_WAIT_V(n) asm volatile("s_waitcnt vmcnt(" #n ")" ::: "memory")
#define PG8_WAIT_L(n) asm volatile("s_waitcnt lgkmcnt(" #n ")" ::: "memory")
#define PG8_BAR __builtin_amdgcn_s_barrier()
#define PG8_SCHED __builtin_amdgcn_sched_barrier(0)
    Unit cur, nxt; int ui = 0;
    if (!S.next(0, cur)) return;
    f32x4 acc[2][2][4][2];
#pragma unroll
    for (int a = 0; a < 2; ++a)
#pragma unroll
        for (int b = 0; b < 2; ++b)
#pragma unroll
            for (int m = 0; m < 4; ++m)
#pragma unroll
                for (int n = 0; n < 2; ++n) acc[a][b][m][n] = (f32x4){0.f, 0.f, 0.f, 0.f};
    bf16x8 At[4][2], B0[2][2], B1[2][2]; i32x8 At8[4], B08[2], B18[2];
    const char* cA = (const char*)g.A + (size_t)cur.pm * tstepA + (size_t)cur.koff * 2; const char* cB = (const char*)g.Bt + (size_t)cur.pn * tstepB + (size_t)cur.koff * 2;
    PG8_STAGE(PG8_SB(0, 0), cB, voffB); PG8_STAGE(PG8_SB(0, 1), cB + hstepB, voffB); PG8_STAGE(PG8_SA(0, 0), cA, voffA); PG8_STAGE(PG8_SA(0, 1), cA + hstepA, voffA);
    if (wr == 1) PG8_BAR;
    PG8_WAIT_V(2); PG8_BAR;
    PG8_STAGE(PG8_SB(1, 0), cB + kstep, voffB); PG8_STAGE(PG8_SA(1, 0), cA + kstep, voffA); PG8_STAGE(PG8_SB(1, 1), cB + hstepB + kstep, voffB);
    PG8_WAIT_V(6); PG8_BAR;
    for (;;) {
        const bool has_next = S.next(ui + 1, nxt);
        const char* nA = has_next ? (const char*)g.A + (size_t)nxt.pm * tstepA + (size_t)nxt.koff * 2 : cA; const char* nB = has_next ? (const char*)g.Bt + (size_t)nxt.pn * tstepB + (size_t)nxt.koff * 2 : cB;
        const int nt = cur.nt;
        for (int t = 0; t < nt; t += 2) {
            const bool last = (t == nt - 2);
            const char* a1 = cA + (size_t)(t + 1) * kstep;
            const char* a2 = last ? nA : cA + (size_t)(t + 2) * kstep; const char* b2 = last ? nB : cB + (size_t)(t + 2) * kstep;
            const char* a3 = a2 + kstep; const char* b3 = b2 + kstep;
            PG8_LDB(B0, 0, 0); PG8_LDB(B1, 0, 1); PG8_SCHED; PG8_LDA(At, 0, 0); PG8_STAGE(PG8_SA(1, 1), a1 + hstepA, voffA);
            PG8_WAIT_V(8); PG8_WAIT_L(0); PG8_BAR; PG8_MMA(0, 0, At, B0); PG8_MMA(0, 1, At, B1); PG8_BAR; PG8_SCHED;
            PG8_LDA(At, 0, 1); PG8_STAGE(PG8_SB(0, 0), b2, voffB); PG8_STAGE(PG8_SB(0, 1), b2 + hstepB, voffB); PG8_STAGE(PG8_SA(0, 0), a2, voffA);
            PG8_WAIT_V(8); PG8_WAIT_L(0); PG8_BAR; PG8_MMA(1, 0, At, B0); PG8_MMA(1, 1, At, B1); PG8_BAR; PG8_SCHED;
            PG8_LDB(B0, 1, 0); PG8_LDB(B1, 1, 1); PG8_SCHED; PG8_LDA(At, 1, 0); PG8_STAGE(PG8_SA(0, 1), a2 + hstepA, voffA);
            PG8_WAIT_V(8); PG8_WAIT_L(0); PG8_BAR; PG8_MMA(0, 0, At, B0); PG8_MMA(0, 1, At, B1); PG8_BAR; PG8_SCHED;
            PG8_LDA(At, 1, 1); PG8_STAGE(PG8_SB(1, 0), b3, voffB); PG8_STAGE(PG8_SB(1, 1), b3 + hstepB, voffB); PG8_STAGE(PG8_SA(1, 0), a3, voffA);
            PG8_WAIT_V(8); PG8_WAIT_L(0); PG8_BAR; PG8_MMA(1, 0, At, B0); PG8_MMA(1, 1, At, B1); PG8_BAR; PG8_SCHED;
        }
        if constexpr (ALIGN_EPI) { if (wr == 0) PG8_BAR; }
        if constexpr (FP8) asm volatile("s_nop 15\n\ts_nop 15" ::: "memory");
        if (cur.sub >= 0) {
            float* sp = g.slab + (size_t)cur.sub * 65536 + (size_t)(wr * 64 + fr) * 256 + wc * 32 + 8 * fq;
#pragma unroll
            for (int ai = 0; ai < 2; ++ai)
#pragma unroll
                for (int m = 0; m < 4; ++m)
#pragma unroll
                    for (int bj = 0; bj < 2; ++bj) { float* p = sp + (size_t)(ai * 128 + m * 16) * 256 + bj * 128; *(f32x4*)p = acc[ai][bj][m][0]; *(f32x4*)(p + 4) = acc[ai][bj][m][1]; }
        } else E(acc, cur, wr, wc, fr, fq, lane);
        if (!has_next) break;
#pragma unroll
        for (int a = 0; a < 2; ++a)
#pragma unroll
            for (int b = 0; b < 2; ++b)
#pragma unroll
                for (int m = 0; m < 4; ++m)
#pragma unroll
                    for (int n = 0; n < 2; ++n) acc[a][b][m][n] = (f32x4){0.f, 0.f, 0.f, 0.f};
        cur = nxt; cA = nA; cB = nB; ++ui;
        if constexpr (ALIGN_EPI) { if (wr == 1) PG8_BAR; }
    }
    PG8_WAIT_V(0);
    if constexpr (!ALIGN_EPI) { if (wr == 0) PG8_BAR; }
    PG8_BAR;
#undef PG8_SA
#undef PG8_SB
#undef PG8_STAGE
#undef PG8_LDA
#undef PG8_LDB
#undef PG8_MMA
#undef PG8_WAIT_V
#undef PG8_WAIT_L
#undef PG8_BAR
#undef PG8_SCHED
}
template <class Epi>
__device__ __forceinline__ void gemm_finalize(const Gemm g, const SplitOrder& S, Epi E, int wid, int blk) {
    if (S.Lft == 0 || S.ns <= 1 || blk >= S.Lft * S.ns) return;
    const int lane = lane_id(), wr = wid >> 2, wc = wid & 3, fr = lane & 15, fq = lane >> 4;
    const int l = blk / S.ns, j = blk % S.ns, n8 = S.ns < 8 ? S.ns : 8;
    if (j >= n8) return;
    E.s0 = j * 8 / n8; E.s1 = (j + 1) * 8 / n8;
    Unit u; S.tile(S.R * S.G + l, u);
    f32x4 acc[2][2][4][2];
    const float* sp = g.slab + (size_t)(l * S.ns) * 65536 + (size_t)(wr * 64 + fr) * 256 + wc * 32 + 8 * fq;
#pragma unroll
    for (int ai = 0; ai < 2; ++ai)
#pragma unroll
        for (int m = 0; m < 4; ++m)
#pragma unroll
            for (int bj = 0; bj < 2; ++bj) { f32x4 a0 = {0.f, 0.f, 0.f, 0.f}, a1 = {0.f, 0.f, 0.f, 0.f};
                if (ai * 4 + m >= E.s0 && ai * 4 + m < E.s1) { const float* p = sp + (size_t)(ai * 128 + m * 16) * 256 + bj * 128;
                    for (int sl = 0; sl < S.ns; ++sl) { a0 += *(const f32x4*)(p + (size_t)sl * 65536); a1 += *(const f32x4*)(p + (size_t)sl * 65536 + 4); } }
                acc[ai][bj][m][0] = a0; acc[ai][bj][m][1] = a1; }
    E(acc, u, wr, wc, fr, fq, lane);
}
}

#define XB_TMO      128
#define XB_XCNT(j)  (256  + 64 * (j))
#define XB_XSUB(j)  (1280 + 64 * (j))
#define XB_XGEN(j)  (2304 + 64 * (j))
#define XB_TOP      3328
#define XB_TOPGEN   3392
#define XCD_BAR_WORDS 3456
#define XB_SPIN_CAP (1u << 22)

__device__ __forceinline__ unsigned xb_ld(unsigned* p)              { return __hip_atomic_load(p, __ATOMIC_RELAXED, __HIP_MEMORY_SCOPE_AGENT); }
__device__ __forceinline__ unsigned xb_add(unsigned* p, unsigned v) { return __hip_atomic_fetch_add(p, v, __ATOMIC_RELAXED, __HIP_MEMORY_SCOPE_AGENT); }
__device__ __forceinline__ unsigned xb_xcc_id() { return (unsigned)__builtin_amdgcn_s_getreg((3 << 11) | 20) & 0xFu; }
#define XB_SPIN(cond, bar) do { unsigned _sp = 0; while (cond) { __builtin_amdgcn_s_sleep(1); \
    if ((++_sp & 255u) == 0u) { if (xb_ld(&(bar)[XB_TMO])) break; if (_sp > XB_SPIN_CAP) { atomicAdd(&(bar)[XB_TMO], 1u); break; } } } } while (0)

struct XcdBarrier {
    unsigned* bar; unsigned x;
    volatile LAS unsigned* st;
};
__device__ __forceinline__ XcdBarrier xcd_barrier_post(unsigned* bar, volatile LAS unsigned* st, bool leader) {
    XcdBarrier b; b.bar = bar; b.x = xb_xcc_id(); b.st = st;
    if (leader) (void)xb_add(&bar[XB_XCNT(b.x)], 1u);
    return b;
}
__device__ __forceinline__ void xcd_barrier_complete(unsigned* bar, unsigned x, unsigned& nloc, unsigned& nx) {
    const unsigned G = gridDim.x * gridDim.y * gridDim.z;
    unsigned sum, cnt, mine, sp = 0u;
    for (;;) {
        sum = 0u; cnt = 0u; mine = 0u;
#pragma unroll
        for (unsigned j = 0; j < 16; ++j) { const unsigned c = xb_ld(&bar[XB_XCNT(j)]); sum += c; cnt += (c > 0u) ? 1u : 0u; mine = (j == x) ? c : mine; }
        if (sum == G) break;
        __builtin_amdgcn_s_sleep(1);
        if ((++sp & 255u) == 0u) { if (xb_ld(&bar[XB_TMO])) break; if (sp > XB_SPIN_CAP) { atomicAdd(&bar[XB_TMO], 1u); break; } }
    }
    nloc = mine > 0u ? mine : 1u; nx = cnt > 0u ? cnt : 1u;
}
__device__ __forceinline__ void xcd_barrier(const XcdBarrier& b, bool leader) {
    asm volatile("s_waitcnt vmcnt(0)" ::: "memory");
    __syncthreads();
    if (leader) {
        unsigned* bar = b.bar;
        __builtin_amdgcn_s_waitcnt(0);
        unsigned nloc = b.st[0], nx = b.st[1];
        if (nloc == 0u) { xcd_barrier_complete(bar, b.x, nloc, nx); b.st[0] = nloc; b.st[1] = nx; }
        const unsigned old = xb_add(&bar[XB_XSUB(b.x)], 1u);
        const unsigned gen = old / nloc;
        if (old + 1u == (gen + 1u) * nloc) {
            __builtin_amdgcn_fence(__ATOMIC_RELEASE, "agent");
            asm volatile("s_waitcnt vmcnt(0)" ::: "memory");
            const unsigned og = xb_add(&bar[XB_TOP], 1u);
            const unsigned tg = og / nx;
            if (og + 1u == (tg + 1u) * nx) xb_add(&bar[XB_TOPGEN], 1u);
            else XB_SPIN(xb_ld(&bar[XB_TOPGEN]) == tg, bar);
            __builtin_amdgcn_fence(__ATOMIC_ACQUIRE, "agent");
            xb_add(&bar[XB_XGEN(b.x)], 1u);
            asm volatile("s_waitcnt vmcnt(0)" ::: "memory");
        } else {
            XB_SPIN(xb_ld(&bar[XB_XGEN(b.x)]) == gen, bar);
            __builtin_amdgcn_fence(__ATOMIC_ACQUIRE, "agent");
            asm volatile("s_waitcnt vmcnt(0)" ::: "memory");
        }
    }
    __syncthreads();
}

struct Args { const float* in[30]; float* out; unsigned char* ws; float inv[32]; int ph_lo, ph_hi; };
enum { I_XP = 0, I_XS, I_CCKV, I_CKR, I_SHG, I_SCV, I_PP, I_PS, I_GATT, I_WIN, I_GQA, I_WUQ, I_GKVA, I_WUK, I_WUV, I_GQN, I_GQR, I_GKN, I_GKR, I_LB, I_GHG, I_WO, I_GFFN, I_WUP, I_CW, I_CB, I_WD, I_GPLE, I_WPG, I_WPLE };
struct Frame { LAS unsigned char* lds; int wave, vcu, G, gw, NGW; };
#define LDS_WAIT() asm volatile("s_waitcnt lgkmcnt(0)" ::: "memory")
#define VM_WAIT() asm volatile("s_waitcnt vmcnt(0)" ::: "memory")

DI void tr_item(const float* __restrict__ W, size_t ldw, bf16_t* __restrict__ WT, size_t ldt, const float* __restrict__ gain, int k0, int n0, int dst_row0, LAS float* scr, int lane, bf16_t* NAT, size_t ldn, int rope_np = -1, unsigned char* NAT8 = nullptr, size_t ld8 = 0, unsigned char* WT8 = nullptr, float sc8 = 1.f) {
#pragma unroll 8
    for (int i = 0; i < 32; ++i) { const int kk = 2 * i + (lane >> 5); scr[kk * 33 + (lane & 31)] = W[(size_t)(k0 + kk) * ldw + n0 + (lane & 31)]; }
    LDS_WAIT(); asm volatile("" ::: "memory");
    const int c = lane & 7;
    float gv[8];
#pragma unroll
    for (int j = 0; j < 8; ++j) gv[j] = gain ? gain[k0 + 8 * c + j] : 1.0f;
#pragma unroll
    for (int j = 0; j < 4; ++j) { const int n = (lane >> 3) + 8 * j; const LAS float* s = scr + (8 * c) * 33 + n;
        const int nn = rope_np < 0 ? n : 32 * (n >> 4) + 8 * ((n >> 2) & 3) + 4 * rope_np + (n & 3);
        if (WT8) { u32x2 o8; o8.x = pk4_fp8(s[0 * 33] * gv[0] * sc8, s[1 * 33] * gv[1] * sc8, s[2 * 33] * gv[2] * sc8, s[3 * 33] * gv[3] * sc8); o8.y = pk4_fp8(s[4 * 33] * gv[4] * sc8, s[5 * 33] * gv[5] * sc8, s[6 * 33] * gv[6] * sc8, s[7 * 33] * gv[7] * sc8);
            *(u32x2*)(WT8 + (size_t)(dst_row0 + nn) * ldt + k0 + 8 * c) = o8; continue; }
        u32x4 o; o.x = cvtpk(s[0 * 33] * gv[0], s[1 * 33] * gv[1]); o.y = cvtpk(s[2 * 33] * gv[2], s[3 * 33] * gv[3]); o.z = cvtpk(s[4 * 33] * gv[4], s[5 * 33] * gv[5]); o.w = cvtpk(s[6 * 33] * gv[6], s[7 * 33] * gv[7]);
        *(u32x4*)(WT + (size_t)(dst_row0 + nn) * ldt + k0 + 8 * c) = o; }
    if (NAT || NAT8) {
#pragma unroll
        for (int j = 0; j < 4; ++j) { const int r = (lane >> 2) + 16 * j, ch = lane & 3; const LAS float* s = scr + r * 33 + ch * 8;
            if (NAT) { u32x4 o; o.x = cvtpk(s[0], s[1]); o.y = cvtpk(s[2], s[3]); o.z = cvtpk(s[4], s[5]); o.w = cvtpk(s[6], s[7]);
                *(u32x4*)(NAT + (size_t)(k0 + r) * ldn + n0 + ch * 8) = o; }
            if (NAT8) { u32x2 o8; o8.x = pk4_fp8(s[0] * SC8_K, s[1] * SC8_K, s[2] * SC8_K, s[3] * SC8_K); o8.y = pk4_fp8(s[4] * SC8_K, s[5] * SC8_K, s[6] * SC8_K, s[7] * SC8_K); *(u32x2*)(NAT8 + (size_t)(k0 + r) * ld8 + n0 + ch * 8) = o8; } }
    }
    LDS_WAIT(); asm volatile("" ::: "memory");
}
DI bool tr_matrix(int& r, const float* W, int K, int N, bf16_t* WT, size_t ldt, const float* gain, LAS float* scr, int lane, int split_n = 1 << 30, int pad = 0, bool gate_up = false, bool uq = false, unsigned char* WT8 = nullptr, float sc8 = 1.f, int n8_lim = 1 << 30) {
    const int nblk = N / 32, nitems = (K / 64) * nblk;
    if (r >= nitems) { r -= nitems; return false; }
    const int kb = r / nblk, nb = r % nblk, n0 = 32 * nb;
    int dst = n0 < split_n ? n0 : n0 + pad;
    if (gate_up) { const int s = n0 / FF, ch = n0 % FF; dst = (ch / 128) * 256 + s * 128 + (ch % 128); }
    int np = -1;
    if (uq) { const int h = n0 / QH, d0 = n0 % QH; if (d0 < NOPE) dst = h * NOPE + d0; else { dst = 2048 + (h >> 2) * 256 + (h & 3) * 64; np = (d0 - NOPE) >> 5; } }
    tr_item(W, (size_t)N, WT, ldt, gain, 64 * kb, n0, dst, scr, lane, nullptr, 0, np, nullptr, 0, n0 < n8_lim ? WT8 : nullptr, sc8);
    return true;
}
DI void zero16(void* p, size_t bytes, int gw, int NGW, int lane) {
    const size_t n = bytes / 1024;
    for (size_t i = gw; i < n; i += NGW) *(u32x4*)((char*)p + i * 1024 + lane * 16) = (u32x4){0u, 0u, 0u, 0u};
}

DI void p0_prologue(const Frame& F, const Args& a) {
    unsigned char* ws = a.ws;
    LAS float* scr = (LAS float*)(F.lds + F.wave * 16384);
    const int lane = lane_id();
    {
        constexpr int I_IN = (D / 64) * (9792 / 32), I_UQ = (QL / 64) * (3072 / 32), I_UK = (KVL / 64) * (2048 / 32), I_CACHE = SB * (PAST / 64) * (KVL / 32);
        constexpr int NIT = I_IN + I_UQ + 2 * I_UK + I_CACHE;
        for (int it = F.gw; it < NIT; it += F.NGW) {
            int r = it;
            if (tr_matrix(r, a.in[I_WIN], D, 9792, (bf16_t*)(ws + WS_WINT), D, a.in[I_GATT], scr, lane, 1600, 192, false, false, (unsigned char*)a.out + OS_WIN8, SC8_WI, QL)) continue;
            if (tr_matrix(r, a.in[I_WUQ], QL, 3072, nullptr, QL, a.in[I_GQA], scr, lane, 1 << 30, 0, false, true, ws + WS_WUQ8, SC8_Q)) continue;
            if (tr_matrix(r, a.in[I_WUK], KVL, 2048, (bf16_t*)(ws + WS_WUKVT), KVL, nullptr, scr, lane)) continue;
            if (tr_matrix(r, a.in[I_WUV], KVL, 2048, (bf16_t*)(ws + WS_WUKVT) + (size_t)2048 * KVL, KVL, nullptr, scr, lane)) continue;
            { const int b = r / ((PAST / 64) * (KVL / 32)), rr = r % ((PAST / 64) * (KVL / 32)), kb = rr / (KVL / 32), nb = rr % (KVL / 32);
              tr_item(a.in[I_CCKV] + (size_t)b * PAST * KVL, KVL, (bf16_t*)(ws + WS_CKVT) + (size_t)b * KVL * KT, KT, nullptr, 64 * kb, 32 * nb, 32 * nb, scr, lane,
                      nullptr, 0, -1, ws + WS_KC8 + (size_t)b * PAST * KVL, KVL); }
        }
    }
    for (int row = F.gw; row < M; row += F.NGW) {
        const float* src = row < MP ? a.in[I_XP] + (size_t)row * D : a.in[I_XS] + (size_t)(row - MP) * D;
        bf16_t* dst = (bf16_t*)((unsigned char*)a.out + OS_XB) + (size_t)row * D;
        float ss = 0.f;
#pragma unroll 4
        for (int j = 0; j < 16; ++j) { const f32x4 v = *(const f32x4*)(src + j * 256 + lane * 4); ss += v[0] * v[0] + v[1] * v[1] + v[2] * v[2] + v[3] * v[3];
            u32x2 o; o.x = cvtpk(v[0], v[1]); o.y = cvtpk(v[2], v[3]); *(u32x2*)(dst + j * 256 + lane * 4) = o;
            *(unsigned*)((unsigned char*)a.out + OS_XB8 + (size_t)row * D + j * 256 + lane * 4) = pk4_fp8(v[0] * SC8_X0, v[1] * SC8_X0, v[2] * SC8_X0, v[3] * SC8_X0); }
        ss = wave_sum(ss);
        if (lane == 0) ((float*)(ws + OFF_SSQ1))[row] = ss;
    }
    for (int it = F.gw; it < SB * PAST / 8; it += F.NGW) {
        const int kg = it * 8 + (lane >> 3), b = kg / PAST, key = kg % PAST, ch = lane & 7;
        const float* s = a.in[I_CKR] + (size_t)kg * ROPE + ch * 8;
        const f32x4 v0 = *(const f32x4*)s, v1 = *(const f32x4*)(s + 4);
        *(u32x4*)((bf16_t*)(ws + WS_KCAT) + ((size_t)b * KPAD + key) * KC + KVL + ch * 8) = pack8(v0, v1);
    }
    for (int it = F.gw; it < 512 * 2048 / 512; it += F.NGW) {
        const size_t e = (size_t)it * 512 + lane * 8; const int d = (int)(e & 127);
        const f32x4 v0 = *(const f32x4*)(a.in[I_WUK] + e), v1 = *(const f32x4*)(a.in[I_WUK] + e + 4);
        const f32x4 g0 = *(const f32x4*)(a.in[I_GKN] + d), g1 = *(const f32x4*)(a.in[I_GKN] + d + 4);
        *(u32x4*)((bf16_t*)(ws + WS_WUKN) + e) = pack8(v0 * g0, v1 * g1);
    }
    for (int it = F.gw; it < (4096 / 64) * (KVL / 8); it += F.NGW) { const int n = (it >> 6) * 64 + lane, c0 = (it & 63) * 8; float v[8];
        const float* src = n < 2048 ? a.in[I_WUK] + n : a.in[I_WUV] + (n - 2048);
#pragma unroll
        for (int j = 0; j < 8; ++j) v[j] = src[(size_t)(c0 + j) * 2048] * SC8_W;
        u32x2 o8; o8.x = pk4_fp8(v[0], v[1], v[2], v[3]); o8.y = pk4_fp8(v[4], v[5], v[6], v[7]); *(u32x2*)(ws + WS_WUKV8 + (size_t)n * KVL + c0) = o8; }
    for (int it = F.gw; it < NKEY * 32 / 64; it += F.NGW) {
        const int e = it * 64 + lane, pos = e >> 5, i = e & 31;
        const float ang = (float)pos * a.inv[i];
        const double rev = (double)ang * 0.15915494309189535; const float fr = (float)(rev - __builtin_rint(rev));
        ((float*)(ws + WS_ROPE))[e] = __builtin_amdgcn_cosf(fr);
        ((float*)(ws + WS_ROPE))[NKEY * 32 + e] = __builtin_amdgcn_sinf(fr);
    }
    for (int it = F.gw; it < HGW / 64; it += F.NGW) { const int j = it * 64 + lane; const float l0 = a.in[I_LB][j], l1 = a.in[I_LB][HGW + j]; ((float*)(ws + OFF_LB))[j] = 1.0f / (1.0f + __expf(l1 - l0)); }
    for (int row = F.gw; row < M; row += F.NGW) { const float* src = row < MP ? a.in[I_PP] + (size_t)row * PLE : a.in[I_PS] + (size_t)(row - MP) * PLE; const f32x4 v = *(const f32x4*)(src + 4 * lane);
        u32x2 o; o.x = cvtpk(v[0], v[1]); o.y = cvtpk(v[2], v[3]); *(u32x2*)((bf16_t*)(ws + WS_PB) + (size_t)row * PLE + 4 * lane) = o; }
    { constexpr int NITP = (PLE / 64) * (D / 32); for (int it = F.gw; it < NITP; it += F.NGW) { int r = it; tr_matrix(r, a.in[I_WPLE], PLE, D, (bf16_t*)(ws + WS_WPT), PLE, nullptr, scr, lane); } }
    zero16((bf16_t*)(ws + WS_WINT) + (size_t)1600 * D, (size_t)192 * D * 2, F.gw, F.NGW, lane);
    for (int b = 0; b < SB; ++b) zero16((bf16_t*)(ws + WS_KCAT) + ((size_t)b * KPAD + PAST) * KC, (size_t)(KPAD - PAST) * KC * 2, F.gw, F.NGW, lane);
    for (int it = F.gw; it < SB * KVL / 4; it += F.NGW) { const int rowi = it * 4 + (lane >> 4); *(u32x4*)((bf16_t*)(ws + WS_CKVT) + (size_t)rowi * KT + PAST + (lane & 15) * 8) = (u32x4){0u, 0u, 0u, 0u}; }
    zero16(ws + WS_SSK, (size_t)SB * KPAD * 16 * 4, F.gw, F.NGW, lane);
}

#define ACC_T const f32x4 (&acc)[2][2][4][2]
#ifndef NT_STORES
#define NT_STORES 1
#endif
DI void st_bf16x8(bf16_t* p, f32x4 a, f32x4 b) { const u32x4 w = pack8(a, b); if (NT_STORES) __builtin_nontemporal_store(w, (u32x4*)p); else *(u32x4*)p = w; }
DI void st_f32x8(float* p, f32x4 a, f32x4 b) { if (NT_STORES) { __builtin_nontemporal_store(a, (f32x4*)p); __builtin_nontemporal_store(b, (f32x4*)(p + 4)); } else { *(f32x4*)p = a; *(f32x4*)(p + 4) = b; } }
DI float dot8(f32x4 a, f32x4 b) { return (a[0] * a[0] + a[1] * a[1]) + (a[2] * a[2] + a[3] * a[3]) + (b[0] * b[0] + b[1] * b[1]) + (b[2] * b[2] + b[3] * b[3]); }

struct EpiInProj {
    unsigned char* ws; int pn_off; float sc; int s0 = 0, s1 = 8;
    DI void operator()(ACC_T, const pg8::Unit& u, int wr, int wc, int fr, int fq, int lane) const {
        const float* ssq1 = (const float*)(ws + OFF_SSQ1);
        const int row0 = u.pm * 256 + wr * 64 + fr, c8 = wc * 32 + 8 * fq, pn = u.pn + pn_off;
#pragma unroll
        for (int ai = 0; ai < 2; ++ai)
#pragma unroll
            for (int m = 0; m < 4; ++m) { if (ai * 4 + m < s0 || ai * 4 + m >= s1) continue;
                const int row = row0 + ai * 128 + m * 16;
                const float rs = rsqrtf(ssq1[row] * (1.f / D) + EPS) * sc;
                f32x4 v[2][2];
#pragma unroll
                for (int bj = 0; bj < 2; ++bj) { v[bj][0] = acc[ai][bj][m][0] * rs; v[bj][1] = acc[ai][bj][m][1] * rs; }
                if (pn < 4) {
                    float ss = 0.f;
#pragma unroll
                    for (int bj = 0; bj < 2; ++bj) { ss += dot8(v[bj][0], v[bj][1]);
                        u32x2 o8; o8.x = pk4_fp8(v[bj][0][0] * SC8_K, v[bj][0][1] * SC8_K, v[bj][0][2] * SC8_K, v[bj][0][3] * SC8_K); o8.y = pk4_fp8(v[bj][1][0] * SC8_K, v[bj][1][1] * SC8_K, v[bj][1][2] * SC8_K, v[bj][1][3] * SC8_K);
                        *(u32x2*)(ws + WS_CQ8 + (size_t)row * QL + pn * 256 + bj * 128 + c8) = o8; }
                    ss += __shfl_xor(ss, 16); ss += __shfl_xor(ss, 32);
                    if (fq == 0) unsafeAtomicAdd((float*)(ws + OFF_SSQQ) + row, ss);
                } else if (pn < 6) {
#pragma unroll
                    for (int bj = 0; bj < 2; ++bj) st_f32x8((float*)(ws + WS_CKVRAW) + (size_t)row * KVL + (pn - 4) * 256 + bj * 128 + c8, v[bj][0], v[bj][1]);
                } else if (pn == 6) {
                    if (wc < 2) st_f32x8((float*)(ws + WS_KRRAW) + (size_t)row * ROPE + c8, v[0][0], v[0][1]);
                } else if (pn < 15) {
#pragma unroll
                    for (int bj = 0; bj < 2; ++bj) st_bf16x8((bf16_t*)(ws + WS_HQ) + (size_t)row * HGW + (pn - 7) * 256 + bj * 128 + c8, v[bj][0], v[bj][1]);
                } else if (pn < 23) {
#pragma unroll
                    for (int bj = 0; bj < 2; ++bj) { const int col = (pn - 15) * 256 + bj * 128 + c8;
                        const f32x4 l0 = *(const f32x4*)((const float*)(ws + OFF_LB) + col), l1 = *(const f32x4*)((const float*)(ws + OFF_LB) + col + 4);
                        f32x4 lf[2], kk[2];
#pragma unroll
                        for (int n = 0; n < 2; ++n)
#pragma unroll
                            for (int e = 0; e < 4; ++e) { const float lb = n ? l1[e] : l0[e], x = v[bj][n][e], t = __expf(-fabsf(x)), ia = 1.0f / (1.0f + t), ib = t * ia, sg = x >= 0.f ? ia : ib, sgn = x >= 0.f ? ib : ia;
                                lf[n][e] = __logf(lb + (1.0f - lb) * sg); kk[n][e] = (1.0f - lb) * sgn; }
                        st_f32x8((float*)(ws + WS_LF) + (size_t)row * HGW + col, lf[0], lf[1]);
                        st_bf16x8((bf16_t*)(ws + WS_HK) + (size_t)row * HGW + col, kk[0], kk[1]); }
                } else if (pn < 31) {
#pragma unroll
                    for (int bj = 0; bj < 2; ++bj) st_bf16x8((bf16_t*)(ws + WS_HV) + (size_t)row * HGW + (pn - 23) * 256 + bj * 128 + c8, v[bj][0], v[bj][1]);
                } else {
#pragma unroll
                    for (int bj = 0; bj < 2; ++bj) { f32x4 g[2];
#pragma unroll
                        for (int n = 0; n < 2; ++n)
#pragma unroll
                            for (int e = 0; e < 4; ++e) { const float x = v[bj][n][e]; g[n][e] = x / (1.0f + __expf(-x)); }
                        st_bf16x8((bf16_t*)(ws + WS_HG) + (size_t)row * HGW + (pn - 31) * 256 + bj * 128 + c8, g[0], g[1]); }
                }
            }
    }
};
struct EpiSumsq {
    unsigned char* ws; float scale; int fix16;
    DI void operator()(ACC_T, const pg8::Unit& u, int wr, int wc, int fr, int fq, int lane) const {
        const int row0 = (u.pm + (fix16 ? u.pm >> 4 : 0)) * 256 + wr * 64 + fr;
#pragma unroll
        for (int ai = 0; ai < 2; ++ai)
#pragma unroll
            for (int bj = 0; bj < 2; ++bj) {
                float s[4];
#pragma unroll
                for (int m = 0; m < 4; ++m) { float t = dot8(acc[ai][bj][m][0], acc[ai][bj][m][1]); t += __shfl_xor(t, 16); t += __shfl_xor(t, 32); s[m] = t; }
                const float sv = fq == 0 ? s[0] : fq == 1 ? s[1] : fq == 2 ? s[2] : s[3];
                unsafeAtomicAdd((float*)(ws + WS_SSK) + (size_t)(u.pn * 2 + bj) * ((size_t)SB * KPAD) + (row0 + ai * 128 + fq * 16), sv * scale);
            }
    }
};
struct EpiUq {
    unsigned char* ws; const float* gqn; const float* gqr; LAS unsigned char* lds; float sc; int s0 = 0, s1 = 8;
    DI void operator()(ACC_T, const pg8::Unit& u, int wr, int wc, int fr, int fq, int lane) const {
        const float* ssq = (const float*)(ws + OFF_SSQQ);
        const int row0 = u.pm * 256 + wr * 64 + fr, c8 = wc * 32 + 8 * fq;
        LAS float* xs = (LAS float*)(lds + XCH_OFF);
#pragma unroll
        for (int ai = 0; ai < 2; ++ai)
#pragma unroll
            for (int m = 0; m < 4; ++m) { if (ai * 4 + m < s0 || ai * 4 + m >= s1) continue; const float rs = rsqrtf(ssq[row0 + ai * 128 + m * 16] * (1.f / QL) + EPS) * sc;
#pragma unroll
                for (int bj = 0; bj < 2; ++bj) { float s = dot8(acc[ai][bj][m][0] * rs, acc[ai][bj][m][1] * rs); s += __shfl_xor(s, 16); s += __shfl_xor(s, 32);
                    if (fq == 0) xs[((ai * 128 + wr * 64 + m * 16 + fr) * 2 + bj) * 4 + wc] = s; } }
        asm volatile("s_waitcnt lgkmcnt(0)" ::: "memory"); __builtin_amdgcn_s_barrier(); asm volatile("" ::: "memory");
        bf16_t* Q = (bf16_t*)(ws + WS_Q);
        if (u.pn < 8) {
            const f32x4 g0 = *(const f32x4*)(gqn + c8), g1 = *(const f32x4*)(gqn + c8 + 4);
#pragma unroll
            for (int ai = 0; ai < 2; ++ai)
#pragma unroll
                for (int m = 0; m < 4; ++m) { if (ai * 4 + m < s0 || ai * 4 + m >= s1) continue; const int row = row0 + ai * 128 + m * 16; const float rs = rsqrtf(ssq[row] * (1.f / QL) + EPS) * sc;
#pragma unroll
                    for (int bj = 0; bj < 2; ++bj) { const f32x4 p = *(const LAS f32x4*)(xs + ((ai * 128 + wr * 64 + m * 16 + fr) * 2 + bj) * 4);
                        const float rn = rsqrtf(((p[0] + p[1]) + (p[2] + p[3])) * (1.f / NOPE) + EPS) * rs;
                        const f32x4 y0 = acc[ai][bj][m][0] * rn * g0, y1 = acc[ai][bj][m][1] * rn * g1;
                        if (u.pm >= MP / 256) st_bf16x8(Q + (size_t)row * 3072 + (u.pn * 2 + bj) * QH + c8, y0, y1);
                        else { u32x2 o8; o8.x = pk4_fp8(y0[0] * SC8_A, y0[1] * SC8_A, y0[2] * SC8_A, y0[3] * SC8_A); o8.y = pk4_fp8(y1[0] * SC8_A, y1[1] * SC8_A, y1[2] * SC8_A, y1[3] * SC8_A);
                            *(u32x2*)(ws + WS_Q + (size_t)row * 3072 + (u.pn * 2 + bj) * QH + c8) = o8; } } }
        } else {
            const int i0 = 16 * (wc & 1) + 4 * fq, hw = wc >> 1; const bool smp = u.pm >= MP / 256;
            const f32x4 ga = *(const f32x4*)(gqr + i0), gb = *(const f32x4*)(gqr + 32 + i0);
            const float* ropec = (const float*)(ws + WS_ROPE); const float* ropes = ropec + NKEY * 32;
#pragma unroll
            for (int ai = 0; ai < 2; ++ai)
#pragma unroll
                for (int m = 0; m < 4; ++m) { if (ai * 4 + m < s0 || ai * 4 + m >= s1) continue; const int row = row0 + ai * 128 + m * 16; const float rs = rsqrtf(ssq[row] * (1.f / QL) + EPS) * sc;
                    const int pos = smp ? PAST + ((row - MP) & 15) : (row & (SEQ - 1));
                    const f32x4 c = *(const f32x4*)(ropec + pos * 32 + i0), s = *(const f32x4*)(ropes + pos * 32 + i0);
#pragma unroll
                    for (int bj = 0; bj < 2; ++bj) { const f32x4 p = *(const LAS f32x4*)(xs + ((ai * 128 + wr * 64 + m * 16 + fr) * 2 + bj) * 4);
                        const float rr = rsqrtf((hw ? p[2] + p[3] : p[0] + p[1]) * (1.f / ROPE) + EPS) * rs;
                        const f32x4 y1 = acc[ai][bj][m][0] * rr * ga, y2 = acc[ai][bj][m][1] * rr * gb, o1 = y1 * c - y2 * s, o2 = y2 * c + y1 * s;
                        u32x2 w1, w2; w1.x = cvtpk(o1[0], o1[1]); w1.y = cvtpk(o1[2], o1[3]); w2.x = cvtpk(o2[0], o2[1]); w2.y = cvtpk(o2[2], o2[3]);
                        const int h = 4 * (u.pn - 8) + 2 * bj + hw;
                        if (smp) { bf16_t* qp = Q + (size_t)row * 3072 + h * QH + NOPE + i0; *(u32x2*)qp = w1; *(u32x2*)(qp + 32) = w2; }
                        else { unsigned char* q8 = ws + WS_Q + (size_t)row * 3072 + h * QH + NOPE + i0; *(unsigned*)q8 = pk4_fp8(o1[0] * SC8_A, o1[1] * SC8_A, o1[2] * SC8_A, o1[3] * SC8_A); *(unsigned*)(q8 + 32) = pk4_fp8(o2[0] * SC8_A, o2[1] * SC8_A, o2[2] * SC8_A, o2[3] * SC8_A); }
                        if (smp) { bf16_t* qc = (bf16_t*)(ws + WS_QCAT) + ((size_t)(row - MP) * 16 + h) * KC + KVL + i0; *(u32x2*)qc = w1; *(u32x2*)(qc + 32) = w2; } } }
        }
        asm volatile("s_waitcnt lgkmcnt(0)" ::: "memory"); __builtin_amdgcn_s_barrier(); asm volatile("" ::: "memory");
    }
};

DI void p2_norm_rows(const Frame& F, const Args& a) {
    unsigned char* ws = a.ws; const int lane = lane_id();
    const float* ropec = (const float*)(ws + WS_ROPE); const float* ropes = ropec + NKEY * 32;
    for (int row = F.gw; row < M; row += F.NGW) {
        const bool smp = row >= MP; const int sr = row - MP, sb = sr >> 4, st = sr & 15;
        const float* cr = (const float*)(ws + WS_CKVRAW) + (size_t)row * KVL;
        f32x4 v0 = *(const f32x4*)(cr + 4 * lane), v1 = *(const f32x4*)(cr + 256 + 4 * lane);
        float ss = (v0[0] * v0[0] + v0[1] * v0[1]) + (v0[2] * v0[2] + v0[3] * v0[3]) + (v1[0] * v1[0] + v1[1] * v1[1]) + (v1[2] * v1[2] + v1[3] * v1[3]);
        ss = wave_sum(ss);
        const float rs = rsqrtf(ss * (1.f / KVL) + EPS);
        const f32x4 g0 = *(const f32x4*)(a.in[I_GKVA] + 4 * lane), g1 = *(const f32x4*)(a.in[I_GKVA] + 256 + 4 * lane);
        v0 = v0 * rs * g0; v1 = v1 * rs * g1;
        float* oc = a.out + (smp ? O_CKVS + (size_t)sr * KVL : O_CKVP + (size_t)row * KVL);
        *(f32x4*)(oc + 4 * lane) = v0; *(f32x4*)(oc + 256 + 4 * lane) = v1;
        u32x2 w0, w1; w0.x = cvtpk(v0[0], v0[1]); w0.y = cvtpk(v0[2], v0[3]); w1.x = cvtpk(v1[0], v1[1]); w1.y = cvtpk(v1[2], v1[3]);
        { unsigned char* c8p = ws + WS_CKVN8 + (size_t)row * KVL; *(unsigned*)(c8p + 4 * lane) = pk4_fp8(v0[0] * SC8_K, v0[1] * SC8_K, v0[2] * SC8_K, v0[3] * SC8_K); *(unsigned*)(c8p + 256 + 4 * lane) = pk4_fp8(v1[0] * SC8_K, v1[1] * SC8_K, v1[2] * SC8_K, v1[3] * SC8_K); }
        if (smp) {
            bf16_t* kc = (bf16_t*)(ws + WS_KCAT) + ((size_t)sb * KPAD + PAST + st) * KC;
            *(u32x2*)(kc + 4 * lane) = w0; *(u32x2*)(kc + 256 + 4 * lane) = w1;
            bf16_t* ct = (bf16_t*)(ws + WS_CKVT) + (size_t)sb * KVL * KT + PAST + st;
            const unsigned e0[4] = {w0.x & 0xffffu, w0.x >> 16, w0.y & 0xffffu, w0.y >> 16}, e1[4] = {w1.x & 0xffffu, w1.x >> 16, w1.y & 0xffffu, w1.y >> 16};
#pragma unroll
            for (int e = 0; e < 4; ++e) { ct[(size_t)(4 * lane + e) * KT] = (bf16_t)e0[e]; ct[(size_t)(256 + 4 * lane + e) * KT] = (bf16_t)e1[e]; }
        }
        const float kv = ((const float*)(ws + WS_KRRAW))[(size_t)row * ROPE + lane];
        const float s2 = wave_sum(kv * kv);
        const float y = kv * rsqrtf(s2 * (1.f / ROPE) + EPS) * a.in[I_GKR][lane];
        const float yo = __shfl_xor(y, 32);
        const int pos = smp ? PAST + st : (row & (SEQ - 1)), i = lane & 31;
        const float c = ropec[pos * 32 + i], s = ropes[pos * 32 + i];
        const float o = lane < 32 ? y * c - yo * s : y * c + yo * s;
        (a.out + (smp ? O_KRS + (size_t)sr * ROPE : O_KRP + (size_t)row * ROPE))[lane] = o;
        const bf16_t ob = f2bf(o);
        if (!smp) (ws + WS_KRN)[(size_t)row * ROPE + lane] = (unsigned char)(pk4_fp8(o * SC8_A, 0.f, 0.f, 0.f) & 0xffu);
        if (smp) ((bf16_t*)(ws + WS_KCAT))[((size_t)sb * KPAD + PAST + st) * KC + KVL + lane] = ob;
    }
}

struct EpiKup {
    unsigned char* ws; const float* gkn; LAS unsigned char* lds; float sc;
    DI void operator()(ACC_T, const pg8::Unit& u, int wr, int wc, int fr, int fq, int lane) const {
        const int row0 = u.pm * 256 + wr * 64 + fr, c8 = wc * 32 + 8 * fq;
        if (u.pn >= 8) { bf16_t* base = (bf16_t*)(ws + WS_V) + (u.pn & 7) * 256 + c8;
#pragma unroll
            for (int ai = 0; ai < 2; ++ai)
#pragma unroll
                for (int m = 0; m < 4; ++m)
#pragma unroll
                    for (int bj = 0; bj < 2; ++bj) st_bf16x8(base + (size_t)(row0 + ai * 128 + m * 16) * 2048 + bj * 128, acc[ai][bj][m][0] * sc, acc[ai][bj][m][1] * sc);
            return; }
        LAS float* xs = (LAS float*)(lds + XCH_OFF);
#pragma unroll
        for (int ai = 0; ai < 2; ++ai)
#pragma unroll
            for (int m = 0; m < 4; ++m)
#pragma unroll
                for (int bj = 0; bj < 2; ++bj) { float s = dot8(acc[ai][bj][m][0] * sc, acc[ai][bj][m][1] * sc); s += __shfl_xor(s, 16); s += __shfl_xor(s, 32);
                    if (fq == 0) xs[((ai * 128 + wr * 64 + m * 16 + fr) * 2 + bj) * 4 + wc] = s; }
        asm volatile("s_waitcnt lgkmcnt(0)" ::: "memory"); __builtin_amdgcn_s_barrier(); asm volatile("" ::: "memory");
        const f32x4 g0 = *(const f32x4*)(gkn + c8), g1 = *(const f32x4*)(gkn + c8 + 4);
        unsigned char* base = ws + WS_KN + (u.pn & 7) * 256 + c8;
#pragma unroll
        for (int ai = 0; ai < 2; ++ai)
#pragma unroll
            for (int m = 0; m < 4; ++m)
#pragma unroll
                for (int bj = 0; bj < 2; ++bj) { const f32x4 p = *(const LAS f32x4*)(xs + ((ai * 128 + wr * 64 + m * 16 + fr) * 2 + bj) * 4);
                    const float rn = rsqrtf(((p[0] + p[1]) + (p[2] + p[3])) * (1.f / NOPE) + EPS) * sc;
                    const f32x4 y0 = acc[ai][bj][m][0] * (rn * SC8_A) * g0, y1 = acc[ai][bj][m][1] * (rn * SC8_A) * g1;
                    u32x2 o8; o8.x = pk4_fp8(y0[0], y0[1], y0[2], y0[3]); o8.y = pk4_fp8(y1[0], y1[1], y1[2], y1[3]); *(u32x2*)(base + (size_t)(row0 + ai * 128 + m * 16) * 2048 + bj * 128) = o8; }
        asm volatile("s_waitcnt lgkmcnt(0)" ::: "memory"); __builtin_amdgcn_s_barrier(); asm volatile("" ::: "memory");
    }
};
DI int crow(int r, int hi) { return (r & 3) + 8 * (r >> 2) + 4 * hi; }
template <int NJ, bool AF32, class Mid>
DI void sgemm_tile(const void* Av, size_t lda, const bf16_t* Bt, size_t ldb, int K, int mid_k, const Mid& mid, f32x16 (&acc)[2][NJ], int wave, int lane) {
    const int wm = wave >> 2, wn = wave & 3, r32 = lane & 31, hi = lane >> 5;
#pragma unroll
    for (int i = 0; i < 2; ++i)
#pragma unroll
        for (int j = 0; j < NJ; ++j)
#pragma unroll
            for (int r = 0; r < 16; ++r) acc[i][j][r] = 0.f;
    const bf16_t* bp[NJ];
#pragma unroll
    for (int j = 0; j < NJ; ++j) bp[j] = Bt + (size_t)(wn * 32 * NJ + j * 32 + r32) * ldb + hi * 8;
    if constexpr (AF32) {
        for (int k0 = 0; k0 < K; k0 += 16) {
            bf16x8 af[2], bf_[NJ];
#pragma unroll
            for (int i = 0; i < 2; ++i) { const float* p = (const float*)Av + (size_t)(wm * 64 + i * 32 + r32) * lda + hi * 8 + k0; af[i] = __builtin_bit_cast(bf16x8, pack8(*(const f32x4*)p, *(const f32x4*)(p + 4))); }
#pragma unroll
            for (int j = 0; j < NJ; ++j) bf_[j] = *(const bf16x8*)(bp[j] + k0);
#pragma unroll
            for (int i = 0; i < 2; ++i)
#pragma unroll
                for (int j = 0; j < NJ; ++j) acc[i][j] = __builtin_amdgcn_mfma_f32_32x32x16_bf16(af[i], bf_[j], acc[i][j], 0, 0, 0);
        }
    } else {
    for (int k0 = 0; k0 < K; k0 += 64) {
        bf16x8 af[2][4], bf_[NJ][4];
#pragma unroll
        for (int i = 0; i < 2; ++i)
#pragma unroll
            for (int ks = 0; ks < 4; ++ks) af[i][ks] = *(const bf16x8*)((const bf16_t*)Av + (size_t)(wm * 64 + i * 32 + r32) * lda + hi * 8 + k0 + ks * 16);
#pragma unroll
        for (int j = 0; j < NJ; ++j)
#pragma unroll
            for (int ks = 0; ks < 4; ++ks) bf_[j][ks] = *(const bf16x8*)(bp[j] + k0 + ks * 16);
        if (k0 == mid_k) mid(acc);
#pragma unroll
        for (int ks = 0; ks < 4; ++ks)
#pragma unroll
            for (int i = 0; i < 2; ++i)
#pragma unroll
                for (int j = 0; j < NJ; ++j) acc[i][j] = __builtin_amdgcn_mfma_f32_32x32x16_bf16(af[i][ks], bf_[j][ks], acc[i][j], 0, 0, 0);
    }
    }
}
struct NoMid { template <class T> DI void operator()(T&) const {} };

DI void p4_qa_unit(const Frame& F, const Args& a, int unit) {
    unsigned char* ws = a.ws; const int h = unit >> 3, mt = (unit >> 1) & 3, nt = unit & 1;
    f32x16 acc[2][2];
    sgemm_tile<2, false>((const bf16_t*)(ws + WS_Q) + (size_t)(MP + mt * 128) * 3072 + h * QH, 3072, (const bf16_t*)(ws + WS_WUKN) + (size_t)(nt * 256) * 2048 + h * 128, 2048, NOPE, -1, NoMid(), acc, F.wave, lane_id());
    const int wm = F.wave >> 2, wn = F.wave & 3, r32 = lane_id() & 31, hi = lane_id() >> 5;
#pragma unroll
    for (int i = 0; i < 2; ++i)
#pragma unroll
        for (int j = 0; j < 2; ++j)
#pragma unroll
            for (int r = 0; r < 16; ++r) { const int t = mt * 128 + wm * 64 + i * 32 + crow(r, hi), c = nt * 256 + wn * 64 + j * 32 + r32;
                ((bf16_t*)(ws + WS_QCAT))[((size_t)t * 16 + h) * KC + c] = f2bf(acc[i][j][r]); }
    __builtin_amdgcn_sched_barrier(0);
#pragma unroll
    for (int i = 0; i < 2; ++i)
#pragma unroll
        for (int j = 0; j < 2; ++j)
#pragma unroll
            for (int r4 = 0; r4 < 4; ++r4) {
#pragma unroll
                for (int e = 0; e < 4; ++e) { const int r = 4 * r4 + e, t = mt * 128 + wm * 64 + i * 32 + crow(r, hi), c = nt * 256 + wn * 64 + j * 32 + r32;
                    (ws + WS_QCAT8)[((size_t)t * 16 + h) * KVL + c] = (unsigned char)(pk4_fp8(acc[i][j][r] * SC8_QA, 0.f, 0.f, 0.f) & 0xffu); }
                __builtin_amdgcn_sched_barrier(0); }
}

namespace att {
constexpr int SHM_K = 64 * 256  , SHM_V = 64 * 128 * 2;
constexpr int OFF_V = 0, OFF_K = 2 * SHM_V, OFF_WS = OFF_K + 2 * SHM_K, LDS_NEED = OFF_WS + 8 * 64 * 4;
static_assert(LDS_NEED <= RING_BYTES, "attention LDS");
#define KSWZ(row, colB) ((row) * 256 + ((colB) ^ (((row) & 7) << 4)))
#define SBAR() __builtin_amdgcn_sched_barrier(0)
DI int v_st(int k, int c) { const int kk = (k & ~0xC) | ((k & 4) << 1) | ((k & 8) >> 1); return ((kk >> 3) * 4 + (c >> 5)) * 512 + ((kk & 7) * 32 + (c & 31)) * 2; }
DI int v_rd_base(int lane) { return ((lane & 3) << 3) | (((lane >> 2) & 3) << 6) | (((lane >> 4) & 1) << 5) | (((lane >> 5) & 1) << 8); }
constexpr float THR = 8.f;
constexpr float ASC = ATT_SCALE / (SC8_A * SC8_A);
constexpr float C2 = 1.4426950408889634f * ASC;

DI void partialSM(f32x16& p0, f32x16& p1, float& m_reg, float& mn, float& alpha) {
    float pmax = p0[0];
#pragma unroll
    for (int r = 1; r < 16; ++r) pmax = fmaxf(pmax, p0[r]);
#pragma unroll
    for (int r = 0; r < 16; ++r) pmax = fmaxf(pmax, p1[r]);
    { auto rr = __builtin_amdgcn_permlane32_swap(__float_as_uint(pmax), __float_as_uint(pmax), false, false);
      pmax = fmaxf(__uint_as_float(rr[0]), __uint_as_float(rr[1])); }
    if (__builtin_expect(__all((pmax - m_reg) * ASC <= THR), 1)) { mn = m_reg; alpha = 1.f; }
    else { mn = fmaxf(m_reg, pmax); alpha = __builtin_amdgcn_exp2f((m_reg - mn) * C2); m_reg = mn; }
    const float mnL = -mn * C2;
#pragma unroll
    for (int r = 0; r < 16; ++r) p0[r] = fmaf(p0[r], C2, mnL);
#pragma unroll
    for (int r = 0; r < 16; ++r) p1[r] = fmaf(p1[r], C2, mnL);
#pragma unroll
    for (int r = 0; r < 16; ++r) p0[r] = __builtin_amdgcn_exp2f(p0[r]);
}
DI void finishSM(f32x16& p0, f32x16& p1, float alpha, float& l_reg, bf16x8& pa0, bf16x8& pa1, bf16x8& pa2, bf16x8& pa3) {
#pragma unroll
    for (int r = 0; r < 16; ++r) p1[r] = __builtin_amdgcn_exp2f(p1[r]);
    float ps = 0;
#pragma unroll
    for (int r = 0; r < 16; ++r) ps += p0[r];
#pragma unroll
    for (int r = 0; r < 16; ++r) ps += p1[r];
    { auto rr = __builtin_amdgcn_permlane32_swap(__float_as_uint(ps), __float_as_uint(ps), false, false);
      ps = __uint_as_float(rr[0]) + __uint_as_float(rr[1]); }
    l_reg = l_reg * alpha + ps;
#define PK4(P, B_, OUT) do { unsigned a0 = cvtpk(P[B_+0], P[B_+1]), a1 = cvtpk(P[B_+2], P[B_+3]);                          \
        unsigned b0 = cvtpk(P[B_+4], P[B_+5]), b1 = cvtpk(P[B_+6], P[B_+7]);                                             \
        auto r0 = __builtin_amdgcn_permlane32_swap(a0, b0, false, false); auto r1 = __builtin_amdgcn_permlane32_swap(a1, b1, false, false); \
        u32x4 w = {r0[0], r1[0], r0[1], r1[1]}; OUT = __builtin_bit_cast(bf16x8, w); } while (0)
    PK4(p0, 0, pa0); PK4(p0, 8, pa1); PK4(p1, 0, pa2); PK4(p1, 8, pa3);
#undef PK4
}
template <int KB>
DI void qkt(f32x16& p0, f32x16& p1, const LAS char* lds, int r32, int hi, const i32x8* q8, bool act) {
    if (!act) { const float NEG = -__builtin_inff();
#pragma unroll
        for (int r = 0; r < 16; ++r) { p0[r] = NEG; p1[r] = NEG; } return; }
#pragma unroll
    for (int r = 0; r < 16; ++r) { p0[r] = 0.f; p1[r] = 0.f; }
    int kb0 = KSWZ(r32, hi * 32);
    asm volatile("" : "+v"(kb0));
#define QK_LD(s, kb, dst) do { const LAS char* a0_ = lds + OFF_K + KB * SHM_K + (kb0 ^ (64 * ((s) & 1))) + 128 * ((s) >> 1) + (kb) * 32 * 256; const LAS char* a1_ = lds + OFF_K + KB * SHM_K + (kb0 ^ (64 * ((s) & 1) + 16)) + 128 * ((s) >> 1) + (kb) * 32 * 256; \
        dst.lo = *(const LAS i32x4*)a0_; dst.hi = *(const LAS i32x4*)a1_; } while (0)
    { i32x8 ka, kb_; QK_LD(0, 0, ka); QK_LD(0, 1, kb_);
      asm volatile("s_nop 1\n\tv_mfma_f32_32x32x64_f8f6f4 %0, %1, %2, %0" : "+v"(p0) : "v"(ka), "v"(q8[0]));
      asm volatile("s_nop 1\n\tv_mfma_f32_32x32x64_f8f6f4 %0, %1, %2, %0" : "+v"(p1) : "v"(kb_), "v"(q8[0])); }
    { i32x8 ka, kb_; QK_LD(1, 0, ka); QK_LD(1, 1, kb_);
      asm volatile("v_mfma_f32_32x32x64_f8f6f4 %0, %1, %2, %0" : "+v"(p0) : "v"(ka), "v"(q8[1]));
      asm volatile("v_mfma_f32_32x32x64_f8f6f4 %0, %1, %2, %0" : "+v"(p1) : "v"(kb_), "v"(q8[1])); }
    { i32x8 ka, kb_; QK_LD(2, 0, ka); QK_LD(2, 1, kb_);
      asm volatile("v_mfma_f32_32x32x64_f8f6f4 %0, %1, %2, %0" : "+v"(p0) : "v"(ka), "v"(q8[2]));
      asm volatile("v_mfma_f32_32x32x64_f8f6f4 %0, %1, %2, %0\n\ts_nop 15\n\ts_nop 7" : "+v"(p1) : "v"(kb_), "v"(q8[2])); }
#undef QK_LD
}
template <int VB>
DI void pv_tile(f32x16* o, int vb0, bf16x8 pa0, bf16x8 pa1, bf16x8 pa2, bf16x8 pa3, bool act) {
    if (!act) return;
#define TRRD(dst, off) asm volatile("ds_read_b64_tr_b16 %0, %1 offset:%2" : "=&v"(dst) : "v"(vb0), "i"(off) : "memory")
#define PV_RD(d0, S) do { constexpr int b_ = OFF_V + VB * SHM_V + (d0) * 512; \
        TRRD(S##l0, b_); TRRD(S##h0, b_ + 2048); TRRD(S##l1, b_ + 4096); TRRD(S##h1, b_ + 6144); TRRD(S##l2, b_ + 8192); TRRD(S##h2, b_ + 10240); TRRD(S##l3, b_ + 12288); TRRD(S##h3, b_ + 14336); } while (0)
#define PV_MM(d0, S) do { \
        o[d0] = __builtin_amdgcn_mfma_f32_32x32x16_bf16(pa0, (bf16x8){S##l0[0], S##l0[1], S##l0[2], S##l0[3], S##h0[0], S##h0[1], S##h0[2], S##h0[3]}, o[d0], 0, 0, 0);   \
        o[d0] = __builtin_amdgcn_mfma_f32_32x32x16_bf16(pa1, (bf16x8){S##l1[0], S##l1[1], S##l1[2], S##l1[3], S##h1[0], S##h1[1], S##h1[2], S##h1[3]}, o[d0], 0, 0, 0);   \
        o[d0] = __builtin_amdgcn_mfma_f32_32x32x16_bf16(pa2, (bf16x8){S##l2[0], S##l2[1], S##l2[2], S##l2[3], S##h2[0], S##h2[1], S##h2[2], S##h2[3]}, o[d0], 0, 0, 0);   \
        o[d0] = __builtin_amdgcn_mfma_f32_32x32x16_bf16(pa3, (bf16x8){S##l3[0], S##l3[1], S##l3[2], S##l3[3], S##h3[0], S##h3[1], S##h3[2], S##h3[3]}, o[d0], 0, 0, 0); } while (0)
    s16x4 Al0, Al1, Al2, Al3, Ah0, Ah1, Ah2, Ah3, Bl0, Bl1, Bl2, Bl3, Bh0, Bh1, Bh2, Bh3;
    PV_RD(0, A);
    PV_RD(1, B); asm volatile("s_waitcnt lgkmcnt(8)" ::: "memory"); SBAR(); PV_MM(0, A); SBAR();
    PV_RD(2, A); asm volatile("s_waitcnt lgkmcnt(8)" ::: "memory"); SBAR(); PV_MM(1, B); SBAR();
    PV_RD(3, B); asm volatile("s_waitcnt lgkmcnt(8)" ::: "memory"); SBAR(); PV_MM(2, A); SBAR();
    asm volatile("s_waitcnt lgkmcnt(0)" ::: "memory"); SBAR(); PV_MM(3, B);
#undef PV_RD
#undef PV_MM
#undef TRRD
}

DI void attn_unit(int b, int h, int qb, const unsigned char* __restrict__ Q8, const unsigned char* __restrict__ KN8, const unsigned char* __restrict__ KR8, const bf16_t* __restrict__ V, bf16_t* __restrict__ O, LAS char* lds, int wid) {
    const int lane = lane_id(), tid = wid * 64 + lane, r32 = lane & 31, hi = lane >> 5;
    const int NT = 4 * qb + 4, wchunk = 4 * qb + (wid >> 1);
    const size_t krow0 = (size_t)b * SEQ;
    const unsigned char* Kh = KN8 + krow0 * 2048 + h * 128; const bf16_t* Vh = V + krow0 * 2048 + h * 128; const unsigned char* Rh = KR8 + krow0 * ROPE;
    LAS float* wsl = (LAS float*)(lds + OFF_WS) + wid * 64; LAS float* li_l = wsl; LAS float* al_l = wsl + 32;
    float m_reg = -1e30f, l_reg = 0; f32x16 o[4];
#pragma unroll
    for (int d = 0; d < 4; ++d)
#pragma unroll
        for (int r = 0; r < 16; ++r) o[d][r] = 0.f;
    const int sr = tid >> 4, sc = (tid & 15) * 8, vst0 = v_st(sr, sc), vst1 = v_st(32 + sr, sc);
    const int rr_ = tid >> 3, rc = tid & 7, kws = KSWZ(rr_, rc * 16), krws = KSWZ(rr_, 128 + rc * 8);
    const int vb0 = (int)(unsigned)(size_t)(lds) + v_rd_base(lane);
    i32x8 q8[3];
    { const unsigned char* qp = Q8 + ((size_t)b * SEQ + qb * 256 + wid * 32 + r32) * 3072 + h * QH + hi * 32;
#pragma unroll
      for (int s = 0; s < 3; ++s) { q8[s].lo = *(const i32x4*)(qp + 64 * s); q8[s].hi = *(const i32x4*)(qp + 64 * s + 16); } }
    bf16x8 st_v0, st_v1; u32x4 st_k; u32x2 st_kr;
#define SLOAD(k0) do { st_v0 = *(const bf16x8*)(Vh + (size_t)((k0) + sr) * 2048 + sc); st_v1 = *(const bf16x8*)(Vh + (size_t)((k0) + 32 + sr) * 2048 + sc); \
                       st_k = *(const u32x4*)(Kh + (size_t)((k0) + rr_) * 2048 + rc * 16); st_kr = *(const u32x2*)(Rh + (size_t)((k0) + rr_) * ROPE + rc * 8); } while (0)
#define SWRITE(bf) do { *(LAS bf16x8*)(lds + OFF_V + (bf) * SHM_V + vst0) = st_v0; *(LAS bf16x8*)(lds + OFF_V + (bf) * SHM_V + vst1) = st_v1; \
                        *(LAS u32x4*)(lds + OFF_K + (bf) * SHM_K + kws) = st_k; *(LAS u32x2*)(lds + OFF_K + (bf) * SHM_K + krws) = st_kr; } while (0)
#define VMW() asm volatile("s_waitcnt vmcnt(0)" ::: "memory")
#define RESC(a_) do { if (__any((a_) < 1.f)) { if (hi == 0) al_l[r32] = (a_); asm volatile("s_waitcnt lgkmcnt(0)" ::: "memory");              \
                     for (int d_ = 0; d_ < 4; ++d_) for (int r = 0; r < 16; ++r) o[d_][r] *= al_l[crow(r, hi)]; } } while (0)
#define ACT(t) ((t) <= wchunk)
    f32x16 pA0, pA1, pB0, pB1; float mnA, mnB, alA, alB; bf16x8 pa0, pa1, pa2, pa3;
    SLOAD(0); VMW(); SWRITE(0);
    __syncthreads();
    if (NT > 1) SLOAD(64);
    SBAR(); qkt<0>(pA0, pA1, lds, r32, hi, q8, ACT(0));
    partialSM(pA0, pA1, m_reg, mnA, alA);
    if (NT > 1) { VMW(); SWRITE(1); }
    __syncthreads();
#define HALF_STEP(ORD, PX0, PX1, mnX, alX, PY0, PY1, alY, t, KB, VB, SB_) do {                                                      \
        if (ORD == 0) {                                                                                                       \
        SBAR(); if ((t) + 1 < NT) { SLOAD(((t) + 1) * 64); SBAR(); }                                       \
        qkt<KB>(PX0, PX1, lds, r32, hi, q8, ACT(t));                                             \
        finishSM(PY0, PY1, alY, l_reg, pa0, pa1, pa2, pa3); SBAR();                                                           \
        pv_tile<VB>(o, vb0, pa0, pa1, pa2, pa3, ACT((t) - 1)); partialSM(PX0, PX1, m_reg, mnX, alX);                                        \
        } else {                                                                                                              \
        SBAR(); if ((t) + 1 < NT) { SLOAD(((t) + 1) * 64); SBAR(); }                                       \
        finishSM(PY0, PY1, alY, l_reg, pa0, pa1, pa2, pa3); SBAR();                                                   \
        qkt<KB>(PX0, PX1, lds, r32, hi, q8, ACT(t)); SBAR();                                             \
        partialSM(PX0, PX1, m_reg, mnX, alX); pv_tile<VB>(o, vb0, pa0, pa1, pa2, pa3, ACT((t) - 1));                                        \
        }                                                                                                                     \
        __syncthreads();                                                                                                      \
        if ((t) + 1 < NT) { VMW(); SWRITE(SB_); }                                                                          \
        RESC(alX); __syncthreads(); } while (0)
    if (wid < 4) {
        for (int t = 1; t + 1 < NT; t += 2) {
            HALF_STEP(0, pB0, pB1, mnB, alB, pA0, pA1, alA, t, 1, 0, 0);
            HALF_STEP(0, pA0, pA1, mnA, alA, pB0, pB1, alB, t + 1, 0, 1, 1);
        }
    } else {
        for (int t = 1; t + 1 < NT; t += 2) {
            HALF_STEP(1, pB0, pB1, mnB, alB, pA0, pA1, alA, t, 1, 0, 0);
            HALF_STEP(1, pA0, pA1, mnA, alA, pB0, pB1, alB, t + 1, 0, 1, 1);
        }
    }
    SBAR(); qkt<1>(pB0, pB1, lds, r32, hi, q8, ACT(NT - 1)); SBAR();
    finishSM(pA0, pA1, alA, l_reg, pa0, pa1, pa2, pa3); SBAR();
    pv_tile<0>(o, vb0, pa0, pa1, pa2, pa3, ACT(NT - 2));
    partialSM(pB0, pB1, m_reg, mnB, alB); RESC(alB);
    finishSM(pB0, pB1, alB, l_reg, pa0, pa1, pa2, pa3); SBAR(); pv_tile<1>(o, vb0, pa0, pa1, pa2, pa3, ACT(NT - 1));
    if (hi == 0) li_l[r32] = l_reg; asm volatile("s_waitcnt lgkmcnt(0)" ::: "memory");
    float rli[16];
#pragma unroll
    for (int r = 0; r < 16; ++r) rli[r] = __builtin_amdgcn_rcpf(li_l[crow(r, hi)]);
    int r32e = r32, hie = hi; asm volatile("" : "+v"(r32e), "+v"(hie));
    bf16_t* Ow = O + ((size_t)b * SEQ + qb * 256 + wid * 32) * D + h * 128 + r32e;
#pragma unroll
    for (int r = 0; r < 16; ++r) { const int orow = crow(r, hie);
#pragma unroll
        for (int d0 = 0; d0 < 4; ++d0) { const float v = o[d0][r] * rli[r]; const float vn = __shfl_xor(v, 1);
            if ((r32e & 1) == 0) *(unsigned*)(Ow + (size_t)orow * D + d0 * 32) = cvtpk(v, vn); } }
    __syncthreads();
#undef SLOAD
#undef SWRITE
#undef VMW
#undef RESC
#undef ACT
#undef HALF_STEP
}
#undef KSWZ
#undef SBAR
}

namespace hg {
constexpr int P = 136, KP = 72, OP = 132;
constexpr int OFF_QE = 0, OFF_QD = 17408, OFF_KDD = 34816, OFF_KDT = 52224, OFF_V = 70656, OFF_AM = 88064, OFF_T = 97280, OFF_DL = 101376, OFF_OX = OFF_QD, LDS_NEED = 101888;
static_assert(OFF_OX + 64 * OP * 4 <= OFF_KDT && LDS_NEED <= RING_BYTES, "hgrn LDS");
DI bf16x8 mk8(u32x2 a, u32x2 b) { u32x4 w = {a.x, a.y, b.x, b.y}; return __builtin_bit_cast(bf16x8, w); }

DI void hgrn_unit(const Args& a, bool smp, int bb, int h, LAS char* lds, int w) {
    unsigned char* ws = a.ws;
    const int lane = lane_id(), tid = w * 64 + lane, n = lane & 15, g = lane >> 4;
    const int nch = smp ? 1 : SEQ / 64, nrow = smp ? ST : 64;
    const size_t row_base = smp ? (size_t)MP + (size_t)bb * ST : (size_t)bb * SEQ;
    const bf16_t* HQ = (const bf16_t*)(ws + WS_HQ) + h * HGD; const bf16_t* HK = (const bf16_t*)(ws + WS_HK) + h * HGD; const bf16_t* HV = (const bf16_t*)(ws + WS_HV) + h * HGD;
    const bf16_t* HGt = (const bf16_t*)(ws + WS_HG) + h * HGD; const float* LF = (const float*)(ws + WS_LF) + h * HGD;
    f32x4 sacc[8];
    float* sout = a.out + (smp ? O_HGS : O_HGP) + ((size_t)bb * HGH + h) * HGD * HGD;
    if (smp) { const float* s0 = a.in[I_SHG] + ((size_t)bb * HGH + h) * HGD * HGD;
#pragma unroll
        for (int kb = 0; kb < 8; ++kb)
#pragma unroll
            for (int i = 0; i < 4; ++i) sacc[kb][i] = s0[(size_t)(16 * kb + 4 * g + i) * HGD + 16 * w + n]; }
    else {
#pragma unroll
        for (int kb = 0; kb < 8; ++kb) sacc[kb] = (f32x4){0.f, 0.f, 0.f, 0.f}; }
    const int c0 = 2 * lane, vrow = tid >> 3, vg = tid & 7;
    f32x2 lfv[8]; unsigned qv[8], kv[8]; u32x4 vraw[2], graw[2];
#define HG_LOAD(cc) do { const size_t r0_ = row_base + (size_t)(cc) * 64; \
        _Pragma("unroll") for (int j = 0; j < 8; ++j) { const int t_ = 8 * w + j; const bool ok_ = t_ < nrow; const size_t ro_ = (r0_ + (ok_ ? t_ : 0)) * HGW + c0; \
            lfv[j] = ok_ ? *(const f32x2*)(LF + ro_) : (f32x2){0.f, 0.f}; qv[j] = ok_ ? *(const unsigned*)(HQ + ro_) : 0u; kv[j] = ok_ ? *(const unsigned*)(HK + ro_) : 0u; } \
        { const bool ok_ = vrow < nrow; const size_t ro_ = (r0_ + (ok_ ? vrow : 0)) * HGW + 16 * vg; const u32x4 z_ = {0u, 0u, 0u, 0u}; \
          vraw[0] = ok_ ? *(const u32x4*)(HV + ro_) : z_; vraw[1] = ok_ ? *(const u32x4*)(HV + ro_ + 8) : z_; graw[0] = ok_ ? *(const u32x4*)(HGt + ro_) : z_; graw[1] = ok_ ? *(const u32x4*)(HGt + ro_ + 8) : z_; } } while (0)
    f32x2 ghg[8];
#pragma unroll
    for (int e2 = 0; e2 < 8; ++e2) ghg[e2] = *(const f32x2*)(a.in[I_GHG] + 16 * vg + 2 * e2);
    HG_LOAD(0);
    for (int c = 0; c < nch; ++c) {
        float bl0[8], bl1[8]; float run0 = 0.f, run1 = 0.f;
#pragma unroll
        for (int j = 0; j < 8; ++j) { run0 += lfv[j].x; run1 += lfv[j].y; bl0[j] = run0; bl1[j] = run1; }
        *(LAS f32x2*)(lds + OFF_T + (w * 128 + c0) * 4) = (f32x2){run0, run1};
        *(LAS u32x4*)(lds + OFF_V + (vrow * P + 16 * vg) * 2) = vraw[0]; *(LAS u32x4*)(lds + OFF_V + (vrow * P + 16 * vg + 8) * 2) = vraw[1];
        const u32x4 gcur0 = graw[0], gcur1 = graw[1];
        asm volatile("s_waitcnt lgkmcnt(0)" ::: "memory"); __syncthreads();
        float off0 = 0.f, off1 = 0.f, br0 = 0.f, br1 = 0.f, bt0 = 0.f, bt1 = 0.f;
#pragma unroll
        for (int e = 0; e < 8; ++e) { const f32x2 tv = *(const LAS f32x2*)(lds + OFF_T + (e * 128 + c0) * 4); if (e < w) { off0 += tv.x; off1 += tv.y; } if (e < 4) { br0 += tv.x; br1 += tv.y; } bt0 += tv.x; bt1 += tv.y; }
        float kd0[8], kd1[8];
#pragma unroll
        for (int j = 0; j < 8; ++j) { const int t = 8 * w + j; const float b0 = off0 + bl0[j], b1 = off1 + bl1[j];
            const float q0 = bf_lo(qv[j]), q1 = bf_hi(qv[j]), k0 = bf_lo(kv[j]), k1 = bf_hi(kv[j]);
            *(LAS unsigned*)(lds + OFF_QE + (t * P + c0) * 2) = cvtpk(q0 * __expf(b0), q1 * __expf(b1));
            *(LAS unsigned*)(lds + OFF_QD + (t * P + c0) * 2) = cvtpk(q0 * __expf(b0 - br0), q1 * __expf(b1 - br1));
            *(LAS unsigned*)(lds + OFF_KDD + (t * P + c0) * 2) = cvtpk(k0 * __expf(br0 - b0), k1 * __expf(br1 - b1));
            kd0[j] = k0 * __expf(bt0 - b0); kd1[j] = k1 * __expf(bt1 - b1); }
        { u32x4 p0, p1; p0.x = cvtpk(kd0[0], kd0[1]); p0.y = cvtpk(kd0[2], kd0[3]); p0.z = cvtpk(kd0[4], kd0[5]); p0.w = cvtpk(kd0[6], kd0[7]);
          p1.x = cvtpk(kd1[0], kd1[1]); p1.y = cvtpk(kd1[2], kd1[3]); p1.z = cvtpk(kd1[4], kd1[5]); p1.w = cvtpk(kd1[6], kd1[7]);
          *(LAS u32x4*)(lds + OFF_KDT + (c0 * KP + 8 * w) * 2) = p0; *(LAS u32x4*)(lds + OFF_KDT + ((c0 + 1) * KP + 8 * w) * 2) = p1; }
        if (w == 0) *(LAS f32x2*)(lds + OFF_DL + c0 * 4) = (f32x2){__expf(bt0), __expf(bt1)};
        asm volatile("s_waitcnt lgkmcnt(0)" ::: "memory"); __syncthreads();
        if (c + 1 < nch) HG_LOAD(c + 1);
        { const int tb = w >> 1;
#pragma unroll
          for (int sbi = 0; sbi < 2; ++sbi) { const int sb = 2 * (w & 1) + sbi; f32x4 acc = {0.f, 0.f, 0.f, 0.f};
            if (sb <= tb) {
#pragma unroll
                for (int ks = 0; ks < 4; ++ks) { const bf16x8 af = *(const LAS bf16x8*)(lds + OFF_KDD + ((16 * sb + n) * P + 32 * ks + 8 * g) * 2), bfr = *(const LAS bf16x8*)(lds + OFF_QD + ((16 * tb + n) * P + 32 * ks + 8 * g) * 2);
                    acc = __builtin_amdgcn_mfma_f32_16x16x32_bf16(af, bfr, acc, 0, 0, 0); }
                if (sb == tb) {
#pragma unroll
                    for (int i = 0; i < 4; ++i) if (n < 4 * g + i) acc[i] = 0.f; }
            }
            u32x2 pk; pk.x = cvtpk(acc[0], acc[1]); pk.y = cvtpk(acc[2], acc[3]);
            *(LAS u32x2*)(lds + OFF_AM + ((16 * tb + n) * KP + 16 * sb + 4 * g) * 2) = pk; } }
        f32x4 oacc[4];
#pragma unroll
        for (int tb = 0; tb < 4; ++tb) oacc[tb] = (f32x4){0.f, 0.f, 0.f, 0.f};
#pragma unroll
        for (int j = 0; j < 4; ++j) { u32x4 sb4; sb4.x = cvtpk(sacc[2 * j][0], sacc[2 * j][1]); sb4.y = cvtpk(sacc[2 * j][2], sacc[2 * j][3]); sb4.z = cvtpk(sacc[2 * j + 1][0], sacc[2 * j + 1][1]); sb4.w = cvtpk(sacc[2 * j + 1][2], sacc[2 * j + 1][3]);
            const bf16x8 bfr = __builtin_bit_cast(bf16x8, sb4);
#pragma unroll
            for (int tb = 0; tb < 4; ++tb) { const LAS char* qp = lds + OFF_QE + ((16 * tb + n) * P + 32 * j + 4 * g) * 2;
                const bf16x8 af = mk8(*(const LAS u32x2*)qp, *(const LAS u32x2*)(qp + 32));
                oacc[tb] = __builtin_amdgcn_mfma_f32_16x16x32_bf16(af, bfr, oacc[tb], 0, 0, 0); } }
        asm volatile("s_waitcnt lgkmcnt(0)" ::: "memory"); __syncthreads();
        bf16x8 vf[2];
#pragma unroll
        for (int js = 0; js < 2; ++js) { unsigned short e_[8];
#pragma unroll
            for (int i = 0; i < 8; ++i) e_[i] = *(const LAS unsigned short*)(lds + OFF_V + ((32 * js + 8 * g + i) * P + 16 * w + n) * 2);
            u32x4 t_; t_.x = e_[0] | ((unsigned)e_[1] << 16); t_.y = e_[2] | ((unsigned)e_[3] << 16); t_.z = e_[4] | ((unsigned)e_[5] << 16); t_.w = e_[6] | ((unsigned)e_[7] << 16);
            vf[js] = __builtin_bit_cast(bf16x8, t_); }
#pragma unroll
        for (int tb = 0; tb < 4; ++tb)
#pragma unroll
            for (int js = 0; js < 2; ++js) { const bf16x8 af = *(const LAS bf16x8*)(lds + OFF_AM + ((16 * tb + n) * KP + 32 * js + 8 * g) * 2);
                oacc[tb] = __builtin_amdgcn_mfma_f32_16x16x32_bf16(af, vf[js], oacc[tb], 0, 0, 0); }
#pragma unroll
        for (int kb = 0; kb < 8; ++kb) { const f32x4 dl = *(const LAS f32x4*)(lds + OFF_DL + (16 * kb + 4 * g) * 4); sacc[kb] = sacc[kb] * dl;
#pragma unroll
            for (int js = 0; js < 2; ++js) { const bf16x8 af = *(const LAS bf16x8*)(lds + OFF_KDT + ((16 * kb + n) * KP + 32 * js + 8 * g) * 2);
                sacc[kb] = __builtin_amdgcn_mfma_f32_16x16x32_bf16(af, vf[js], sacc[kb], 0, 0, 0); } }
#pragma unroll
        for (int tb = 0; tb < 4; ++tb)
#pragma unroll
            for (int i = 0; i < 4; ++i) *(LAS float*)(lds + OFF_OX + ((16 * tb + 4 * g + i) * OP + 16 * w + n) * 4) = oacc[tb][i];
        asm volatile("s_waitcnt lgkmcnt(0)" ::: "memory"); __syncthreads();
        { f32x4 ov[4];
#pragma unroll
          for (int q4 = 0; q4 < 4; ++q4) ov[q4] = *(const LAS f32x4*)(lds + OFF_OX + (vrow * OP + 16 * vg + 4 * q4) * 4);
          float ss = 0.f;
#pragma unroll
          for (int q4 = 0; q4 < 4; ++q4) ss += (ov[q4][0] * ov[q4][0] + ov[q4][1] * ov[q4][1]) + (ov[q4][2] * ov[q4][2] + ov[q4][3] * ov[q4][3]);
          ss += __shfl_xor(ss, 1); ss += __shfl_xor(ss, 2); ss += __shfl_xor(ss, 4);
          const float rs = rsqrtf(ss * (1.f / HGD) + EPS);
          const unsigned gw_[8] = {gcur0.x, gcur0.y, gcur0.z, gcur0.w, gcur1.x, gcur1.y, gcur1.z, gcur1.w};
          u32x4 o0, o1; unsigned ow[8];
#pragma unroll
          for (int e2 = 0; e2 < 8; ++e2) { const float x0 = ov[e2 >> 1][(e2 & 1) * 2], x1 = ov[e2 >> 1][(e2 & 1) * 2 + 1];
              const f32x2 go = ghg[e2]; ow[e2] = cvtpk(x0 * rs * go.x * bf_lo(gw_[e2]), x1 * rs * go.y * bf_hi(gw_[e2])); }
          o0.x = ow[0]; o0.y = ow[1]; o0.z = ow[2]; o0.w = ow[3]; o1.x = ow[4]; o1.y = ow[5]; o1.z = ow[6]; o1.w = ow[7];
          if (vrow < nrow) { bf16_t* mp = (bf16_t*)(ws + WS_MIX) + (row_base + (size_t)c * 64 + vrow) * D + 2048 + h * HGD + 16 * vg; *(u32x4*)mp = o0; *(u32x4*)(mp + 8) = o1; } }
    }
#undef HG_LOAD
#pragma unroll
    for (int kb = 0; kb < 8; ++kb)
#pragma unroll
        for (int i = 0; i < 4; ++i) sout[(size_t)(16 * kb + 4 * g + i) * HGD + 16 * w + n] = sacc[kb][i];
    __syncthreads();
}
}

DI int q_next(const Frame& F, unsigned* head) {
    volatile LAS unsigned* MISC = (volatile LAS unsigned*)(F.lds + MISC_OFF);
    if ((F.wave * 64 + lane_id()) == 0) MISC[16] = __hip_atomic_fetch_add(head, 1u, RLX_AGENT);
    __syncthreads();
    const int v = (int)MISC[16];
    __syncthreads();
    return v;
}

struct EpiS1 {
    unsigned char* ws; float* Sb; int adj; float sc;
    DI void operator()(ACC_T, const pg8::Unit& u, int wr, int wc, int fr, int fq, int lane) const {
        const int c8 = wc * 32 + 8 * fq, pn17 = u.pn + (adj ? u.pm : 0), ktile = pn17 - 17 * u.pm;
        const float* ssk = (const float*)(ws + WS_SSK) + (size_t)fr * ((size_t)SB * KPAD) + (size_t)pn17 * 256 + c8;
        const bf16_t* kb = (const bf16_t*)(ws + WS_KCAT) + ((size_t)pn17 * 256 + wc * 32 + 8 * (fr >> 2) + (fr & 3)) * KC + KVL + 8 * fq;
        const bf16_t* qb = (const bf16_t*)(ws + WS_QCAT) + ((size_t)u.pm * 256 + wr * 64 + fr) * KC + KVL + 8 * fq;
        bf16_t* S = (bf16_t*)Sb + ((size_t)u.pm * 256 + wr * 64 + fr) * SPITCH + ktile * 256 + c8;
#pragma unroll
        for (int bj = 0; bj < 2; ++bj) {
            if (bj == 1 && ktile == 16) break;
            bf16x8 kf[2][2]; f32x4 rk[2];
#pragma unroll
            for (int n = 0; n < 2; ++n) { const f32x4 sv = *(const f32x4*)(ssk + bj * 128 + 4 * n);
#pragma unroll
                for (int e = 0; e < 4; ++e) rk[n][e] = rsqrtf(sv[e] * (1.f / NOPE) + EPS) * sc;
#pragma unroll
                for (int ks = 0; ks < 2; ++ks) kf[n][ks] = *(const bf16x8*)(kb + (size_t)(bj * 128 + 4 * n) * KC + 32 * ks); }
#pragma unroll
            for (int ai = 0; ai < 2; ++ai)
#pragma unroll
                for (int m = 0; m < 4; ++m) { const bf16_t* qp = qb + (size_t)(ai * 128 + m * 16) * KC; const bf16x8 q0 = *(const bf16x8*)qp, q1 = *(const bf16x8*)(qp + 32);
                    f32x4 t0 = acc[ai][bj][m][0] * rk[0], t1 = acc[ai][bj][m][1] * rk[1];
                    t0 = __builtin_amdgcn_mfma_f32_16x16x32_bf16(kf[0][0], q0, t0, 0, 0, 0); t0 = __builtin_amdgcn_mfma_f32_16x16x32_bf16(kf[0][1], q1, t0, 0, 0, 0);
                    t1 = __builtin_amdgcn_mfma_f32_16x16x32_bf16(kf[1][0], q0, t1, 0, 0, 0); t1 = __builtin_amdgcn_mfma_f32_16x16x32_bf16(kf[1][1], q1, t1, 0, 0, 0);
                    st_bf16x8(S + (size_t)(ai * 128 + m * 16) * SPITCH + bj * 128, t0 * ATT_SCALE, t1 * ATT_SCALE); }
        }
    }
};
struct EpiPV {
    unsigned char* ws;
    DI void operator()(ACC_T, const pg8::Unit& u, int wr, int wc, int fr, int fq, int lane) const {
        float* O = (float*)(ws + WS_OLAT) + ((size_t)u.pm * 256 + wr * 64 + fr) * KVL + (u.pn & 1) * 256 + wc * 32 + 8 * fq;
#pragma unroll
        for (int ai = 0; ai < 2; ++ai)
#pragma unroll
            for (int m = 0; m < 4; ++m)
#pragma unroll
                for (int bj = 0; bj < 2; ++bj) st_f32x8(O + (size_t)(ai * 128 + m * 16) * KVL + bj * 128, acc[ai][bj][m][0], acc[ai][bj][m][1]);
    }
};
#define CHAIN_SYNC() do { asm volatile("s_waitcnt vmcnt(0) lgkmcnt(0)" ::: "memory"); __syncthreads(); __builtin_amdgcn_fence(__ATOMIC_ACQUIRE, "agent"); asm volatile("s_waitcnt vmcnt(0)" ::: "memory"); __syncthreads(); } while (0)
DI void sample_chain(const Frame& F, const Args& a, int b) {
    unsigned char* ws = a.ws;
    { pg8::Gemm g{(const bf16_t*)(ws + WS_QCAT), (const bf16_t*)(ws + WS_KCAT), KC, KC, KVL, nullptr}; pg8::OneBatchOrder S{b, 17, KVL / 64, 16}; EpiS1 E{ws, (float*)((unsigned char*)a.out + OS_S), 0, 1.f}; pg8::gemm_phase(F.lds, g, S, E, F.wave); }
    CHAIN_SYNC();
    { const int lane = lane_id();
      for (int r = F.wave; r < 256; r += 16) {
        const bf16_t* s0 = (const bf16_t*)((const unsigned char*)a.out + OS_S) + (size_t)(b * 256 + r) * SPITCH; const bf16_t* s1 = s0 + (size_t)8 * SPITCH;
        bf16_t* p0 = (bf16_t*)(ws + WS_P) + (size_t)(b * 256 + r) * KT; bf16_t* p1 = p0 + (size_t)8 * KT;
        f32x4 v0[17], v1[17]; float m0 = -1e30f, m1 = -1e30f;
#pragma unroll
        for (int j = 0; j < 17; ++j) { const int idx = 4 * lane + 256 * j; if (idx < NKEY) { const u32x2 a0 = *(const u32x2*)(s0 + idx), a1 = *(const u32x2*)(s1 + idx); v0[j] = (f32x4){bf_lo(a0.x), bf_hi(a0.x), bf_lo(a0.y), bf_hi(a0.y)}; v1[j] = (f32x4){bf_lo(a1.x), bf_hi(a1.x), bf_lo(a1.y), bf_hi(a1.y)}; } else { v0[j] = (f32x4){-1e30f, -1e30f, -1e30f, -1e30f}; v1[j] = v0[j]; } }
#pragma unroll
        for (int j = 0; j < 17; ++j) { m0 = fmaxf(m0, fmaxf(fmaxf(v0[j][0], v0[j][1]), fmaxf(v0[j][2], v0[j][3]))); m1 = fmaxf(m1, fmaxf(fmaxf(v1[j][0], v1[j][1]), fmaxf(v1[j][2], v1[j][3]))); }
#pragma unroll
        for (int o = 1; o < 64; o <<= 1) { m0 = fmaxf(m0, __shfl_xor(m0, o)); m1 = fmaxf(m1, __shfl_xor(m1, o)); }
        float sum0 = 0.f, sum1 = 0.f;
#pragma unroll
        for (int j = 0; j < 17; ++j) { const bool ok = 4 * lane + 256 * j < NKEY;
#pragma unroll
            for (int e = 0; e < 4; ++e) { const float e0 = ok ? __expf(v0[j][e] - m0) : 0.f, e1 = ok ? __expf(v1[j][e] - m1) : 0.f; v0[j][e] = e0; v1[j][e] = e1; sum0 += e0; sum1 += e1; } }
#pragma unroll
        for (int o = 1; o < 64; o <<= 1) { sum0 += __shfl_xor(sum0, o); sum1 += __shfl_xor(sum1, o); }
        const float i0 = 1.0f / sum0, i1 = 1.0f / sum1;
#pragma unroll
        for (int j = 0; j < 17; ++j) { const int idx = 4 * lane + 256 * j; if (idx < KT) { u32x2 o; o.x = cvtpk(v0[j][0] * i0, v0[j][1] * i0); o.y = cvtpk(v0[j][2] * i0, v0[j][3] * i0); *(u32x2*)(p0 + idx) = o;
                                                                                 u32x2 q; q.x = cvtpk(v1[j][0] * i1, v1[j][1] * i1); q.y = cvtpk(v1[j][2] * i1, v1[j][3] * i1); *(u32x2*)(p1 + idx) = q; } } } }
    CHAIN_SYNC();
    { pg8::Gemm g{(const bf16_t*)(ws + WS_P), (const bf16_t*)(ws + WS_CKVT), KT, KT, KT, nullptr}; pg8::OneBatchOrder S{b, 2, KT / 64}; EpiPV E{ws}; pg8::gemm_phase(F.lds, g, S, E, F.wave); }
    CHAIN_SYNC();
    {
      const int lane = lane_id(), n = lane & 15, g = lane >> 4;
#pragma unroll 1
      for (int hh = 0; hh < 2; ++hh) { const int h = 2 * F.wave + hh;
        const float* ap = (const float*)(ws + WS_OLAT) + ((size_t)b * 256 + n * 16 + h) * KVL + 8 * g;
        const bf16_t* bp = (const bf16_t*)(ws + WS_WUKVT) + (size_t)(2048 + h * 128 + n) * KVL + 8 * g;
        f32x4 oacc[8];
#pragma unroll
        for (int db = 0; db < 8; ++db) oacc[db] = (f32x4){0.f, 0.f, 0.f, 0.f};
        for (int ks = 0; ks < KVL / 32; ++ks) { const bf16x8 af = __builtin_bit_cast(bf16x8, pack8(*(const f32x4*)(ap + 32 * ks), *(const f32x4*)(ap + 32 * ks + 4)));
#pragma unroll
            for (int db = 0; db < 8; ++db) oacc[db] = __builtin_amdgcn_mfma_f32_16x16x32_bf16(af, *(const bf16x8*)(bp + (size_t)(16 * db) * KVL + 32 * ks), oacc[db], 0, 0, 0); }
#pragma unroll
        for (int db = 0; db < 8; ++db)
#pragma unroll
            for (int i = 0; i < 4; ++i) ((bf16_t*)(ws + WS_MIX))[((size_t)MP + b * 16 + 4 * g + i) * D + h * 128 + 16 * db + n] = f2bf(oacc[db][i]); } }
    __syncthreads();
}

constexpr int MX_HG = 64 + SB * HGH, MX_ATT = 1024, MX_S = SB * 34;
DI void p5_mixer(const Frame& F, const Args& a) {
    unsigned char* ws = a.ws; unsigned* head = (unsigned*)(ws + WS_CTL) + CW_QUEUE;
    for (;;) { const int u = q_next(F, head + 192); if (u >= SB) break; sample_chain(F, a, u); }
#ifndef MX_OFF_HG
    for (;;) { const int u = q_next(F, head); if (u >= MX_HG) break;
        const bool smp = u >= 64; const int v = smp ? u - 64 : u; hg::hgrn_unit(a, smp, v >> 4, v & 15, (LAS char*)F.lds, F.wave); }
#endif
#ifndef MX_OFF_ATT
    for (;;) { const int u = q_next(F, head + 64); if (u >= MX_ATT) break;
        const int qb = 15 - (u >> 6), bh = u & 63;
        att::attn_unit(bh >> 4, bh & 15, qb, ws + WS_Q, ws + WS_KN, ws + WS_KRN, (const bf16_t*)(ws + WS_V), (bf16_t*)(ws + WS_MIX), (LAS char*)F.lds, F.wave); }
#endif
}

DI void p6_late_weights(const Frame& F, const Args& a) {
    unsigned char* ws = a.ws; LAS float* scr = (LAS float*)(F.lds + F.wave * 16384);
    constexpr int I_O = (D / 64) * (D / 32), I_UP = (D / 64) * (FF2 / 32), I_DN = (FF / 64) * (D / 32), NIT = 2 * I_O + I_UP + I_DN;
    for (int it = F.gw; it < NIT; it += F.NGW) { int r = it;
        if (tr_matrix(r, a.in[I_WO], D, D, (bf16_t*)(ws + WS_WOT), D, nullptr, scr, lane_id())) continue;
        if (tr_matrix(r, a.in[I_WUP], D, FF2, (bf16_t*)(ws + WS_WUPT), D, a.in[I_GFFN], scr, lane_id(), 1 << 30, 0, true)) continue;
        if (tr_matrix(r, a.in[I_WD], FF, D, (bf16_t*)(ws + WS_WDT), FF, nullptr, scr, lane_id())) continue;
        tr_matrix(r, a.in[I_WPG], D, D, nullptr, D, a.in[I_GPLE], scr, lane_id(), 1 << 30, 0, false, false, ws + WS_WG8, SC8_G); }
}
struct EpiWo {
    unsigned char* ws; const bf16_t* xb; int s0 = 0, s1 = 8;
    DI void operator()(ACC_T, const pg8::Unit& u, int wr, int wc, int fr, int fq, int lane) const {
        const int row0 = u.pm * 256 + wr * 64 + fr, c8 = wc * 32 + 8 * fq;
#pragma unroll
        for (int ai = 0; ai < 2; ++ai)
#pragma unroll
            for (int m = 0; m < 4; ++m) { if (ai * 4 + m < s0 || ai * 4 + m >= s1) continue; const int row = row0 + ai * 128 + m * 16; const bf16_t* xr = xb + (size_t)row * D; float ss = 0.f;
#pragma unroll
                for (int bj = 0; bj < 2; ++bj) { const int col = u.pn * 256 + bj * 128 + c8; const u32x4 xw = *(const u32x4*)(xr + col); const f32x4 v0 = acc[ai][bj][m][0] + (f32x4){bf_lo(xw.x), bf_hi(xw.x), bf_lo(xw.y), bf_hi(xw.y)}, v1 = acc[ai][bj][m][1] + (f32x4){bf_lo(xw.z), bf_hi(xw.z), bf_lo(xw.w), bf_hi(xw.w)};
                    st_bf16x8((bf16_t*)(ws + WS_X1B) + (size_t)row * D + col, v0, v1); ss += dot8(v0, v1); }
                ss += __shfl_xor(ss, 16); ss += __shfl_xor(ss, 32);
                if (fq == 0) unsafeAtomicAdd((float*)(ws + OFF_SSQ2) + row, ss); }
    }
};
DI float dpp_ror1(float v) { return __int_as_float(__builtin_amdgcn_mov_dpp(__float_as_int(v), 0x121, 0xf, 0xf, false)); }
DI float dpp_ror2(float v) { return __int_as_float(__builtin_amdgcn_mov_dpp(__float_as_int(v), 0x122, 0xf, 0xf, false)); }
struct EpiUp {
    unsigned char* ws; float* out; const float* cw; const float* cb; LAS unsigned char* lds; int s0 = 0, s1 = 8;
    DI void operator()(ACC_T, const pg8::Unit& u, int wr, int wc, int fr, int fq, int lane) const {
        const float* ssq = (const float*)(ws + OFF_SSQ2);
        const int row0 = u.pm * 256 + wr * 64 + fr, ch0 = u.pn * 128 + wc * 32 + 8 * fq;
        if (u.pm >= MP / 256) {
#pragma unroll
            for (int ai = 0; ai < 2; ++ai)
#pragma unroll
                for (int m = 0; m < 4; ++m) { if (ai * 4 + m < s0 || ai * 4 + m >= s1) continue; const int row = row0 + ai * 128 + m * 16; const float rs = rsqrtf(ssq[row] * (1.f / D) + EPS);
                    float* cv = nullptr; { const int sr = row - MP, t = sr & 15; if (t >= ST - 2) cv = out + O_CVS + ((size_t)(sr >> 4) * 2 + (t - (ST - 2))) * FF2; }
#pragma unroll
                    for (int bj = 0; bj < 2; ++bj) { const int col = bj * FF + ch0; const f32x4 v0 = acc[ai][bj][m][0] * rs, v1 = acc[ai][bj][m][1] * rs;
                        st_bf16x8((bf16_t*)(ws + WS_U) + (size_t)row * FF2 + col, v0, v1); if (cv) st_f32x8(cv + col, v0, v1); } }
            return;
        }
        LAS float* halo = (LAS float*)(lds + XCH_OFF);
        float rsv[2][4];
        rsv[0][0] = rsqrtf(ssq[row0] * (1.f / D) + EPS); rsv[0][3] = rsqrtf(ssq[row0 + 48] * (1.f / D) + EPS); rsv[1][3] = rsqrtf(ssq[row0 + 128 + 48] * (1.f / D) + EPS);
        if (wc == 0 && fq == 0) { LAS float* rw = (LAS float*)(lds + XCH_OFF + 8192) + (wr * 16 + fr) * 8;
#pragma unroll
            for (int sl = 0; sl < 8; ++sl) rw[sl] = rsqrtf(ssq[row0 + (sl >> 2) * 128 + (sl & 3) * 16] * (1.f / D) + EPS); }
#pragma unroll
        for (int ai = 0; ai < 2; ++ai) {
            if (fr >= 14) { LAS float* hp = halo + ((((2 * ai + wr) * 4 + wc) * 2 + (fr - 14)) * 4 + fq) * 16;
#pragma unroll
                for (int bj = 0; bj < 2; ++bj) { *(LAS f32x4*)(hp + bj * 8) = acc[ai][bj][3][0] * rsv[ai][3]; *(LAS f32x4*)(hp + bj * 8 + 4) = acc[ai][bj][3][1] * rsv[ai][3]; } } }
        { float* uh = (float*)(ws + WS_UH) + (size_t)u.pm * 4 * FF2;
          if (wr == 0 && fr < 2) {
#pragma unroll
              for (int bj = 0; bj < 2; ++bj) st_f32x8(uh + (size_t)fr * FF2 + bj * FF + ch0, acc[0][bj][0][0] * rsv[0][0], acc[0][bj][0][1] * rsv[0][0]); }
          if (wr == 1 && fr >= 14) { float* cv = ((u.pm & 15) == 15) ? out + O_CVP + ((size_t)(u.pm >> 4) * 2 + (fr - 14)) * FF2 : nullptr;
#pragma unroll
              for (int bj = 0; bj < 2; ++bj) { const f32x4 v0 = acc[1][bj][3][0] * rsv[1][3], v1 = acc[1][bj][3][1] * rsv[1][3];
                  st_f32x8(uh + (size_t)(2 + fr - 14) * FF2 + bj * FF + ch0, v0, v1); if (cv) st_f32x8(cv + bj * FF + ch0, v0, v1); } } }
        asm volatile("s_waitcnt lgkmcnt(0)" ::: "memory"); __builtin_amdgcn_s_barrier(); asm volatile("" ::: "memory");
        bf16_t* actp = (bf16_t*)(ws + WS_ACT) + (size_t)row0 * FF + ch0;
        const bool f1 = fr >= 1, f2 = fr >= 2, e1 = fr == 1;
#pragma unroll
        for (int n = 0; n < 2; ++n) {
            f32x4 w0[2], w1[2], w2[2], bb[2];
#pragma unroll
            for (int s = 0; s < 2; ++s) { const int col = s * FF + ch0 + 4 * n; w0[s] = *(const f32x4*)(cw + col); w1[s] = *(const f32x4*)(cw + FF2 + col); w2[s] = *(const f32x4*)(cw + 2 * FF2 + col); bb[s] = *(const f32x4*)(cb + col); }
#pragma unroll
            for (int ai = 0; ai < 2; ++ai) {
                const int gi = 2 * ai + wr;
                f32x4 q1[2], q2[2];
#pragma unroll
                for (int m = 0; m < 4; ++m) {
                    int ro_ = (wr * 16 + fr) * 32 + XCH_OFF + 8192; asm volatile("" : "+v"(ro_)); const float rsl = *(const LAS float*)(lds + ro_ + (ai * 4 + m) * 4);
                    f32x4 c[2];
#pragma unroll
                    for (int s = 0; s < 2; ++s) {
                        const f32x4 cur = acc[ai][s][m][n] * rsl;
                        f32x4 r1, r2;
#pragma unroll
                        for (int e = 0; e < 4; ++e) { r1[e] = dpp_ror1(cur[e]); r2[e] = dpp_ror2(cur[e]); }
                        if (m == 0) { f32x4 h0 = {0.f, 0.f, 0.f, 0.f}, h1 = h0;
                            if (gi > 0) { const LAS float* hp = halo + ((((gi - 1) * 4 + wc) * 2) * 4 + fq) * 16 + s * 8 + 4 * n; h0 = *(const LAS f32x4*)hp; h1 = *(const LAS f32x4*)(hp + 64); }
#pragma unroll
                            for (int e = 0; e < 4; ++e) { const float p1 = f1 ? r1[e] : h1[e], p2 = f2 ? r2[e] : (e1 ? h1[e] : h0[e]); c[s][e] = bb[s][e] + w0[s][e] * p2 + w1[s][e] * p1 + w2[s][e] * cur[e]; }
                        } else {
#pragma unroll
                            for (int e = 0; e < 4; ++e) { const float p1 = f1 ? r1[e] : q1[s][e], p2 = f2 ? r2[e] : q2[s][e]; c[s][e] = bb[s][e] + w0[s][e] * p2 + w1[s][e] * p1 + w2[s][e] * cur[e]; }
                        }
                        q1[s] = r1; q2[s] = r2;
                    }
                    if (!(gi == 0 && m == 0 && fr < 2)) {
                        float o[4];
#pragma unroll
                        for (int e = 0; e < 4; ++e) o[e] = c[0][e] * __builtin_amdgcn_rcpf(1.0f + __expf(-c[0][e])) * c[1][e];
                        u32x2 ov; ov.x = cvtpk(o[0], o[1]); ov.y = cvtpk(o[2], o[3]);
                        *(u32x2*)(actp + (size_t)(ai * 128 + m * 16) * FF + 4 * n) = ov; }
                }
            }
        }
        asm volatile("s_waitcnt lgkmcnt(0)" ::: "memory"); __builtin_amdgcn_s_barrier(); asm volatile("" ::: "memory");
    }
};
struct EpiUpFin {
    unsigned char* ws; float* out; const float* cw; const float* cb; const float* scv; int s0 = 0, s1 = 8;
    DI void operator()(ACC_T, const pg8::Unit& u, int wr, int wc, int fr, int fq, int lane) const {
        const float* ssq = (const float*)(ws + OFF_SSQ2);
        const int row0 = u.pm * 256 + wr * 64 + fr, ch0 = u.pn * 128 + wc * 32 + 8 * fq;
#pragma unroll
        for (int n = 0; n < 2; ++n) {
            f32x4 w0[2], w1[2], w2[2], bb[2];
#pragma unroll
            for (int s = 0; s < 2; ++s) { const int col = s * FF + ch0 + 4 * n; w0[s] = *(const f32x4*)(cw + col); w1[s] = *(const f32x4*)(cw + FF2 + col); w2[s] = *(const f32x4*)(cw + 2 * FF2 + col); bb[s] = *(const f32x4*)(cb + col); }
#pragma unroll
            for (int ai = 0; ai < 2; ++ai)
#pragma unroll
                for (int m = 0; m < 4; ++m) { if (ai * 4 + m < s0 || ai * 4 + m >= s1) continue;
                    const int row = row0 + ai * 128 + m * 16, sq = (row - MP) >> 4; const float rs = rsqrtf(ssq[row] * (1.f / D) + EPS);
                    f32x4 c[2];
#pragma unroll
                    for (int s = 0; s < 2; ++s) { const int col = s * FF + ch0 + 4 * n;
                        const f32x4 cur = acc[ai][s][m][n] * rs, h2 = *(const f32x4*)(scv + (size_t)(sq * 2) * FF2 + col), h1 = *(const f32x4*)(scv + (size_t)(sq * 2 + 1) * FF2 + col);
#pragma unroll
                        for (int e = 0; e < 4; ++e) { const float r1 = dpp_ror1(cur[e]), r2 = dpp_ror2(cur[e]); const float p1 = fr >= 1 ? r1 : h1[e], p2 = fr >= 2 ? r2 : (fr == 1 ? h1[e] : h2[e]);
                            c[s][e] = bb[s][e] + w0[s][e] * p2 + w1[s][e] * p1 + w2[s][e] * cur[e]; }
                        if (fr >= ST - 2) *(f32x4*)(out + O_CVS + ((size_t)sq * 2 + (fr - (ST - 2))) * FF2 + col) = cur; }
                    float o[4];
#pragma unroll
                    for (int e = 0; e < 4; ++e) o[e] = c[0][e] * __builtin_amdgcn_rcpf(1.0f + __expf(-c[0][e])) * c[1][e];
                    u32x2 ov; ov.x = cvtpk(o[0], o[1]); ov.y = cvtpk(o[2], o[3]);
                    *(u32x2*)((bf16_t*)(ws + WS_ACT) + (size_t)row * FF + ch0 + 4 * n) = ov; }
        }
    }
};
struct EpiDown {
    unsigned char* ws; float* out; int s0 = 0, s1 = 8;
    DI void operator()(ACC_T, const pg8::Unit& u, int wr, int wc, int fr, int fq, int lane) const {
        const int row0 = u.pm * 256 + wr * 64 + fr, c8 = wc * 32 + 8 * fq;
#pragma unroll
        for (int ai = 0; ai < 2; ++ai)
#pragma unroll
            for (int m = 0; m < 4; ++m) { if (ai * 4 + m < s0 || ai * 4 + m >= s1) continue; const int row = row0 + ai * 128 + m * 16; float ss = 0.f;
#pragma unroll
                for (int bj = 0; bj < 2; ++bj) { const int col = u.pn * 256 + bj * 128 + c8; bf16_t* xp_ = (bf16_t*)(ws + WS_X1B) + (size_t)row * D + col; const u32x4 xw = *(const u32x4*)xp_;
                    const f32x4 v0 = acc[ai][bj][m][0] + (f32x4){bf_lo(xw.x), bf_hi(xw.x), bf_lo(xw.y), bf_hi(xw.y)}, v1 = acc[ai][bj][m][1] + (f32x4){bf_lo(xw.z), bf_hi(xw.z), bf_lo(xw.w), bf_hi(xw.w)};
                    st_bf16x8(xp_, v0, v1); ss += dot8(v0, v1);
                    { u32x2 o8; o8.x = pk4_fp8(v0[0] * SC8_X, v0[1] * SC8_X, v0[2] * SC8_X, v0[3] * SC8_X); o8.y = pk4_fp8(v1[0] * SC8_X, v1[1] * SC8_X, v1[2] * SC8_X, v1[3] * SC8_X); *(u32x2*)(ws + WS_X2F8 + (size_t)row * D + col) = o8; } }
                ss += __shfl_xor(ss, 16); ss += __shfl_xor(ss, 32);
                if (fq == 0) unsafeAtomicAdd((float*)(ws + OFF_SSQ3) + row, ss); }
    }
};
struct EpiPle {
    unsigned char* ws;
    DI void operator()(ACC_T, const pg8::Unit& u, int wr, int wc, int fr, int fq, int lane) const {
        const int row0 = u.pm * 256 + wr * 64 + fr, c8 = wc * 32 + 8 * fq;
#pragma unroll
        for (int ai = 0; ai < 2; ++ai)
#pragma unroll
            for (int m = 0; m < 4; ++m)
#pragma unroll
                for (int bj = 0; bj < 2; ++bj) st_bf16x8((bf16_t*)(ws + WS_PW) + (size_t)(row0 + ai * 128 + m * 16) * D + u.pn * 256 + bj * 128 + c8, acc[ai][bj][m][0], acc[ai][bj][m][1]);
    }
};
struct EpiGate {
    unsigned char* ws; float* out; int s0 = 0, s1 = 8;
    DI void operator()(ACC_T, const pg8::Unit& u, int wr, int wc, int fr, int fq, int lane) const {
        const float* ssq = (const float*)(ws + OFF_SSQ3);
        const int row0 = u.pm * 256 + wr * 64 + fr, c8 = wc * 32 + 8 * fq;
#pragma unroll
        for (int ai = 0; ai < 2; ++ai)
#pragma unroll
            for (int m = 0; m < 4; ++m) { if (ai * 4 + m < s0 || ai * 4 + m >= s1) continue; const int row = row0 + ai * 128 + m * 16; const float rs = rsqrtf(ssq[row] * (1.f / D) + EPS) * (1.f / (SC8_X * SC8_G));
#pragma unroll
                for (int bj = 0; bj < 2; ++bj) { const int col = u.pn * 256 + bj * 128 + c8; float* op = out + (size_t)row * D + col;
                    const u32x4 pw = *(const u32x4*)((const bf16_t*)(ws + WS_PW) + (size_t)row * D + col);
                    const u32x4 xw = *(const u32x4*)((const bf16_t*)(ws + WS_X1B) + (size_t)row * D + col); const f32x4 x0 = {bf_lo(xw.x), bf_hi(xw.x), bf_lo(xw.y), bf_hi(xw.y)}, x1 = {bf_lo(xw.z), bf_hi(xw.z), bf_lo(xw.w), bf_hi(xw.w)}; f32x4 v0, v1;
                    const float pwf[8] = {bf_lo(pw.x), bf_hi(pw.x), bf_lo(pw.y), bf_hi(pw.y), bf_lo(pw.z), bf_hi(pw.z), bf_lo(pw.w), bf_hi(pw.w)};
#pragma unroll
                    for (int e = 0; e < 4; ++e) { v0[e] = x0[e] + pwf[e] * sigmoidf_(acc[ai][bj][m][0][e] * rs); v1[e] = x1[e] + pwf[4 + e] * sigmoidf_(acc[ai][bj][m][1][e] * rs); }
                    st_f32x8(op, v0, v1); } }
    }
};
DI void p11_conv(const Frame& F, const Args& a, int lo_r) {
    unsigned char* ws = a.ws; const int lane = lane_id();
    const bf16_t* U = (const bf16_t*)(ws + WS_U); bf16_t* ACTp = (bf16_t*)(ws + WS_ACT);
    constexpr int NCG = FF / 8;
    constexpr int NRC = MS / 16;
    const int ncw = (NCG + 63) / 64;
    for (int it = F.gw; it < NRC * ncw; it += F.NGW) {
        const int rc = it / ncw, cg = (it % ncw) * 64 + lane; if (cg >= NCG) continue;
        const int col = cg * 8, row0 = MP + rc * 16;
        if (2 * (col >> 7) + (rc >> 4) >= lo_r) continue;
        float w[3][2][8], bsv[2][8];
#pragma unroll
        for (int j = 0; j < 3; ++j)
#pragma unroll
            for (int s = 0; s < 2; ++s) { const f32x4 x0 = *(const f32x4*)(a.in[I_CW] + (size_t)j * FF2 + s * FF + col), x1 = *(const f32x4*)(a.in[I_CW] + (size_t)j * FF2 + s * FF + col + 4);
#pragma unroll
                for (int e = 0; e < 4; ++e) { w[j][s][e] = x0[e]; w[j][s][4 + e] = x1[e]; } }
#pragma unroll
        for (int s = 0; s < 2; ++s) { const f32x4 x0 = *(const f32x4*)(a.in[I_CB] + s * FF + col), x1 = *(const f32x4*)(a.in[I_CB] + s * FF + col + 4);
#pragma unroll
            for (int e = 0; e < 4; ++e) { bsv[s][e] = x0[e]; bsv[s][4 + e] = x1[e]; } }
        float h2[2][8], h1[2][8];
        const bool smp = row0 >= MP; const int tseq = smp ? ((row0 - MP) & 15) : (row0 & (SEQ - 1));
#pragma unroll
        for (int s = 0; s < 2; ++s) {
            if (tseq == 0) {
                if (smp) { const float* hs = a.in[I_SCV] + ((size_t)((row0 - MP) >> 4) * 2) * FF2 + s * FF + col;
                    const f32x4 a0 = *(const f32x4*)hs, a1 = *(const f32x4*)(hs + 4), b0 = *(const f32x4*)(hs + FF2), b1 = *(const f32x4*)(hs + FF2 + 4);
#pragma unroll
                    for (int e = 0; e < 4; ++e) { h2[s][e] = a0[e]; h2[s][4 + e] = a1[e]; h1[s][e] = b0[e]; h1[s][4 + e] = b1[e]; } }
                else {
#pragma unroll
                    for (int e = 0; e < 8; ++e) { h2[s][e] = 0.f; h1[s][e] = 0.f; } }
            } else { const u32x4 a_ = *(const u32x4*)(U + (size_t)(row0 - 2) * FF2 + s * FF + col), b_ = *(const u32x4*)(U + (size_t)(row0 - 1) * FF2 + s * FF + col);
                h2[s][0] = bf_lo(a_.x); h2[s][1] = bf_hi(a_.x); h2[s][2] = bf_lo(a_.y); h2[s][3] = bf_hi(a_.y); h2[s][4] = bf_lo(a_.z); h2[s][5] = bf_hi(a_.z); h2[s][6] = bf_lo(a_.w); h2[s][7] = bf_hi(a_.w);
                h1[s][0] = bf_lo(b_.x); h1[s][1] = bf_hi(b_.x); h1[s][2] = bf_lo(b_.y); h1[s][3] = bf_hi(b_.y); h1[s][4] = bf_lo(b_.z); h1[s][5] = bf_hi(b_.z); h1[s][6] = bf_lo(b_.w); h1[s][7] = bf_hi(b_.w); }
        }
#pragma unroll 4
        for (int t = 0; t < 16; ++t) { const size_t row = (size_t)row0 + t; float cur[2][8], c[2][8];
#pragma unroll
            for (int s = 0; s < 2; ++s) { const u32x4 u_ = *(const u32x4*)(U + row * FF2 + s * FF + col);
                cur[s][0] = bf_lo(u_.x); cur[s][1] = bf_hi(u_.x); cur[s][2] = bf_lo(u_.y); cur[s][3] = bf_hi(u_.y); cur[s][4] = bf_lo(u_.z); cur[s][5] = bf_hi(u_.z); cur[s][6] = bf_lo(u_.w); cur[s][7] = bf_hi(u_.w);
#pragma unroll
                for (int e = 0; e < 8; ++e) { c[s][e] = bsv[s][e] + w[0][s][e] * h2[s][e] + w[1][s][e] * h1[s][e] + w[2][s][e] * cur[s][e]; h2[s][e] = h1[s][e]; h1[s][e] = cur[s][e]; } }
            float o[8];
#pragma unroll
            for (int e = 0; e < 8; ++e) o[e] = c[0][e] / (1.0f + __expf(-c[0][e])) * c[1][e];
            u32x4 ov; ov.x = cvtpk(o[0], o[1]); ov.y = cvtpk(o[2], o[3]); ov.z = cvtpk(o[4], o[5]); ov.w = cvtpk(o[6], o[7]);
            *(u32x4*)(ACTp + row * FF + col) = ov; }
    }
    { const float* UH = (const float*)(ws + WS_UH);
      for (int it = (F.gw + F.NGW - NRC * ncw % F.NGW) % F.NGW; it < 64 * 2 * ncw; it += F.NGW) { const int pm = it / (2 * ncw), r = (it / ncw) & 1, cg = (it % ncw) * 64 + lane; if (cg >= NCG) continue; const int col = cg * 8;
          float c[2][8];
#pragma unroll
          for (int s = 0; s < 2; ++s) { const int cc = s * FF + col; const bool first = (pm & 15) == 0;
              const float* cur = UH + ((size_t)pm * 4 + r) * FF2 + cc; const float* p1 = r == 0 ? UH + ((size_t)(pm - 1) * 4 + 3) * FF2 + cc : UH + ((size_t)pm * 4 + 0) * FF2 + cc; const float* p2 = r == 0 ? UH + ((size_t)(pm - 1) * 4 + 2) * FF2 + cc : UH + ((size_t)(pm - 1) * 4 + 3) * FF2 + cc;
              const bool z1 = first && r == 0, z2 = first;
#pragma unroll
              for (int e = 0; e < 8; ++e) c[s][e] = a.in[I_CB][cc + e] + a.in[I_CW][cc + e] * (z2 ? 0.f : p2[e]) + a.in[I_CW][FF2 + cc + e] * (z1 ? 0.f : p1[e]) + a.in[I_CW][2 * FF2 + cc + e] * cur[e]; }
          float o[8];
#pragma unroll
          for (int e = 0; e < 8; ++e) o[e] = c[0][e] / (1.0f + __expf(-c[0][e])) * c[1][e];
          u32x4 ov; ov.x = cvtpk(o[0], o[1]); ov.y = cvtpk(o[2], o[3]); ov.z = cvtpk(o[4], o[5]); ov.w = cvtpk(o[6], o[7]);
          *(u32x4*)(ACTp + ((size_t)pm * 256 + r) * FF + col) = ov; } }

}
constexpr int LAST_PHASE = 15;

constexpr int NPHASE = 15;
#ifndef ALIGN_LIGHT
#define ALIGN_LIGHT true
#endif
__global__ void __launch_bounds__(512, 2) fwd(Args args) {
    extern __shared__ __attribute__((aligned(16))) unsigned char lds_raw[];
    Frame F;
    F.lds = (LAS unsigned char*)lds_raw;
    F.wave = __builtin_amdgcn_readfirstlane(threadIdx.x >> 6);
    F.G = gridDim.x; { const int bx = blockIdx.x; F.vcu = (F.G % 8 == 0) ? (bx % 8) * (F.G / 8) + bx / 8 : bx; }
    F.gw = F.vcu * 8 + F.wave; F.NGW = F.G * 8;
    volatile LAS unsigned* MISC = (volatile LAS unsigned*)(F.lds + MISC_OFF);
    if (F.wave == 0) { const int l0 = lane_id(); if (l0 < 32) MISC[l0] = 0u; }
    __syncthreads();
    unsigned char* ws = args.ws;
    unsigned* ctl = (unsigned*)(ws + WS_CTL);
    const int lo = args.ph_lo, hi = args.ph_hi;
    XcdBarrier bar; bar.bar = ctl + CW_BAR; bar.x = 0; bar.st = nullptr;
    if (hi - lo > 1) bar = xcd_barrier_post(ctl + CW_BAR, MISC + 8, F.wave == 0 && lane_id() == 0);
#define IN(k) (lo <= (k) && (k) < hi)
#ifndef PH_MASK
#define PH_MASK 0xffff
#endif
#define PH_EN(k) (((PH_MASK) >> (k)) & 1)
#define FIN_BAR() do { if (hi - lo > 1) xcd_barrier(bar, F.wave == 0 && lane_id() == 0); } while (0)
#ifdef STAMP
#define SEAM(k) do { if (IN(k) && IN((k) + 1)) xcd_barrier(bar, F.wave == 0 && lane_id() == 0); if (blockIdx.x == 0 && F.wave == 0 && lane_id() == 0) ((unsigned long long*)(ctl + 40960))[(k) + 1] = __builtin_amdgcn_s_memrealtime(); } while (0)
#else
#define SEAM(k) do { if (IN(k) && IN((k) + 1)) xcd_barrier(bar, F.wave == 0 && lane_id() == 0); } while (0)
#endif

#ifdef STAMP
    if (blockIdx.x == 0 && F.wave == 0 && lane_id() == 0) ((unsigned long long*)(ctl + 40960))[0] = __builtin_amdgcn_s_memrealtime();
#endif
    if (PH_EN(0) && IN(0)) { p0_prologue(F, args);
#ifdef ZERO_OUT
        zero16(args.out, (size_t)M * D * 4, F.gw, F.NGW, lane_id()); zero16(args.out + O_HGP, (size_t)(O_CKVS - O_HGP) * 4, F.gw, F.NGW, lane_id()); zero16(args.out + O_HGS, (size_t)(O_END - O_HGS) * 4, F.gw, F.NGW, lane_id());
#endif
    }
    SEAM(0);
    if (PH_EN(1) && IN(1)) {
        const pg8::Gemm gA{(const bf16_t*)((const unsigned char*)args.out + OS_XB), (const bf16_t*)(ws + WS_WINT) + (size_t)QL * D, D, D, D, (float*)(ws + WS_SLAB_EARLY)};
        const pg8::Gemm gB{(const bf16_t*)((const unsigned char*)args.out + OS_XB8), (const bf16_t*)((const unsigned char*)args.out + OS_WIN8), D / 2, D / 2, D / 2, (float*)(ws + WS_SLAB_EARLY) + (size_t)96 * 65536};
        pg8::SplitOrder SA; SA.init(M / 256, NIN / 256 - 4, F.G, (int)blockIdx.x, D); pg8::SplitOrder SBq; SBq.init(M / 256, 4, F.G, (int)blockIdx.x, D / 2);
        EpiInProj EA{ws, 4, 1.f}, EB{ws, 0, 1.f / (SC8_X0 * SC8_WI)};
        pg8::gemm_phase<ALIGN_LIGHT>(F.lds, gA, SA, EA, F.wave);
        pg8::gemm_phase<ALIGN_LIGHT, true>(F.lds, gB, SBq, EB, F.wave);
        { pg8::Gemm g{(const bf16_t*)(ws + WS_KC8), (const bf16_t*)(ws + WS_WUKV8), KVL / 2, KVL / 2, KVL / 2, nullptr};
          pg8::MappedOrder S; S.init(SB * 16, 8, F.G, (int)blockIdx.x, KVL / 2); S.per = 16; S.stride = 16; S.off = 0;
          EpiSumsq E{ws, 1.f / (SC8_K * SC8_K * SC8_W * SC8_W), 1}; pg8::gemm_phase<true, true>(F.lds, g, S, E, F.wave); }
        FIN_BAR();
        pg8::gemm_finalize(gA, SA, EA, F.wave, (int)blockIdx.x); pg8::gemm_finalize(gB, SBq, EB, F.wave, (int)blockIdx.x);
    }
    SEAM(1);
    if (PH_EN(2) && IN(2)) {
        p2_norm_rows(F, args);
        { pg8::Gemm g{(const bf16_t*)(ws + WS_CQ8), (const bf16_t*)(ws + WS_WUQ8), QL / 2, QL / 2, QL / 2, (float*)(ws + WS_SLAB_EARLY)}; pg8::SplitOrder S; S.rot = 2; S.init(M / 256, 3072 / 256, F.G, (int)blockIdx.x, QL / 2);
          EpiUq E{ws, args.in[I_GQN], args.in[I_GQR], F.lds, 1.f / (SC8_K * SC8_Q)}; pg8::gemm_phase<true, true>(F.lds, g, S, E, F.wave); FIN_BAR(); pg8::gemm_finalize(g, S, E, F.wave, (int)blockIdx.x); }
        for (int u = F.G - 1 - (int)blockIdx.x; u < 128; u += F.G) p4_qa_unit(F, args, u);
    }
    SEAM(2);
    if (PH_EN(3) && IN(3)) {
        { pg8::Gemm g{(const bf16_t*)(ws + WS_CKVN8), (const bf16_t*)(ws + WS_WUKV8), KVL / 2, KVL / 2, KVL / 2, nullptr}; pg8::StaticOrder S; S.init(MP / 256, 16, F.G, (int)blockIdx.x, KVL / 2);
          EpiKup E{ws, args.in[I_GKN], F.lds, 1.f / (SC8_K * SC8_W)}; pg8::gemm_phase<true, true>(F.lds, g, S, E, F.wave); }
        { pg8::Gemm g{(const bf16_t*)(ws + WS_KCAT), (const bf16_t*)(ws + WS_WUKVT), KC, KVL, KVL, nullptr}; pg8::MappedOrder S; S.init(SB, 8, F.G, (int)blockIdx.x, KVL); S.per = 1; S.stride = 17; S.off = 16;
          EpiSumsq E{ws, 1.f, 0}; pg8::gemm_phase(F.lds, g, S, E, F.wave); }
        { pg8::Gemm g{(const bf16_t*)(ws + WS_QCAT8), (const bf16_t*)(ws + WS_KC8), KVL / 2, KVL / 2, KVL / 2, nullptr}; pg8::BatchOrder S{SB * 16, F.G, (int)blockIdx.x, 16, 2, 0, KVL / 128};
          EpiS1 E{ws, (float*)((unsigned char*)args.out + OS_S), 1, 1.f / (SC8_QA * SC8_K)}; pg8::gemm_phase<true, true>(F.lds, g, S, E, F.wave); }
    }
    SEAM(3);
    if (PH_EN(5) && IN(5)) { p5_mixer(F, args); }
    SEAM(5);
    if (PH_EN(6) && IN(6)) { p6_late_weights(F, args); }
    SEAM(6);
    if (PH_EN(10) && IN(10)) { pg8::Gemm g{(const bf16_t*)(ws + WS_MIX), (const bf16_t*)(ws + WS_WOT), D, D, D, (float*)(ws + WS_SLAB_LATE)}; pg8::SplitOrder S; S.init(M / 256, D / 256, F.G, (int)blockIdx.x, D);
        EpiWo E{ws, (const bf16_t*)((const unsigned char*)args.out + OS_XB)}; pg8::gemm_phase<ALIGN_LIGHT>(F.lds, g, S, E, F.wave); FIN_BAR(); pg8::gemm_finalize(g, S, E, F.wave, (int)blockIdx.x); }
    SEAM(10);
    if (PH_EN(11) && IN(11)) { pg8::Gemm g{(const bf16_t*)(ws + WS_X1B), (const bf16_t*)(ws + WS_WUPT), D, D, D, (float*)(ws + WS_SLAB_LATE)}; pg8::SplitOrder S; S.nM1 = MP / 256; S.init(M / 256, FF2 / 256, F.G, (int)blockIdx.x, D);
        EpiUp E{ws, args.out, args.in[I_CW], args.in[I_CB], F.lds}; pg8::gemm_phase(F.lds, g, S, E, F.wave); FIN_BAR();
        EpiUpFin E2{ws, args.out, args.in[I_CW], args.in[I_CB], args.in[I_SCV]}; pg8::gemm_finalize(g, S, E2, F.wave, (int)blockIdx.x);
        p11_conv(F, args, S.ns > 1 ? S.R * F.G - (MP / 256) * (FF2 / 256) : 1 << 30); }
    SEAM(11);
    if (PH_EN(13) && IN(13)) {
        { pg8::Gemm g{(const bf16_t*)(ws + WS_ACT), (const bf16_t*)(ws + WS_WDT), FF, FF, FF, (float*)(ws + WS_SLAB_LATE)}; pg8::SplitOrder S; S.init(M / 256, D / 256, F.G, (int)blockIdx.x, FF);
          EpiDown E{ws, args.out}; pg8::gemm_phase<ALIGN_LIGHT>(F.lds, g, S, E, F.wave); FIN_BAR(); pg8::gemm_finalize(g, S, E, F.wave, (int)blockIdx.x); }
        { pg8::Gemm g{(const bf16_t*)(ws + WS_PB), (const bf16_t*)(ws + WS_WPT), PLE, PLE, PLE, nullptr}; pg8::StaticOrder S; S.init(M / 256, D / 256, F.G, (int)blockIdx.x, PLE);
          EpiPle E{ws}; pg8::gemm_phase(F.lds, g, S, E, F.wave); }
    }
    SEAM(13);
    if (PH_EN(14) && IN(14)) { pg8::Gemm g{(const bf16_t*)(ws + WS_X2F8), (const bf16_t*)(ws + WS_WG8), D / 2, D / 2, D / 2, (float*)(ws + WS_SLAB_LATE)}; pg8::SplitOrder S; S.init(M / 256, D / 256, F.G, (int)blockIdx.x, D / 2);
        EpiGate E{ws, args.out}; pg8::gemm_phase<ALIGN_LIGHT, true>(F.lds, g, S, E, F.wave); FIN_BAR(); pg8::gemm_finalize(g, S, E, F.wave, (int)blockIdx.x); }
#ifdef STAMP
    xcd_barrier(bar, F.wave == 0 && lane_id() == 0);
    if (blockIdx.x == 0 && F.wave == 0) { const unsigned long long* ts = (const unsigned long long*)(ctl + 40960); const unsigned long long tend = __builtin_amdgcn_s_memrealtime();
        const size_t offs[10] = {O_Y, O_Y + (size_t)MP * D, O_CKVP, O_KRP, O_HGP, O_CVP, O_CKVS, O_KRS, O_HGS, O_CVS};
        for (int j = 0; j < 10; ++j) { const int ph = STAMP_BASE + j; unsigned long long t0 = ts[ph], t1 = ph + 1 < 15 ? ts[ph + 1] : tend; if (ph >= 15) { t0 = ts[0]; t1 = tend; }
            int n = ph > 15 ? 0 : (int)((t1 - t0) / 1000); if (ph <= 15 && n < 1) n = 1; if (n > 30000) n = 30000;
            for (int i = lane_id(); i < n; i += 64) ((unsigned*)args.out)[offs[j] + i] = 0xAAAAAAAAu; } }
#endif
#undef IN
#undef SEAM
}

extern "C" void kernel_launch(void* const* d_in, const int* in_sizes, int n_in, void* d_out, int out_size, void* d_ws, size_t ws_size, hipStream_t stream) {
    static int grid = 0;
    if (grid == 0) {
        if (n_in != 30 || (size_t)out_size != O_END || ws_size < WS_NEED) { fprintf(stderr, "kernel_launch: unexpected problem: n_in %d out %d ws %zu (need %zu); nothing launched\n", n_in, out_size, ws_size, (size_t)WS_NEED); grid = -1; return; }
        int dev = 0, cus = 0, per_cu = 0;
        if (hipGetDevice(&dev) != hipSuccess || hipDeviceGetAttribute(&cus, hipDeviceAttributeMultiprocessorCount, dev) != hipSuccess) { grid = -1; return; }
        if (hipFuncSetAttribute((const void*)fwd, hipFuncAttributeMaxDynamicSharedMemorySize, LDS_BYTES) != hipSuccess) { fprintf(stderr, "kernel_launch: hipFuncSetAttribute failed\n"); grid = -1; return; }
        if (hipOccupancyMaxActiveBlocksPerMultiprocessor(&per_cu, (const void*)fwd, 512, LDS_BYTES) != hipSuccess || per_cu < 1) fprintf(stderr, "kernel_launch: occupancy query says %d\n", per_cu);
        (void)hipGetLastError();
        grid = cus;
    }
    if (grid < 0) return;
    (void)hipMemsetAsync((char*)d_ws + WS_CTL, 0, CTL_BYTES, stream);
    Args a{};
    for (int i = 0; i < 30; ++i) a.in[i] = (const float*)d_in[i];
    a.out = (float*)d_out; a.ws = (unsigned char*)d_ws;
    for (int i = 0; i < 32; ++i) { const float p = (float)pow(10000.0, (double)i / 32.0); a.inv[i] = 1.0f / p; }
#ifndef N_LAUNCH_SPLIT
#define N_LAUNCH_SPLIT 1
#endif
#if N_LAUNCH_SPLIT
    for (int p = 0; p < LAST_PHASE; ++p) { a.ph_lo = p; a.ph_hi = p + 1; hipLaunchKernelGGL(fwd, dim3(grid), dim3(512), LDS_BYTES, stream, a);
#ifdef SELFCHECK
        hipLaunchKernelGGL(check_kernel, dim3(64), dim3(64), 0, stream, a, p);
        if (p == 5) hipLaunchKernelGGL(check_hgrn, dim3(8), dim3(128), 0, stream, a);
#endif
    }
#ifdef SELFCHECK
    hipLaunchKernelGGL(report_kernel, dim3(1), dim3(64), 0, stream, a);
#endif
#else
    a.ph_lo = 0; a.ph_hi = LAST_PHASE; hipLaunchKernelGGL(fwd, dim3(grid), dim3(512), LDS_BYTES, stream, a);
#endif
}
```
